# Optimizing an MI355X kernel written in HIP

```python
import jax, jax.numpy as jnp
from jax import lax
import numpy as np

D_MODEL = 1024
BATCH = 4
SEQ = 8192
DEPTH = 1

CHUNK = 64
Q_BLOCK = 128
RET_HEADS = 4
RET_HEAD_DIM = 128
RET_WIDTH = RET_HEADS * RET_HEAD_DIM
FOX_HEADS = 8
FOX_HEAD_DIM = 64
FOX_WIDTH = FOX_HEADS * FOX_HEAD_DIM
MIX_WIDTH = RET_WIDTH + FOX_WIDTH
IN_PROJ_WIDTH = 4 * RET_WIDTH + 3 * FOX_WIDTH + FOX_HEADS
ROPE_BASE = 10000.0
N_EXPERTS = 32
TOP_K = 4
D_FF = D_MODEL
SWIGLU_ALPHA = 1.702
SWIGLU_LIMIT = 7.0
EXPERT_BLOCK = 256
RMS_EPS = 1e-5
GN_EPS = 1e-5

kernel_name = "hybrid_retention_fox_moe_block"


def rms_norm(x, g):
    xf = x.astype(jnp.float32)
    y = xf * lax.rsqrt(jnp.mean(xf * xf, axis=-1, keepdims=True) + RMS_EPS)
    return (y * g.astype(jnp.float32)).astype(x.dtype)


def rotary(x, pos):
    half = x.shape[-1] // 2
    inv_freq = ROPE_BASE ** (-jnp.arange(half, dtype=jnp.float32) / half)
    ang = pos[:, None] * inv_freq[None, :]
    cos = jnp.cos(ang)[None, :, None, :]
    sin = jnp.sin(ang)[None, :, None, :]
    x1, x2 = x[..., :half], x[..., half:]
    return jnp.concatenate([x1 * cos - x2 * sin, x1 * sin + x2 * cos], axis=-1)


def retention(q, k, v, g):
    dtype = q.dtype
    B, S, H, d = q.shape
    NC = S // CHUNK
    log_gamma = jnp.log1p(-jnp.exp2(-5.0 - jnp.arange(H, dtype=jnp.float32)))
    qf = q.astype(jnp.float32).reshape(B, NC, CHUNK, H, d)
    kf = (k.astype(jnp.float32) * (d ** -0.5)).reshape(B, NC, CHUNK, H, d)
    vf = v.astype(jnp.float32).reshape(B, NC, CHUNK, H, d)
    pos_c = jnp.arange(CHUNK, dtype=jnp.float32)
    dist = jnp.abs(pos_c[:, None] - pos_c[None, :])
    decay_intra = jnp.exp(log_gamma[:, None, None] * dist)
    scores = jnp.einsum('bnqhd,bnkhd->bnhqk', qf, kf) * decay_intra
    o_intra = jnp.einsum('bnhqk,bnkhe->bnqhe', scores, vf)
    q_w = jnp.exp(log_gamma[None, :] * (pos_c[:, None] + 1.0))
    k_w = jnp.exp(log_gamma[None, :] * (CHUNK - 1.0 - pos_c[:, None]))
    chunk_decay = jnp.exp(log_gamma * CHUNK)[None, :, None, None]
    q_t = jnp.moveaxis(qf * q_w[:, :, None], 1, 0)
    k_t = jnp.moveaxis(kf * k_w[:, :, None], 1, 0)
    v_t = jnp.moveaxis(vf, 1, 0)

    def step(state, inp):
        qc, kc, vc = inp
        o = jnp.einsum('bqhd,bhde->bqhe', qc, state)
        new_state = state * chunk_decay + jnp.einsum('bkhd,bkhe->bhde', kc, vc)
        return new_state, o

    state0 = jnp.zeros((B, H, d, d), jnp.float32)
    _, o_inter = lax.scan(step, state0, (q_t, k_t, v_t))
    o = (o_intra + jnp.moveaxis(o_inter, 0, 1)).reshape(B, S, H, d)
    mu = jnp.mean(o, axis=-1, keepdims=True)
    var = jnp.mean(jnp.square(o - mu), axis=-1, keepdims=True)
    o = (o - mu) * lax.rsqrt(var + GN_EPS)
    o = o * jax.nn.silu(g.astype(jnp.float32))
    return o.reshape(B, S, H * d).astype(dtype)


def forgetting_attention(q, k, v, z_f, b_f):
    dtype = q.dtype
    B, S, H, d = q.shape
    NQB = S // Q_BLOCK
    log_f = jax.nn.log_sigmoid(z_f.astype(jnp.float32) + b_f.astype(jnp.float32))
    F = jnp.cumsum(log_f, axis=1).transpose(0, 2, 1)
    qh = q.astype(jnp.float32).transpose(0, 2, 1, 3) * (d ** -0.5)
    kh = k.astype(jnp.float32).transpose(0, 2, 1, 3)
    vh = v.astype(jnp.float32).transpose(0, 2, 1, 3)
    q_blocks = qh.reshape(B, H, NQB, Q_BLOCK, d).transpose(2, 0, 1, 3, 4)
    F_blocks = F.reshape(B, H, NQB, Q_BLOCK).transpose(2, 0, 1, 3)
    t_blocks = jnp.arange(S, dtype=jnp.int32).reshape(NQB, Q_BLOCK)
    s_idx = jnp.arange(S, dtype=jnp.int32)

    def block(args):
        q_i, F_i, t_i = args
        logits = jnp.einsum('bhqd,bhkd->bhqk', q_i, kh) + F_i[..., None] - F[:, :, None, :]
        mask = s_idx[None, :] <= t_i[:, None]
        logits = jnp.where(mask[None, None], logits, -jnp.inf)
        p = jax.nn.softmax(logits, axis=-1)
        return jnp.einsum('bhqk,bhkd->bhqd', p, vh)

    out = lax.map(block, (q_blocks, F_blocks, t_blocks))
    out = out.transpose(1, 0, 3, 2, 4).reshape(B, S, H * d)
    return out.astype(dtype)


def clamped_swiglu(h):
    x_glu, x_lin = h[..., :D_FF], h[..., D_FF:]
    x_glu = jnp.minimum(x_glu, SWIGLU_LIMIT)
    x_lin = jnp.clip(x_lin, -SWIGLU_LIMIT, SWIGLU_LIMIT)
    return x_glu * jax.nn.sigmoid(SWIGLU_ALPHA * x_glu) * (x_lin + 1.0)


def moe(x, w_router, b_router, w1, b1, w2, b2):
    B, S, D = x.shape
    T = B * S
    A = T * TOP_K
    xs = x.reshape(T, D)
    logits = xs.astype(jnp.float32) @ w_router.astype(jnp.float32) + b_router.astype(jnp.float32)
    top_val, top_idx = lax.top_k(logits, TOP_K)
    gates = jax.nn.softmax(top_val, axis=-1)
    e_flat = top_idx.reshape(A).astype(jnp.int32)
    tok_flat = jnp.repeat(jnp.arange(T, dtype=jnp.int32), TOP_K)
    gate_flat = gates.reshape(A)
    order = jnp.argsort(e_flat, stable=True)
    e_s, tok_s, gate_s = e_flat[order], tok_flat[order], gate_flat[order]
    counts = jax.ops.segment_sum(jnp.ones((A,), jnp.int32), e_flat, num_segments=N_EXPERTS)
    starts = jnp.cumsum(counts) - counts
    padded = (counts + EXPERT_BLOCK - 1) // EXPERT_BLOCK * EXPERT_BLOCK
    pad_ends = jnp.cumsum(padded)
    pad_starts = pad_ends - padded
    dest = pad_starts[e_s] + (jnp.arange(A, dtype=jnp.int32) - starts[e_s])
    NB = (A + EXPERT_BLOCK - 1) // EXPERT_BLOCK + N_EXPERTS
    buf_tok = jnp.full((NB * EXPERT_BLOCK,), T, jnp.int32).at[dest].set(tok_s)
    buf_gate = jnp.zeros((NB * EXPERT_BLOCK,), jnp.float32).at[dest].set(gate_s)
    block_start = jnp.arange(NB, dtype=jnp.int32) * EXPERT_BLOCK
    block_exp = jnp.minimum(jnp.searchsorted(pad_ends, block_start, side='right'),
                            N_EXPERTS - 1).astype(jnp.int32)
    x_pad = jnp.concatenate([xs, jnp.zeros((1, D), xs.dtype)], axis=0)

    def expert_block(args):
        tok_b, gate_b, e = args
        xb = x_pad[tok_b]
        h = xb @ w1[e] + b1[e]
        y = clamped_swiglu(h) @ w2[e] + b2[e]
        return y * gate_b[:, None].astype(y.dtype)

    y_blocks = lax.map(expert_block, (buf_tok.reshape(NB, EXPERT_BLOCK),
                                      buf_gate.reshape(NB, EXPERT_BLOCK), block_exp))
    out = jnp.zeros((T + 1, D), y_blocks.dtype).at[buf_tok].add(y_blocks.reshape(-1, D))
    return out[:T].reshape(B, S, D).astype(x.dtype)


def setup_inputs(seed: int = 0) -> dict:
    key = jax.random.key(seed)
    ks = jax.random.split(key, 14)
    f32 = jnp.float32
    x = jax.random.normal(ks[0], (BATCH, SEQ, D_MODEL), f32)
    norm_mix_g = 1.0 + 0.02 * jax.random.normal(ks[1], (DEPTH, D_MODEL), f32)
    w_in = jax.random.normal(ks[2], (DEPTH, D_MODEL, IN_PROJ_WIDTH), f32) * D_MODEL ** -0.5
    b_forget = jax.random.uniform(ks[3], (DEPTH, FOX_HEADS), f32, minval=1.0, maxval=6.0)
    w_out = jax.random.normal(ks[4], (DEPTH, MIX_WIDTH, D_MODEL), f32) * MIX_WIDTH ** -0.5
    norm_ffn_g = 1.0 + 0.02 * jax.random.normal(ks[5], (DEPTH, D_MODEL), f32)
    w_router = jax.random.normal(ks[6], (DEPTH, D_MODEL, N_EXPERTS), f32) * D_MODEL ** -0.5
    b_router = 0.01 * jax.random.normal(ks[7], (DEPTH, N_EXPERTS), f32)
    w_exp_in = jax.random.normal(ks[8], (DEPTH, N_EXPERTS, D_MODEL, 2 * D_FF), f32) * D_MODEL ** -0.5
    b_exp_in = 0.01 * jax.random.normal(ks[9], (DEPTH, N_EXPERTS, 2 * D_FF), f32)
    w_exp_out = jax.random.normal(ks[10], (DEPTH, N_EXPERTS, D_FF, D_MODEL), f32) * D_FF ** -0.5
    b_exp_out = 0.01 * jax.random.normal(ks[11], (DEPTH, N_EXPERTS, D_MODEL), f32)
    norm_final_g = 1.0 + 0.02 * jax.random.normal(ks[12], (D_MODEL,), f32)
    return {"x": x, "norm_mix_g": norm_mix_g, "w_in": w_in, "b_forget": b_forget,
            "w_out": w_out, "norm_ffn_g": norm_ffn_g, "w_router": w_router,
            "b_router": b_router, "w_exp_in": w_exp_in, "b_exp_in": b_exp_in,
            "w_exp_out": w_exp_out, "b_exp_out": b_exp_out, "norm_final_g": norm_final_g}


def reference(x, norm_mix_g, w_in, b_forget, w_out, norm_ffn_g, w_router, b_router,
              w_exp_in, b_exp_in, w_exp_out, b_exp_out, norm_final_g):
    B, S, _ = x.shape
    pos = jnp.arange(S, dtype=jnp.float32)
    split_points = [RET_WIDTH * i for i in range(1, 5)] + \
                   [4 * RET_WIDTH + FOX_WIDTH * i for i in range(1, 4)]
    h = x
    for l in range(DEPTH):
        u = rms_norm(h, norm_mix_g[l])
        proj = u @ w_in[l]
        rq, rk, rv, rg, fq, fk, fv, fz = jnp.split(proj, split_points, axis=-1)
        rh = lambda t: t.reshape(B, S, RET_HEADS, RET_HEAD_DIM)
        fh = lambda t: t.reshape(B, S, FOX_HEADS, FOX_HEAD_DIM)
        o_ret = retention(rotary(rh(rq), pos), rotary(rh(rk), pos), rh(rv), rh(rg))
        o_fox = forgetting_attention(fh(fq), fh(fk), fh(fv), fz, b_forget[l])
        mix = jnp.concatenate([o_ret, o_fox], axis=-1)
        h = h + mix @ w_out[l]
        h = h + moe(rms_norm(h, norm_ffn_g[l]), w_router[l], b_router[l],
                    w_exp_in[l], b_exp_in[l], w_exp_out[l], b_exp_out[l])
    return rms_norm(h, norm_final_g)
```

```cpp
#include <hip/hip_runtime.h>
#include <hip/hip_cooperative_groups.h>
#include <cstdio>
#include <cstdint>
namespace cg = cooperative_groups;

#ifndef MK_N_LAUNCHES
#define MK_N_LAUNCHES 1
#endif
#ifndef MK_DIAG
#define MK_DIAG 0
#endif

#define LAS __attribute__((address_space(3)))
#define GAS __attribute__((address_space(1)))
typedef unsigned short bf16_t;
typedef short bf16x8 __attribute__((ext_vector_type(8)));
typedef short s16x4 __attribute__((ext_vector_type(4)));
typedef float f32x2 __attribute__((ext_vector_type(2)));
typedef float f32x4 __attribute__((ext_vector_type(4)));
typedef float f32x16 __attribute__((ext_vector_type(16)));
typedef unsigned u32x2 __attribute__((ext_vector_type(2)));
typedef unsigned u32x4 __attribute__((ext_vector_type(4)));
typedef __bf16 bf16x2_t __attribute__((ext_vector_type(2)));

constexpr int BATCH = 4, SEQ = 8192, DM = 1024, T = BATCH * SEQ;
constexpr int RH = 4, RD = 128, FH = 8, FD = 64;
constexpr int NPROJ = 3584, INW = 3592;
constexpr int NE = 32, TOPK = 4, DFF = 1024;
constexpr int CAP = T;
constexpr int NBMAX = (T * TOPK) / 256 + NE;
constexpr float RMS_EPS = 1e-5f, GN_EPS = 1e-5f;
constexpr float LOG2E = 1.4426950408889634f;
constexpr float C2 = 0.125f * 1.4426950408889634f;
constexpr int NTHREADS = 512, NWAVES = 8;

constexpr size_t MiB = 1u << 20;
constexpr size_t WS_CTL = 0, CTL_BYTES = 1 * MiB;
constexpr size_t WS_ROPEC = 1 * MiB, WS_ROPES = 3 * MiB;
constexpr size_t WS_WR3 = 5 * MiB;
constexpr size_t WS_LOGF = 6 * MiB;
constexpr size_t WS_F2 = 7 * MiB;
constexpr size_t WS_LTOK = 8 * MiB;
constexpr size_t WS_LRSTD = 12 * MiB;
constexpr size_t WS_INV = 16 * MiB;
constexpr size_t WS_GATE = 17 * MiB;
constexpr size_t WS_H1B = 32 * MiB;
constexpr size_t WS_WINT = 96 * MiB;
constexpr size_t WS_WOT = 104 * MiB;
constexpr size_t WS_W2T = 112 * MiB;
constexpr size_t WS_W1T = 176 * MiB;
constexpr size_t WS_Y = 176 * MiB;
constexpr size_t WS_U = 448 * MiB;
constexpr size_t WS_PROJ = 512 * MiB;
constexpr size_t PROJ_STRIDE = 32 * MiB;
constexpr size_t WS_GST = 736 * MiB;
constexpr size_t WS_MIX = 752 * MiB;
constexpr size_t WS_H = 448 * MiB;
constexpr size_t WS_END = 816 * MiB;
constexpr int CW_CNT = 0;
constexpr int CW_DIAG = 64;

constexpr int LDS_BYTES = 163840;

__device__ __forceinline__ unsigned cvtpk(float lo, float hi) { f32x2 v = {lo, hi}; bf16x2_t b = __builtin_convertvector(v, bf16x2_t); return __builtin_bit_cast(unsigned, b); }
__device__ __forceinline__ float bf2f(unsigned short h) { return __uint_as_float(((unsigned)h) << 16); }
__device__ __forceinline__ float bflo(unsigned w) { return __uint_as_float(w << 16); }
__device__ __forceinline__ float bfhi(unsigned w) { return __uint_as_float(w & 0xffff0000u); }
__device__ __forceinline__ float wave_sum(float v) {
#pragma unroll
    for (int o = 1; o < 64; o <<= 1) v += __shfl_xor(v, o);
    return v;
}
#define LDS_WAIT() asm volatile("s_waitcnt lgkmcnt(0)" ::: "memory")
#define VM_WAIT() asm volatile("s_waitcnt vmcnt(0)" ::: "memory")

struct Params {
    const float *x, *g_mix, *w_in, *b_forget, *w_out, *g_ffn, *w_router, *b_router, *w1, *b1, *w2, *b2, *g_final;
    float* out; unsigned char* ws; int ph_lo, ph_hi;
};

namespace pg8 {
constexpr int BM = 256, BK = 64, HALF = 128, HTB = HALF * BK * 2, STAGE_BYTES = 8 * HTB, NXCD = 8, WGM = 8;
__host__ __device__ __forceinline__ int lds_byte(int r, int c) { const int st = (r >> 4) * 2 + (c >> 5), rr = r & 15, cc = c & 31, ob = rr * 64 + cc * 2; return st * 1024 + (ob ^ (((ob >> 9) & 1) << 5)); }
__host__ __device__ __forceinline__ void stage_rc(int b, int& R, int& C) { const int st = b / 1024, sb = b % 1024, swz = sb ^ (((sb >> 9) & 1) << 5); R = (st >> 1) * 16 + swz / 64; C = (st & 1) * 32 + (swz % 64) / 2; }

struct Unit { int pm, pn, e, lb; };

struct DenseOrder {
    int nM, nN, nwg, G, c; int K;
    __device__ void init(int M, int N, int K_, int G_, int c_) { nM = M / BM; nN = N / BM; nwg = nM * nN; G = G_; c = c_; K = K_; }
    __device__ __forceinline__ bool next(int i, Unit& u) const {
        const long L = (long)i * G + c; if (L >= nwg) return false;
        int wgid = (int)L; { const int q = nwg / NXCD, r = nwg % NXCD, xcd = wgid % NXCD, off = wgid / NXCD; wgid = (xcd < r ? xcd * (q + 1) : r * (q + 1) + (xcd - r) * q) + off; }
        const int nig = WGM * nN, gid = wgid / nig, fm = gid * WGM, gsz = (nM - fm) < WGM ? (nM - fm) : WGM;
        u.pm = fm + ((wgid % nig) % gsz); u.pn = (wgid % nig) / gsz; u.e = 0; u.lb = 0; return true;
    }
    __device__ __forceinline__ void aoffs(const Unit& u, unsigned (&ao)[2][2], const int (&R)[2], const int (&C)[2]) const {
#pragma unroll
        for (int h = 0; h < 2; ++h)
#pragma unroll
            for (int i = 0; i < 2; ++i) ao[h][i] = (unsigned)(((u.pm * BM + h * HALF + R[i]) * K + C[i]) * 2);
    }
};

template <class Epi, class Sched, bool ALIGN_EPI, bool SP2>
__device__ __forceinline__ void gemm_phase(LAS unsigned char* lds, const bf16_t* Abase, const bf16_t* Btbase, const int K, const Sched& S, const Epi& E) {
    const int tid = threadIdx.x, wid = __builtin_amdgcn_readfirstlane(tid >> 6), lane = tid & 63, wr = wid >> 2, wc = wid & 3, fr = lane & 15, fq = lane >> 4;
    const int nt = K / BK;
    int RR[2], CC[2]; unsigned voffB[2];
#pragma unroll
    for (int i = 0; i < 2; ++i) { stage_rc(tid * 16 + i * 8192, RR[i], CC[i]); voffB[i] = (unsigned)(RR[i] * K + CC[i]) * 2u; }
    const size_t kstep = (size_t)(BK * 2);
    const size_t hstep = (size_t)HALF * K * 2;
    const size_t tstep = 2 * hstep;
    const unsigned ldsw = (unsigned)wid * 1024u;
    const int aoff = lds_byte(wr * 64 + fr, fq * 8), boff = lds_byte(wc * 32 + fr, fq * 8);
    const char* Ab = (const char*)Abase;
#define PG8_SA(b, h) (((b) * 2 + (h)) * HTB)
#define PG8_SB(b, h) ((4 + (b) * 2 + (h)) * HTB)
#define PG8_STAGE(bufoff, gbase, voff) do { _Pragma("unroll") for (int _i = 0; _i < 2; ++_i) \
        __builtin_amdgcn_global_load_lds((const unsigned*)((const char*)(gbase) + (voff)[_i]), (LAS unsigned*)(lds + (bufoff) + ldsw + _i * 8192), 16, 0, 0); } while (0)
#define PG8_STAGE_A(bufoff, kb, AO, h) do { _Pragma("unroll") for (int _i = 0; _i < 2; ++_i) \
        __builtin_amdgcn_global_load_lds((const unsigned*)(Ab + (kb) + (AO)[h][_i]), (LAS unsigned*)(lds + (bufoff) + ldsw + _i * 8192), 16, 0, 0); } while (0)
#define PG8_LDA(dst, b, h) do { _Pragma("unroll") for (int m = 0; m < 4; ++m) _Pragma("unroll") for (int k = 0; k < 2; ++k) dst[m][k] = *(const LAS bf16x8*)(lds + PG8_SA(b, h) + aoff + m * 2048 + k * 1024); } while (0)
#define PG8_LDB(dst, b, h) do { _Pragma("unroll") for (int n = 0; n < 2; ++n) _Pragma("unroll") for (int k = 0; k < 2; ++k) dst[n][k] = *(const LAS bf16x8*)(lds + PG8_SB(b, h) + boff + n * 2048 + k * 1024); } while (0)
#define PG8_MMA(ai, bj, At, Bt) do { __builtin_amdgcn_s_setprio(1); _Pragma("unroll") for (int m = 0; m < 4; ++m) _Pragma("unroll") for (int n = 0; n < 2; ++n) _Pragma("unroll") for (int k = 0; k < 2; ++k) \
        acc[ai][bj][m][n] = __builtin_amdgcn_mfma_f32_16x16x32_bf16(Bt[n][k], At[m][k], acc[ai][bj][m][n], 0, 0, 0); __builtin_amdgcn_s_setprio(0); } while (0)
#define PG8_WAIT_V(n) asm volatile("s_waitcnt vmcnt(" #n ")" ::: "memory")
#define PG8_WAIT_L(n) asm volatile("s_waitcnt lgkmcnt(" #n ")" ::: "memory")
#define PG8_BAR __builtin_amdgcn_s_barrier()
#define PG8_SCHED __builtin_amdgcn_sched_barrier(0)
    Unit cur, nxt; int ui = 0;
    if (!S.next(0, cur)) return;
    f32x4 acc[2][2][4][2];
#pragma unroll
    for (int a = 0; a < 2; ++a)
#pragma unroll
        for (int b = 0; b < 2; ++b)
#pragma unroll
            for (int m = 0; m < 4; ++m)
#pragma unroll
                for (int n = 0; n < 2; ++n) acc[a][b][m][n] = (f32x4){0.f, 0.f, 0.f, 0.f};
    bf16x8 At[4][2], B0[2][2], B1[2][2];
    unsigned aoC[2][2], aoN[2][2];
    S.aoffs(cur, aoC, RR, CC);
    const char* cB = (const char*)Btbase + (size_t)cur.pn * tstep;
    static_assert(SP2, "only the SP2 loop is kept");
    PG8_STAGE(PG8_SB(0, 0), cB, voffB); PG8_STAGE(PG8_SB(0, 1), cB + hstep, voffB); PG8_STAGE_A(PG8_SA(0, 0), 0, aoC, 0); PG8_STAGE_A(PG8_SA(0, 1), 0, aoC, 1);
    if (wr == 1) PG8_BAR;
    PG8_WAIT_V(2); PG8_BAR;
    PG8_STAGE(PG8_SB(1, 0), cB + kstep, voffB); PG8_STAGE_A(PG8_SA(1, 0), kstep, aoC, 0); PG8_STAGE(PG8_SB(1, 1), cB + hstep + kstep, voffB);
    PG8_WAIT_V(6); PG8_BAR;
    for (;;) {
        const bool has_next = S.next(ui + 1, nxt);
        if (has_next) S.aoffs(nxt, aoN, RR, CC);
        else {
#pragma unroll
            for (int h = 0; h < 2; ++h)
#pragma unroll
                for (int i = 0; i < 2; ++i) aoN[h][i] = aoC[h][i];
        }
        const char* nB = has_next ? (const char*)Btbase + (size_t)nxt.pn * tstep : cB;
        for (int t = 0; t < nt; t += 2) {
            const bool last = (t == nt - 2);
            const size_t kb1 = (size_t)(t + 1) * kstep;
            const size_t kb2 = last ? 0 : (size_t)(t + 2) * kstep, kb3 = kb2 + kstep;
            unsigned ao2[2][2];
#pragma unroll
            for (int h = 0; h < 2; ++h)
#pragma unroll
                for (int i = 0; i < 2; ++i) ao2[h][i] = last ? aoN[h][i] : aoC[h][i];
            const char* b2 = last ? nB : cB + (size_t)(t + 2) * kstep;
            const char* b3 = b2 + kstep;
            PG8_LDB(B0, 0, 0); PG8_LDB(B1, 0, 1); PG8_SCHED; PG8_LDA(At, 0, 0); PG8_STAGE_A(PG8_SA(1, 1), kb1, aoC, 1);
            PG8_WAIT_V(8); PG8_WAIT_L(0); PG8_BAR; PG8_MMA(0, 0, At, B0); PG8_MMA(0, 1, At, B1); PG8_BAR; PG8_SCHED;
            PG8_LDA(At, 0, 1); PG8_STAGE(PG8_SB(0, 0), b2, voffB); PG8_STAGE(PG8_SB(0, 1), b2 + hstep, voffB); PG8_STAGE_A(PG8_SA(0, 0), kb2, ao2, 0);
            PG8_WAIT_V(8); PG8_WAIT_L(0); PG8_BAR; PG8_MMA(1, 0, At, B0); PG8_MMA(1, 1, At, B1); PG8_BAR; PG8_SCHED;
            PG8_LDB(B0, 1, 0); PG8_LDB(B1, 1, 1); PG8_SCHED; PG8_LDA(At, 1, 0); PG8_STAGE_A(PG8_SA(0, 1), kb2, ao2, 1);
            PG8_WAIT_V(8); PG8_WAIT_L(0); PG8_BAR; PG8_MMA(0, 0, At, B0); PG8_MMA(0, 1, At, B1); PG8_BAR; PG8_SCHED;
            PG8_LDA(At, 1, 1); PG8_STAGE(PG8_SB(1, 0), b3, voffB); PG8_STAGE(PG8_SB(1, 1), b3 + hstep, voffB); PG8_STAGE_A(PG8_SA(1, 0), kb3, ao2, 0);
            PG8_WAIT_V(8); PG8_WAIT_L(0); PG8_BAR; PG8_MMA(1, 0, At, B0); PG8_MMA(1, 1, At, B1); PG8_BAR; PG8_SCHED;
        }
        if constexpr (ALIGN_EPI) { if (wr == 0) PG8_BAR; }
        E(acc, cur, wr, wc, fr, fq);
        if (!has_next) break;
#pragma unroll
        for (int a = 0; a < 2; ++a)
#pragma unroll
            for (int b = 0; b < 2; ++b)
#pragma unroll
                for (int m = 0; m < 4; ++m)
#pragma unroll
                    for (int n = 0; n < 2; ++n) acc[a][b][m][n] = (f32x4){0.f, 0.f, 0.f, 0.f};
        cur = nxt; cB = nB; ++ui;
#pragma unroll
        for (int h = 0; h < 2; ++h)
#pragma unroll
            for (int i = 0; i < 2; ++i) aoC[h][i] = aoN[h][i];
        if constexpr (ALIGN_EPI) { if (wr == 1) PG8_BAR; }
    }
    PG8_WAIT_V(0);
    if constexpr (!ALIGN_EPI) { if (wr == 0) PG8_BAR; }
    PG8_BAR;
#undef PG8_SA
#undef PG8_SB
#undef PG8_STAGE
#undef PG8_STAGE_A
#undef PG8_LDA
#undef PG8_LDB
#undef PG8_MMA
#undef PG8_WAIT_V
#undef PG8_WAIT_L
#undef PG8_BAR
#undef PG8_SCHED
}
}


__device__ __forceinline__ int perm32_pos(int t) { return 16 * ((t >> 2) & 1) + 4 * ((t >> 3) & 3) + (t & 3); }
__device__ __forceinline__ int pos_inproj(int c) {
    if (c < 1024) { const int hc = c & 127; return (c & ~127) | (32 * ((hc >> 4) & 3) + 16 * (hc >> 6) + (hc & 15)); }
    return (c & ~31) | perm32_pos(c & 31);
}
__device__ __forceinline__ int pos_plain(int c) { return (c & ~31) | perm32_pos(c & 31); }
__device__ __forceinline__ int pos_w1(int n) { const int jj = n & 1023, lin = n >> 10, pn = jj >> 7, tp = jj & 127; return pn * 256 + lin * 128 + ((tp & ~31) | perm32_pos(tp & 31)); }

struct EpiInProj {
    unsigned char* proj; const float* ropec; const float* ropes;
    __device__ __forceinline__ void operator()(const f32x4 (&acc)[2][2][4][2], const pg8::Unit& u, int wr, int wc, int fr, int fq) const {
        const int type = u.pn >> 1; bf16_t* base = (bf16_t*)(proj + (size_t)type * PROJ_STRIDE);
        const int colh = (u.pn & 1) * 256;
        if (type < 2) {
            const float sc = (type == 1) ? 0.08838834764831845f : 1.0f;
            const int i0 = 16 * wc + 4 * fq;
#pragma unroll
            for (int ai = 0; ai < 2; ++ai)
#pragma unroll
                for (int m = 0; m < 4; ++m) {
                    const int row = u.pm * 256 + ai * 128 + wr * 64 + m * 16 + fr; const int pos = row & (SEQ - 1);
                    const f32x4 cs = *(const f32x4*)(ropec + pos * 64 + i0), sn = *(const f32x4*)(ropes + pos * 64 + i0);
#pragma unroll
                    for (int bj = 0; bj < 2; ++bj) {
                        const f32x4 x1 = acc[ai][bj][m][0], x2 = acc[ai][bj][m][1];
                        const f32x4 o1 = (x1 * cs - x2 * sn) * sc, o2 = (x1 * sn + x2 * cs) * sc;
                        bf16_t* dst = base + (size_t)row * 512 + colh + bj * 128 + i0;
                        u32x2 w1, w2; w1.x = cvtpk(o1[0], o1[1]); w1.y = cvtpk(o1[2], o1[3]); w2.x = cvtpk(o2[0], o2[1]); w2.y = cvtpk(o2[2], o2[3]);
                        *(u32x2*)dst = w1; *(u32x2*)(dst + 64) = w2;
                    }
                }
        } else {
            const float sc = (type == 4) ? C2 : 1.0f;
#pragma unroll
            for (int ai = 0; ai < 2; ++ai)
#pragma unroll
                for (int m = 0; m < 4; ++m) {
                    const int row = u.pm * 256 + ai * 128 + wr * 64 + m * 16 + fr;
#pragma unroll
                    for (int bj = 0; bj < 2; ++bj) {
                        f32x4 v0 = acc[ai][bj][m][0] * sc, v1 = acc[ai][bj][m][1] * sc;
                        if (type == 3) {
#pragma unroll
                            for (int j = 0; j < 4; ++j) { v0[j] = v0[j] / (1.0f + __expf(-v0[j])); v1[j] = v1[j] / (1.0f + __expf(-v1[j])); }
                        }
                        u32x4 w; w.x = cvtpk(v0[0], v0[1]); w.y = cvtpk(v0[2], v0[3]); w.z = cvtpk(v1[0], v1[1]); w.w = cvtpk(v1[2], v1[3]);
                        *(u32x4*)(base + (size_t)row * 512 + colh + bj * 128 + wc * 32 + 8 * fq) = w;
                    }
                }
        }
    }
};

struct EpiOutProj {
    const float* x; bf16_t* h1b;
    __device__ __forceinline__ void operator()(const f32x4 (&acc)[2][2][4][2], const pg8::Unit& u, int wr, int wc, int fr, int fq) const {
#pragma unroll
        for (int ai = 0; ai < 2; ++ai)
#pragma unroll
            for (int m = 0; m < 4; ++m) {
                const int row = u.pm * 256 + ai * 128 + wr * 64 + m * 16 + fr;
#pragma unroll
                for (int bj = 0; bj < 2; ++bj) {
                    const int col = u.pn * 256 + bj * 128 + wc * 32 + 8 * fq;
                    const f32x4 xa = *(const f32x4*)(x + (size_t)row * DM + col), xb = *(const f32x4*)(x + (size_t)row * DM + col + 4);
                    const f32x4 v0 = acc[ai][bj][m][0] + xa, v1 = acc[ai][bj][m][1] + xb;
                    u32x4 w; w.x = cvtpk(v0[0], v0[1]); w.y = cvtpk(v0[2], v0[3]); w.z = cvtpk(v1[0], v1[1]); w.w = cvtpk(v1[2], v1[3]);
                    *(u32x4*)(h1b + (size_t)row * DM + col) = w;
                }
            }
    }
};

struct EpiMoe1 {
    bf16_t* H; const float* b1; const float* lrstd; const int* cnt;
    __device__ __forceinline__ void operator()(const f32x4 (&acc)[2][2][4][2], const pg8::Unit& u, int wr, int wc, int fr, int fq) const {
        const int e = u.e, pnl = u.pn - e * 8; const int cq = pnl * 128 + wc * 32 + 8 * fq;
        const float* bg = b1 + (size_t)e * 2048 + cq; const float* bl = bg + 1024;
        const f32x4 bg0 = *(const f32x4*)bg, bg1 = *(const f32x4*)(bg + 4), bl0 = *(const f32x4*)bl, bl1 = *(const f32x4*)(bl + 4);
        const int ce = cnt[e];
#pragma unroll
        for (int ai = 0; ai < 2; ++ai)
#pragma unroll
            for (int m = 0; m < 4; ++m) {
                const int rt = ai * 128 + wr * 64 + m * 16 + fr; const int slot = u.lb * 256 + rt;
                const float rs = (slot < ce) ? lrstd[(size_t)e * CAP + slot] : 0.f;
                f32x4 g0 = acc[ai][0][m][0] * rs + bg0, g1 = acc[ai][0][m][1] * rs + bg1, l0 = acc[ai][1][m][0] * rs + bl0, l1 = acc[ai][1][m][1] * rs + bl1;
                float o[8];
#pragma unroll
                for (int j = 0; j < 4; ++j) {
                    float g = fminf(g0[j], 7.0f), l = fminf(fmaxf(l0[j], -7.0f), 7.0f); o[j] = g / (1.0f + __expf(-1.702f * g)) * (l + 1.0f);
                    g = fminf(g1[j], 7.0f); l = fminf(fmaxf(l1[j], -7.0f), 7.0f); o[4 + j] = g / (1.0f + __expf(-1.702f * g)) * (l + 1.0f);
                }
                u32x4 w; w.x = cvtpk(o[0], o[1]); w.y = cvtpk(o[2], o[3]); w.z = cvtpk(o[4], o[5]); w.w = cvtpk(o[6], o[7]);
                *(u32x4*)(H + (size_t)(u.pm * 256 + rt) * DFF + cq) = w;
            }
    }
};

struct EpiMoe2 {
    bf16_t* Y; const float* b2;
    __device__ __forceinline__ void operator()(const f32x4 (&acc)[2][2][4][2], const pg8::Unit& u, int wr, int wc, int fr, int fq) const {
        const int e = u.e, pnl = u.pn - e * 4;
#pragma unroll
        for (int bj = 0; bj < 2; ++bj) {
            const int col = pnl * 256 + bj * 128 + wc * 32 + 8 * fq;
            const f32x4 ba = *(const f32x4*)(b2 + (size_t)e * DM + col), bb = *(const f32x4*)(b2 + (size_t)e * DM + col + 4);
#pragma unroll
            for (int ai = 0; ai < 2; ++ai)
#pragma unroll
                for (int m = 0; m < 4; ++m) {
                    const int rt = ai * 128 + wr * 64 + m * 16 + fr;
                    const f32x4 v0 = acc[ai][bj][m][0] + ba, v1 = acc[ai][bj][m][1] + bb;
                    u32x4 w; w.x = cvtpk(v0[0], v0[1]); w.y = cvtpk(v0[2], v0[3]); w.z = cvtpk(v1[0], v1[1]); w.w = cvtpk(v1[2], v1[3]);
                    *(u32x4*)(Y + (size_t)(u.pm * 256 + rt) * DM + col) = w;
                }
        }
    }
};

template <int NT, bool GATHER>
struct MoeOrder {
    const LAS int* boff;
    const LAS int* cntl;
    const int* ltok;
    int G, vcu;
    __device__ __forceinline__ bool next(int i, pg8::Unit& u) const {
        const int cpx = G >> 3, x = vcu / cpx, j = vcu % cpx, rpb = cpx / NT;
        const int rb = (i * 8 + x) * rpb + j / NT; const int nb = boff[32];
        if (rb >= nb) return false;
        int e = 0;
#pragma unroll 1
        for (int k = 1; k < 32; ++k) if (boff[k] <= rb) e = k;
        u.pm = rb; u.e = e; u.lb = rb - boff[e]; u.pn = e * NT + (j % NT); return true;
    }
    __device__ __forceinline__ void aoffs(const pg8::Unit& u, unsigned (&ao)[2][2], const int (&R)[2], const int (&C)[2]) const {
#pragma unroll
        for (int h = 0; h < 2; ++h)
#pragma unroll
            for (int i = 0; i < 2; ++i) {
                if constexpr (GATHER) {
                    const int slot = u.lb * 256 + h * 128 + R[i]; int tok = 0;
                    if (slot < cntl[u.e]) tok = ltok[(size_t)u.e * CAP + slot];
                    ao[h][i] = (unsigned)((tok * 1024 + C[i]) * 2);
                } else ao[h][i] = (unsigned)(((u.pm * 256 + h * 128 + R[i]) * 1024 + C[i]) * 2);
            }
    }
};

namespace attn_body {
constexpr int NHEAD = FH, D = 64, PQ = 512, PO = 1024;
constexpr int NW = 8, QBLK = 32, QB = QBLK * NW, KVBLK = 64, NQB = SEQ / QB;
__device__ __forceinline__ int crow(int r, int hi) { return (r & 3) + 8 * (r >> 2) + 4 * hi; }
#define SBAR() __builtin_amdgcn_sched_barrier(0)
__device__ __forceinline__ void cmask(f32x16& p0, f32x16& p1, int jb, int qrel, int hi) {
    const float NEG = -INFINITY; int kb = 64 * jb + 4 * hi;
#pragma unroll
    for (int r = 0; r < 16; ++r) { int kv = kb + (r & 3) + 8 * (r >> 2); if (kv > qrel) p0[r] = NEG; if (kv + 32 > qrel) p1[r] = NEG; }
}
constexpr int NSLOT = 3, SLOTB = 8192;
constexpr int LDS_K = 0, LDS_V = NSLOT * SLOTB, LDS_WS = 2 * NSLOT * SLOTB, LDS_OST = LDS_WS + NW * 64 * 4, LDS_END = LDS_OST + NW * 4096;
constexpr int LDS_F = 86016, LDS_F_BYTES = SEQ * 4 + 1024;
static_assert(LDS_F >= LDS_END && LDS_F + LDS_F_BYTES <= LDS_BYTES, "attention LDS map");
__device__ __forceinline__ void glds16(const void* gsrc, unsigned lds_dst) { unsigned keep;
    asm volatile("s_mov_b32 %0, m0\n\ts_mov_b32 m0, %2\n\ts_nop 0\n\tglobal_load_lds_dwordx4 %1, off\n\ts_mov_b32 m0, %0" : "=&s"(keep) : "v"(gsrc), "s"(lds_dst) : "memory"); }
__device__ __forceinline__ float max3f(float a, float b, float c) { float r; asm("v_max3_f32 %0, %1, %2, %3" : "=v"(r) : "v"(a), "v"(b), "v"(c)); return r; }
__device__ __forceinline__ float max2f(float a, float b) { float r; asm("v_max_f32_e32 %0, %1, %2" : "=v"(r) : "v"(a), "v"(b)); return r; }
__device__ __forceinline__ float fadd_s(float a, float b) { float r; asm("v_add_f32_e32 %0, %1, %2" : "=v"(r) : "v"(a), "v"(b)); return r; }
__device__ __forceinline__ float fsub_s(float a, float b) { float r; asm("v_sub_f32_e32 %0, %1, %2" : "=v"(r) : "v"(a), "v"(b)); return r; }
#define WAIT_BAR(N) asm volatile("s_waitcnt vmcnt(" #N ") lgkmcnt(0)\n\ts_barrier" ::: "memory")

typedef LAS const char* lds_cptr;
typedef short v4i16_t __attribute__((ext_vector_type(4)));
__device__ __forceinline__ void kload8(bf16x8* kf, lds_cptr kp) {
    kf[0] = *(const LAS bf16x8*)(kp);        kf[1] = *(const LAS bf16x8*)(kp + 512);
    kf[2] = *(const LAS bf16x8*)(kp + 2048); kf[3] = *(const LAS bf16x8*)(kp + 2560);
    kf[4] = *(const LAS bf16x8*)(kp + 4096); kf[5] = *(const LAS bf16x8*)(kp + 4608);
    kf[6] = *(const LAS bf16x8*)(kp + 6144); kf[7] = *(const LAS bf16x8*)(kp + 6656);
}
__device__ __forceinline__ void kload2(bf16x8* kf, lds_cptr kp, int j) { kf[2 * j] = *(const LAS bf16x8*)(kp + j * 2048); kf[2 * j + 1] = *(const LAS bf16x8*)(kp + j * 2048 + 512); }
__device__ __forceinline__ s16x4 vtr(lds_cptr p) { return __builtin_bit_cast(s16x4, __builtin_amdgcn_ds_read_tr16_b64_v4i16((LAS v4i16_t*)p)); }
__device__ __forceinline__ float rowmax(const f32x16& p0, const f32x16& p1) {
    float a = max3f(p0[0], p0[1], p1[0]), b = max3f(p0[2], p0[3], p1[1]); a = max3f(a, p1[2], p1[3]);
#pragma unroll
    for (int r = 4; r < 16; r += 4) { a = max3f(a, p0[r], p0[r + 1]); b = max3f(b, p0[r + 2], p0[r + 3]); a = max3f(a, p1[r], p1[r + 1]); b = max3f(b, p1[r + 2], p1[r + 3]); }
    const float m = max2f(a, b);
    auto rr = __builtin_amdgcn_permlane32_swap(__float_as_uint(m), __float_as_uint(m), false, false);
    return max2f(__uint_as_float(rr[0]), __uint_as_float(rr[1]));
}
__device__ __forceinline__ void pv(f32x16* o, int vb, bf16x8 pa0, bf16x8 pa1, bf16x8 pa2, bf16x8 pa3) {
#pragma unroll
    for (int d0 = 0; d0 < 2; ++d0) { s16x4 lo[4], hi[4];
#pragma unroll
        for (int ks = 0; ks < 4; ++ks) {
            asm volatile("ds_read_b64_tr_b16 %0,%1 offset:%c2" : "=&v"(lo[ks]) : "v"(vb), "i"(d0 * 4096 + ks * 1024) : "memory");
            asm volatile("ds_read_b64_tr_b16 %0,%1 offset:%c2" : "=&v"(hi[ks]) : "v"(vb), "i"(d0 * 4096 + ks * 1024 + 512) : "memory"); }
        asm volatile("s_waitcnt lgkmcnt(0)" ::: "memory"); SBAR();
#define PK(k) (bf16x8){lo[k][0], lo[k][1], lo[k][2], lo[k][3], hi[k][0], hi[k][1], hi[k][2], hi[k][3]}
        o[d0] = __builtin_amdgcn_mfma_f32_32x32x16_bf16(pa0, PK(0), o[d0], 0, 0, 0);
        o[d0] = __builtin_amdgcn_mfma_f32_32x32x16_bf16(pa1, PK(1), o[d0], 0, 0, 0);
        o[d0] = __builtin_amdgcn_mfma_f32_32x32x16_bf16(pa2, PK(2), o[d0], 0, 0, 0);
        o[d0] = __builtin_amdgcn_mfma_f32_32x32x16_bf16(pa3, PK(3), o[d0], 0, 0, 0);
#undef PK
    }
}

template <int THRL> __device__ __forceinline__ void attn_unit(int b, int h, int qb, const bf16_t* Q, const bf16_t* __restrict__ K, const bf16_t* __restrict__ V, bf16_t* O, const float* __restrict__ F2, char* shm) {
    const int tid = threadIdx.x, lane = tid & 63, r32 = lane & 31, hi = lane >> 5; const int wid = __builtin_amdgcn_readfirstlane(tid >> 6);
    const long rowbase = (long)b * SEQ; const int q0 = qb * QB;
    const bf16_t* Qw = Q + (rowbase + q0 + wid * QBLK) * PQ + h * D;
    const bf16_t* Kh = K + rowbase * PQ + h * D, *Vh = V + rowbase * PQ + h * D;
    const unsigned lds0 = (unsigned)(uintptr_t)shm;
    float* wsf = (float*)(shm + LDS_WS) + wid * 64;
    { const f32x4* Fg = (const f32x4*)(F2 + (size_t)(b * NHEAD + h) * SEQ); LAS f32x4* Fl4 = (LAS f32x4*)((LAS char*)(lds_cptr)shm + LDS_F); const int n4 = (q0 + QB) / 4;
      for (int p = tid; p < n4; p += NW * 64) Fl4[p] = Fg[p]; }
    const LAS float* Fl = (const LAS float*)((lds_cptr)shm + LDS_F);
    asm volatile("s_waitcnt vmcnt(0) lgkmcnt(0)" ::: "memory");
    const bf16_t* ksrc = Kh + (long)lane * PQ + wid * 8;
    const bf16_t* vsrc = Vh + (long)(16 * (wid & 3) + (lane >> 2)) * PQ + (wid >> 2) * 32 + (lane & 3) * 8;
    const unsigned kdst = lds0 + LDS_K + wid * 1024, vdst = lds0 + LDS_V + wid * 1024;
#define DMA_K(t, slot) glds16(ksrc + (long)(t) * KVBLK * PQ, (unsigned)__builtin_amdgcn_readfirstlane(kdst + (slot)))
#define DMA_V(t, slot) glds16(vsrc + (long)(t) * KVBLK * PQ, (unsigned)__builtin_amdgcn_readfirstlane(vdst + (slot)))
    const int vb0 = (int)(lds0 + LDS_V) + ((lane >> 4) & 1) * 32 + (lane & 3) * 8 + (4 * hi + ((lane & 15) >> 2)) * 64;
    bf16x8 kf[8];
    const lds_cptr shm3 = (lds_cptr)shm; const lds_cptr kp0 = shm3 + LDS_K + hi * 1024 + r32 * 16; const lds_cptr vp0 = shm3 + LDS_V + ((lane >> 4) & 1) * 32 + (lane & 3) * 8 + (4 * hi + ((lane & 15) >> 2)) * 64;
    const int NT = (q0 + QB) / KVBLK;
    DMA_K(0, 0); DMA_V(0, 0); DMA_K(1, SLOTB);
    bf16x8 qr[4];
#pragma unroll
    for (int d0 = 0; d0 < 4; ++d0) qr[d0] = *reinterpret_cast<const bf16x8*>(&Qw[(long)r32 * PQ + d0 * 16 + hi * 8]);
    float mhat = 0.f, l_reg = 0.f, nm = 0.f; f32x16 o[2]; o[0] = f32x16{}; o[1] = f32x16{};
    f32x4 fa[4], fb[4];
#define FLD(tt) do { const LAS float* fp_ = Fl + 64 * (tt) + 4 * hi; _Pragma("unroll") for (int g_ = 0; g_ < 4; ++g_) { fa[g_] = *(const LAS f32x4*)(fp_ + 8 * g_); fb[g_] = *(const LAS f32x4*)(fp_ + 32 + 8 * g_); } } while (0)
#define CINIT(C0, C1) do { _Pragma("unroll") for (int g_ = 0; g_ < 4; ++g_) { _Pragma("unroll") for (int e_ = 0; e_ < 4; ++e_) { C0[4 * g_ + e_] = nm - fa[g_][e_]; C1[4 * g_ + e_] = nm - fb[g_][e_]; } } } while (0)
    const int qrel = wid * QBLK + r32;
#define CMASK(P0, P1, t) do { int jb_ = (t) - (NT - 4); if (jb_ >= 0) cmask(P0, P1, jb_, qrel, hi); } while (0)
    bool resc = false;
#define START(P0, P1) do { const float rm = rowmax(P0, P1); resc = false; \
    { const float dl = rm; mhat = fadd_s(mhat, dl); \
      _Pragma("unroll") for (int r = 0; r < 16; ++r) { P0[r] = fsub_s(P0[r], dl); P1[r] = fsub_s(P1[r], dl); } \
      nm = -mhat; } \
    _Pragma("unroll") for (int r = 0; r < 16; ++r) P0[r] = __builtin_amdgcn_exp2f(P0[r]); } while (0)
#define RESC() do { if (resc) { asm volatile("s_waitcnt lgkmcnt(0)" ::: "memory"); \
      _Pragma("unroll") for (int d_ = 0; d_ < 2; ++d_) _Pragma("unroll") for (int r = 0; r < 16; ++r) o[d_][r] *= wsf[crow(r, hi)]; } } while (0)
    f32x16 pA0, pA1, pB0, pB1;
    int sl_prev = 0, sl_cur = 0, sl_next = SLOTB;
#define ROT() do { sl_prev = sl_cur; sl_cur = sl_next; sl_next = (sl_next == (NSLOT - 1) * SLOTB) ? 0 : sl_next + SLOTB; } while (0)
    DMA_K(2, 2 * SLOTB);
    WAIT_BAR(3);
    FLD(0); CINIT(pA0, pA1);
    { const lds_cptr kb = shm3 + LDS_K + hi * 1024 + r32 * 16;
#pragma unroll
      for (int d0 = 0; d0 < 4; ++d0) { const bf16x8 b0 = *(const LAS bf16x8*)(kb + d0 * 2048); const bf16x8 b1 = *(const LAS bf16x8*)(kb + d0 * 2048 + 512);
          pA0 = __builtin_amdgcn_mfma_f32_32x32x16_bf16(b0, qr[d0], pA0, 0, 0, 0); pA1 = __builtin_amdgcn_mfma_f32_32x32x16_bf16(b1, qr[d0], pA1, 0, 0, 0); } }
    asm volatile("s_nop 15\n\ts_nop 7" : "+v"(pA0), "+v"(pA1)); CMASK(pA0, pA1, 0);
    START(pA0, pA1);
    _Pragma("unroll") for (int r = 0; r < 16; ++r) pA1[r] = __builtin_amdgcn_exp2f(pA1[r]);
    FLD(1);
    WAIT_BAR(0);
    DMA_K(3, 0); DMA_V(1, SLOTB);
    ROT();
    kload8(kf, kp0 + sl_cur);
    WAIT_BAR(2);
    s16x4 vlo[8], vhi[8]; u32x4 pw0, pw1, pw2, pw3;
#define PKW(P, B) cvtpk(P[B], P[B + 1])
#define PAF(k) __builtin_bit_cast(bf16x8, pw##k)
#define VFR(i) (bf16x8){vlo[i][0], vlo[i][1], vlo[i][2], vlo[i][3], vhi[i][0], vhi[i][1], vhi[i][2], vhi[i][3]}
#define PIN(x) asm volatile("" : "+v"(x))
#define MX3(a, b, c) __builtin_fmaxf(__builtin_fmaxf((a), (b)), (c))
#define GAPA(MF, A0, A1, A2, A3, W0, W1, PW) do { MF; sacc += A0; sacc += A1; sacc += A2; sacc += A3; PIN(sacc); W0; W1; PIN(PW); SBAR(); } while (0)
#define EX(v) __builtin_amdgcn_exp2f(v)
#define GAPB(MF, X, B) do { MF; X[B] = EX(X[B]); X[B + 1] = EX(X[B + 1]); X[B + 2] = EX(X[B + 2]); X[B + 3] = EX(X[B + 3]); PIN(X); SBAR(); } while (0)
#define VRD(i) do { vlo[i] = vtr(vp_ + (((i) >> 2) * 4096 + ((i) & 3) * 1024)); vhi[i] = vtr(vp_ + (((i) >> 2) * 4096 + ((i) & 3) * 1024 + 512)); } while (0)
#define KRD(G, j) do { if (G) { kload2(kf, kp0 + sl_next, j); SBAR(); } } while (0)
#define STEP(C0, C1, P0, P1, t, GK, GV, GL) do { SBAR(); \
    CINIT(C0, C1); SBAR(); \
    const lds_cptr vp_ = vp0 + sl_prev; \
    VRD(0); SBAR(); float sacc = (P0[0] + P0[1]); \
    GAPA(C0 = __builtin_amdgcn_mfma_f32_32x32x16_bf16(kf[0], qr[0], C0, 0, 0, 0), P0[2], P0[3], P0[4], P0[5],     pw0[0] = PKW(P0, 0), pw0[1] = PKW(P0, 2), pw0); \
    VRD(4); SBAR(); GAPA(C1 = __builtin_amdgcn_mfma_f32_32x32x16_bf16(kf[1], qr[0], C1, 0, 0, 0), P0[6], P0[7], P0[8], P0[9],     pw0[2] = PKW(P0, 4), pw0[3] = PKW(P0, 6), pw0); \
    VRD(1); SBAR(); GAPA(C0 = __builtin_amdgcn_mfma_f32_32x32x16_bf16(kf[2], qr[1], C0, 0, 0, 0),   P0[10], P0[11], P0[12], P0[13], pw1[0] = PKW(P0, 8), pw1[1] = PKW(P0, 10), pw1); \
    VRD(5); SBAR(); GAPA(C1 = __builtin_amdgcn_mfma_f32_32x32x16_bf16(kf[3], qr[1], C1, 0, 0, 0),   P0[14], P0[15], P1[0], P1[1],   pw1[2] = PKW(P0, 12), pw1[3] = PKW(P0, 14), pw1); \
    VRD(2); SBAR(); GAPA(C0 = __builtin_amdgcn_mfma_f32_32x32x16_bf16(kf[4], qr[2], C0, 0, 0, 0),   P1[2], P1[3], P1[4], P1[5],     pw2[0] = PKW(P1, 0), pw2[1] = PKW(P1, 2), pw2); \
    VRD(6); SBAR(); GAPA(C1 = __builtin_amdgcn_mfma_f32_32x32x16_bf16(kf[5], qr[2], C1, 0, 0, 0),   P1[6], P1[7], P1[8], P1[9],     pw2[2] = PKW(P1, 4), pw2[3] = PKW(P1, 6), pw2); \
    VRD(3); SBAR(); GAPA(C0 = __builtin_amdgcn_mfma_f32_32x32x16_bf16(kf[6], qr[3], C0, 0, 0, 0),   P1[10], P1[11], P1[12], P1[13], pw3[0] = PKW(P1, 8), pw3[1] = PKW(P1, 10), pw3); \
    VRD(7); SBAR(); GAPA(C1 = __builtin_amdgcn_mfma_f32_32x32x16_bf16(kf[7], qr[3], C1, 0, 0, 0),   P1[14], P1[15], 0.f, 0.f,       pw3[2] = PKW(P1, 12), pw3[3] = PKW(P1, 14), pw3); \
    l_reg += sacc; \
    if (GK) { DMA_K((t) + 3, sl_cur); } if (GV) { DMA_V((t) + 1, sl_next); } \
    CMASK(C0, C1, t); \
    { float a = MX3(C0[0], C0[1], C1[0]), b = MX3(C0[2], C0[3], C1[1]); a = MX3(a, C1[2], C1[3]); \
      _Pragma("unroll") for (int r = 4; r < 16; r += 4) { a = MX3(a, C0[r], C0[r + 1]); b = MX3(b, C0[r + 2], C0[r + 3]); a = MX3(a, C1[r], C1[r + 1]); b = MX3(b, C1[r + 2], C1[r + 3]); } \
      float rm = __builtin_fmaxf(a, b); { auto rr = __builtin_amdgcn_permlane32_swap(__float_as_uint(rm), __float_as_uint(rm), false, false); rm = __builtin_fmaxf(__uint_as_float(rr[0]), __uint_as_float(rr[1])); } \
      resc = false; \
      if (__builtin_expect(__any(rm > (float)THRL), 0)) { const float dl = __builtin_fmaxf(rm, 0.f); mhat += dl; \
        _Pragma("unroll") for (int r = 0; r < 16; ++r) { C0[r] -= dl; C1[r] -= dl; } \
        nm = -mhat; \
        const float f = __builtin_amdgcn_exp2f(-dl); l_reg *= f; if (hi == 0) wsf[r32] = f; resc = true; } } \
    SBAR(); \
    GAPB(o[0] = __builtin_amdgcn_mfma_f32_32x32x16_bf16(PAF(0), VFR(0), o[0], 0, 0, 0), C0, 0); \
    GAPB(o[1] = __builtin_amdgcn_mfma_f32_32x32x16_bf16(PAF(0), VFR(4), o[1], 0, 0, 0), C0, 4); \
    KRD(GL, 0); GAPB(o[0] = __builtin_amdgcn_mfma_f32_32x32x16_bf16(PAF(1), VFR(1), o[0], 0, 0, 0), C0, 8); \
    KRD(GL, 1); GAPB(o[1] = __builtin_amdgcn_mfma_f32_32x32x16_bf16(PAF(1), VFR(5), o[1], 0, 0, 0), C0, 12); \
    KRD(GL, 2); GAPB(o[0] = __builtin_amdgcn_mfma_f32_32x32x16_bf16(PAF(2), VFR(2), o[0], 0, 0, 0), C1, 0); \
    KRD(GL, 3); GAPB(o[1] = __builtin_amdgcn_mfma_f32_32x32x16_bf16(PAF(2), VFR(6), o[1], 0, 0, 0), C1, 4); \
    GAPB(o[0] = __builtin_amdgcn_mfma_f32_32x32x16_bf16(PAF(3), VFR(3), o[0], 0, 0, 0), C1, 8); \
    GAPB(o[1] = __builtin_amdgcn_mfma_f32_32x32x16_bf16(PAF(3), VFR(7), o[1], 0, 0, 0), C1, 12); \
    FLD((t) + 1); \
    } while (0)
    int t = 1;
#undef CMASK
#define CMASK(P0, P1, t) do { } while (0)
    for (; t + 5 < NT; t += 2) {
        STEP(pB0, pB1, pA0, pA1, t, true, true, true);     WAIT_BAR(2); RESC(); ROT();
        STEP(pA0, pA1, pB0, pB1, t + 1, true, true, true);   WAIT_BAR(2); RESC(); ROT();
    }
#undef CMASK
#define CMASK(P0, P1, t) do { int jb_ = (t) - (NT - 4); if (jb_ >= 0) cmask(P0, P1, jb_, qrel, hi); } while (0)
#define ENDW(tt) do { if ((tt) + 3 < NT) { WAIT_BAR(2); } else if ((tt) + 2 < NT) { WAIT_BAR(1); } else { WAIT_BAR(0); } } while (0)
    for (; t + 1 < NT; t += 2) {
        STEP(pB0, pB1, pA0, pA1, t, (t + 3 < NT), (t + 1 < NT), (t + 1 < NT));       ENDW(t);   RESC(); ROT();
        STEP(pA0, pA1, pB0, pB1, t + 1, (t + 4 < NT), (t + 2 < NT), (t + 2 < NT));     ENDW(t + 1); RESC(); ROT();
    }
    STEP(pB0, pB1, pA0, pA1, NT - 1, false, false, false); RESC();
    { float sacc = pB0[0] + pB0[1]; _Pragma("unroll") for (int r = 2; r < 16; ++r) sacc += pB0[r]; _Pragma("unroll") for (int r = 0; r < 16; ++r) sacc += pB1[r]; l_reg += sacc;
      pw0 = (u32x4){PKW(pB0, 0), PKW(pB0, 2), PKW(pB0, 4), PKW(pB0, 6)}; pw1 = (u32x4){PKW(pB0, 8), PKW(pB0, 10), PKW(pB0, 12), PKW(pB0, 14)}; pw2 = (u32x4){PKW(pB1, 0), PKW(pB1, 2), PKW(pB1, 4), PKW(pB1, 6)}; pw3 = (u32x4){PKW(pB1, 8), PKW(pB1, 10), PKW(pB1, 12), PKW(pB1, 14)};
      SBAR(); pv(o, vb0 + sl_cur, PAF(0), PAF(1), PAF(2), PAF(3)); }
#undef PKW
#undef PAF
#undef VFR
#undef PIN
#undef MX3
#undef GAPA
#undef GAPB
#undef EX
#undef VRD
#undef KRD
#undef STEP
#undef ENDW
    { auto rr = __builtin_amdgcn_permlane32_swap(__float_as_uint(l_reg), __float_as_uint(l_reg), false, false); l_reg = __uint_as_float(rr[0]) + __uint_as_float(rr[1]); }
    if (hi == 0) wsf[32 + r32] = l_reg; asm volatile("s_waitcnt lgkmcnt(0)" ::: "memory");
    float rli[16];
#pragma unroll
    for (int r = 0; r < 16; ++r) rli[r] = __builtin_amdgcn_rcpf(wsf[32 + crow(r, hi)]);
    bf16_t* Ow = O + (rowbase + q0 + wid * QBLK) * PO + h * D;
    { bf16_t* stg = (bf16_t*)(shm + LDS_OST) + wid * 2048;
#pragma unroll
      for (int r = 0; r < 16; ++r) { const int orow = crow(r, hi);
#pragma unroll
          for (int d0 = 0; d0 < 2; ++d0) { const float v = o[d0][r] * rli[r]; stg[orow * 64 + d0 * 32 + r32] = (bf16_t)(cvtpk(v, v) & 0xffffu); } }
      asm volatile("s_waitcnt lgkmcnt(0)" ::: "memory");
#pragma unroll
      for (int i = 0; i < 4; ++i) { const int row = i * 8 + (lane >> 3), ch = lane & 7; const u32x4 v = *(const u32x4*)(stg + row * 64 + ch * 8); *(u32x4*)(Ow + (long)row * PO + ch * 8) = v; } }
    asm volatile("s_waitcnt lgkmcnt(0)\n\ts_barrier" ::: "memory");
#undef DMA_K
#undef DMA_V
#undef CMASK
#undef START
#undef RESC
#undef ROT
#undef FLD
#undef CINIT
}
#undef SBAR
#undef WAIT_BAR
}

namespace ret {
constexpr int RS = 272;
constexpr int IMG_Q = 0, IMG_K = 64 * RS, IMG_KT = 2 * 64 * RS, IMG_V = 3 * 64 * RS;
constexpr int PS = 144;
constexpr int IMG_P = 4 * 64 * RS;
constexpr int IMG_ST = IMG_P + 64 * PS;
constexpr int OS = 132;
constexpr int IMG_O = IMG_ST + 128 * RS;
constexpr int LDS_END = IMG_O + 64 * OS * 4;
static_assert(LDS_END <= LDS_BYTES, "retention LDS map");
typedef short v4i16_t __attribute__((ext_vector_type(4)));
__device__ __forceinline__ s16x4 tr4(LAS const char* p) { return __builtin_bit_cast(s16x4, __builtin_amdgcn_ds_read_tr16_b64_v4i16((LAS v4i16_t*)p)); }
__device__ __forceinline__ bf16x8 frag_tr(LAS const char* img, int stride, int k0, int c0, int lane) {
    const int g4 = lane >> 4, i = lane & 15, qq = i >> 2, p = i & 3, hh = g4 >> 1, nh = g4 & 1;
    LAS const char* a = img + (k0 + 8 * hh + qq) * stride + (c0 + 16 * nh + 4 * p) * 2;
    const s16x4 lo = tr4(a), hi = tr4(a + 4 * stride);
    return (bf16x8){lo[0], lo[1], lo[2], lo[3], hi[0], hi[1], hi[2], hi[3]};
}
__device__ __forceinline__ bf16x8 frag_row(LAS const char* img, int stride, int r0, int k0, int lane) {
    return *(const LAS bf16x8*)(img + (r0 + (lane & 31)) * stride + (k0 + 8 * (lane >> 5)) * 2);
}
__device__ __forceinline__ int crow(int r, int hi) { return (r & 3) + 8 * (r >> 2) + 4 * hi; }

template <bool APPLY>
__device__ __forceinline__ void unit(int bh, int g, const bf16_t* RQ, const bf16_t* RK, const bf16_t* RV, const bf16_t* SG, float* GST, bf16_t* MIX, LAS char* lds) {
    int tid_ = threadIdx.x; asm volatile("" : "+v"(tid_));
    const int tid = tid_, lane = tid & 63, hi = lane >> 5; const int w = __builtin_amdgcn_readfirstlane(tid >> 6);
    const int b = bh >> 2, h = bh & 3;
    const float l2g = log2f(1.0f - exp2f(-5.0f - (float)h));
    const float cd = exp2f(64.0f * l2g);
    const size_t row0 = (size_t)b * SEQ + (size_t)g * 512;
    u32x4 rq[2], rk[2], rv[2];
    auto issue = [&](int j) {
#pragma unroll
        for (int i = 0; i < 2; ++i) { const int p = tid + 512 * i, row = p >> 4, ch = p & 15; const size_t off = (row0 + j * 64 + row) * 512 + h * 128 + ch * 8;
            if (APPLY) rq[i] = *(const u32x4*)(RQ + off);
            rk[i] = *(const u32x4*)(RK + off); rv[i] = *(const u32x4*)(RV + off); }
    };
    const int db = w >> 1, eb0 = 2 * (w & 1);
    f32x16 S0 = f32x16{}, S1 = f32x16{};
    if (APPLY) {
        const float Gm = exp2f(512.0f * l2g);
        for (int gp = 0; gp < g; ++gp) {
            const float* src = GST + ((((size_t)(bh * 16 + gp) * 8 + w) * 2) * 16) * 64 + lane;
#pragma unroll
            for (int r = 0; r < 16; ++r) { S0[r] = S0[r] * Gm + src[r * 64]; S1[r] = S1[r] * Gm + src[(16 + r) * 64]; }
        }
    }
    issue(0);
    for (int j = 0; j < 8; ++j) {
#pragma unroll
        for (int i = 0; i < 2; ++i) { const int p = tid + 512 * i, row = p >> 4, ch = p & 15; const int o = row * RS + ch * 16;
            if (APPLY) { *(LAS u32x4*)(lds + IMG_Q + o) = rq[i]; *(LAS u32x4*)(lds + IMG_K + o) = rk[i]; }
            *(LAS u32x4*)(lds + IMG_V + o) = rv[i];
            const float kw = exp2f((float)(63 - row) * l2g);
            u32x4 kt;
#pragma unroll
            for (int e = 0; e < 4; ++e) kt[e] = cvtpk(bflo(rk[i][e]) * kw, bfhi(rk[i][e]) * kw);
            *(LAS u32x4*)(lds + IMG_KT + o) = kt; }
        if (APPLY) {
#pragma unroll
            for (int tile = 0; tile < 2; ++tile) { const f32x16& S = tile ? S1 : S0; const int e = (eb0 + tile) * 32 + (lane & 31);
#pragma unroll
                for (int g4 = 0; g4 < 4; ++g4) { const int d = db * 32 + 8 * g4 + 4 * hi; u32x2 v; v.x = cvtpk(S[4 * g4], S[4 * g4 + 1]); v.y = cvtpk(S[4 * g4 + 2], S[4 * g4 + 3]);
                    *(LAS u32x2*)(lds + IMG_ST + e * RS + d * 2) = v; } }
        }
        if (j + 1 < 8) issue(j + 1);
        LDS_WAIT(); __builtin_amdgcn_s_barrier();
        f32x16 oin = f32x16{}, oit = f32x16{};
        const int qb = w >> 2, eb = w & 3;
        if (APPLY) {
#pragma unroll
            for (int s = 0; s < 8; ++s) oin = __builtin_amdgcn_mfma_f32_32x32x16_bf16(frag_row(lds + IMG_Q, RS, qb * 32, s * 16, lane), frag_row(lds + IMG_ST, RS, eb * 32, s * 16, lane), oin, 0, 0, 0);
            if (w < 4) {
                const int tb = w >> 1, qb2 = w & 1; f32x16 sc = f32x16{};
#pragma unroll
                for (int s = 0; s < 8; ++s) sc = __builtin_amdgcn_mfma_f32_32x32x16_bf16(frag_row(lds + IMG_K, RS, tb * 32, s * 16, lane), frag_row(lds + IMG_Q, RS, qb2 * 32, s * 16, lane), sc, 0, 0, 0);
                const int q = qb2 * 32 + (lane & 31);
#pragma unroll
                for (int g4 = 0; g4 < 4; ++g4) { const int t0 = tb * 32 + 8 * g4 + 4 * hi; float pv4[4];
#pragma unroll
                    for (int e = 0; e < 4; ++e) { const int dd = q - (t0 + e); pv4[e] = sc[4 * g4 + e] * exp2f((float)(dd < 0 ? -dd : dd) * l2g); }
                    u32x2 v; v.x = cvtpk(pv4[0], pv4[1]); v.y = cvtpk(pv4[2], pv4[3]);
                    *(LAS u32x2*)(lds + IMG_P + q * PS + t0 * 2) = v; }
            }
            LDS_WAIT(); __builtin_amdgcn_s_barrier();
#pragma unroll
            for (int s = 0; s < 4; ++s) oit = __builtin_amdgcn_mfma_f32_32x32x16_bf16(frag_row(lds + IMG_P, PS, qb * 32, s * 16, lane), frag_tr(lds + IMG_V, RS, s * 16, eb * 32, lane), oit, 0, 0, 0);
#pragma unroll
            for (int r = 0; r < 16; ++r) { const int q = qb * 32 + crow(r, hi); const float qw = exp2f((float)(q + 1) * l2g);
                *(LAS float*)(lds + IMG_O + (q * OS + eb * 32 + (lane & 31)) * 4) = oit[r] + qw * oin[r]; }
        }
#pragma unroll
        for (int r = 0; r < 16; ++r) { S0[r] *= cd; S1[r] *= cd; }
#pragma unroll
        for (int s = 0; s < 4; ++s) { const bf16x8 a = frag_tr(lds + IMG_KT, RS, s * 16, db * 32, lane);
            S0 = __builtin_amdgcn_mfma_f32_32x32x16_bf16(a, frag_tr(lds + IMG_V, RS, s * 16, eb0 * 32, lane), S0, 0, 0, 0);
            S1 = __builtin_amdgcn_mfma_f32_32x32x16_bf16(a, frag_tr(lds + IMG_V, RS, s * 16, (eb0 + 1) * 32, lane), S1, 0, 0, 0); }
        LDS_WAIT(); __builtin_amdgcn_s_barrier();
        if (APPLY) {
#pragma unroll
            for (int rr = 0; rr < 8; ++rr) { const int q = w * 8 + rr; const f32x2 v = *(const LAS f32x2*)(lds + IMG_O + (q * OS + 2 * lane) * 4);
                const float mu = wave_sum(v.x + v.y) * (1.0f / 128.0f); const float dx = v.x - mu, dy = v.y - mu;
                const float var = wave_sum(dx * dx + dy * dy) * (1.0f / 128.0f); const float rstd = rsqrtf(var + GN_EPS);
                const size_t trow = row0 + j * 64 + q; const unsigned gw = *(const unsigned*)(SG + trow * 512 + h * 128 + 2 * lane);
                *(unsigned*)(MIX + trow * 1024 + h * 128 + 2 * lane) = cvtpk(dx * rstd * bflo(gw), dy * rstd * bfhi(gw)); }
        }
    }
    if (!APPLY) {
        float* dst = GST + ((((size_t)(bh * 16 + g) * 8 + w) * 2) * 16) * 64 + lane;
#pragma unroll
        for (int r = 0; r < 16; ++r) { dst[r * 64] = S0[r]; dst[(16 + r) * 64] = S1[r]; }
    }
    LDS_WAIT(); __builtin_amdgcn_s_barrier();
}
}

struct Frame {
    LAS unsigned char* lds; int tid, lane, wave, vcu, G;
};

__device__ __forceinline__ void tr_item(const float* __restrict__ W, int ldw, int k0, int n0, const float* __restrict__ gk, bf16_t* WT, int kind, LAS float* scr, int lane) {
#pragma unroll 8
    for (int i = 0; i < 32; ++i) { const int kk = 2 * i + (lane >> 5); float v = W[(size_t)(k0 + kk) * ldw + n0 + (lane & 31)]; if (gk) v *= gk[k0 + kk]; scr[kk * 33 + (lane & 31)] = v; }
    LDS_WAIT(); asm volatile("" ::: "memory");
    const int c = lane & 7;
#pragma unroll
    for (int j = 0; j < 4; ++j) { const int n = (lane >> 3) + 8 * j; const LAS float* s = scr + (8 * c) * 33 + n;
        const int cn = n0 + n; const int row = (kind == 0) ? pos_inproj(cn) : (kind == 1) ? pos_plain(cn) : pos_w1(cn);
        u32x4 o; o.x = cvtpk(s[0 * 33], s[1 * 33]); o.y = cvtpk(s[2 * 33], s[3 * 33]); o.z = cvtpk(s[4 * 33], s[5 * 33]); o.w = cvtpk(s[6 * 33], s[7 * 33]);
        *(u32x4*)(WT + (size_t)row * 1024 + k0 + 8 * c) = o; }
    LDS_WAIT(); asm volatile("" ::: "memory");
}

__global__ void __launch_bounds__(NTHREADS, 2) mk_fwd(Params P) {
    __builtin_assume(__builtin_amdgcn_workitem_id_y() == 0); __builtin_assume(__builtin_amdgcn_workitem_id_z() == 0);
    extern __shared__ __attribute__((aligned(16))) unsigned char lds_raw[];
    cg::grid_group grid = cg::this_grid();
    Frame F; F.lds = (LAS unsigned char*)lds_raw; F.tid = threadIdx.x; F.lane = F.tid & 63; F.wave = __builtin_amdgcn_readfirstlane(F.tid >> 6);
    F.G = gridDim.x; { const int bx = blockIdx.x; F.vcu = (F.G % 8 == 0) ? (bx % 8) * (F.G / 8) + bx / 8 : bx; }
    unsigned char* ws = P.ws;
    unsigned* ctl = (unsigned*)(ws + WS_CTL);
    float* ropec = (float*)(ws + WS_ROPEC); float* ropes = (float*)(ws + WS_ROPES);
    float* wr3 = (float*)(ws + WS_WR3); float* logf2 = (float*)(ws + WS_LOGF); float* F2 = (float*)(ws + WS_F2);
    int* ltok = (int*)(ws + WS_LTOK); float* lrstd = (float*)(ws + WS_LRSTD); int* inv = (int*)(ws + WS_INV); float* gates = (float*)(ws + WS_GATE);
    bf16_t* H1B = (bf16_t*)(ws + WS_H1B); bf16_t* WinT = (bf16_t*)(ws + WS_WINT); bf16_t* WoT = (bf16_t*)(ws + WS_WOT);
    bf16_t* W2T = (bf16_t*)(ws + WS_W2T); bf16_t* W1T = (bf16_t*)(ws + WS_W1T); bf16_t* Yb = (bf16_t*)(ws + WS_Y);
    bf16_t* U = (bf16_t*)(ws + WS_U); unsigned char* proj = ws + WS_PROJ;
    bf16_t* RQ = (bf16_t*)(proj); bf16_t* RK = (bf16_t*)(proj + PROJ_STRIDE); bf16_t* RV = (bf16_t*)(proj + 2 * PROJ_STRIDE); bf16_t* SG = (bf16_t*)(proj + 3 * PROJ_STRIDE);
    bf16_t* FQ = (bf16_t*)(proj + 4 * PROJ_STRIDE); bf16_t* FK = (bf16_t*)(proj + 5 * PROJ_STRIDE); bf16_t* FV = (bf16_t*)(proj + 6 * PROJ_STRIDE);
    float* GST = (float*)(ws + WS_GST); bf16_t* MIX = (bf16_t*)(ws + WS_MIX); bf16_t* Hb = (bf16_t*)(ws + WS_H);
    const int lo = P.ph_lo, hi_ph = P.ph_hi;
#ifndef MK_PHMASK
#define MK_PHMASK 0x1ff
#endif
#define IN(k) (((MK_PHMASK >> (k)) & 1) && lo <= (k) && (k) < hi_ph)
#define SEAM(k) do { if (IN(k) && IN((k) + 1)) grid.sync(); } while (0)
    const int gw = F.vcu * NWAVES + F.wave, NGW = F.G * NWAVES;

    if (IN(0)) {
        LAS float* scr = (LAS float*)(F.lds + F.wave * 16384);
        constexpr int I_IN = 16 * 112, I_O = 16 * 32, I_1 = 32 * 16 * 64, I_2 = 32 * 16 * 32, NIT = I_IN + I_O + I_1 + I_2;
        for (int it = gw; it < NIT; it += NGW) {
            int r = it;
            if (r < I_IN) { tr_item(P.w_in, INW, 64 * (r / 112), 32 * (r % 112), nullptr, WinT, 0, scr, F.lane); continue; } r -= I_IN;
            if (r < I_O) { tr_item(P.w_out, 1024, 64 * (r / 32), 32 * (r % 32), nullptr, WoT, 1, scr, F.lane); continue; } r -= I_O;
            if (r < I_1) { const int e = r >> 10, rr = r & 1023; tr_item(P.w1 + (size_t)e * 1024 * 2048, 2048, 64 * (rr / 64), 32 * (rr % 64), P.g_ffn, W1T + (size_t)e * 2048 * 1024, 2, scr, F.lane); continue; } r -= I_1;
            { const int e = r >> 9, rr = r & 511; tr_item(P.w2 + (size_t)e * 1024 * 1024, 1024, 64 * (rr / 32), 32 * (rr % 32), nullptr, W2T + (size_t)e * 1024 * 1024, 1, scr, F.lane); }
        }
        for (int m = gw; m < T; m += NGW) {
            const f32x4* xr = (const f32x4*)(P.x + (size_t)m * DM) + F.lane; const f32x4* gr = (const f32x4*)P.g_mix + F.lane;
            f32x4 v[4]; float ss = 0.f;
#pragma unroll
            for (int j = 0; j < 4; ++j) { v[j] = xr[64 * j]; ss += (v[j].x * v[j].x + v[j].y * v[j].y) + (v[j].z * v[j].z + v[j].w * v[j].w); }
            const float rstd = rsqrtf(wave_sum(ss) * (1.0f / DM) + RMS_EPS);
            float z[8];
#pragma unroll
            for (int hh = 0; hh < 8; ++hh) z[hh] = 0.f;
            unsigned long long* o8 = (unsigned long long*)(U + (size_t)m * DM) + F.lane;
#pragma unroll
            for (int j = 0; j < 4; ++j) { v[j] = v[j] * rstd * gr[64 * j];
                o8[64 * j] = (unsigned long long)cvtpk(v[j].x, v[j].y) | ((unsigned long long)cvtpk(v[j].z, v[j].w) << 32);
#pragma unroll
                for (int e = 0; e < 4; ++e) { const int k = 4 * F.lane + 256 * j + e; const f32x4* wf = (const f32x4*)(P.w_in + (size_t)k * INW + NPROJ); const f32x4 wa = wf[0], wb = wf[1];
                    z[0] += v[j][e] * wa.x; z[1] += v[j][e] * wa.y; z[2] += v[j][e] * wa.z; z[3] += v[j][e] * wa.w; z[4] += v[j][e] * wb.x; z[5] += v[j][e] * wb.y; z[6] += v[j][e] * wb.z; z[7] += v[j][e] * wb.w; } }
#pragma unroll
            for (int hh = 0; hh < 8; ++hh) z[hh] = wave_sum(z[hh]);
            float zz = z[0];
#pragma unroll
            for (int hh = 1; hh < 8; ++hh) zz = (F.lane == hh) ? z[hh] : zz;
            if (F.lane < 8) { const float xx = zz + P.b_forget[F.lane]; const float lf = fminf(xx, 0.f) - log1pf(__expf(-fabsf(xx))); logf2[(size_t)m * 8 + F.lane] = lf * LOG2E; }
        }
        for (int idx = blockIdx.x * NTHREADS + F.tid; idx < SEQ * 64; idx += F.G * NTHREADS) {
            const int pos = idx >> 6, i = idx & 63; const float invf = exp2f(-(float)i * (13.287712379549449f / 64.0f));
            const float ang = (float)pos * invf; double tt = (double)ang * 0.15915494309189535; tt -= __builtin_rint(tt); const float tf = (float)tt;
            ropec[idx] = __builtin_amdgcn_cosf(tf); ropes[idx] = __builtin_amdgcn_sinf(tf);
        }
        for (int idx = blockIdx.x * NTHREADS + F.tid; idx < 32768; idx += F.G * NTHREADS) {
            const int s = idx & 3, e16 = (idx >> 2) & 15, half = (idx >> 6) & 1, kq = (idx >> 7) & 3, c = idx >> 9; const int k = 16 * c + 4 * kq + s, e = 16 * half + e16;
            wr3[idx] = P.w_router[k * 32 + e] * P.g_ffn[k];
        }
    }
    SEAM(0);

    if (IN(1)) {
        pg8::DenseOrder S; S.init(T, NPROJ, DM, F.G, (int)blockIdx.x);
        EpiInProj E{proj, ropec, ropes};
        pg8::gemm_phase<EpiInProj, pg8::DenseOrder, true, true>(F.lds, U, WinT, DM, S, E);
    }
    SEAM(1);

    if (IN(2)) {
        for (int u = F.vcu; u < 256; u += F.G) ret::unit<false>(u >> 4, u & 15, RQ, RK, RV, SG, GST, MIX, (LAS char*)F.lds);
        for (int bh = F.vcu; bh < 32; bh += F.G) {
            const int b = bh >> 3, h = bh & 7; LAS double* sd = (LAS double*)F.lds;
            double loc[16]; double run = 0.0;
#pragma unroll
            for (int i = 0; i < 16; ++i) { run += (double)logf2[((size_t)b * SEQ + 16 * F.tid + i) * 8 + h]; loc[i] = run; }
            double incl = run;
#pragma unroll
            for (int o = 1; o < 64; o <<= 1) { const double t = __shfl_up(incl, o); if (F.lane >= o) incl += t; }
            __syncthreads();
            if (F.lane == 63) sd[F.wave] = incl;
            __syncthreads();
            double off = incl - run;
            for (int w2 = 0; w2 < F.wave; ++w2) off += sd[w2];
#pragma unroll
            for (int i = 0; i < 16; ++i) F2[(size_t)bh * SEQ + 16 * F.tid + i] = (float)(off + loc[i]);
            __syncthreads();
        }
    }
    SEAM(2);

    if (IN(3)) {
        for (int i = 0;; ++i) { const int idx = i * F.G + F.vcu; if (idx >= 1024) break;
            const int bh = (idx & 255) >> 3, s = idx & 7, rd = idx >> 8; const int qb = (rd == 0) ? s : (rd == 1) ? 15 - s : (rd == 2) ? 16 + s : 31 - s;
            attn_body::attn_unit<8>(bh >> 3, bh & 7, qb, FQ, FK, FV, MIX + 512, F2, (char*)lds_raw); }
        for (int u = F.vcu; u < 256; u += F.G) ret::unit<true>(u >> 4, u & 15, RQ, RK, RV, SG, GST, MIX, (LAS char*)F.lds);
    }
    SEAM(3);

    if (IN(4)) {
        pg8::DenseOrder S; S.init(T, DM, DM, F.G, (int)blockIdx.x);
        EpiOutProj E{P.x, H1B};
        pg8::gemm_phase<EpiOutProj, pg8::DenseOrder, true, true>(F.lds, MIX, WoT, DM, S, E);
    }
    SEAM(4);

    if (IN(5)) {
        LAS float* wl = (LAS float*)F.lds;
        LAS float* lg = (LAS float*)(F.lds + 131072);
        LAS float* ssb = (LAS float*)(F.lds + 131072 + 128 * 33 * 4);
        LAS int* ecnt = (LAS int*)(F.lds + 131072 + 128 * 33 * 4 + 512);
        LAS int* ebase = ecnt + 32;
        for (int i = F.tid; i < 8192; i += NTHREADS) ((LAS f32x4*)wl)[i] = ((const f32x4*)wr3)[i];
        for (int tb = blockIdx.x; tb < T / 128; tb += F.G) {
            if (F.tid < 32) ecnt[F.tid] = 0;
            __syncthreads();
            const int tok16 = F.lane & 15, kq = F.lane >> 4; const int tokw = tb * 128 + F.wave * 16 + tok16;
            const bf16_t* hrow = H1B + (size_t)tokw * DM + 4 * kq;
            f32x4 a0 = {0.f, 0.f, 0.f, 0.f}, a1 = {0.f, 0.f, 0.f, 0.f}; float ss = 0.f;
#pragma unroll 8
            for (int c = 0; c < 64; ++c) {
                const u32x2 hv = *(const u32x2*)(hrow + 16 * c); const float av[4] = {bflo(hv.x), bfhi(hv.x), bflo(hv.y), bfhi(hv.y)};
                const f32x4 w0 = *(const LAS f32x4*)(wl + (((c * 4 + kq) * 2 + 0) * 16 + tok16) * 4), w1 = *(const LAS f32x4*)(wl + (((c * 4 + kq) * 2 + 1) * 16 + tok16) * 4);
#pragma unroll
                for (int s = 0; s < 4; ++s) { ss += av[s] * av[s]; a0 = __builtin_amdgcn_mfma_f32_16x16x4f32(av[s], w0[s], a0, 0, 0, 0); a1 = __builtin_amdgcn_mfma_f32_16x16x4f32(av[s], w1[s], a1, 0, 0, 0); }
            }
            ss += __shfl_xor(ss, 16); ss += __shfl_xor(ss, 32);
            if (kq == 0) ssb[F.wave * 16 + tok16] = ss;
#pragma unroll
            for (int r = 0; r < 4; ++r) { const int tk = F.wave * 16 + kq * 4 + r; lg[tk * 33 + tok16] = a0[r]; lg[tk * 33 + 16 + tok16] = a1[r]; }
            __syncthreads();
            int esel[4] = {0, 0, 0, 0}, rank[4] = {0, 0, 0, 0}; float gsel[4] = {0.f, 0.f, 0.f, 0.f}; float rstd = 0.f;
            if (F.tid < 128) {
                rstd = rsqrtf(ssb[F.tid] * (1.0f / DM) + RMS_EPS);
                float l[32];
#pragma unroll
                for (int e = 0; e < 32; ++e) l[e] = lg[F.tid * 33 + e] * rstd + P.b_router[e];
                float vs[4];
#pragma unroll
                for (int k = 0; k < 4; ++k) { float best = -INFINITY; int bi = 0;
#pragma unroll
                    for (int e = 0; e < 32; ++e) { const bool bt = l[e] > best; best = bt ? l[e] : best; bi = bt ? e : bi; }
                    vs[k] = best; esel[k] = bi;
#pragma unroll
                    for (int e = 0; e < 32; ++e) l[e] = (e == bi) ? -INFINITY : l[e]; }
                float den = 0.f;
#pragma unroll
                for (int k = 0; k < 4; ++k) { gsel[k] = __expf(vs[k] - vs[0]); den += gsel[k]; }
#pragma unroll
                for (int k = 0; k < 4; ++k) { gsel[k] /= den; rank[k] = atomicAdd((int*)&ecnt[esel[k]], 1); }
            }
            __syncthreads();
            if (F.tid < 32) ebase[F.tid] = (int)atomicAdd(ctl + CW_CNT + F.tid, (unsigned)ecnt[F.tid]);
            __syncthreads();
            if (F.tid < 128) { const int tok = tb * 128 + F.tid;
#pragma unroll
                for (int k = 0; k < 4; ++k) { const int e = esel[k], slot = ebase[e] + rank[k];
                    ltok[(size_t)e * CAP + slot] = tok; lrstd[(size_t)e * CAP + slot] = rstd; inv[tok * 4 + k] = (e << 16) | slot; gates[tok * 4 + k] = gsel[k]; } }
            __syncthreads();
        }
    }
    SEAM(5);

    if (IN(6) || IN(7)) {
        LAS int* boff = (LAS int*)(F.lds + 131072); LAS int* cntl = boff + 64;
        if (F.tid == 0) { int a = 0; for (int e = 0; e < 32; ++e) { const int c = (int)ctl[CW_CNT + e]; cntl[e] = c; boff[e] = a; a += (c + 255) >> 8; } boff[32] = a; }
        __syncthreads();
        if (IN(6)) {
            MoeOrder<8, true> S{boff, cntl, ltok, F.G, F.vcu};
            EpiMoe1 E{Hb, P.b1, lrstd, (const int*)(ctl + CW_CNT)};
            pg8::gemm_phase<EpiMoe1, MoeOrder<8, true>, true, true>(F.lds, H1B, W1T, DM, S, E);
        }
        SEAM(6);
        if (IN(7)) {
            MoeOrder<4, false> S{boff, cntl, ltok, F.G, F.vcu};
            EpiMoe2 E{Yb, P.b2};
            pg8::gemm_phase<EpiMoe2, MoeOrder<4, false>, true, true>(F.lds, Hb, W2T, DM, S, E);
        }
    }
    SEAM(7);

    if (IN(8)) {
        LAS int* boff = (LAS int*)(F.lds + 131072);
        __syncthreads();
        if (F.tid == 0) { int a = 0; for (int e = 0; e < 32; ++e) { const int c = (int)ctl[CW_CNT + e]; boff[e] = a; a += (c + 255) >> 8; } boff[32] = a; }
        __syncthreads();
        for (int m = gw; m < T; m += NGW) {
            float v[16];
            { const u32x4 a = *(const u32x4*)(H1B + (size_t)m * DM + 8 * F.lane), bq = *(const u32x4*)(H1B + (size_t)m * DM + 512 + 8 * F.lane);
#pragma unroll
              for (int e = 0; e < 4; ++e) { v[2 * e] = bflo(a[e]); v[2 * e + 1] = bfhi(a[e]); v[8 + 2 * e] = bflo(bq[e]); v[8 + 2 * e + 1] = bfhi(bq[e]); } }
#pragma unroll
            for (int k = 0; k < 4; ++k) { const int iv = inv[m * 4 + k]; const float gt = gates[m * 4 + k]; const int e = iv >> 16, slot = iv & 0xffff;
                const size_t yrow = (size_t)boff[e] * 256 + slot;
                const u32x4 a = *(const u32x4*)(Yb + yrow * DM + 8 * F.lane), bq = *(const u32x4*)(Yb + yrow * DM + 512 + 8 * F.lane);
#pragma unroll
                for (int q = 0; q < 4; ++q) { v[2 * q] += gt * bflo(a[q]); v[2 * q + 1] += gt * bfhi(a[q]); v[8 + 2 * q] += gt * bflo(bq[q]); v[8 + 2 * q + 1] += gt * bfhi(bq[q]); } }
            float ss = 0.f;
#pragma unroll
            for (int i = 0; i < 16; ++i) ss += v[i] * v[i];
            const float rstd = rsqrtf(wave_sum(ss) * (1.0f / DM) + RMS_EPS);
            const f32x4* gf = (const f32x4*)P.g_final; f32x4* op = (f32x4*)(P.out + (size_t)m * DM);
            const f32x4 g0 = gf[2 * F.lane], g1 = gf[2 * F.lane + 1], g2 = gf[128 + 2 * F.lane], g3 = gf[128 + 2 * F.lane + 1];
            op[2 * F.lane] = (f32x4){v[0], v[1], v[2], v[3]} * rstd * g0; op[2 * F.lane + 1] = (f32x4){v[4], v[5], v[6], v[7]} * rstd * g1;
            op[128 + 2 * F.lane] = (f32x4){v[8], v[9], v[10], v[11]} * rstd * g2; op[128 + 2 * F.lane + 1] = (f32x4){v[12], v[13], v[14], v[15]} * rstd * g3;
        }
    }
#undef IN
#undef SEAM
}

extern "C" void kernel_launch(void* const* d_in, const int* in_sizes, int n_in, void* d_out, int out_size, void* d_ws, size_t ws_size, hipStream_t stream) {
    static int grid = 0;
    if (grid == 0) {
        if (n_in != 13 || in_sizes[0] != T * DM || out_size != T * DM || ws_size < WS_END) { fprintf(stderr, "kernel_launch: unexpected shapes (n_in %d, in0 %d, out %d, ws %zu)\n", n_in, n_in > 0 ? in_sizes[0] : -1, out_size, ws_size); grid = -1; return; }
        int dev = 0, cus = 0, per_cu = 0;
        if (hipGetDevice(&dev) != hipSuccess || hipDeviceGetAttribute(&cus, hipDeviceAttributeMultiprocessorCount, dev) != hipSuccess) { fprintf(stderr, "kernel_launch: device query failed\n"); grid = -1; return; }
        if (hipFuncSetAttribute((const void*)mk_fwd, hipFuncAttributeMaxDynamicSharedMemorySize, LDS_BYTES) != hipSuccess) { fprintf(stderr, "kernel_launch: hipFuncSetAttribute failed\n"); grid = -1; return; }
        if (hipOccupancyMaxActiveBlocksPerMultiprocessor(&per_cu, (const void*)mk_fwd, NTHREADS, LDS_BYTES) != hipSuccess || per_cu < 1) { fprintf(stderr, "kernel_launch: occupancy query says %d\n", per_cu); per_cu = 1; }
        (void)hipGetLastError();
        grid = cus * 1;
        if (grid != 256) fprintf(stderr, "kernel_launch: %d CUs (built for 256)\n", grid);
    }
    if (grid < 0) return;
    (void)hipMemsetAsync((char*)d_ws + WS_CTL, 0, CTL_BYTES, stream);
    Params p{};
    const float** pin = (const float**)&p;
    for (int i = 0; i < 13; ++i) pin[i] = (const float*)d_in[i];
    p.out = (float*)d_out; p.ws = (unsigned char*)d_ws;
#if MK_N_LAUNCHES == 1
    p.ph_lo = 0; p.ph_hi = 9;
    void* args[] = {&p};
    hipError_t e = hipLaunchCooperativeKernel((const void*)mk_fwd, dim3(grid), dim3(NTHREADS), args, LDS_BYTES, stream);
    if (e != hipSuccess) fprintf(stderr, "kernel_launch: cooperative launch failed: %s (grid %d)\n", hipGetErrorString(e), grid);
#else
    for (int k = 0; k < 9; ++k) { p.ph_lo = k; p.ph_hi = k + 1; hipLaunchKernelGGL(mk_fwd, dim3(grid), dim3(NTHREADS), LDS_BYTES, stream, p); }
#endif
}
```

```cpp
#include <hip/hip_runtime.h>
#include <hip/hip_cooperative_groups.h>
#include <cstdio>
#include <cstdint>
namespace cg = cooperative_groups;

#ifndef MK_N_LAUNCHES
#define MK_N_LAUNCHES 1
#endif
#ifndef MK_DUP
#define MK_DUP -1
#endif
#ifndef MK_DIAG
#define MK_DIAG 0
#endif

#define LAS __attribute__((address_space(3)))
#define GAS __attribute__((address_space(1)))
typedef unsigned short bf16_t;
typedef short bf16x8 __attribute__((ext_vector_type(8)));
typedef short s16x4 __attribute__((ext_vector_type(4)));
typedef float f32x2 __attribute__((ext_vector_type(2)));
typedef float f32x4 __attribute__((ext_vector_type(4)));
typedef float f32x16 __attribute__((ext_vector_type(16)));
typedef unsigned u32x2 __attribute__((ext_vector_type(2)));
typedef unsigned u32x4 __attribute__((ext_vector_type(4)));
typedef __bf16 bf16x2_t __attribute__((ext_vector_type(2)));

constexpr int BATCH = 4, SEQ = 8192, DM = 1024, T = BATCH * SEQ;
constexpr int RH = 4, RD = 128, FH = 8, FD = 64;
constexpr int NPROJ = 3584, INW = 3592;
constexpr int NE = 32, TOPK = 4, DFF = 1024;
constexpr int CAP = T;
constexpr int NBMAX = (T * TOPK) / 256 + NE;
constexpr float RMS_EPS = 1e-5f, GN_EPS = 1e-5f;
constexpr float LOG2E = 1.4426950408889634f;
constexpr float C2 = 0.125f * 1.4426950408889634f;
constexpr int NTHREADS = 512, NWAVES = 8;

constexpr size_t MiB = 1u << 20;
constexpr size_t WS_CTL = 0, CTL_BYTES = 1 * MiB;
constexpr size_t WS_ROPEC = 1 * MiB, WS_ROPES = 3 * MiB;
constexpr size_t WS_WR3 = 5 * MiB;
constexpr size_t WS_LOGF = 6 * MiB;
constexpr size_t WS_F2 = 7 * MiB;
constexpr size_t WS_LTOK = 8 * MiB;
constexpr size_t WS_LRSTD = 12 * MiB;
constexpr size_t WS_INV = 16 * MiB;
constexpr size_t WS_GATE = 17 * MiB;
constexpr size_t WS_H1B = 32 * MiB;
constexpr size_t WS_WINT = 96 * MiB;
constexpr size_t WS_WOT = 104 * MiB;
constexpr size_t WS_W2T = 112 * MiB;
constexpr size_t WS_W1T = 176 * MiB;
constexpr size_t WS_Y = 176 * MiB;
constexpr size_t WS_U = 448 * MiB;
constexpr size_t WS_PROJ = 512 * MiB;
constexpr size_t PROJ_STRIDE = 32 * MiB;
constexpr size_t WS_GST = 736 * MiB;
constexpr size_t WS_MIX = 752 * MiB;
constexpr size_t WS_H = 448 * MiB;
constexpr size_t WS_END = 816 * MiB;
constexpr int CW_CNT = 0;
constexpr int CW_DIAG = 64;
constexpr int CW_BAR = 4096;


constexpr int LDS_BYTES = 163840;
constexpr int LDS_MISC = LDS_BYTES - 16;

__device__ __forceinline__ unsigned cvtpk(float lo, float hi) { f32x2 v = {lo, hi}; bf16x2_t b = __builtin_convertvector(v, bf16x2_t); return __builtin_bit_cast(unsigned, b); }
__device__ __forceinline__ float bf2f(unsigned short h) { return __uint_as_float(((unsigned)h) << 16); }
__device__ __forceinline__ float bflo(unsigned w) { return __uint_as_float(w << 16); }
__device__ __forceinline__ float bfhi(unsigned w) { return __uint_as_float(w & 0xffff0000u); }
__device__ __forceinline__ float wave_sum(float v) {
#pragma unroll
    for (int o = 1; o < 64; o <<= 1) v += __shfl_xor(v, o);
    return v;
}
#define LDS_WAIT() asm volatile("s_waitcnt lgkmcnt(0)" ::: "memory")
#define VM_WAIT() asm volatile("s_waitcnt vmcnt(0)" ::: "memory")

struct Params {
    const float *x, *g_mix, *w_in, *b_forget, *w_out, *g_ffn, *w_router, *b_router, *w1, *b1, *w2, *b2, *g_final;
    float* out; unsigned char* ws; int ph_lo, ph_hi;
};

namespace pg8 {
constexpr int BM = 256, BK = 64, HALF = 128, HTB = HALF * BK * 2, STAGE_BYTES = 8 * HTB, NXCD = 8, WGM = 8;
__host__ __device__ __forceinline__ int lds_byte(int r, int c) { const int st = (r >> 4) * 2 + (c >> 5), rr = r & 15, cc = c & 31, ob = rr * 64 + cc * 2; return st * 1024 + (ob ^ (((ob >> 9) & 1) << 5)); }
__host__ __device__ __forceinline__ void stage_rc(int b, int& R, int& C) { const int st = b / 1024, sb = b % 1024, swz = sb ^ (((sb >> 9) & 1) << 5); R = (st >> 1) * 16 + swz / 64; C = (st & 1) * 32 + (swz % 64) / 2; }

struct Unit { int pm, pn, e, lb; };

struct DenseOrder {
    int nM, nN, nwg, G, c; int K;
    __device__ void init(int M, int N, int K_, int G_, int c_) { nM = M / BM; nN = N / BM; nwg = nM * nN; G = G_; c = c_; K = K_; }
    __device__ __forceinline__ bool next(int i, Unit& u) const {
        const long L = (long)i * G + c; if (L >= nwg) return false;
        int wgid = (int)L; { const int q = nwg / NXCD, r = nwg % NXCD, xcd = wgid % NXCD, off = wgid / NXCD; wgid = (xcd < r ? xcd * (q + 1) : r * (q + 1) + (xcd - r) * q) + off; }
        const int nig = WGM * nN, gid = wgid / nig, fm = gid * WGM, gsz = (nM - fm) < WGM ? (nM - fm) : WGM;
        u.pm = fm + ((wgid % nig) % gsz); u.pn = (wgid % nig) / gsz; u.e = 0; u.lb = 0; return true;
    }
    __device__ __forceinline__ void aoffs(const Unit& u, unsigned (&ao)[2][2], const int (&R)[2], const int (&C)[2]) const {
#pragma unroll
        for (int h = 0; h < 2; ++h)
#pragma unroll
            for (int i = 0; i < 2; ++i) ao[h][i] = (unsigned)(((u.pm * BM + h * HALF + R[i]) * K + C[i]) * 2);
    }
};

template <class Epi, class Sched, bool ALIGN_EPI, bool SP2>
__device__ __forceinline__ void gemm_phase(LAS unsigned char* lds, const bf16_t* Abase, const bf16_t* Btbase, const int K, const Sched& S, const Epi& E) {
    const int tid = threadIdx.x, wid = __builtin_amdgcn_readfirstlane(tid >> 6), lane = tid & 63, wr = wid >> 2, wc = wid & 3, fr = lane & 15, fq = lane >> 4;
    const int nt = K / BK;
    int RR[2], CC[2]; unsigned voffB[2];
#pragma unroll
    for (int i = 0; i < 2; ++i) { stage_rc(tid * 16 + i * 8192, RR[i], CC[i]); voffB[i] = (unsigned)(RR[i] * K + CC[i]) * 2u; }
    const size_t kstep = (size_t)(BK * 2);
    const size_t hstep = (size_t)HALF * K * 2;
    const size_t tstep = 2 * hstep;
    const unsigned ldsw = (unsigned)wid * 1024u;
    const int aoff = lds_byte(wr * 64 + fr, fq * 8), boff = lds_byte(wc * 32 + fr, fq * 8);
    const char* Ab = (const char*)Abase;
#define PG8_SA(b, h) (((b) * 2 + (h)) * HTB)
#define PG8_SB(b, h) ((4 + (b) * 2 + (h)) * HTB)
#define PG8_STAGE(bufoff, gbase, voff) do { _Pragma("unroll") for (int _i = 0; _i < 2; ++_i) \
        __builtin_amdgcn_global_load_lds((const unsigned*)((const char*)(gbase) + (voff)[_i]), (LAS unsigned*)(lds + (bufoff) + ldsw + _i * 8192), 16, 0, 0); } while (0)
#define PG8_STAGE_A(bufoff, kb, AO, h) do { _Pragma("unroll") for (int _i = 0; _i < 2; ++_i) \
        __builtin_amdgcn_global_load_lds((const unsigned*)(Ab + (kb) + (AO)[h][_i]), (LAS unsigned*)(lds + (bufoff) + ldsw + _i * 8192), 16, 0, 0); } while (0)
#define PG8_LDA(dst, b, h) do { _Pragma("unroll") for (int m = 0; m < 4; ++m) _Pragma("unroll") for (int k = 0; k < 2; ++k) dst[m][k] = *(const LAS bf16x8*)(lds + PG8_SA(b, h) + aoff + m * 2048 + k * 1024); } while (0)
#define PG8_LDB(dst, b, h) do { _Pragma("unroll") for (int n = 0; n < 2; ++n) _Pragma("unroll") for (int k = 0; k < 2; ++k) dst[n][k] = *(const LAS bf16x8*)(lds + PG8_SB(b, h) + boff + n * 2048 + k * 1024); } while (0)
#define PG8_MMA(ai, bj, At, Bt) do { __builtin_amdgcn_s_setprio(1); _Pragma("unroll") for (int m = 0; m < 4; ++m) _Pragma("unroll") for (int n = 0; n < 2; ++n) _Pragma("unroll") for (int k = 0; k < 2; ++k) \
        acc[ai][bj][m][n] = __builtin_amdgcn_mfma_f32_16x16x32_bf16(Bt[n][k], At[m][k], acc[ai][bj][m][n], 0, 0, 0); __builtin_amdgcn_s_setprio(0); } while (0)
#define PG8_WAIT_V(n) asm volatile("s_waitcnt vmcnt(" #n ")" ::: "memory")
#define PG8_WAIT_L(n) asm volatile("s_waitcnt lgkmcnt(" #n ")" ::: "memory")
#define PG8_BAR __builtin_amdgcn_s_barrier()
#define PG8_SCHED __builtin_amdgcn_sched_barrier(0)
    Unit cur, nxt; int ui = 0;
    if (!S.next(0, cur)) return;
    f32x4 acc[2][2][4][2];
#pragma unroll
    for (int a = 0; a < 2; ++a)
#pragma unroll
        for (int b = 0; b < 2; ++b)
#pragma unroll
            for (int m = 0; m < 4; ++m)
#pragma unroll
                for (int n = 0; n < 2; ++n) acc[a][b][m][n] = (f32x4){0.f, 0.f, 0.f, 0.f};
    bf16x8 At[4][2], B0[2][2], B1[2][2];
    unsigned aoC[2][2], aoN[2][2];
    S.aoffs(cur, aoC, RR, CC);
    const char* cB = (const char*)Btbase + (size_t)cur.pn * tstep;
    static_assert(SP2, "only the SP2 loop is kept");
    PG8_STAGE(PG8_SB(0, 0), cB, voffB); PG8_STAGE(PG8_SB(0, 1), cB + hstep, voffB); PG8_STAGE_A(PG8_SA(0, 0), 0, aoC, 0); PG8_STAGE_A(PG8_SA(0, 1), 0, aoC, 1);
    if (wr == 1) PG8_BAR;
    PG8_WAIT_V(2); PG8_BAR;
    PG8_STAGE(PG8_SB(1, 0), cB + kstep, voffB); PG8_STAGE_A(PG8_SA(1, 0), kstep, aoC, 0); PG8_STAGE(PG8_SB(1, 1), cB + hstep + kstep, voffB);
    PG8_WAIT_V(6); PG8_BAR;
    for (;;) {
        const bool has_next = S.next(ui + 1, nxt);
        if (has_next) S.aoffs(nxt, aoN, RR, CC);
        else {
#pragma unroll
            for (int h = 0; h < 2; ++h)
#pragma unroll
                for (int i = 0; i < 2; ++i) aoN[h][i] = aoC[h][i];
        }
        const char* nB = has_next ? (const char*)Btbase + (size_t)nxt.pn * tstep : cB;
        for (int t = 0; t < nt; t += 2) {
            const bool last = (t == nt - 2);
            const size_t kb1 = (size_t)(t + 1) * kstep;
            const size_t kb2 = last ? 0 : (size_t)(t + 2) * kstep, kb3 = kb2 + kstep;
            unsigned ao2[2][2];
#pragma unroll
            for (int h = 0; h < 2; ++h)
#pragma unroll
                for (int i = 0; i < 2; ++i) ao2[h][i] = last ? aoN[h][i] : aoC[h][i];
            const char* b2 = last ? nB : cB + (size_t)(t + 2) * kstep;
            const char* b3 = b2 + kstep;
            PG8_LDB(B0, 0, 0); PG8_LDB(B1, 0, 1); PG8_SCHED; PG8_LDA(At, 0, 0); PG8_STAGE_A(PG8_SA(1, 1), kb1, aoC, 1);
            PG8_WAIT_V(8); PG8_WAIT_L(0); PG8_BAR; PG8_MMA(0, 0, At, B0); PG8_MMA(0, 1, At, B1); PG8_BAR; PG8_SCHED;
            PG8_LDA(At, 0, 1); PG8_STAGE(PG8_SB(0, 0), b2, voffB); PG8_STAGE(PG8_SB(0, 1), b2 + hstep, voffB); PG8_STAGE_A(PG8_SA(0, 0), kb2, ao2, 0);
            PG8_WAIT_V(8); PG8_WAIT_L(0); PG8_BAR; PG8_MMA(1, 0, At, B0); PG8_MMA(1, 1, At, B1); PG8_BAR; PG8_SCHED;
            PG8_LDB(B0, 1, 0); PG8_LDB(B1, 1, 1); PG8_SCHED; PG8_LDA(At, 1, 0); PG8_STAGE_A(PG8_SA(0, 1), kb2, ao2, 1);
            PG8_WAIT_V(8); PG8_WAIT_L(0); PG8_BAR; PG8_MMA(0, 0, At, B0); PG8_MMA(0, 1, At, B1); PG8_BAR; PG8_SCHED;
            PG8_LDA(At, 1, 1); PG8_STAGE(PG8_SB(1, 0), b3, voffB); PG8_STAGE(PG8_SB(1, 1), b3 + hstep, voffB); PG8_STAGE_A(PG8_SA(1, 0), kb3, ao2, 0);
            PG8_WAIT_V(8); PG8_WAIT_L(0); PG8_BAR; PG8_MMA(1, 0, At, B0); PG8_MMA(1, 1, At, B1); PG8_BAR; PG8_SCHED;
        }
        if constexpr (ALIGN_EPI) { if (wr == 0) PG8_BAR; }
        E(acc, cur, wr, wc, fr, fq);
        if (!has_next) break;
#pragma unroll
        for (int a = 0; a < 2; ++a)
#pragma unroll
            for (int b = 0; b < 2; ++b)
#pragma unroll
                for (int m = 0; m < 4; ++m)
#pragma unroll
                    for (int n = 0; n < 2; ++n) acc[a][b][m][n] = (f32x4){0.f, 0.f, 0.f, 0.f};
        cur = nxt; cB = nB; ++ui;
#pragma unroll
        for (int h = 0; h < 2; ++h)
#pragma unroll
            for (int i = 0; i < 2; ++i) aoC[h][i] = aoN[h][i];
        if constexpr (ALIGN_EPI) { if (wr == 1) PG8_BAR; }
    }
    PG8_WAIT_V(0);
    if constexpr (!ALIGN_EPI) { if (wr == 0) PG8_BAR; }
    PG8_BAR;
#undef PG8_SA
#undef PG8_SB
#undef PG8_STAGE
#undef PG8_STAGE_A
#undef PG8_LDA
#undef PG8_LDB
#undef PG8_MMA
#undef PG8_WAIT_V
#undef PG8_WAIT_L
#undef PG8_BAR
#undef PG8_SCHED
}
}


__device__ __forceinline__ int perm32_pos(int t) { return 16 * ((t >> 2) & 1) + 4 * ((t >> 3) & 3) + (t & 3); }
__device__ __forceinline__ int pos_inproj(int c) {
    if (c < 1024) { const int hc = c & 127; return (c & ~127) | (32 * ((hc >> 4) & 3) + 16 * (hc >> 6) + (hc & 15)); }
    return (c & ~31) | perm32_pos(c & 31);
}
__device__ __forceinline__ int pos_plain(int c) { return (c & ~31) | perm32_pos(c & 31); }
__device__ __forceinline__ int pos_w1(int n) { const int jj = n & 1023, lin = n >> 10, pn = jj >> 7, tp = jj & 127; return pn * 256 + lin * 128 + ((tp & ~31) | perm32_pos(tp & 31)); }

struct EpiInProj {
    unsigned char* proj; const float* ropec; const float* ropes;
    __device__ __forceinline__ void operator()(const f32x4 (&acc)[2][2][4][2], const pg8::Unit& u, int wr, int wc, int fr, int fq) const {
        const int type = u.pn >> 1; bf16_t* base = (bf16_t*)(proj + (size_t)type * PROJ_STRIDE);
        const int colh = (u.pn & 1) * 256;
        if (type < 2) {
            const float sc = (type == 1) ? 0.08838834764831845f : 1.0f;
            const int i0 = 16 * wc + 4 * fq;
#pragma unroll
            for (int ai = 0; ai < 2; ++ai)
#pragma unroll
                for (int m = 0; m < 4; ++m) {
                    const int row = u.pm * 256 + ai * 128 + wr * 64 + m * 16 + fr; const int pos = row & (SEQ - 1);
                    const f32x4 cs = *(const f32x4*)(ropec + pos * 64 + i0), sn = *(const f32x4*)(ropes + pos * 64 + i0);
#pragma unroll
                    for (int bj = 0; bj < 2; ++bj) {
                        const f32x4 x1 = acc[ai][bj][m][0], x2 = acc[ai][bj][m][1];
                        const f32x4 o1 = (x1 * cs - x2 * sn) * sc, o2 = (x1 * sn + x2 * cs) * sc;
                        bf16_t* dst = base + (size_t)row * 512 + colh + bj * 128 + i0;
                        u32x2 w1, w2; w1.x = cvtpk(o1[0], o1[1]); w1.y = cvtpk(o1[2], o1[3]); w2.x = cvtpk(o2[0], o2[1]); w2.y = cvtpk(o2[2], o2[3]);
                        *(u32x2*)dst = w1; *(u32x2*)(dst + 64) = w2;
                    }
                }
        } else {
            const float sc = (type == 4) ? C2 : 1.0f;
#pragma unroll
            for (int ai = 0; ai < 2; ++ai)
#pragma unroll
                for (int m = 0; m < 4; ++m) {
                    const int row = u.pm * 256 + ai * 128 + wr * 64 + m * 16 + fr;
#pragma unroll
                    for (int bj = 0; bj < 2; ++bj) {
                        f32x4 v0 = acc[ai][bj][m][0] * sc, v1 = acc[ai][bj][m][1] * sc;
                        if (type == 3) {
#pragma unroll
                            for (int j = 0; j < 4; ++j) { v0[j] = v0[j] / (1.0f + __expf(-v0[j])); v1[j] = v1[j] / (1.0f + __expf(-v1[j])); }
                        }
                        u32x4 w; w.x = cvtpk(v0[0], v0[1]); w.y = cvtpk(v0[2], v0[3]); w.z = cvtpk(v1[0], v1[1]); w.w = cvtpk(v1[2], v1[3]);
                        *(u32x4*)(base + (size_t)row * 512 + colh + bj * 128 + wc * 32 + 8 * fq) = w;
                    }
                }
        }
    }
};

struct EpiOutProj {
    const float* x; bf16_t* h1b;
    __device__ __forceinline__ void operator()(const f32x4 (&acc)[2][2][4][2], const pg8::Unit& u, int wr, int wc, int fr, int fq) const {
#pragma unroll
        for (int ai = 0; ai < 2; ++ai)
#pragma unroll
            for (int m = 0; m < 4; ++m) {
                const int row = u.pm * 256 + ai * 128 + wr * 64 + m * 16 + fr;
#pragma unroll
                for (int bj = 0; bj < 2; ++bj) {
                    const int col = u.pn * 256 + bj * 128 + wc * 32 + 8 * fq;
                    const f32x4 xa = *(const f32x4*)(x + (size_t)row * DM + col), xb = *(const f32x4*)(x + (size_t)row * DM + col + 4);
                    const f32x4 v0 = acc[ai][bj][m][0] + xa, v1 = acc[ai][bj][m][1] + xb;
                    u32x4 w; w.x = cvtpk(v0[0], v0[1]); w.y = cvtpk(v0[2], v0[3]); w.z = cvtpk(v1[0], v1[1]); w.w = cvtpk(v1[2], v1[3]);
                    *(u32x4*)(h1b + (size_t)row * DM + col) = w;
                }
            }
    }
};

struct EpiMoe1 {
    bf16_t* H; const float* b1; const float* lrstd; const int* cnt;
    __device__ __forceinline__ void operator()(const f32x4 (&acc)[2][2][4][2], const pg8::Unit& u, int wr, int wc, int fr, int fq) const {
        const int e = u.e, pnl = u.pn - e * 8; const int cq = pnl * 128 + wc * 32 + 8 * fq;
        const float* bg = b1 + (size_t)e * 2048 + cq; const float* bl = bg + 1024;
        const f32x4 bg0 = *(const f32x4*)bg, bg1 = *(const f32x4*)(bg + 4), bl0 = *(const f32x4*)bl, bl1 = *(const f32x4*)(bl + 4);
        const int ce = cnt[e];
#pragma unroll
        for (int ai = 0; ai < 2; ++ai)
#pragma unroll
            for (int m = 0; m < 4; ++m) {
                const int rt = ai * 128 + wr * 64 + m * 16 + fr; const int slot = u.lb * 256 + rt;
                const float rs = (slot < ce) ? lrstd[(size_t)e * CAP + slot] : 0.f;
                f32x4 g0 = acc[ai][0][m][0] * rs + bg0, g1 = acc[ai][0][m][1] * rs + bg1, l0 = acc[ai][1][m][0] * rs + bl0, l1 = acc[ai][1][m][1] * rs + bl1;
                float o[8];
#pragma unroll
                for (int j = 0; j < 4; ++j) {
                    float g = fminf(g0[j], 7.0f), l = fminf(fmaxf(l0[j], -7.0f), 7.0f); o[j] = g / (1.0f + __expf(-1.702f * g)) * (l + 1.0f);
                    g = fminf(g1[j], 7.0f); l = fminf(fmaxf(l1[j], -7.0f), 7.0f); o[4 + j] = g / (1.0f + __expf(-1.702f * g)) * (l + 1.0f);
                }
                u32x4 w; w.x = cvtpk(o[0], o[1]); w.y = cvtpk(o[2], o[3]); w.z = cvtpk(o[4], o[5]); w.w = cvtpk(o[6], o[7]);
                *(u32x4*)(H + (size_t)(u.pm * 256 + rt) * DFF + cq) = w;
            }
    }
};

struct EpiMoe2 {
    bf16_t* Y; const float* b2;
    __device__ __forceinline__ void operator()(const f32x4 (&acc)[2][2][4][2], const pg8::Unit& u, int wr, int wc, int fr, int fq) const {
        const int e = u.e, pnl = u.pn - e * 4;
#pragma unroll
        for (int bj = 0; bj < 2; ++bj) {
            const int col = pnl * 256 + bj * 128 + wc * 32 + 8 * fq;
            const f32x4 ba = *(const f32x4*)(b2 + (size_t)e * DM + col), bb = *(const f32x4*)(b2 + (size_t)e * DM + col + 4);
#pragma unroll
            for (int ai = 0; ai < 2; ++ai)
#pragma unroll
                for (int m = 0; m < 4; ++m) {
                    const int rt = ai * 128 + wr * 64 + m * 16 + fr;
                    const f32x4 v0 = acc[ai][bj][m][0] + ba, v1 = acc[ai][bj][m][1] + bb;
                    u32x4 w; w.x = cvtpk(v0[0], v0[1]); w.y = cvtpk(v0[2], v0[3]); w.z = cvtpk(v1[0], v1[1]); w.w = cvtpk(v1[2], v1[3]);
                    *(u32x4*)(Y + (size_t)(u.pm * 256 + rt) * DM + col) = w;
                }
        }
    }
};

template <int NT, bool GATHER>
struct MoeOrder {
    const LAS int* boff;
    const LAS int* cntl;
    const int* ltok;
    int G, vcu;
    __device__ __forceinline__ bool next(int i, pg8::Unit& u) const {
        const int cpx = G >> 3, x = vcu / cpx, j = vcu % cpx, rpb = cpx / NT;
        const int rb = (i * 8 + x) * rpb + j / NT; const int nb = boff[32];
        if (rb >= nb) return false;
        int e = 0;
#pragma unroll 1
        for (int k = 1; k < 32; ++k) if (boff[k] <= rb) e = k;
        u.pm = rb; u.e = e; u.lb = rb - boff[e]; u.pn = e * NT + (j % NT); return true;
    }
    __device__ __forceinline__ void aoffs(const pg8::Unit& u, unsigned (&ao)[2][2], const int (&R)[2], const int (&C)[2]) const {
#pragma unroll
        for (int h = 0; h < 2; ++h)
#pragma unroll
            for (int i = 0; i < 2; ++i) {
                if constexpr (GATHER) {
                    const int slot = u.lb * 256 + h * 128 + R[i]; int tok = 0;
                    if (slot < cntl[u.e]) tok = ltok[(size_t)u.e * CAP + slot];
                    ao[h][i] = (unsigned)((tok * 1024 + C[i]) * 2);
                } else ao[h][i] = (unsigned)(((u.pm * 256 + h * 128 + R[i]) * 1024 + C[i]) * 2);
            }
    }
};

namespace attn_body {
constexpr int NHEAD = FH, D = 64, PQ = 512, PO = 1024;
constexpr int NW = 8, QBLK = 32, QB = QBLK * NW, KVBLK = 64, NQB = SEQ / QB;
__device__ __forceinline__ int crow(int r, int hi) { return (r & 3) + 8 * (r >> 2) + 4 * hi; }
#define SBAR() __builtin_amdgcn_sched_barrier(0)
__device__ __forceinline__ void cmask(f32x16& p0, f32x16& p1, int jb, int qrel, int hi) {
    const float NEG = -INFINITY; int kb = 64 * jb + 4 * hi;
#pragma unroll
    for (int r = 0; r < 16; ++r) { int kv = kb + (r & 3) + 8 * (r >> 2); if (kv > qrel) p0[r] = NEG; if (kv + 32 > qrel) p1[r] = NEG; }
}
constexpr int NSLOT = 3, SLOTB = 8192;
constexpr int LDS_K = 0, LDS_V = NSLOT * SLOTB, LDS_WS = 2 * NSLOT * SLOTB, LDS_OST = LDS_WS + NW * 64 * 4, LDS_END = LDS_OST + NW * 4096;
constexpr int LDS_F = 86016, LDS_F_BYTES = SEQ * 4 + 1024;
static_assert(LDS_F >= LDS_END && LDS_F + LDS_F_BYTES <= LDS_BYTES, "attention LDS map");
__device__ __forceinline__ void glds16(const void* gsrc, unsigned lds_dst) { unsigned keep;
    asm volatile("s_mov_b32 %0, m0\n\ts_mov_b32 m0, %2\n\ts_nop 0\n\tglobal_load_lds_dwordx4 %1, off\n\ts_mov_b32 m0, %0" : "=&s"(keep) : "v"(gsrc), "s"(lds_dst) : "memory"); }
__device__ __forceinline__ float max3f(float a, float b, float c) { float r; asm("v_max3_f32 %0, %1, %2, %3" : "=v"(r) : "v"(a), "v"(b), "v"(c)); return r; }
__device__ __forceinline__ float max2f(float a, float b) { float r; asm("v_max_f32_e32 %0, %1, %2" : "=v"(r) : "v"(a), "v"(b)); return r; }
__device__ __forceinline__ float fadd_s(float a, float b) { float r; asm("v_add_f32_e32 %0, %1, %2" : "=v"(r) : "v"(a), "v"(b)); return r; }
__device__ __forceinline__ float fsub_s(float a, float b) { float r; asm("v_sub_f32_e32 %0, %1, %2" : "=v"(r) : "v"(a), "v"(b)); return r; }
#define WAIT_BAR(N) asm volatile("s_waitcnt vmcnt(" #N ") lgkmcnt(0)\n\ts_barrier" ::: "memory")

typedef LAS const char* lds_cptr;
typedef short v4i16_t __attribute__((ext_vector_type(4)));
__device__ __forceinline__ void kload8(bf16x8* kf, lds_cptr kp) {
    kf[0] = *(const LAS bf16x8*)(kp);        kf[1] = *(const LAS bf16x8*)(kp + 512);
    kf[2] = *(const LAS bf16x8*)(kp + 2048); kf[3] = *(const LAS bf16x8*)(kp + 2560);
    kf[4] = *(const LAS bf16x8*)(kp + 4096); kf[5] = *(const LAS bf16x8*)(kp + 4608);
    kf[6] = *(const LAS bf16x8*)(kp + 6144); kf[7] = *(const LAS bf16x8*)(kp + 6656);
}
__device__ __forceinline__ void kload2(bf16x8* kf, lds_cptr kp, int j) { kf[2 * j] = *(const LAS bf16x8*)(kp + j * 2048); kf[2 * j + 1] = *(const LAS bf16x8*)(kp + j * 2048 + 512); }
__device__ __forceinline__ s16x4 vtr(lds_cptr p) { return __builtin_bit_cast(s16x4, __builtin_amdgcn_ds_read_tr16_b64_v4i16((LAS v4i16_t*)p)); }
__device__ __forceinline__ float rowmax(const f32x16& p0, const f32x16& p1) {
    float a = max3f(p0[0], p0[1], p1[0]), b = max3f(p0[2], p0[3], p1[1]); a = max3f(a, p1[2], p1[3]);
#pragma unroll
    for (int r = 4; r < 16; r += 4) { a = max3f(a, p0[r], p0[r + 1]); b = max3f(b, p0[r + 2], p0[r + 3]); a = max3f(a, p1[r], p1[r + 1]); b = max3f(b, p1[r + 2], p1[r + 3]); }
    const float m = max2f(a, b);
    auto rr = __builtin_amdgcn_permlane32_swap(__float_as_uint(m), __float_as_uint(m), false, false);
    return max2f(__uint_as_float(rr[0]), __uint_as_float(rr[1]));
}
__device__ __forceinline__ void pv(f32x16* o, int vb, bf16x8 pa0, bf16x8 pa1, bf16x8 pa2, bf16x8 pa3) {
#pragma unroll
    for (int d0 = 0; d0 < 2; ++d0) { s16x4 lo[4], hi[4];
#pragma unroll
        for (int ks = 0; ks < 4; ++ks) {
            asm volatile("ds_read_b64_tr_b16 %0,%1 offset:%c2" : "=&v"(lo[ks]) : "v"(vb), "i"(d0 * 4096 + ks * 1024) : "memory");
            asm volatile("ds_read_b64_tr_b16 %0,%1 offset:%c2" : "=&v"(hi[ks]) : "v"(vb), "i"(d0 * 4096 + ks * 1024 + 512) : "memory"); }
        asm volatile("s_waitcnt lgkmcnt(0)" ::: "memory"); SBAR();
#define PK(k) (bf16x8){lo[k][0], lo[k][1], lo[k][2], lo[k][3], hi[k][0], hi[k][1], hi[k][2], hi[k][3]}
        o[d0] = __builtin_amdgcn_mfma_f32_32x32x16_bf16(pa0, PK(0), o[d0], 0, 0, 0);
        o[d0] = __builtin_amdgcn_mfma_f32_32x32x16_bf16(pa1, PK(1), o[d0], 0, 0, 0);
        o[d0] = __builtin_amdgcn_mfma_f32_32x32x16_bf16(pa2, PK(2), o[d0], 0, 0, 0);
        o[d0] = __builtin_amdgcn_mfma_f32_32x32x16_bf16(pa3, PK(3), o[d0], 0, 0, 0);
#undef PK
    }
}

template <int THRL> __device__ __forceinline__ void attn_unit(int b, int h, int qb, const bf16_t* Q, const bf16_t* __restrict__ K, const bf16_t* __restrict__ V, bf16_t* O, const float* __restrict__ F2, char* shm) {
    const int tid = threadIdx.x, lane = tid & 63, r32 = lane & 31, hi = lane >> 5; const int wid = __builtin_amdgcn_readfirstlane(tid >> 6);
    const long rowbase = (long)b * SEQ; const int q0 = qb * QB;
    const bf16_t* Qw = Q + (rowbase + q0 + wid * QBLK) * PQ + h * D;
    const bf16_t* Kh = K + rowbase * PQ + h * D, *Vh = V + rowbase * PQ + h * D;
    const unsigned lds0 = (unsigned)(uintptr_t)shm;
    float* wsf = (float*)(shm + LDS_WS) + wid * 64;
    { const f32x4* Fg = (const f32x4*)(F2 + (size_t)(b * NHEAD + h) * SEQ); LAS f32x4* Fl4 = (LAS f32x4*)((LAS char*)(lds_cptr)shm + LDS_F); const int n4 = (q0 + QB) / 4;
      for (int p = tid; p < n4; p += NW * 64) Fl4[p] = Fg[p]; }
    const LAS float* Fl = (const LAS float*)((lds_cptr)shm + LDS_F);
    asm volatile("s_waitcnt vmcnt(0) lgkmcnt(0)" ::: "memory");
    const bf16_t* ksrc = Kh + (long)lane * PQ + wid * 8;
    const bf16_t* vsrc = Vh + (long)(16 * (wid & 3) + (lane >> 2)) * PQ + (wid >> 2) * 32 + (lane & 3) * 8;
    const unsigned kdst = lds0 + LDS_K + wid * 1024, vdst = lds0 + LDS_V + wid * 1024;
#define DMA_K(t, slot) glds16(ksrc + (long)(t) * KVBLK * PQ, (unsigned)__builtin_amdgcn_readfirstlane(kdst + (slot)))
#define DMA_V(t, slot) glds16(vsrc + (long)(t) * KVBLK * PQ, (unsigned)__builtin_amdgcn_readfirstlane(vdst + (slot)))
    const int vb0 = (int)(lds0 + LDS_V) + ((lane >> 4) & 1) * 32 + (lane & 3) * 8 + (4 * hi + ((lane & 15) >> 2)) * 64;
    bf16x8 kf[8];
    const lds_cptr shm3 = (lds_cptr)shm; const lds_cptr kp0 = shm3 + LDS_K + hi * 1024 + r32 * 16; const lds_cptr vp0 = shm3 + LDS_V + ((lane >> 4) & 1) * 32 + (lane & 3) * 8 + (4 * hi + ((lane & 15) >> 2)) * 64;
    const int NT = (q0 + QB) / KVBLK;
    DMA_K(0, 0); DMA_V(0, 0); DMA_K(1, SLOTB);
    bf16x8 qr[4];
#pragma unroll
    for (int d0 = 0; d0 < 4; ++d0) qr[d0] = *reinterpret_cast<const bf16x8*>(&Qw[(long)r32 * PQ + d0 * 16 + hi * 8]);
    float mhat = 0.f, l_reg = 0.f, nm = 0.f; f32x16 o[2]; o[0] = f32x16{}; o[1] = f32x16{};
    f32x4 fa[4], fb[4];
#define FLD(tt) do { const LAS float* fp_ = Fl + 64 * (tt) + 4 * hi; _Pragma("unroll") for (int g_ = 0; g_ < 4; ++g_) { fa[g_] = *(const LAS f32x4*)(fp_ + 8 * g_); fb[g_] = *(const LAS f32x4*)(fp_ + 32 + 8 * g_); } } while (0)
#define CINIT(C0, C1) do { _Pragma("unroll") for (int g_ = 0; g_ < 4; ++g_) { _Pragma("unroll") for (int e_ = 0; e_ < 4; ++e_) { C0[4 * g_ + e_] = nm - fa[g_][e_]; C1[4 * g_ + e_] = nm - fb[g_][e_]; } } } while (0)
    const int qrel = wid * QBLK + r32;
#define CMASK(P0, P1, t) do { int jb_ = (t) - (NT - 4); if (jb_ >= 0) cmask(P0, P1, jb_, qrel, hi); } while (0)
    bool resc = false;
#define START(P0, P1) do { const float rm = rowmax(P0, P1); resc = false; \
    { const float dl = rm; mhat = fadd_s(mhat, dl); \
      _Pragma("unroll") for (int r = 0; r < 16; ++r) { P0[r] = fsub_s(P0[r], dl); P1[r] = fsub_s(P1[r], dl); } \
      nm = -mhat; } \
    _Pragma("unroll") for (int r = 0; r < 16; ++r) P0[r] = __builtin_amdgcn_exp2f(P0[r]); } while (0)
#define RESC() do { if (resc) { asm volatile("s_waitcnt lgkmcnt(0)" ::: "memory"); \
      _Pragma("unroll") for (int d_ = 0; d_ < 2; ++d_) _Pragma("unroll") for (int r = 0; r < 16; ++r) o[d_][r] *= wsf[crow(r, hi)]; } } while (0)
    f32x16 pA0, pA1, pB0, pB1;
    int sl_prev = 0, sl_cur = 0, sl_next = SLOTB;
#define ROT() do { sl_prev = sl_cur; sl_cur = sl_next; sl_next = (sl_next == (NSLOT - 1) * SLOTB) ? 0 : sl_next + SLOTB; } while (0)
    DMA_K(2, 2 * SLOTB);
    WAIT_BAR(3);
    FLD(0); CINIT(pA0, pA1);
    { const lds_cptr kb = shm3 + LDS_K + hi * 1024 + r32 * 16;
#pragma unroll
      for (int d0 = 0; d0 < 4; ++d0) { const bf16x8 b0 = *(const LAS bf16x8*)(kb + d0 * 2048); const bf16x8 b1 = *(const LAS bf16x8*)(kb + d0 * 2048 + 512);
          pA0 = __builtin_amdgcn_mfma_f32_32x32x16_bf16(b0, qr[d0], pA0, 0, 0, 0); pA1 = __builtin_amdgcn_mfma_f32_32x32x16_bf16(b1, qr[d0], pA1, 0, 0, 0); } }
    asm volatile("s_nop 15\n\ts_nop 7" : "+v"(pA0), "+v"(pA1)); CMASK(pA0, pA1, 0);
    START(pA0, pA1);
    _Pragma("unroll") for (int r = 0; r < 16; ++r) pA1[r] = __builtin_amdgcn_exp2f(pA1[r]);
    FLD(1);
    WAIT_BAR(0);
    DMA_K(3, 0); DMA_V(1, SLOTB);
    ROT();
    kload8(kf, kp0 + sl_cur);
    WAIT_BAR(2);
    s16x4 vlo[8], vhi[8]; u32x4 pw0, pw1, pw2, pw3;
#define PKW(P, B) cvtpk(P[B], P[B + 1])
#define PAF(k) __builtin_bit_cast(bf16x8, pw##k)
#define VFR(i) (bf16x8){vlo[i][0], vlo[i][1], vlo[i][2], vlo[i][3], vhi[i][0], vhi[i][1], vhi[i][2], vhi[i][3]}
#define PIN(x) asm volatile("" : "+v"(x))
#define MX3(a, b, c) __builtin_fmaxf(__builtin_fmaxf((a), (b)), (c))
#define GAPA(MF, A0, A1, A2, A3, W0, W1, PW) do { MF; sacc += A0; sacc += A1; sacc += A2; sacc += A3; PIN(sacc); W0; W1; PIN(PW); SBAR(); } while (0)
#define EX(v) __builtin_amdgcn_exp2f(v)
#define GAPB(MF, X, B) do { MF; X[B] = EX(X[B]); X[B + 1] = EX(X[B + 1]); X[B + 2] = EX(X[B + 2]); X[B + 3] = EX(X[B + 3]); PIN(X); SBAR(); } while (0)
#define VRD(i) do { vlo[i] = vtr(vp_ + (((i) >> 2) * 4096 + ((i) & 3) * 1024)); vhi[i] = vtr(vp_ + (((i) >> 2) * 4096 + ((i) & 3) * 1024 + 512)); } while (0)
#define KRD(G, j) do { if (G) { kload2(kf, kp0 + sl_next, j); SBAR(); } } while (0)
#define STEP(C0, C1, P0, P1, t, GK, GV, GL) do { SBAR(); \
    CINIT(C0, C1); SBAR(); \
    const lds_cptr vp_ = vp0 + sl_prev; \
    VRD(0); SBAR(); float sacc = (P0[0] + P0[1]); \
    GAPA(C0 = __builtin_amdgcn_mfma_f32_32x32x16_bf16(kf[0], qr[0], C0, 0, 0, 0), P0[2], P0[3], P0[4], P0[5],     pw0[0] = PKW(P0, 0), pw0[1] = PKW(P0, 2), pw0); \
    VRD(4); SBAR(); GAPA(C1 = __builtin_amdgcn_mfma_f32_32x32x16_bf16(kf[1], qr[0], C1, 0, 0, 0), P0[6], P0[7], P0[8], P0[9],     pw0[2] = PKW(P0, 4), pw0[3] = PKW(P0, 6), pw0); \
    VRD(1); SBAR(); GAPA(C0 = __builtin_amdgcn_mfma_f32_32x32x16_bf16(kf[2], qr[1], C0, 0, 0, 0),   P0[10], P0[11], P0[12], P0[13], pw1[0] = PKW(P0, 8), pw1[1] = PKW(P0, 10), pw1); \
    VRD(5); SBAR(); GAPA(C1 = __builtin_amdgcn_mfma_f32_32x32x16_bf16(kf[3], qr[1], C1, 0, 0, 0),   P0[14], P0[15], P1[0], P1[1],   pw1[2] = PKW(P0, 12), pw1[3] = PKW(P0, 14), pw1); \
    VRD(2); SBAR(); GAPA(C0 = __builtin_amdgcn_mfma_f32_32x32x16_bf16(kf[4], qr[2], C0, 0, 0, 0),   P1[2], P1[3], P1[4], P1[5],     pw2[0] = PKW(P1, 0), pw2[1] = PKW(P1, 2), pw2); \
    VRD(6); SBAR(); GAPA(C1 = __builtin_amdgcn_mfma_f32_32x32x16_bf16(kf[5], qr[2], C1, 0, 0, 0),   P1[6], P1[7], P1[8], P1[9],     pw2[2] = PKW(P1, 4), pw2[3] = PKW(P1, 6), pw2); \
    VRD(3); SBAR(); GAPA(C0 = __builtin_amdgcn_mfma_f32_32x32x16_bf16(kf[6], qr[3], C0, 0, 0, 0),   P1[10], P1[11], P1[12], P1[13], pw3[0] = PKW(P1, 8), pw3[1] = PKW(P1, 10), pw3); \
    VRD(7); SBAR(); GAPA(C1 = __builtin_amdgcn_mfma_f32_32x32x16_bf16(kf[7], qr[3], C1, 0, 0, 0),   P1[14], P1[15], 0.f, 0.f,       pw3[2] = PKW(P1, 12), pw3[3] = PKW(P1, 14), pw3); \
    l_reg += sacc; \
    if (GK) { DMA_K((t) + 3, sl_cur); } if (GV) { DMA_V((t) + 1, sl_next); } \
    CMASK(C0, C1, t); \
    { float a = MX3(C0[0], C0[1], C1[0]), b = MX3(C0[2], C0[3], C1[1]); a = MX3(a, C1[2], C1[3]); \
      _Pragma("unroll") for (int r = 4; r < 16; r += 4) { a = MX3(a, C0[r], C0[r + 1]); b = MX3(b, C0[r + 2], C0[r + 3]); a = MX3(a, C1[r], C1[r + 1]); b = MX3(b, C1[r + 2], C1[r + 3]); } \
      float rm = __builtin_fmaxf(a, b); { auto rr = __builtin_amdgcn_permlane32_swap(__float_as_uint(rm), __float_as_uint(rm), false, false); rm = __builtin_fmaxf(__uint_as_float(rr[0]), __uint_as_float(rr[1])); } \
      resc = false; \
      if (__builtin_expect(__any(rm > (float)THRL), 0)) { const float dl = __builtin_fmaxf(rm, 0.f); mhat += dl; \
        _Pragma("unroll") for (int r = 0; r < 16; ++r) { C0[r] -= dl; C1[r] -= dl; } \
        nm = -mhat; \
        const float f = __builtin_amdgcn_exp2f(-dl); l_reg *= f; if (hi == 0) wsf[r32] = f; resc = true; } } \
    SBAR(); \
    GAPB(o[0] = __builtin_amdgcn_mfma_f32_32x32x16_bf16(PAF(0), VFR(0), o[0], 0, 0, 0), C0, 0); \
    GAPB(o[1] = __builtin_amdgcn_mfma_f32_32x32x16_bf16(PAF(0), VFR(4), o[1], 0, 0, 0), C0, 4); \
    KRD(GL, 0); GAPB(o[0] = __builtin_amdgcn_mfma_f32_32x32x16_bf16(PAF(1), VFR(1), o[0], 0, 0, 0), C0, 8); \
    KRD(GL, 1); GAPB(o[1] = __builtin_amdgcn_mfma_f32_32x32x16_bf16(PAF(1), VFR(5), o[1], 0, 0, 0), C0, 12); \
    KRD(GL, 2); GAPB(o[0] = __builtin_amdgcn_mfma_f32_32x32x16_bf16(PAF(2), VFR(2), o[0], 0, 0, 0), C1, 0); \
    KRD(GL, 3); GAPB(o[1] = __builtin_amdgcn_mfma_f32_32x32x16_bf16(PAF(2), VFR(6), o[1], 0, 0, 0), C1, 4); \
    GAPB(o[0] = __builtin_amdgcn_mfma_f32_32x32x16_bf16(PAF(3), VFR(3), o[0], 0, 0, 0), C1, 8); \
    GAPB(o[1] = __builtin_amdgcn_mfma_f32_32x32x16_bf16(PAF(3), VFR(7), o[1], 0, 0, 0), C1, 12); \
    FLD((t) + 1); \
    } while (0)
    int t = 1;
#undef CMASK
#define CMASK(P0, P1, t) do { } while (0)
    for (; t + 5 < NT; t += 2) {
        STEP(pB0, pB1, pA0, pA1, t, true, true, true);     WAIT_BAR(2); RESC(); ROT();
        STEP(pA0, pA1, pB0, pB1, t + 1, true, true, true);   WAIT_BAR(2); RESC(); ROT();
    }
#undef CMASK
#define CMASK(P0, P1, t) do { int jb_ = (t) - (NT - 4); if (jb_ >= 0) cmask(P0, P1, jb_, qrel, hi); } while (0)
#define ENDW(tt) do { if ((tt) + 3 < NT) { WAIT_BAR(2); } else if ((tt) + 2 < NT) { WAIT_BAR(1); } else { WAIT_BAR(0); } } while (0)
    for (; t + 1 < NT; t += 2) {
        STEP(pB0, pB1, pA0, pA1, t, (t + 3 < NT), (t + 1 < NT), (t + 1 < NT));       ENDW(t);   RESC(); ROT();
        STEP(pA0, pA1, pB0, pB1, t + 1, (t + 4 < NT), (t + 2 < NT), (t + 2 < NT));     ENDW(t + 1); RESC(); ROT();
    }
    STEP(pB0, pB1, pA0, pA1, NT - 1, false, false, false); RESC();
    { float sacc = pB0[0] + pB0[1]; _Pragma("unroll") for (int r = 2; r < 16; ++r) sacc += pB0[r]; _Pragma("unroll") for (int r = 0; r < 16; ++r) sacc += pB1[r]; l_reg += sacc;
      pw0 = (u32x4){PKW(pB0, 0), PKW(pB0, 2), PKW(pB0, 4), PKW(pB0, 6)}; pw1 = (u32x4){PKW(pB0, 8), PKW(pB0, 10), PKW(pB0, 12), PKW(pB0, 14)}; pw2 = (u32x4){PKW(pB1, 0), PKW(pB1, 2), PKW(pB1, 4), PKW(pB1, 6)}; pw3 = (u32x4){PKW(pB1, 8), PKW(pB1, 10), PKW(pB1, 12), PKW(pB1, 14)};
      SBAR(); pv(o, vb0 + sl_cur, PAF(0), PAF(1), PAF(2), PAF(3)); }
#undef PKW
#undef PAF
#undef VFR
#undef PIN
#undef MX3
#undef GAPA
#undef GAPB
#undef EX
#undef VRD
#undef KRD
#undef STEP
#undef ENDW
    { auto rr = __builtin_amdgcn_permlane32_swap(__float_as_uint(l_reg), __float_as_uint(l_reg), false, false); l_reg = __uint_as_float(rr[0]) + __uint_as_float(rr[1]); }
    if (hi == 0) wsf[32 + r32] = l_reg; asm volatile("s_waitcnt lgkmcnt(0)" ::: "memory");
    float rli[16];
#pragma unroll
    for (int r = 0; r < 16; ++r) rli[r] = __builtin_amdgcn_rcpf(wsf[32 + crow(r, hi)]);
    bf16_t* Ow = O + (rowbase + q0 + wid * QBLK) * PO + h * D;
    { bf16_t* stg = (bf16_t*)(shm + LDS_OST) + wid * 2048;
#pragma unroll
      for (int r = 0; r < 16; ++r) { const int orow = crow(r, hi);
#pragma unroll
          for (int d0 = 0; d0 < 2; ++d0) { const float v = o[d0][r] * rli[r]; stg[orow * 64 + d0 * 32 + r32] = (bf16_t)(cvtpk(v, v) & 0xffffu); } }
      asm volatile("s_waitcnt lgkmcnt(0)" ::: "memory");
#pragma unroll
      for (int i = 0; i < 4; ++i) { const int row = i * 8 + (lane >> 3), ch = lane & 7; const u32x4 v = *(const u32x4*)(stg + row * 64 + ch * 8); *(u32x4*)(Ow + (long)row * PO + ch * 8) = v; } }
    asm volatile("s_waitcnt lgkmcnt(0)\n\ts_barrier" ::: "memory");
#undef DMA_K
#undef DMA_V
#undef CMASK
#undef START
#undef RESC
#undef ROT
#undef FLD
#undef CINIT
}
#undef SBAR
#undef WAIT_BAR
}

namespace ret {
constexpr int RS = 272;
constexpr int IMG_Q = 0, IMG_K = 64 * RS, IMG_KT = 2 * 64 * RS, IMG_V = 3 * 64 * RS;
constexpr int PS = 144;
constexpr int IMG_P = 4 * 64 * RS;
constexpr int IMG_ST = IMG_P + 64 * PS;
constexpr int OS = 132;
constexpr int IMG_O = IMG_ST + 128 * RS;
constexpr int LDS_END = IMG_O + 64 * OS * 4;
static_assert(LDS_END <= LDS_BYTES, "retention LDS map");
typedef short v4i16_t __attribute__((ext_vector_type(4)));
__device__ __forceinline__ s16x4 tr4(LAS const char* p) { return __builtin_bit_cast(s16x4, __builtin_amdgcn_ds_read_tr16_b64_v4i16((LAS v4i16_t*)p)); }
__device__ __forceinline__ bf16x8 frag_tr(LAS const char* img, int stride, int k0, int c0, int lane) {
    const int g4 = lane >> 4, i = lane & 15, qq = i >> 2, p = i & 3, hh = g4 >> 1, nh = g4 & 1;
    LAS const char* a = img + (k0 + 8 * hh + qq) * stride + (c0 + 16 * nh + 4 * p) * 2;
    const s16x4 lo = tr4(a), hi = tr4(a + 4 * stride);
    return (bf16x8){lo[0], lo[1], lo[2], lo[3], hi[0], hi[1], hi[2], hi[3]};
}
__device__ __forceinline__ bf16x8 frag_row(LAS const char* img, int stride, int r0, int k0, int lane) {
    return *(const LAS bf16x8*)(img + (r0 + (lane & 31)) * stride + (k0 + 8 * (lane >> 5)) * 2);
}
__device__ __forceinline__ int crow(int r, int hi) { return (r & 3) + 8 * (r >> 2) + 4 * hi; }

template <bool APPLY>
__device__ __forceinline__ void unit(int bh, int g, const bf16_t* RQ, const bf16_t* RK, const bf16_t* RV, const bf16_t* SG, float* GST, bf16_t* MIX, LAS char* lds) {
    int tid_ = threadIdx.x; asm volatile("" : "+v"(tid_));
    const int tid = tid_, lane = tid & 63, hi = lane >> 5; const int w = __builtin_amdgcn_readfirstlane(tid >> 6);
    const int b = bh >> 2, h = bh & 3;
    const float l2g = log2f(1.0f - exp2f(-5.0f - (float)h));
    const float cd = exp2f(64.0f * l2g);
    const size_t row0 = (size_t)b * SEQ + (size_t)g * 512;
    u32x4 rq[2], rk[2], rv[2];
    auto issue = [&](int j) {
#pragma unroll
        for (int i = 0; i < 2; ++i) { const int p = tid + 512 * i, row = p >> 4, ch = p & 15; const size_t off = (row0 + j * 64 + row) * 512 + h * 128 + ch * 8;
            if (APPLY) rq[i] = *(const u32x4*)(RQ + off);
            rk[i] = *(const u32x4*)(RK + off); rv[i] = *(const u32x4*)(RV + off); }
    };
    const int db = w >> 1, eb0 = 2 * (w & 1);
    f32x16 S0 = f32x16{}, S1 = f32x16{};
    if (APPLY) {
        const float Gm = exp2f(512.0f * l2g);
        for (int gp = 0; gp < g; ++gp) {
            const float* src = GST + ((((size_t)(bh * 16 + gp) * 8 + w) * 2) * 16) * 64 + lane;
#pragma unroll
            for (int r = 0; r < 16; ++r) { S0[r] = S0[r] * Gm + src[r * 64]; S1[r] = S1[r] * Gm + src[(16 + r) * 64]; }
        }
    }
    issue(0);
    for (int j = 0; j < 8; ++j) {
#pragma unroll
        for (int i = 0; i < 2; ++i) { const int p = tid + 512 * i, row = p >> 4, ch = p & 15; const int o = row * RS + ch * 16;
            if (APPLY) { *(LAS u32x4*)(lds + IMG_Q + o) = rq[i]; *(LAS u32x4*)(lds + IMG_K + o) = rk[i]; }
            *(LAS u32x4*)(lds + IMG_V + o) = rv[i];
            const float kw = exp2f((float)(63 - row) * l2g);
            u32x4 kt;
#pragma unroll
            for (int e = 0; e < 4; ++e) kt[e] = cvtpk(bflo(rk[i][e]) * kw, bfhi(rk[i][e]) * kw);
            *(LAS u32x4*)(lds + IMG_KT + o) = kt; }
        if (APPLY) {
#pragma unroll
            for (int tile = 0; tile < 2; ++tile) { const f32x16& S = tile ? S1 : S0; const int e = (eb0 + tile) * 32 + (lane & 31);
#pragma unroll
                for (int g4 = 0; g4 < 4; ++g4) { const int d = db * 32 + 8 * g4 + 4 * hi; u32x2 v; v.x = cvtpk(S[4 * g4], S[4 * g4 + 1]); v.y = cvtpk(S[4 * g4 + 2], S[4 * g4 + 3]);
                    *(LAS u32x2*)(lds + IMG_ST + e * RS + d * 2) = v; } }
        }
        if (j + 1 < 8) issue(j + 1);
        LDS_WAIT(); __builtin_amdgcn_s_barrier();
        f32x16 oin = f32x16{}, oit = f32x16{};
        const int qb = w >> 2, eb = w & 3;
        if (APPLY) {
#pragma unroll
            for (int s = 0; s < 8; ++s) oin = __builtin_amdgcn_mfma_f32_32x32x16_bf16(frag_row(lds + IMG_Q, RS, qb * 32, s * 16, lane), frag_row(lds + IMG_ST, RS, eb * 32, s * 16, lane), oin, 0, 0, 0);
            if (w < 4) {
                const int tb = w >> 1, qb2 = w & 1; f32x16 sc = f32x16{};
#pragma unroll
                for (int s = 0; s < 8; ++s) sc = __builtin_amdgcn_mfma_f32_32x32x16_bf16(frag_row(lds + IMG_K, RS, tb * 32, s * 16, lane), frag_row(lds + IMG_Q, RS, qb2 * 32, s * 16, lane), sc, 0, 0, 0);
                const int q = qb2 * 32 + (lane & 31);
#pragma unroll
                for (int g4 = 0; g4 < 4; ++g4) { const int t0 = tb * 32 + 8 * g4 + 4 * hi; float pv4[4];
#pragma unroll
                    for (int e = 0; e < 4; ++e) { const int dd = q - (t0 + e); pv4[e] = sc[4 * g4 + e] * exp2f((float)(dd < 0 ? -dd : dd) * l2g); }
                    u32x2 v; v.x = cvtpk(pv4[0], pv4[1]); v.y = cvtpk(pv4[2], pv4[3]);
                    *(LAS u32x2*)(lds + IMG_P + q * PS + t0 * 2) = v; }
            }
            LDS_WAIT(); __builtin_amdgcn_s_barrier();
#pragma unroll
            for (int s = 0; s < 4; ++s) oit = __builtin_amdgcn_mfma_f32_32x32x16_bf16(frag_row(lds + IMG_P, PS, qb * 32, s * 16, lane), frag_tr(lds + IMG_V, RS, s * 16, eb * 32, lane), oit, 0, 0, 0);
#pragma unroll
            for (int r = 0; r < 16; ++r) { const int q = qb * 32 + crow(r, hi); const float qw = exp2f((float)(q + 1) * l2g);
                *(LAS float*)(lds + IMG_O + (q * OS + eb * 32 + (lane & 31)) * 4) = oit[r] + qw * oin[r]; }
        }
#pragma unroll
        for (int r = 0; r < 16; ++r) { S0[r] *= cd; S1[r] *= cd; }
#pragma unroll
        for (int s = 0; s < 4; ++s) { const bf16x8 a = frag_tr(lds + IMG_KT, RS, s * 16, db * 32, lane);
            S0 = __builtin_amdgcn_mfma_f32_32x32x16_bf16(a, frag_tr(lds + IMG_V, RS, s * 16, eb0 * 32, lane), S0, 0, 0, 0);
            S1 = __builtin_amdgcn_mfma_f32_32x32x16_bf16(a, frag_tr(lds + IMG_V, RS, s * 16, (eb0 + 1) * 32, lane), S1, 0, 0, 0); }
        LDS_WAIT(); __builtin_amdgcn_s_barrier();
        if (APPLY) {
#pragma unroll
            for (int rr = 0; rr < 8; ++rr) { const int q = w * 8 + rr; const f32x2 v = *(const LAS f32x2*)(lds + IMG_O + (q * OS + 2 * lane) * 4);
                const float mu = wave_sum(v.x + v.y) * (1.0f / 128.0f); const float dx = v.x - mu, dy = v.y - mu;
                const float var = wave_sum(dx * dx + dy * dy) * (1.0f / 128.0f); const float rstd = rsqrtf(var + GN_EPS);
                const size_t trow = row0 + j * 64 + q; const unsigned gw = *(const unsigned*)(SG + trow * 512 + h * 128 + 2 * lane);
                *(unsigned*)(MIX + trow * 1024 + h * 128 + 2 * lane) = cvtpk(dx * rstd * bflo(gw), dy * rstd * bfhi(gw)); }
        }
    }
    if (!APPLY) {
        float* dst = GST + ((((size_t)(bh * 16 + g) * 8 + w) * 2) * 16) * 64 + lane;
#pragma unroll
        for (int r = 0; r < 16; ++r) { dst[r * 64] = S0[r]; dst[(16 + r) * 64] = S1[r]; }
    }
    LDS_WAIT(); __builtin_amdgcn_s_barrier();
}
}


#define XB_TMO      128
#define XB_XCNT(j)  (256  + 64 * (j))
#define XB_XSUB(j)  (1280 + 64 * (j))
#define XB_XGEN(j)  (2304 + 64 * (j))
#define XB_TOP      3328
#define XB_TOPGEN   3392
#define XCD_BAR_WORDS 3456
#define XB_SPIN_CAP (1u << 18)
__device__ __forceinline__ unsigned xb_ld(unsigned* p)              { return __hip_atomic_load(p, __ATOMIC_RELAXED, __HIP_MEMORY_SCOPE_AGENT); }
__device__ __forceinline__ unsigned xb_add(unsigned* p, unsigned v) { return __hip_atomic_fetch_add(p, v, __ATOMIC_RELAXED, __HIP_MEMORY_SCOPE_AGENT); }
__device__ __forceinline__ unsigned xb_xcc_id() { return (unsigned)__builtin_amdgcn_s_getreg((3 << 11) | 20) & 0xFu; }
#define XB_SPIN(cond, bar) do { unsigned _sp = 0; while (cond) { __builtin_amdgcn_s_sleep(1); \
    if ((++_sp & 255u) == 0u) { if (xb_ld(&(bar)[XB_TMO])) break; if (_sp > XB_SPIN_CAP) { atomicAdd(&(bar)[XB_TMO], 1u); break; } } } } while (0)
struct XcdBarrier { unsigned* bar; unsigned x; volatile LAS unsigned* st; };
__device__ __forceinline__ XcdBarrier xcd_barrier_post(unsigned* bar, volatile LAS unsigned* st) {
    XcdBarrier b; b.bar = bar; b.x = xb_xcc_id(); b.st = st;
    if (threadIdx.x == 0) (void)xb_add(&bar[XB_XCNT(b.x)], 1u);
    return b;
}
__device__ __forceinline__ void xcd_barrier_complete(unsigned* bar, unsigned x, unsigned& nloc, unsigned& nx) {
    const unsigned G = gridDim.x * gridDim.y * gridDim.z;
    unsigned sum, cnt, mine, sp = 0u;
    for (;;) {
        sum = 0u; cnt = 0u; mine = 0u;
#pragma unroll
        for (unsigned j = 0; j < 16; ++j) { const unsigned c = xb_ld(&bar[XB_XCNT(j)]); sum += c; cnt += (c > 0u) ? 1u : 0u; mine = (j == x) ? c : mine; }
        if (sum == G) break;
        __builtin_amdgcn_s_sleep(1);
        if ((++sp & 255u) == 0u) { if (xb_ld(&bar[XB_TMO])) break; if (sp > XB_SPIN_CAP) { atomicAdd(&bar[XB_TMO], 1u); break; } }
    }
    nloc = mine > 0u ? mine : 1u; nx = cnt > 0u ? cnt : 1u;
}
__device__ __forceinline__ void xcd_barrier(const XcdBarrier& b) {
    asm volatile("s_waitcnt vmcnt(0)" ::: "memory");
    __syncthreads();
    if (threadIdx.x == 0) {
        unsigned* bar = b.bar;
        __builtin_amdgcn_s_waitcnt(0);
        unsigned nloc = b.st[0], nx = b.st[1];
        if (nloc == 0u) { xcd_barrier_complete(bar, b.x, nloc, nx); b.st[0] = nloc; b.st[1] = nx; }
        const unsigned old = xb_add(&bar[XB_XSUB(b.x)], 1u);
        const unsigned gen = old / nloc;
        if (old + 1u == (gen + 1u) * nloc) {
            __builtin_amdgcn_fence(__ATOMIC_RELEASE, "agent");
            asm volatile("s_waitcnt vmcnt(0)" ::: "memory");
            const unsigned og = xb_add(&bar[XB_TOP], 1u);
            const unsigned tg = og / nx;
            if (og + 1u == (tg + 1u) * nx) xb_add(&bar[XB_TOPGEN], 1u);
            else XB_SPIN(xb_ld(&bar[XB_TOPGEN]) == tg, bar);
            __builtin_amdgcn_fence(__ATOMIC_ACQUIRE, "agent");
            xb_add(&bar[XB_XGEN(b.x)], 1u);
            asm volatile("s_waitcnt vmcnt(0)" ::: "memory");
        } else {
            XB_SPIN(xb_ld(&bar[XB_XGEN(b.x)]) == gen, bar);
            __builtin_amdgcn_fence(__ATOMIC_ACQUIRE, "agent");
            asm volatile("s_waitcnt vmcnt(0)" ::: "memory");
        }
    }
    __syncthreads();
}

struct Frame {
    LAS unsigned char* lds; int tid, lane, wave, vcu, G;
};

__device__ __forceinline__ void tr_item(const float* __restrict__ W, int ldw, int k0, int n0, const float* __restrict__ gk, bf16_t* WT, int kind, LAS unsigned* scr, int lane) {
    const int nch = lane & 15, kq = lane >> 4;
    f32x4 a[8], b[8];
#pragma unroll
    for (int i = 0; i < 8; ++i) { const int kp = 4 * i + kq; const float* p = W + (size_t)(k0 + 2 * kp) * ldw + n0 + 4 * nch; a[i] = *(const f32x4*)p; b[i] = *(const f32x4*)(p + ldw); }
#pragma unroll
    for (int i = 0; i < 8; ++i) { const int kp = 4 * i + kq; float ga = 1.f, gb = 1.f; if (gk) { ga = gk[k0 + 2 * kp]; gb = gk[k0 + 2 * kp + 1]; }
#pragma unroll
        for (int e = 0; e < 4; ++e) scr[(4 * nch + e) * 36 + kp] = cvtpk(a[i][e] * ga, b[i][e] * gb); }
    LDS_WAIT(); asm volatile("" ::: "memory");
    const int c = lane & 7, nr = lane >> 3;
#pragma unroll
    for (int j = 0; j < 8; ++j) { const int n = nr + 8 * j; const u32x4 v = *(const LAS u32x4*)(scr + n * 36 + 4 * c);
        const int cn = n0 + n; const int row = (kind == 0) ? pos_inproj(cn) : (kind == 1) ? pos_plain(cn) : pos_w1(cn);
        *(u32x4*)(WT + (size_t)row * 1024 + k0 + 8 * c) = v; }
    LDS_WAIT(); asm volatile("" ::: "memory");
}

__global__ void __launch_bounds__(NTHREADS, 2) mk_fwd(Params P) {
    __builtin_assume(__builtin_amdgcn_workitem_id_y() == 0); __builtin_assume(__builtin_amdgcn_workitem_id_z() == 0);
    extern __shared__ __attribute__((aligned(16))) unsigned char lds_raw[];
    cg::grid_group grid = cg::this_grid();
    Frame F; F.lds = (LAS unsigned char*)lds_raw; F.tid = threadIdx.x; F.lane = F.tid & 63; F.wave = __builtin_amdgcn_readfirstlane(F.tid >> 6);
    F.G = gridDim.x; { const int bx = blockIdx.x; F.vcu = (F.G % 8 == 0) ? (bx % 8) * (F.G / 8) + bx / 8 : bx; }
    unsigned char* ws = P.ws;
    unsigned* ctl = (unsigned*)(ws + WS_CTL);
    float* ropec = (float*)(ws + WS_ROPEC); float* ropes = (float*)(ws + WS_ROPES);
    float* wr3 = (float*)(ws + WS_WR3); float* logf2 = (float*)(ws + WS_LOGF); float* F2 = (float*)(ws + WS_F2);
    int* ltok = (int*)(ws + WS_LTOK); float* lrstd = (float*)(ws + WS_LRSTD); int* inv = (int*)(ws + WS_INV); float* gates = (float*)(ws + WS_GATE);
    bf16_t* H1B = (bf16_t*)(ws + WS_H1B); bf16_t* WinT = (bf16_t*)(ws + WS_WINT); bf16_t* WoT = (bf16_t*)(ws + WS_WOT);
    bf16_t* W2T = (bf16_t*)(ws + WS_W2T); bf16_t* W1T = (bf16_t*)(ws + WS_W1T); bf16_t* Yb = (bf16_t*)(ws + WS_Y);
    bf16_t* U = (bf16_t*)(ws + WS_U); unsigned char* proj = ws + WS_PROJ;
    bf16_t* RQ = (bf16_t*)(proj); bf16_t* RK = (bf16_t*)(proj + PROJ_STRIDE); bf16_t* RV = (bf16_t*)(proj + 2 * PROJ_STRIDE); bf16_t* SG = (bf16_t*)(proj + 3 * PROJ_STRIDE);
    bf16_t* FQ = (bf16_t*)(proj + 4 * PROJ_STRIDE); bf16_t* FK = (bf16_t*)(proj + 5 * PROJ_STRIDE); bf16_t* FV = (bf16_t*)(proj + 6 * PROJ_STRIDE);
    float* GST = (float*)(ws + WS_GST); bf16_t* MIX = (bf16_t*)(ws + WS_MIX); bf16_t* Hb = (bf16_t*)(ws + WS_H);
    const int lo = P.ph_lo, hi_ph = P.ph_hi;
#ifndef MK_PHMASK
#define MK_PHMASK 0x1ff
#endif
#define IN(k) (((MK_PHMASK >> (k)) & 1) && lo <= (k) && (k) < hi_ph)
#define REP(k) for (int rep_ = 0; rep_ < ((MK_DUP == (k)) ? 2 : 1); ++rep_)
#ifndef MK_CG_MASK
#define MK_CG_MASK 0x01
#endif
#define SEAM(k) do { if (IN(k) && IN((k) + 1)) { if ((MK_CG_MASK >> (k)) & 1) grid.sync(); else xcd_barrier(xbar); } } while (0)
    const int gw = F.vcu * NWAVES + F.wave, NGW = F.G * NWAVES;
    volatile LAS unsigned* misc = (volatile LAS unsigned*)(F.lds + LDS_MISC);
    if (F.tid < 4) misc[F.tid] = 0u;
    __syncthreads();
    XcdBarrier xbar = xcd_barrier_post(ctl + CW_BAR, misc);

    if (IN(0)) REP(0) {
        LAS unsigned* scr = (LAS unsigned*)(F.lds + F.wave * 9216);
        LAS float* wfl = (LAS float*)(F.lds + 73728);
        for (int i = F.tid; i < 8192; i += NTHREADS) { const int hh = i & 7, k = i >> 3; wfl[hh * 1024 + k] = P.w_in[(size_t)k * INW + NPROJ + hh]; }
        constexpr int I_IN = 16 * 56, I_O = 16 * 16, I_1 = 32 * 16 * 32, I_2 = 32 * 16 * 16, NIT = I_IN + I_O + I_1 + I_2;
        for (int it = gw; it < NIT; it += NGW) {
            int r = it;
            if (r < I_IN) { tr_item(P.w_in, INW, 64 * (r / 56), 64 * (r % 56), nullptr, WinT, 0, scr, F.lane); continue; } r -= I_IN;
            if (r < I_O) { tr_item(P.w_out, 1024, 64 * (r / 16), 64 * (r % 16), nullptr, WoT, 1, scr, F.lane); continue; } r -= I_O;
            if (r < I_1) { const int e = r >> 9, rr = r & 511; tr_item(P.w1 + (size_t)e * 1024 * 2048, 2048, 64 * (rr / 32), 64 * (rr % 32), P.g_ffn, W1T + (size_t)e * 2048 * 1024, 2, scr, F.lane); continue; } r -= I_1;
            { const int e = r >> 8, rr = r & 255; tr_item(P.w2 + (size_t)e * 1024 * 1024, 1024, 64 * (rr / 16), 64 * (rr % 16), nullptr, W2T + (size_t)e * 1024 * 1024, 1, scr, F.lane); }
        }
        __syncthreads();
        for (int m = gw; m < T; m += NGW) {
            const f32x4* xr = (const f32x4*)(P.x + (size_t)m * DM) + F.lane; const f32x4* gr = (const f32x4*)P.g_mix + F.lane;
            f32x4 v[4]; float ss = 0.f;
#pragma unroll
            for (int j = 0; j < 4; ++j) { v[j] = xr[64 * j]; ss += (v[j].x * v[j].x + v[j].y * v[j].y) + (v[j].z * v[j].z + v[j].w * v[j].w); }
            const float rstd = rsqrtf(wave_sum(ss) * (1.0f / DM) + RMS_EPS);
            float z[8];
#pragma unroll
            for (int hh = 0; hh < 8; ++hh) z[hh] = 0.f;
            unsigned long long* o8 = (unsigned long long*)(U + (size_t)m * DM) + F.lane;
#pragma unroll
            for (int j = 0; j < 4; ++j) { v[j] = v[j] * rstd * gr[64 * j];
                o8[64 * j] = (unsigned long long)cvtpk(v[j].x, v[j].y) | ((unsigned long long)cvtpk(v[j].z, v[j].w) << 32);
#pragma unroll
                for (int hh = 0; hh < 8; ++hh) { const f32x4 w4 = *(const LAS f32x4*)(wfl + hh * 1024 + 4 * F.lane + 256 * j); z[hh] += (v[j].x * w4.x + v[j].y * w4.y) + (v[j].z * w4.z + v[j].w * w4.w); } }
#pragma unroll
            for (int hh = 0; hh < 8; ++hh) z[hh] = wave_sum(z[hh]);
            float zz = z[0];
#pragma unroll
            for (int hh = 1; hh < 8; ++hh) zz = (F.lane == hh) ? z[hh] : zz;
            if (F.lane < 8) { const float xx = zz + P.b_forget[F.lane]; const float lf = fminf(xx, 0.f) - log1pf(__expf(-fabsf(xx))); logf2[(size_t)m * 8 + F.lane] = lf * LOG2E; }
        }
        for (int idx = blockIdx.x * NTHREADS + F.tid; idx < SEQ * 64; idx += F.G * NTHREADS) {
            const int pos = idx >> 6, i = idx & 63; const float invf = exp2f(-(float)i * (13.287712379549449f / 64.0f));
            const float ang = (float)pos * invf; double tt = (double)ang * 0.15915494309189535; tt -= __builtin_rint(tt); const float tf = (float)tt;
            ropec[idx] = __builtin_amdgcn_cosf(tf); ropes[idx] = __builtin_amdgcn_sinf(tf);
        }
        for (int idx = blockIdx.x * NTHREADS + F.tid; idx < 32768; idx += F.G * NTHREADS) {
            const int s = idx & 3, e16 = (idx >> 2) & 15, half = (idx >> 6) & 1, kq = (idx >> 7) & 3, c = idx >> 9; const int k = 16 * c + 4 * kq + s, e = 16 * half + e16;
            wr3[idx] = P.w_router[k * 32 + e] * P.g_ffn[k];
        }
    }
    SEAM(0);

    if (IN(1)) REP(1) {
        pg8::DenseOrder S; S.init(T, NPROJ, DM, F.G, (int)blockIdx.x);
        EpiInProj E{proj, ropec, ropes};
        pg8::gemm_phase<EpiInProj, pg8::DenseOrder, true, true>(F.lds, U, WinT, DM, S, E);
    }
    SEAM(1);

    if (IN(2)) REP(2) {
        for (int u = F.vcu; u < 256; u += F.G) ret::unit<false>(u >> 4, u & 15, RQ, RK, RV, SG, GST, MIX, (LAS char*)F.lds);
        for (int bh = F.vcu; bh < 32; bh += F.G) {
            const int b = bh >> 3, h = bh & 7; LAS double* sd = (LAS double*)F.lds;
            double loc[16]; double run = 0.0;
#pragma unroll
            for (int i = 0; i < 16; ++i) { run += (double)logf2[((size_t)b * SEQ + 16 * F.tid + i) * 8 + h]; loc[i] = run; }
            double incl = run;
#pragma unroll
            for (int o = 1; o < 64; o <<= 1) { const double t = __shfl_up(incl, o); if (F.lane >= o) incl += t; }
            __syncthreads();
            if (F.lane == 63) sd[F.wave] = incl;
            __syncthreads();
            double off = incl - run;
            for (int w2 = 0; w2 < F.wave; ++w2) off += sd[w2];
#pragma unroll
            for (int i = 0; i < 16; ++i) F2[(size_t)bh * SEQ + 16 * F.tid + i] = (float)(off + loc[i]);
            __syncthreads();
        }
    }
    SEAM(2);

    if (IN(3)) REP(3) {
        REP(30) for (int i = 0;; ++i) { const int idx = i * F.G + F.vcu; if (idx >= 1024) break;
            const int bh = (idx & 255) >> 3, s = idx & 7, rd = idx >> 8; const int qb = (rd == 0) ? s : (rd == 1) ? 15 - s : (rd == 2) ? 16 + s : 31 - s;
            attn_body::attn_unit<8>(bh >> 3, bh & 7, qb, FQ, FK, FV, MIX + 512, F2, (char*)lds_raw); }
        REP(31) for (int u = F.vcu; u < 256; u += F.G) ret::unit<true>(u >> 4, u & 15, RQ, RK, RV, SG, GST, MIX, (LAS char*)F.lds);
    }
    SEAM(3);

    if (IN(4)) REP(4) {
        pg8::DenseOrder S; S.init(T, DM, DM, F.G, (int)blockIdx.x);
        EpiOutProj E{P.x, H1B};
        pg8::gemm_phase<EpiOutProj, pg8::DenseOrder, true, true>(F.lds, MIX, WoT, DM, S, E);
    }
    SEAM(4);

    if (IN(5)) {
        LAS float* wl = (LAS float*)F.lds;
        LAS float* lg = (LAS float*)(F.lds + 131072);
        LAS float* ssb = (LAS float*)(F.lds + 131072 + 128 * 33 * 4);
        LAS int* ecnt = (LAS int*)(F.lds + 131072 + 128 * 33 * 4 + 512);
        LAS int* ebase = ecnt + 32;
        for (int i = F.tid; i < 8192; i += NTHREADS) ((LAS f32x4*)wl)[i] = ((const f32x4*)wr3)[i];
        for (int tb = blockIdx.x; tb < T / 128; tb += F.G) {
            if (F.tid < 32) ecnt[F.tid] = 0;
            __syncthreads();
            const int tok16 = F.lane & 15, kq = F.lane >> 4; const int tokw = tb * 128 + F.wave * 16 + tok16;
            const bf16_t* hrow = H1B + (size_t)tokw * DM + 4 * kq;
            f32x4 a0 = {0.f, 0.f, 0.f, 0.f}, a1 = {0.f, 0.f, 0.f, 0.f}; float ss = 0.f;
#pragma unroll 8
            for (int c = 0; c < 64; ++c) {
                const u32x2 hv = *(const u32x2*)(hrow + 16 * c); const float av[4] = {bflo(hv.x), bfhi(hv.x), bflo(hv.y), bfhi(hv.y)};
                const f32x4 w0 = *(const LAS f32x4*)(wl + (((c * 4 + kq) * 2 + 0) * 16 + tok16) * 4), w1 = *(const LAS f32x4*)(wl + (((c * 4 + kq) * 2 + 1) * 16 + tok16) * 4);
#pragma unroll
                for (int s = 0; s < 4; ++s) { ss += av[s] * av[s]; a0 = __builtin_amdgcn_mfma_f32_16x16x4f32(av[s], w0[s], a0, 0, 0, 0); a1 = __builtin_amdgcn_mfma_f32_16x16x4f32(av[s], w1[s], a1, 0, 0, 0); }
            }
            ss += __shfl_xor(ss, 16); ss += __shfl_xor(ss, 32);
            if (kq == 0) ssb[F.wave * 16 + tok16] = ss;
#pragma unroll
            for (int r = 0; r < 4; ++r) { const int tk = F.wave * 16 + kq * 4 + r; lg[tk * 33 + tok16] = a0[r]; lg[tk * 33 + 16 + tok16] = a1[r]; }
            __syncthreads();
            int esel[4] = {0, 0, 0, 0}, rank[4] = {0, 0, 0, 0}; float gsel[4] = {0.f, 0.f, 0.f, 0.f}; float rstd = 0.f;
            if (F.tid < 128) {
                rstd = rsqrtf(ssb[F.tid] * (1.0f / DM) + RMS_EPS);
                float l[32];
#pragma unroll
                for (int e = 0; e < 32; ++e) l[e] = lg[F.tid * 33 + e] * rstd + P.b_router[e];
                float vs[4];
#pragma unroll
                for (int k = 0; k < 4; ++k) { float best = -INFINITY; int bi = 0;
#pragma unroll
                    for (int e = 0; e < 32; ++e) { const bool bt = l[e] > best; best = bt ? l[e] : best; bi = bt ? e : bi; }
                    vs[k] = best; esel[k] = bi;
#pragma unroll
                    for (int e = 0; e < 32; ++e) l[e] = (e == bi) ? -INFINITY : l[e]; }
                float den = 0.f;
#pragma unroll
                for (int k = 0; k < 4; ++k) { gsel[k] = __expf(vs[k] - vs[0]); den += gsel[k]; }
#pragma unroll
                for (int k = 0; k < 4; ++k) { gsel[k] /= den; rank[k] = atomicAdd((int*)&ecnt[esel[k]], 1); }
            }
            __syncthreads();
            if (F.tid < 32) ebase[F.tid] = (int)atomicAdd(ctl + CW_CNT + F.tid, (unsigned)ecnt[F.tid]);
            __syncthreads();
            if (F.tid < 128) { const int tok = tb * 128 + F.tid;
#pragma unroll
                for (int k = 0; k < 4; ++k) { const int e = esel[k], slot = ebase[e] + rank[k];
                    ltok[(size_t)e * CAP + slot] = tok; lrstd[(size_t)e * CAP + slot] = rstd; inv[tok * 4 + k] = (e << 16) | slot; gates[tok * 4 + k] = gsel[k]; } }
            __syncthreads();
        }
    }
    SEAM(5);

    if (IN(6) || IN(7)) {
        LAS int* boff = (LAS int*)(F.lds + 131072); LAS int* cntl = boff + 64;
        if (F.tid == 0) { int a = 0; for (int e = 0; e < 32; ++e) { const int c = (int)ctl[CW_CNT + e]; cntl[e] = c; boff[e] = a; a += (c + 255) >> 8; } boff[32] = a; }
        __syncthreads();
        if (IN(6)) REP(6) {
            MoeOrder<8, true> S{boff, cntl, ltok, F.G, F.vcu};
            EpiMoe1 E{Hb, P.b1, lrstd, (const int*)(ctl + CW_CNT)};
            pg8::gemm_phase<EpiMoe1, MoeOrder<8, true>, true, true>(F.lds, H1B, W1T, DM, S, E);
        }
        SEAM(6);
        if (IN(7)) REP(7) {
            MoeOrder<4, false> S{boff, cntl, ltok, F.G, F.vcu};
            EpiMoe2 E{Yb, P.b2};
            pg8::gemm_phase<EpiMoe2, MoeOrder<4, false>, true, true>(F.lds, Hb, W2T, DM, S, E);
        }
    }
    SEAM(7);

    if (IN(8)) REP(8) {
        LAS int* boff = (LAS int*)(F.lds + 131072);
        __syncthreads();
        if (F.tid == 0) { int a = 0; for (int e = 0; e < 32; ++e) { const int c = (int)ctl[CW_CNT + e]; boff[e] = a; a += (c + 255) >> 8; } boff[32] = a; }
        __syncthreads();
        for (int m = gw; m < T; m += NGW) {
            float v[16];
            { const u32x4 a = *(const u32x4*)(H1B + (size_t)m * DM + 8 * F.lane), bq = *(const u32x4*)(H1B + (size_t)m * DM + 512 + 8 * F.lane);
#pragma unroll
              for (int e = 0; e < 4; ++e) { v[2 * e] = bflo(a[e]); v[2 * e + 1] = bfhi(a[e]); v[8 + 2 * e] = bflo(bq[e]); v[8 + 2 * e + 1] = bfhi(bq[e]); } }
#pragma unroll
            for (int k = 0; k < 4; ++k) { const int iv = inv[m * 4 + k]; const float gt = gates[m * 4 + k]; const int e = iv >> 16, slot = iv & 0xffff;
                const size_t yrow = (size_t)boff[e] * 256 + slot;
                const u32x4 a = *(const u32x4*)(Yb + yrow * DM + 8 * F.lane), bq = *(const u32x4*)(Yb + yrow * DM + 512 + 8 * F.lane);
#pragma unroll
                for (int q = 0; q < 4; ++q) { v[2 * q] += gt * bflo(a[q]); v[2 * q + 1] += gt * bfhi(a[q]); v[8 + 2 * q] += gt * bflo(bq[q]); v[8 + 2 * q + 1] += gt * bfhi(bq[q]); } }
            float ss = 0.f;
#pragma unroll
            for (int i = 0; i < 16; ++i) ss += v[i] * v[i];
            const float rstd = rsqrtf(wave_sum(ss) * (1.0f / DM) + RMS_EPS);
            const f32x4* gf = (const f32x4*)P.g_final; f32x4* op = (f32x4*)(P.out + (size_t)m * DM);
            const f32x4 g0 = gf[2 * F.lane], g1 = gf[2 * F.lane + 1], g2 = gf[128 + 2 * F.lane], g3 = gf[128 + 2 * F.lane + 1];
            op[2 * F.lane] = (f32x4){v[0], v[1], v[2], v[3]} * rstd * g0; op[2 * F.lane + 1] = (f32x4){v[4], v[5], v[6], v[7]} * rstd * g1;
            op[128 + 2 * F.lane] = (f32x4){v[8], v[9], v[10], v[11]} * rstd * g2; op[128 + 2 * F.lane + 1] = (f32x4){v[12], v[13], v[14], v[15]} * rstd * g3;
        }
    }
#undef IN
#undef SEAM
}

extern "C" void kernel_launch(void* const* d_in, const int* in_sizes, int n_in, void* d_out, int out_size, void* d_ws, size_t ws_size, hipStream_t stream) {
    static int grid = 0;
    if (grid == 0) {
        if (n_in != 13 || in_sizes[0] != T * DM || out_size != T * DM || ws_size < WS_END) { fprintf(stderr, "kernel_launch: unexpected shapes (n_in %d, in0 %d, out %d, ws %zu)\n", n_in, n_in > 0 ? in_sizes[0] : -1, out_size, ws_size); grid = -1; return; }
        int dev = 0, cus = 0, per_cu = 0;
        if (hipGetDevice(&dev) != hipSuccess || hipDeviceGetAttribute(&cus, hipDeviceAttributeMultiprocessorCount, dev) != hipSuccess) { fprintf(stderr, "kernel_launch: device query failed\n"); grid = -1; return; }
        if (hipFuncSetAttribute((const void*)mk_fwd, hipFuncAttributeMaxDynamicSharedMemorySize, LDS_BYTES) != hipSuccess) { fprintf(stderr, "kernel_launch: hipFuncSetAttribute failed\n"); grid = -1; return; }
        if (hipOccupancyMaxActiveBlocksPerMultiprocessor(&per_cu, (const void*)mk_fwd, NTHREADS, LDS_BYTES) != hipSuccess || per_cu < 1) { fprintf(stderr, "kernel_launch: occupancy query says %d\n", per_cu); per_cu = 1; }
        (void)hipGetLastError();
        grid = cus * 1;
        if (grid != 256) fprintf(stderr, "kernel_launch: %d CUs (built for 256)\n", grid);
    }
    if (grid < 0) return;
    (void)hipMemsetAsync((char*)d_ws + WS_CTL, 0, CTL_BYTES, stream);
    Params p{};
    const float** pin = (const float**)&p;
    for (int i = 0; i < 13; ++i) pin[i] = (const float*)d_in[i];
    p.out = (float*)d_out; p.ws = (unsigned char*)d_ws;
#if MK_N_LAUNCHES == 1
    p.ph_lo = 0; p.ph_hi = 9;
    void* args[] = {&p};
    hipError_t e = hipLaunchCooperativeKernel((const void*)mk_fwd, dim3(grid), dim3(NTHREADS), args, LDS_BYTES, stream);
    if (e != hipSuccess) fprintf(stderr, "kernel_launch: cooperative launch failed: %s (grid %d)\n", hipGetErrorString(e), grid);
#else
    for (int k = 0; k < 9; ++k) { p.ph_lo = k; p.ph_hi = k + 1; hipLaunchKernelGGL(mk_fwd, dim3(grid), dim3(NTHREADS), LDS_BYTES, stream, p); }
#endif
}
```

```cpp
#include <hip/hip_runtime.h>
#include <hip/hip_cooperative_groups.h>
#include <cstdio>
#include <cstdint>
namespace cg = cooperative_groups;

#ifndef MK_N_LAUNCHES
#define MK_N_LAUNCHES 1
#endif
#ifndef MK_DUP
#define MK_DUP -1
#endif
#ifndef MK_DIAG
#define MK_DIAG 0
#endif

#define LAS __attribute__((address_space(3)))
#define GAS __attribute__((address_space(1)))
typedef unsigned short bf16_t;
typedef short bf16x8 __attribute__((ext_vector_type(8)));
typedef short s16x4 __attribute__((ext_vector_type(4)));
typedef float f32x2 __attribute__((ext_vector_type(2)));
typedef float f32x4 __attribute__((ext_vector_type(4)));
typedef float f32x16 __attribute__((ext_vector_type(16)));
typedef unsigned u32x2 __attribute__((ext_vector_type(2)));
typedef unsigned u32x4 __attribute__((ext_vector_type(4)));
typedef __bf16 bf16x2_t __attribute__((ext_vector_type(2)));

constexpr int BATCH = 4, SEQ = 8192, DM = 1024, T = BATCH * SEQ;
constexpr int RH = 4, RD = 128, FH = 8, FD = 64;
constexpr int NPROJ = 3584, INW = 3592;
constexpr int NE = 32, TOPK = 4, DFF = 1024;
constexpr int CAP = T;
constexpr int NBMAX = (T * TOPK) / 256 + NE;
constexpr float RMS_EPS = 1e-5f, GN_EPS = 1e-5f;
constexpr float LOG2E = 1.4426950408889634f;
constexpr float PRUNE_TH = 40.0f;
constexpr float C2 = 0.125f * 1.4426950408889634f;
constexpr int NTHREADS = 512, NWAVES = 8;

constexpr size_t MiB = 1u << 20;
constexpr size_t WS_CTL = 0, CTL_BYTES = 1 * MiB;
constexpr size_t WS_ROPEC = 1 * MiB, WS_ROPES = 3 * MiB;
constexpr size_t WS_WR3 = 5 * MiB;
constexpr size_t WS_LOGF = 6 * MiB;
constexpr size_t WS_F2 = 7 * MiB;
constexpr size_t WS_LTOK = 8 * MiB;
constexpr size_t WS_LRSTD = 12 * MiB;
constexpr size_t WS_INV = 16 * MiB;
constexpr size_t WS_GATE = 17 * MiB;
constexpr size_t WS_H1B = 32 * MiB;
constexpr size_t WS_WINT = 96 * MiB;
constexpr size_t WS_WOT = 104 * MiB;
constexpr size_t WS_W2T = 112 * MiB;
constexpr size_t WS_W1T = 176 * MiB;
constexpr size_t WS_Y = 176 * MiB;
constexpr size_t WS_U = 448 * MiB;
constexpr size_t WS_PROJ = 512 * MiB;
constexpr size_t PROJ_STRIDE = 32 * MiB;
constexpr size_t WS_GST = 736 * MiB;
constexpr size_t WS_MIX = 752 * MiB;
constexpr size_t WS_H = 448 * MiB;
constexpr size_t WS_END = 816 * MiB;
constexpr int CW_CNT = 0;
constexpr int CW_DIAG = 64;
constexpr int CW_QN2 = 128, CW_KN2 = 192;
constexpr int CW_BIN = 256;
constexpr int CW_QHEAD = 384;
constexpr int CW_UTS = 1024, CW_UPOS = 2048;
constexpr int CW_BAR = 4096;


constexpr int LDS_BYTES = 163840;
constexpr int LDS_MISC = LDS_BYTES - 16;

__device__ __forceinline__ unsigned cvtpk(float lo, float hi) { f32x2 v = {lo, hi}; bf16x2_t b = __builtin_convertvector(v, bf16x2_t); return __builtin_bit_cast(unsigned, b); }
__device__ __forceinline__ float bf2f(unsigned short h) { return __uint_as_float(((unsigned)h) << 16); }
__device__ __forceinline__ float bflo(unsigned w) { return __uint_as_float(w << 16); }
__device__ __forceinline__ float bfhi(unsigned w) { return __uint_as_float(w & 0xffff0000u); }
__device__ __forceinline__ float wave_sum(float v) {
#pragma unroll
    for (int o = 1; o < 64; o <<= 1) v += __shfl_xor(v, o);
    return v;
}
#define LDS_WAIT() asm volatile("s_waitcnt lgkmcnt(0)" ::: "memory")
#define VM_WAIT() asm volatile("s_waitcnt vmcnt(0)" ::: "memory")

struct Params {
    const float *x, *g_mix, *w_in, *b_forget, *w_out, *g_ffn, *w_router, *b_router, *w1, *b1, *w2, *b2, *g_final;
    float* out; unsigned char* ws; int ph_lo, ph_hi;
};

namespace pg8 {
constexpr int BM = 256, BK = 64, HALF = 128, HTB = HALF * BK * 2, STAGE_BYTES = 8 * HTB, NXCD = 8, WGM = 8;
__host__ __device__ __forceinline__ int lds_byte(int r, int c) { const int st = (r >> 4) * 2 + (c >> 5), rr = r & 15, cc = c & 31, ob = rr * 64 + cc * 2; return st * 1024 + (ob ^ (((ob >> 9) & 1) << 5)); }
__host__ __device__ __forceinline__ void stage_rc(int b, int& R, int& C) { const int st = b / 1024, sb = b % 1024, swz = sb ^ (((sb >> 9) & 1) << 5); R = (st >> 1) * 16 + swz / 64; C = (st & 1) * 32 + (swz % 64) / 2; }

struct Unit { int pm, pn, e, lb; };

struct DenseOrder {
    int nM, nN, nwg, G, c; int K; int dup;
    __device__ void init(int M, int N, int K_, int G_, int c_, int dup_ = 1) { nM = M / BM; nN = N / BM; nwg = nM * nN; G = G_; c = c_; K = K_; dup = dup_; }
    __device__ __forceinline__ bool next(int i, Unit& u) const {
        const long L = (long)i * G + c; if (L >= (long)nwg * dup) return false;
        int wgid = (int)(L % nwg); { const int q = nwg / NXCD, r = nwg % NXCD, xcd = wgid % NXCD, off = wgid / NXCD; wgid = (xcd < r ? xcd * (q + 1) : r * (q + 1) + (xcd - r) * q) + off; }
        const int nig = WGM * nN, gid = wgid / nig, fm = gid * WGM, gsz = (nM - fm) < WGM ? (nM - fm) : WGM;
        u.pm = fm + ((wgid % nig) % gsz); u.pn = (wgid % nig) / gsz; u.e = 0; u.lb = 0; return true;
    }
    __device__ __forceinline__ void aoffs(const Unit& u, unsigned (&ao)[2][2], const int (&R)[2], const int (&C)[2]) const {
#pragma unroll
        for (int h = 0; h < 2; ++h)
#pragma unroll
            for (int i = 0; i < 2; ++i) ao[h][i] = (unsigned)(((u.pm * BM + h * HALF + R[i]) * K + C[i]) * 2);
    }
};

template <class Epi, class Sched, bool ALIGN_EPI, bool SP2>
__device__ __forceinline__ void gemm_phase(LAS unsigned char* lds, const bf16_t* Abase, const bf16_t* Btbase, const int K, const Sched& S, const Epi& E) {
    const int tid = threadIdx.x, wid = __builtin_amdgcn_readfirstlane(tid >> 6), lane = tid & 63, wr = wid >> 2, wc = wid & 3, fr = lane & 15, fq = lane >> 4;
    const int nt = K / BK;
    int RR[2], CC[2]; unsigned voffB[2];
#pragma unroll
    for (int i = 0; i < 2; ++i) { stage_rc(tid * 16 + i * 8192, RR[i], CC[i]); voffB[i] = (unsigned)(RR[i] * K + CC[i]) * 2u; }
    const size_t kstep = (size_t)(BK * 2);
    const size_t hstep = (size_t)HALF * K * 2;
    const size_t tstep = 2 * hstep;
    const unsigned ldsw = (unsigned)wid * 1024u;
    const int aoff = lds_byte(wr * 64 + fr, fq * 8), boff = lds_byte(wc * 32 + fr, fq * 8);
    const char* Ab = (const char*)Abase;
#define PG8_SA(b, h) (((b) * 2 + (h)) * HTB)
#define PG8_SB(b, h) ((4 + (b) * 2 + (h)) * HTB)
#define PG8_STAGE(bufoff, gbase, voff) do { _Pragma("unroll") for (int _i = 0; _i < 2; ++_i) \
        __builtin_amdgcn_global_load_lds((const unsigned*)((const char*)(gbase) + (voff)[_i]), (LAS unsigned*)(lds + (bufoff) + ldsw + _i * 8192), 16, 0, 0); } while (0)
#define PG8_STAGE_A(bufoff, kb, AO, h) do { _Pragma("unroll") for (int _i = 0; _i < 2; ++_i) \
        __builtin_amdgcn_global_load_lds((const unsigned*)(Ab + (kb) + (AO)[h][_i]), (LAS unsigned*)(lds + (bufoff) + ldsw + _i * 8192), 16, 0, 0); } while (0)
#define PG8_LDA(dst, b, h) do { _Pragma("unroll") for (int m = 0; m < 4; ++m) _Pragma("unroll") for (int k = 0; k < 2; ++k) dst[m][k] = *(const LAS bf16x8*)(lds + PG8_SA(b, h) + aoff + m * 2048 + k * 1024); } while (0)
#define PG8_LDB(dst, b, h) do { _Pragma("unroll") for (int n = 0; n < 2; ++n) _Pragma("unroll") for (int k = 0; k < 2; ++k) dst[n][k] = *(const LAS bf16x8*)(lds + PG8_SB(b, h) + boff + n * 2048 + k * 1024); } while (0)
#define PG8_MMA(ai, bj, At, Bt) do { __builtin_amdgcn_s_setprio(1); _Pragma("unroll") for (int m = 0; m < 4; ++m) _Pragma("unroll") for (int n = 0; n < 2; ++n) _Pragma("unroll") for (int k = 0; k < 2; ++k) \
        acc[ai][bj][m][n] = __builtin_amdgcn_mfma_f32_16x16x32_bf16(Bt[n][k], At[m][k], acc[ai][bj][m][n], 0, 0, 0); __builtin_amdgcn_s_setprio(0); } while (0)
#define PG8_WAIT_V(n) asm volatile("s_waitcnt vmcnt(" #n ")" ::: "memory")
#define PG8_WAIT_L(n) asm volatile("s_waitcnt lgkmcnt(" #n ")" ::: "memory")
#define PG8_BAR __builtin_amdgcn_s_barrier()
#define PG8_SCHED __builtin_amdgcn_sched_barrier(0)
    Unit cur, nxt; int ui = 0;
    if (!S.next(0, cur)) return;
    f32x4 acc[2][2][4][2];
#pragma unroll
    for (int a = 0; a < 2; ++a)
#pragma unroll
        for (int b = 0; b < 2; ++b)
#pragma unroll
            for (int m = 0; m < 4; ++m)
#pragma unroll
                for (int n = 0; n < 2; ++n) acc[a][b][m][n] = (f32x4){0.f, 0.f, 0.f, 0.f};
    bf16x8 At[4][2], B0[2][2], B1[2][2];
    unsigned aoC[2][2], aoN[2][2];
    S.aoffs(cur, aoC, RR, CC);
    const char* cB = (const char*)Btbase + (size_t)cur.pn * tstep;
    static_assert(SP2, "only the SP2 loop is kept");
    PG8_STAGE(PG8_SB(0, 0), cB, voffB); PG8_STAGE(PG8_SB(0, 1), cB + hstep, voffB); PG8_STAGE_A(PG8_SA(0, 0), 0, aoC, 0); PG8_STAGE_A(PG8_SA(0, 1), 0, aoC, 1);
    if (wr == 1) PG8_BAR;
    PG8_WAIT_V(2); PG8_BAR;
    PG8_STAGE(PG8_SB(1, 0), cB + kstep, voffB); PG8_STAGE_A(PG8_SA(1, 0), kstep, aoC, 0); PG8_STAGE(PG8_SB(1, 1), cB + hstep + kstep, voffB);
    PG8_WAIT_V(6); PG8_BAR;
    for (;;) {
        const bool has_next = S.next(ui + 1, nxt);
        if (has_next) S.aoffs(nxt, aoN, RR, CC);
        else {
#pragma unroll
            for (int h = 0; h < 2; ++h)
#pragma unroll
                for (int i = 0; i < 2; ++i) aoN[h][i] = aoC[h][i];
        }
        const char* nB = has_next ? (const char*)Btbase + (size_t)nxt.pn * tstep : cB;
        for (int t = 0; t < nt; t += 2) {
            const bool last = (t == nt - 2);
            const size_t kb1 = (size_t)(t + 1) * kstep;
            const size_t kb2 = last ? 0 : (size_t)(t + 2) * kstep, kb3 = kb2 + kstep;
            unsigned ao2[2][2];
#pragma unroll
            for (int h = 0; h < 2; ++h)
#pragma unroll
                for (int i = 0; i < 2; ++i) ao2[h][i] = last ? aoN[h][i] : aoC[h][i];
            const char* b2 = last ? nB : cB + (size_t)(t + 2) * kstep;
            const char* b3 = b2 + kstep;
            PG8_LDB(B0, 0, 0); PG8_LDB(B1, 0, 1); PG8_SCHED; PG8_LDA(At, 0, 0); PG8_STAGE_A(PG8_SA(1, 1), kb1, aoC, 1);
            PG8_WAIT_V(8); PG8_WAIT_L(0); PG8_BAR; PG8_MMA(0, 0, At, B0); PG8_MMA(0, 1, At, B1); PG8_BAR; PG8_SCHED;
            PG8_LDA(At, 0, 1); PG8_STAGE(PG8_SB(0, 0), b2, voffB); PG8_STAGE(PG8_SB(0, 1), b2 + hstep, voffB); PG8_STAGE_A(PG8_SA(0, 0), kb2, ao2, 0);
            PG8_WAIT_V(8); PG8_WAIT_L(0); PG8_BAR; PG8_MMA(1, 0, At, B0); PG8_MMA(1, 1, At, B1); PG8_BAR; PG8_SCHED;
            PG8_LDB(B0, 1, 0); PG8_LDB(B1, 1, 1); PG8_SCHED; PG8_LDA(At, 1, 0); PG8_STAGE_A(PG8_SA(0, 1), kb2, ao2, 1);
            PG8_WAIT_V(8); PG8_WAIT_L(0); PG8_BAR; PG8_MMA(0, 0, At, B0); PG8_MMA(0, 1, At, B1); PG8_BAR; PG8_SCHED;
            PG8_LDA(At, 1, 1); PG8_STAGE(PG8_SB(1, 0), b3, voffB); PG8_STAGE(PG8_SB(1, 1), b3 + hstep, voffB); PG8_STAGE_A(PG8_SA(1, 0), kb3, ao2, 0);
            PG8_WAIT_V(8); PG8_WAIT_L(0); PG8_BAR; PG8_MMA(1, 0, At, B0); PG8_MMA(1, 1, At, B1); PG8_BAR; PG8_SCHED;
        }
        if constexpr (ALIGN_EPI) { if (wr == 0) PG8_BAR; }
        E(acc, cur, wr, wc, fr, fq);
        if (!has_next) break;
#pragma unroll
        for (int a = 0; a < 2; ++a)
#pragma unroll
            for (int b = 0; b < 2; ++b)
#pragma unroll
                for (int m = 0; m < 4; ++m)
#pragma unroll
                    for (int n = 0; n < 2; ++n) acc[a][b][m][n] = (f32x4){0.f, 0.f, 0.f, 0.f};
        cur = nxt; cB = nB; ++ui;
#pragma unroll
        for (int h = 0; h < 2; ++h)
#pragma unroll
            for (int i = 0; i < 2; ++i) aoC[h][i] = aoN[h][i];
        if constexpr (ALIGN_EPI) { if (wr == 1) PG8_BAR; }
    }
    PG8_WAIT_V(0);
    if constexpr (!ALIGN_EPI) { if (wr == 0) PG8_BAR; }
    PG8_BAR;
#undef PG8_SA
#undef PG8_SB
#undef PG8_STAGE
#undef PG8_STAGE_A
#undef PG8_LDA
#undef PG8_LDB
#undef PG8_MMA
#undef PG8_WAIT_V
#undef PG8_WAIT_L
#undef PG8_BAR
#undef PG8_SCHED
}
}


__device__ __forceinline__ int perm32_pos(int t) { return 16 * ((t >> 2) & 1) + 4 * ((t >> 3) & 3) + (t & 3); }
__device__ __forceinline__ int pos_inproj(int c) {
    if (c < 1024) { const int hc = c & 127; return (c & ~127) | (32 * ((hc >> 4) & 3) + 16 * (hc >> 6) + (hc & 15)); }
    return (c & ~31) | perm32_pos(c & 31);
}
__device__ __forceinline__ int pos_plain(int c) { return (c & ~31) | perm32_pos(c & 31); }
__device__ __forceinline__ int pos_w1(int n) { const int jj = n & 1023, lin = n >> 10, pn = jj >> 7, tp = jj & 127; return pn * 256 + lin * 128 + ((tp & ~31) | perm32_pos(tp & 31)); }

struct EpiInProj {
    unsigned char* proj; const float* ropec; const float* ropes; unsigned* ctl;
    __device__ __forceinline__ void operator()(const f32x4 (&acc)[2][2][4][2], const pg8::Unit& u, int wr, int wc, int fr, int fq) const {
        const int type = u.pn >> 1; bf16_t* base = (bf16_t*)(proj + (size_t)type * PROJ_STRIDE);
        const int colh = (u.pn & 1) * 256;
        if (type < 2) {
            const float sc = (type == 1) ? 0.08838834764831845f : 1.0f;
            const int i0 = 16 * wc + 4 * fq;
#pragma unroll
            for (int ai = 0; ai < 2; ++ai)
#pragma unroll
                for (int m = 0; m < 4; ++m) {
                    const int row = u.pm * 256 + ai * 128 + wr * 64 + m * 16 + fr; const int pos = row & (SEQ - 1);
                    const f32x4 cs = *(const f32x4*)(ropec + pos * 64 + i0), sn = *(const f32x4*)(ropes + pos * 64 + i0);
#pragma unroll
                    for (int bj = 0; bj < 2; ++bj) {
                        const f32x4 x1 = acc[ai][bj][m][0], x2 = acc[ai][bj][m][1];
                        const f32x4 o1 = (x1 * cs - x2 * sn) * sc, o2 = (x1 * sn + x2 * cs) * sc;
                        bf16_t* dst = base + (size_t)row * 512 + colh + bj * 128 + i0;
                        u32x2 w1, w2; w1.x = cvtpk(o1[0], o1[1]); w1.y = cvtpk(o1[2], o1[3]); w2.x = cvtpk(o2[0], o2[1]); w2.y = cvtpk(o2[2], o2[3]);
                        *(u32x2*)dst = w1; *(u32x2*)(dst + 64) = w2;
                    }
                }
        } else {
            const float sc = (type == 4) ? C2 : 1.0f;
            float mx[2] = {0.f, 0.f};
#pragma unroll
            for (int ai = 0; ai < 2; ++ai)
#pragma unroll
                for (int m = 0; m < 4; ++m) {
                    const int row = u.pm * 256 + ai * 128 + wr * 64 + m * 16 + fr;
#pragma unroll
                    for (int bj = 0; bj < 2; ++bj) {
                        f32x4 v0 = acc[ai][bj][m][0] * sc, v1 = acc[ai][bj][m][1] * sc;
                        if (type == 4 || type == 5) { float ssq = (v0[0] * v0[0] + v0[1] * v0[1]) + (v0[2] * v0[2] + v0[3] * v0[3]) + (v1[0] * v1[0] + v1[1] * v1[1]) + (v1[2] * v1[2] + v1[3] * v1[3]);
                            ssq += __shfl_xor(ssq, 16); ssq += __shfl_xor(ssq, 32); mx[bj] = fmaxf(mx[bj], ssq); }
                        if (type == 3) {
#pragma unroll
                            for (int j = 0; j < 4; ++j) { v0[j] = v0[j] / (1.0f + __expf(-v0[j])); v1[j] = v1[j] / (1.0f + __expf(-v1[j])); }
                        }
                        u32x4 w; w.x = cvtpk(v0[0], v0[1]); w.y = cvtpk(v0[2], v0[3]); w.z = cvtpk(v1[0], v1[1]); w.w = cvtpk(v1[2], v1[3]);
                        *(u32x4*)(base + (size_t)row * 512 + colh + bj * 128 + wc * 32 + 8 * fq) = w;
                    }
                }
            if (type == 4 || type == 5) {
#pragma unroll
                for (int bj = 0; bj < 2; ++bj) { float v = mx[bj]; v = fmaxf(v, __shfl_xor(v, 1)); v = fmaxf(v, __shfl_xor(v, 2)); v = fmaxf(v, __shfl_xor(v, 4)); v = fmaxf(v, __shfl_xor(v, 8));
                    if ((threadIdx.x & 63) == 0) { const int bh = (u.pm >> 5) * 8 + (u.pn & 1) * 4 + bj * 2 + (wc >> 1);
                        atomicMax(ctl + ((type == 4) ? CW_QN2 : CW_KN2) + bh * 2 + (wc & 1), __float_as_uint(v)); } }
            }
        }
    }
};

struct EpiOutProj {
    const float* x; bf16_t* h1b;
    __device__ __forceinline__ void operator()(const f32x4 (&acc)[2][2][4][2], const pg8::Unit& u, int wr, int wc, int fr, int fq) const {
#pragma unroll
        for (int ai = 0; ai < 2; ++ai)
#pragma unroll
            for (int m = 0; m < 4; ++m) {
                const int row = u.pm * 256 + ai * 128 + wr * 64 + m * 16 + fr;
#pragma unroll
                for (int bj = 0; bj < 2; ++bj) {
                    const int col = u.pn * 256 + bj * 128 + wc * 32 + 8 * fq;
                    const f32x4 xa = *(const f32x4*)(x + (size_t)row * DM + col), xb = *(const f32x4*)(x + (size_t)row * DM + col + 4);
                    const f32x4 v0 = acc[ai][bj][m][0] + xa, v1 = acc[ai][bj][m][1] + xb;
                    u32x4 w; w.x = cvtpk(v0[0], v0[1]); w.y = cvtpk(v0[2], v0[3]); w.z = cvtpk(v1[0], v1[1]); w.w = cvtpk(v1[2], v1[3]);
                    *(u32x4*)(h1b + (size_t)row * DM + col) = w;
                }
            }
    }
};

struct EpiMoe1 {
    bf16_t* H; const float* b1; const float* lrstd; const int* cnt;
    __device__ __forceinline__ void operator()(const f32x4 (&acc)[2][2][4][2], const pg8::Unit& u, int wr, int wc, int fr, int fq) const {
        const int e = u.e, pnl = u.pn - e * 8; const int cq = pnl * 128 + wc * 32 + 8 * fq;
        const float* bg = b1 + (size_t)e * 2048 + cq; const float* bl = bg + 1024;
        const f32x4 bg0 = *(const f32x4*)bg, bg1 = *(const f32x4*)(bg + 4), bl0 = *(const f32x4*)bl, bl1 = *(const f32x4*)(bl + 4);
        const int ce = cnt[e];
#pragma unroll
        for (int ai = 0; ai < 2; ++ai)
#pragma unroll
            for (int m = 0; m < 4; ++m) {
                const int rt = ai * 128 + wr * 64 + m * 16 + fr; const int slot = u.lb * 256 + rt;
                const float rs = (slot < ce) ? lrstd[(size_t)e * CAP + slot] : 0.f;
                f32x4 g0 = acc[ai][0][m][0] * rs + bg0, g1 = acc[ai][0][m][1] * rs + bg1, l0 = acc[ai][1][m][0] * rs + bl0, l1 = acc[ai][1][m][1] * rs + bl1;
                float o[8];
#pragma unroll
                for (int j = 0; j < 4; ++j) {
                    float g = fminf(g0[j], 7.0f), l = fminf(fmaxf(l0[j], -7.0f), 7.0f); o[j] = g / (1.0f + __expf(-1.702f * g)) * (l + 1.0f);
                    g = fminf(g1[j], 7.0f); l = fminf(fmaxf(l1[j], -7.0f), 7.0f); o[4 + j] = g / (1.0f + __expf(-1.702f * g)) * (l + 1.0f);
                }
                u32x4 w; w.x = cvtpk(o[0], o[1]); w.y = cvtpk(o[2], o[3]); w.z = cvtpk(o[4], o[5]); w.w = cvtpk(o[6], o[7]);
                *(u32x4*)(H + (size_t)(u.pm * 256 + rt) * DFF + cq) = w;
            }
    }
};

struct EpiMoe2 {
    bf16_t* Y; const float* b2;
    __device__ __forceinline__ void operator()(const f32x4 (&acc)[2][2][4][2], const pg8::Unit& u, int wr, int wc, int fr, int fq) const {
        const int e = u.e, pnl = u.pn - e * 4;
#pragma unroll
        for (int bj = 0; bj < 2; ++bj) {
            const int col = pnl * 256 + bj * 128 + wc * 32 + 8 * fq;
            const f32x4 ba = *(const f32x4*)(b2 + (size_t)e * DM + col), bb = *(const f32x4*)(b2 + (size_t)e * DM + col + 4);
#pragma unroll
            for (int ai = 0; ai < 2; ++ai)
#pragma unroll
                for (int m = 0; m < 4; ++m) {
                    const int rt = ai * 128 + wr * 64 + m * 16 + fr;
                    const f32x4 v0 = acc[ai][bj][m][0] + ba, v1 = acc[ai][bj][m][1] + bb;
                    u32x4 w; w.x = cvtpk(v0[0], v0[1]); w.y = cvtpk(v0[2], v0[3]); w.z = cvtpk(v1[0], v1[1]); w.w = cvtpk(v1[2], v1[3]);
                    *(u32x4*)(Y + (size_t)(u.pm * 256 + rt) * DM + col) = w;
                }
        }
    }
};

template <int NT, bool GATHER>
struct MoeOrder {
    const LAS int* boff;
    const LAS int* cntl;
    const int* ltok;
    int G, vcu;
    __device__ __forceinline__ bool next(int i, pg8::Unit& u) const {
        const int cpx = G >> 3, x = vcu / cpx, j = vcu % cpx, rpb = cpx / NT;
        const int rb = (i * 8 + x) * rpb + j / NT; const int nb = boff[32];
        if (rb >= nb) return false;
        int e = 0;
#pragma unroll 1
        for (int k = 1; k < 32; ++k) if (boff[k] <= rb) e = k;
        u.pm = rb; u.e = e; u.lb = rb - boff[e]; u.pn = e * NT + (j % NT); return true;
    }
    __device__ __forceinline__ void aoffs(const pg8::Unit& u, unsigned (&ao)[2][2], const int (&R)[2], const int (&C)[2]) const {
#pragma unroll
        for (int h = 0; h < 2; ++h)
#pragma unroll
            for (int i = 0; i < 2; ++i) {
                if constexpr (GATHER) {
                    const int slot = u.lb * 256 + h * 128 + R[i]; int tok = 0;
                    if (slot < cntl[u.e]) tok = ltok[(size_t)u.e * CAP + slot];
                    ao[h][i] = (unsigned)((tok * 1024 + C[i]) * 2);
                } else ao[h][i] = (unsigned)(((u.pm * 256 + h * 128 + R[i]) * 1024 + C[i]) * 2);
            }
    }
};

namespace attn_body {
constexpr int NHEAD = FH, D = 64, PQ = 512, PO = 1024;
constexpr int NW = 8, QBLK = 32, QB = QBLK * NW, KVBLK = 64, NQB = SEQ / QB;
__device__ __forceinline__ int crow(int r, int hi) { return (r & 3) + 8 * (r >> 2) + 4 * hi; }
#define SBAR() __builtin_amdgcn_sched_barrier(0)
__device__ __forceinline__ void cmask(f32x16& p0, f32x16& p1, int jb, int qrel, int hi) {
    const float NEG = -INFINITY; int kb = 64 * jb + 4 * hi;
#pragma unroll
    for (int r = 0; r < 16; ++r) { int kv = kb + (r & 3) + 8 * (r >> 2); if (kv > qrel) p0[r] = NEG; if (kv + 32 > qrel) p1[r] = NEG; }
}
constexpr int NSLOT = 3, SLOTB = 8192;
constexpr int LDS_K = 0, LDS_V = NSLOT * SLOTB, LDS_WS = 2 * NSLOT * SLOTB, LDS_OST = LDS_WS + NW * 64 * 4, LDS_END = LDS_OST + NW * 4096;
constexpr int LDS_F = 86016, LDS_F_BYTES = SEQ * 4 + 1024;
static_assert(LDS_F >= LDS_END && LDS_F + LDS_F_BYTES <= LDS_BYTES, "attention LDS map");
__device__ __forceinline__ void glds16(const void* gsrc, unsigned lds_dst) { unsigned keep;
    asm volatile("s_mov_b32 %0, m0\n\ts_mov_b32 m0, %2\n\ts_nop 0\n\tglobal_load_lds_dwordx4 %1, off\n\ts_mov_b32 m0, %0" : "=&s"(keep) : "v"(gsrc), "s"(lds_dst) : "memory"); }
__device__ __forceinline__ float max3f(float a, float b, float c) { float r; asm("v_max3_f32 %0, %1, %2, %3" : "=v"(r) : "v"(a), "v"(b), "v"(c)); return r; }
__device__ __forceinline__ float max2f(float a, float b) { float r; asm("v_max_f32_e32 %0, %1, %2" : "=v"(r) : "v"(a), "v"(b)); return r; }
__device__ __forceinline__ float fadd_s(float a, float b) { float r; asm("v_add_f32_e32 %0, %1, %2" : "=v"(r) : "v"(a), "v"(b)); return r; }
__device__ __forceinline__ float fsub_s(float a, float b) { float r; asm("v_sub_f32_e32 %0, %1, %2" : "=v"(r) : "v"(a), "v"(b)); return r; }
#define WAIT_BAR(N) asm volatile("s_waitcnt vmcnt(" #N ") lgkmcnt(0)\n\ts_barrier" ::: "memory")

typedef LAS const char* lds_cptr;
typedef short v4i16_t __attribute__((ext_vector_type(4)));
__device__ __forceinline__ void kload8(bf16x8* kf, lds_cptr kp) {
    kf[0] = *(const LAS bf16x8*)(kp);        kf[1] = *(const LAS bf16x8*)(kp + 512);
    kf[2] = *(const LAS bf16x8*)(kp + 2048); kf[3] = *(const LAS bf16x8*)(kp + 2560);
    kf[4] = *(const LAS bf16x8*)(kp + 4096); kf[5] = *(const LAS bf16x8*)(kp + 4608);
    kf[6] = *(const LAS bf16x8*)(kp + 6144); kf[7] = *(const LAS bf16x8*)(kp + 6656);
}
__device__ __forceinline__ void kload2(bf16x8* kf, lds_cptr kp, int j) { kf[2 * j] = *(const LAS bf16x8*)(kp + j * 2048); kf[2 * j + 1] = *(const LAS bf16x8*)(kp + j * 2048 + 512); }
__device__ __forceinline__ s16x4 vtr(lds_cptr p) { return __builtin_bit_cast(s16x4, __builtin_amdgcn_ds_read_tr16_b64_v4i16((LAS v4i16_t*)p)); }
__device__ __forceinline__ float rowmax(const f32x16& p0, const f32x16& p1) {
    float a = max3f(p0[0], p0[1], p1[0]), b = max3f(p0[2], p0[3], p1[1]); a = max3f(a, p1[2], p1[3]);
#pragma unroll
    for (int r = 4; r < 16; r += 4) { a = max3f(a, p0[r], p0[r + 1]); b = max3f(b, p0[r + 2], p0[r + 3]); a = max3f(a, p1[r], p1[r + 1]); b = max3f(b, p1[r + 2], p1[r + 3]); }
    const float m = max2f(a, b);
    auto rr = __builtin_amdgcn_permlane32_swap(__float_as_uint(m), __float_as_uint(m), false, false);
    return max2f(__uint_as_float(rr[0]), __uint_as_float(rr[1]));
}
__device__ __forceinline__ void pv(f32x16* o, int vb, bf16x8 pa0, bf16x8 pa1, bf16x8 pa2, bf16x8 pa3) {
#pragma unroll
    for (int d0 = 0; d0 < 2; ++d0) { s16x4 lo[4], hi[4];
#pragma unroll
        for (int ks = 0; ks < 4; ++ks) {
            asm volatile("ds_read_b64_tr_b16 %0,%1 offset:%c2" : "=&v"(lo[ks]) : "v"(vb), "i"(d0 * 4096 + ks * 1024) : "memory");
            asm volatile("ds_read_b64_tr_b16 %0,%1 offset:%c2" : "=&v"(hi[ks]) : "v"(vb), "i"(d0 * 4096 + ks * 1024 + 512) : "memory"); }
        asm volatile("s_waitcnt lgkmcnt(0)" ::: "memory"); SBAR();
#define PK(k) (bf16x8){lo[k][0], lo[k][1], lo[k][2], lo[k][3], hi[k][0], hi[k][1], hi[k][2], hi[k][3]}
        o[d0] = __builtin_amdgcn_mfma_f32_32x32x16_bf16(pa0, PK(0), o[d0], 0, 0, 0);
        o[d0] = __builtin_amdgcn_mfma_f32_32x32x16_bf16(pa1, PK(1), o[d0], 0, 0, 0);
        o[d0] = __builtin_amdgcn_mfma_f32_32x32x16_bf16(pa2, PK(2), o[d0], 0, 0, 0);
        o[d0] = __builtin_amdgcn_mfma_f32_32x32x16_bf16(pa3, PK(3), o[d0], 0, 0, 0);
#undef PK
    }
}

template <int THRL> __device__ __forceinline__ void attn_unit(int b, int h, int qb, int ts, const bf16_t* Q, const bf16_t* __restrict__ K, const bf16_t* __restrict__ V, bf16_t* O, const float* __restrict__ F2, char* shm) {
    const int tid = threadIdx.x, lane = tid & 63, r32 = lane & 31, hi = lane >> 5; const int wid = __builtin_amdgcn_readfirstlane(tid >> 6);
    const long rowbase = (long)b * SEQ; const int q0 = qb * QB;
    const bf16_t* Qw = Q + (rowbase + q0 + wid * QBLK) * PQ + h * D;
    const bf16_t* Kh = K + (rowbase + (long)ts * KVBLK) * PQ + h * D, *Vh = V + (rowbase + (long)ts * KVBLK) * PQ + h * D;
    const unsigned lds0 = (unsigned)(uintptr_t)shm;
    float* wsf = (float*)(shm + LDS_WS) + wid * 64;
    { const f32x4* Fg = (const f32x4*)(F2 + (size_t)(b * NHEAD + h) * SEQ + (size_t)ts * KVBLK); LAS f32x4* Fl4 = (LAS f32x4*)((LAS char*)(lds_cptr)shm + LDS_F); const int n4 = (q0 + QB - ts * KVBLK) / 4;
      for (int p = tid; p < n4; p += NW * 64) Fl4[p] = Fg[p]; }
    const LAS float* Fl = (const LAS float*)((lds_cptr)shm + LDS_F);
    asm volatile("s_waitcnt vmcnt(0) lgkmcnt(0)" ::: "memory");
    const bf16_t* ksrc = Kh + (long)lane * PQ + wid * 8;
    const bf16_t* vsrc = Vh + (long)(16 * (wid & 3) + (lane >> 2)) * PQ + (wid >> 2) * 32 + (lane & 3) * 8;
    const unsigned kdst = lds0 + LDS_K + wid * 1024, vdst = lds0 + LDS_V + wid * 1024;
#define DMA_K(t, slot) glds16(ksrc + (long)(t) * KVBLK * PQ, (unsigned)__builtin_amdgcn_readfirstlane(kdst + (slot)))
#define DMA_V(t, slot) glds16(vsrc + (long)(t) * KVBLK * PQ, (unsigned)__builtin_amdgcn_readfirstlane(vdst + (slot)))
    const int vb0 = (int)(lds0 + LDS_V) + ((lane >> 4) & 1) * 32 + (lane & 3) * 8 + (4 * hi + ((lane & 15) >> 2)) * 64;
    bf16x8 kf[8];
    const lds_cptr shm3 = (lds_cptr)shm; const lds_cptr kp0 = shm3 + LDS_K + hi * 1024 + r32 * 16; const lds_cptr vp0 = shm3 + LDS_V + ((lane >> 4) & 1) * 32 + (lane & 3) * 8 + (4 * hi + ((lane & 15) >> 2)) * 64;
    const int NT = (q0 + QB) / KVBLK - ts;
    DMA_K(0, 0); DMA_V(0, 0); DMA_K(1, SLOTB);
    bf16x8 qr[4];
#pragma unroll
    for (int d0 = 0; d0 < 4; ++d0) qr[d0] = *reinterpret_cast<const bf16x8*>(&Qw[(long)r32 * PQ + d0 * 16 + hi * 8]);
    float mhat = 0.f, l_reg = 0.f, nm = 0.f; f32x16 o[2]; o[0] = f32x16{}; o[1] = f32x16{};
    f32x4 fa[4], fb[4];
#define FLD(tt) do { const LAS float* fp_ = Fl + 64 * (tt) + 4 * hi; _Pragma("unroll") for (int g_ = 0; g_ < 4; ++g_) { fa[g_] = *(const LAS f32x4*)(fp_ + 8 * g_); fb[g_] = *(const LAS f32x4*)(fp_ + 32 + 8 * g_); } } while (0)
#define CINIT(C0, C1) do { _Pragma("unroll") for (int g_ = 0; g_ < 4; ++g_) { _Pragma("unroll") for (int e_ = 0; e_ < 4; ++e_) { C0[4 * g_ + e_] = nm - fa[g_][e_]; C1[4 * g_ + e_] = nm - fb[g_][e_]; } } } while (0)
    const int qrel = wid * QBLK + r32;
#define CMASK(P0, P1, t) do { int jb_ = (t) - (NT - 4); if (jb_ >= 0) cmask(P0, P1, jb_, qrel, hi); } while (0)
    bool resc = false;
#define START(P0, P1) do { const float rm = rowmax(P0, P1); resc = false; \
    { const float dl = rm; mhat = fadd_s(mhat, dl); \
      _Pragma("unroll") for (int r = 0; r < 16; ++r) { P0[r] = fsub_s(P0[r], dl); P1[r] = fsub_s(P1[r], dl); } \
      nm = -mhat; } \
    _Pragma("unroll") for (int r = 0; r < 16; ++r) P0[r] = __builtin_amdgcn_exp2f(P0[r]); } while (0)
#define RESC() do { if (resc) { asm volatile("s_waitcnt lgkmcnt(0)" ::: "memory"); \
      _Pragma("unroll") for (int d_ = 0; d_ < 2; ++d_) _Pragma("unroll") for (int r = 0; r < 16; ++r) o[d_][r] *= wsf[crow(r, hi)]; } } while (0)
    f32x16 pA0, pA1, pB0, pB1;
    int sl_prev = 0, sl_cur = 0, sl_next = SLOTB;
#define ROT() do { sl_prev = sl_cur; sl_cur = sl_next; sl_next = (sl_next == (NSLOT - 1) * SLOTB) ? 0 : sl_next + SLOTB; } while (0)
    DMA_K(2, 2 * SLOTB);
    WAIT_BAR(3);
    FLD(0); CINIT(pA0, pA1);
    { const lds_cptr kb = shm3 + LDS_K + hi * 1024 + r32 * 16;
#pragma unroll
      for (int d0 = 0; d0 < 4; ++d0) { const bf16x8 b0 = *(const LAS bf16x8*)(kb + d0 * 2048); const bf16x8 b1 = *(const LAS bf16x8*)(kb + d0 * 2048 + 512);
          pA0 = __builtin_amdgcn_mfma_f32_32x32x16_bf16(b0, qr[d0], pA0, 0, 0, 0); pA1 = __builtin_amdgcn_mfma_f32_32x32x16_bf16(b1, qr[d0], pA1, 0, 0, 0); } }
    asm volatile("s_nop 15\n\ts_nop 7" : "+v"(pA0), "+v"(pA1)); CMASK(pA0, pA1, 0);
    START(pA0, pA1);
    _Pragma("unroll") for (int r = 0; r < 16; ++r) pA1[r] = __builtin_amdgcn_exp2f(pA1[r]);
    FLD(1);
    WAIT_BAR(0);
    DMA_K(3, 0); DMA_V(1, SLOTB);
    ROT();
    kload8(kf, kp0 + sl_cur);
    WAIT_BAR(2);
    s16x4 vlo[8], vhi[8]; u32x4 pw0, pw1, pw2, pw3;
#define PKW(P, B) cvtpk(P[B], P[B + 1])
#define PAF(k) __builtin_bit_cast(bf16x8, pw##k)
#define VFR(i) (bf16x8){vlo[i][0], vlo[i][1], vlo[i][2], vlo[i][3], vhi[i][0], vhi[i][1], vhi[i][2], vhi[i][3]}
#define PIN(x) asm volatile("" : "+v"(x))
#define MX3(a, b, c) __builtin_fmaxf(__builtin_fmaxf((a), (b)), (c))
#define GAPA(MF, A0, A1, A2, A3, W0, W1, PW) do { MF; sacc += A0; sacc += A1; sacc += A2; sacc += A3; PIN(sacc); W0; W1; PIN(PW); SBAR(); } while (0)
#define EX(v) __builtin_amdgcn_exp2f(v)
#define GAPB(MF, X, B) do { MF; X[B] = EX(X[B]); X[B + 1] = EX(X[B + 1]); X[B + 2] = EX(X[B + 2]); X[B + 3] = EX(X[B + 3]); PIN(X); SBAR(); } while (0)
#define VRD(i) do { vlo[i] = vtr(vp_ + (((i) >> 2) * 4096 + ((i) & 3) * 1024)); vhi[i] = vtr(vp_ + (((i) >> 2) * 4096 + ((i) & 3) * 1024 + 512)); } while (0)
#define KRD(G, j) do { if (G) { kload2(kf, kp0 + sl_next, j); SBAR(); } } while (0)
#define STEP(C0, C1, P0, P1, t, GK, GV, GL) do { SBAR(); \
    CINIT(C0, C1); SBAR(); \
    const lds_cptr vp_ = vp0 + sl_prev; \
    VRD(0); SBAR(); float sacc = (P0[0] + P0[1]); \
    GAPA(C0 = __builtin_amdgcn_mfma_f32_32x32x16_bf16(kf[0], qr[0], C0, 0, 0, 0), P0[2], P0[3], P0[4], P0[5],     pw0[0] = PKW(P0, 0), pw0[1] = PKW(P0, 2), pw0); \
    VRD(4); SBAR(); GAPA(C1 = __builtin_amdgcn_mfma_f32_32x32x16_bf16(kf[1], qr[0], C1, 0, 0, 0), P0[6], P0[7], P0[8], P0[9],     pw0[2] = PKW(P0, 4), pw0[3] = PKW(P0, 6), pw0); \
    VRD(1); SBAR(); GAPA(C0 = __builtin_amdgcn_mfma_f32_32x32x16_bf16(kf[2], qr[1], C0, 0, 0, 0),   P0[10], P0[11], P0[12], P0[13], pw1[0] = PKW(P0, 8), pw1[1] = PKW(P0, 10), pw1); \
    VRD(5); SBAR(); GAPA(C1 = __builtin_amdgcn_mfma_f32_32x32x16_bf16(kf[3], qr[1], C1, 0, 0, 0),   P0[14], P0[15], P1[0], P1[1],   pw1[2] = PKW(P0, 12), pw1[3] = PKW(P0, 14), pw1); \
    VRD(2); SBAR(); GAPA(C0 = __builtin_amdgcn_mfma_f32_32x32x16_bf16(kf[4], qr[2], C0, 0, 0, 0),   P1[2], P1[3], P1[4], P1[5],     pw2[0] = PKW(P1, 0), pw2[1] = PKW(P1, 2), pw2); \
    VRD(6); SBAR(); GAPA(C1 = __builtin_amdgcn_mfma_f32_32x32x16_bf16(kf[5], qr[2], C1, 0, 0, 0),   P1[6], P1[7], P1[8], P1[9],     pw2[2] = PKW(P1, 4), pw2[3] = PKW(P1, 6), pw2); \
    VRD(3); SBAR(); GAPA(C0 = __builtin_amdgcn_mfma_f32_32x32x16_bf16(kf[6], qr[3], C0, 0, 0, 0),   P1[10], P1[11], P1[12], P1[13], pw3[0] = PKW(P1, 8), pw3[1] = PKW(P1, 10), pw3); \
    VRD(7); SBAR(); GAPA(C1 = __builtin_amdgcn_mfma_f32_32x32x16_bf16(kf[7], qr[3], C1, 0, 0, 0),   P1[14], P1[15], 0.f, 0.f,       pw3[2] = PKW(P1, 12), pw3[3] = PKW(P1, 14), pw3); \
    l_reg += sacc; \
    if (GK) { DMA_K((t) + 3, sl_cur); } if (GV) { DMA_V((t) + 1, sl_next); } \
    CMASK(C0, C1, t); \
    { float a = MX3(C0[0], C0[1], C1[0]), b = MX3(C0[2], C0[3], C1[1]); a = MX3(a, C1[2], C1[3]); \
      _Pragma("unroll") for (int r = 4; r < 16; r += 4) { a = MX3(a, C0[r], C0[r + 1]); b = MX3(b, C0[r + 2], C0[r + 3]); a = MX3(a, C1[r], C1[r + 1]); b = MX3(b, C1[r + 2], C1[r + 3]); } \
      float rm = __builtin_fmaxf(a, b); { auto rr = __builtin_amdgcn_permlane32_swap(__float_as_uint(rm), __float_as_uint(rm), false, false); rm = __builtin_fmaxf(__uint_as_float(rr[0]), __uint_as_float(rr[1])); } \
      resc = false; \
      if (__builtin_expect(__any(rm > (float)THRL), 0)) { const float dl = __builtin_fmaxf(rm, 0.f); mhat += dl; \
        _Pragma("unroll") for (int r = 0; r < 16; ++r) { C0[r] -= dl; C1[r] -= dl; } \
        nm = -mhat; \
        const float f = __builtin_amdgcn_exp2f(-dl); l_reg *= f; if (hi == 0) wsf[r32] = f; resc = true; } } \
    SBAR(); \
    GAPB(o[0] = __builtin_amdgcn_mfma_f32_32x32x16_bf16(PAF(0), VFR(0), o[0], 0, 0, 0), C0, 0); \
    GAPB(o[1] = __builtin_amdgcn_mfma_f32_32x32x16_bf16(PAF(0), VFR(4), o[1], 0, 0, 0), C0, 4); \
    KRD(GL, 0); GAPB(o[0] = __builtin_amdgcn_mfma_f32_32x32x16_bf16(PAF(1), VFR(1), o[0], 0, 0, 0), C0, 8); \
    KRD(GL, 1); GAPB(o[1] = __builtin_amdgcn_mfma_f32_32x32x16_bf16(PAF(1), VFR(5), o[1], 0, 0, 0), C0, 12); \
    KRD(GL, 2); GAPB(o[0] = __builtin_amdgcn_mfma_f32_32x32x16_bf16(PAF(2), VFR(2), o[0], 0, 0, 0), C1, 0); \
    KRD(GL, 3); GAPB(o[1] = __builtin_amdgcn_mfma_f32_32x32x16_bf16(PAF(2), VFR(6), o[1], 0, 0, 0), C1, 4); \
    GAPB(o[0] = __builtin_amdgcn_mfma_f32_32x32x16_bf16(PAF(3), VFR(3), o[0], 0, 0, 0), C1, 8); \
    GAPB(o[1] = __builtin_amdgcn_mfma_f32_32x32x16_bf16(PAF(3), VFR(7), o[1], 0, 0, 0), C1, 12); \
    FLD((t) + 1); \
    } while (0)
    int t = 1;
#undef CMASK
#define CMASK(P0, P1, t) do { } while (0)
    for (; t + 5 < NT; t += 2) {
        STEP(pB0, pB1, pA0, pA1, t, true, true, true);     WAIT_BAR(2); RESC(); ROT();
        STEP(pA0, pA1, pB0, pB1, t + 1, true, true, true);   WAIT_BAR(2); RESC(); ROT();
    }
#undef CMASK
#define CMASK(P0, P1, t) do { int jb_ = (t) - (NT - 4); if (jb_ >= 0) cmask(P0, P1, jb_, qrel, hi); } while (0)
#define ENDW(tt) do { if ((tt) + 3 < NT) { WAIT_BAR(2); } else if ((tt) + 2 < NT) { WAIT_BAR(1); } else { WAIT_BAR(0); } } while (0)
    for (; t + 1 < NT; t += 2) {
        STEP(pB0, pB1, pA0, pA1, t, (t + 3 < NT), (t + 1 < NT), (t + 1 < NT));       ENDW(t);   RESC(); ROT();
        STEP(pA0, pA1, pB0, pB1, t + 1, (t + 4 < NT), (t + 2 < NT), (t + 2 < NT));     ENDW(t + 1); RESC(); ROT();
    }
    STEP(pB0, pB1, pA0, pA1, NT - 1, false, false, false); RESC();
    { float sacc = pB0[0] + pB0[1]; _Pragma("unroll") for (int r = 2; r < 16; ++r) sacc += pB0[r]; _Pragma("unroll") for (int r = 0; r < 16; ++r) sacc += pB1[r]; l_reg += sacc;
      pw0 = (u32x4){PKW(pB0, 0), PKW(pB0, 2), PKW(pB0, 4), PKW(pB0, 6)}; pw1 = (u32x4){PKW(pB0, 8), PKW(pB0, 10), PKW(pB0, 12), PKW(pB0, 14)}; pw2 = (u32x4){PKW(pB1, 0), PKW(pB1, 2), PKW(pB1, 4), PKW(pB1, 6)}; pw3 = (u32x4){PKW(pB1, 8), PKW(pB1, 10), PKW(pB1, 12), PKW(pB1, 14)};
      SBAR(); pv(o, vb0 + sl_cur, PAF(0), PAF(1), PAF(2), PAF(3)); }
#undef PKW
#undef PAF
#undef VFR
#undef PIN
#undef MX3
#undef GAPA
#undef GAPB
#undef EX
#undef VRD
#undef KRD
#undef STEP
#undef ENDW
    { auto rr = __builtin_amdgcn_permlane32_swap(__float_as_uint(l_reg), __float_as_uint(l_reg), false, false); l_reg = __uint_as_float(rr[0]) + __uint_as_float(rr[1]); }
    if (hi == 0) wsf[32 + r32] = l_reg; asm volatile("s_waitcnt lgkmcnt(0)" ::: "memory");
    float rli[16];
#pragma unroll
    for (int r = 0; r < 16; ++r) rli[r] = __builtin_amdgcn_rcpf(wsf[32 + crow(r, hi)]);
    bf16_t* Ow = O + (rowbase + q0 + wid * QBLK) * PO + h * D;
    { bf16_t* stg = (bf16_t*)(shm + LDS_OST) + wid * 2048;
#pragma unroll
      for (int r = 0; r < 16; ++r) { const int orow = crow(r, hi);
#pragma unroll
          for (int d0 = 0; d0 < 2; ++d0) { const float v = o[d0][r] * rli[r]; stg[orow * 64 + d0 * 32 + r32] = (bf16_t)(cvtpk(v, v) & 0xffffu); } }
      asm volatile("s_waitcnt lgkmcnt(0)" ::: "memory");
#pragma unroll
      for (int i = 0; i < 4; ++i) { const int row = i * 8 + (lane >> 3), ch = lane & 7; const u32x4 v = *(const u32x4*)(stg + row * 64 + ch * 8); *(u32x4*)(Ow + (long)row * PO + ch * 8) = v; } }
    asm volatile("s_waitcnt lgkmcnt(0)\n\ts_barrier" ::: "memory");
#undef DMA_K
#undef DMA_V
#undef CMASK
#undef START
#undef RESC
#undef ROT
#undef FLD
#undef CINIT
}
#undef SBAR
#undef WAIT_BAR
}

namespace ret {
constexpr int RS = 272;
constexpr int IMG_Q = 0, IMG_K = 64 * RS, IMG_KT = 2 * 64 * RS, IMG_V = 3 * 64 * RS;
constexpr int PS = 144;
constexpr int IMG_P = 4 * 64 * RS;
constexpr int IMG_ST = IMG_P + 64 * PS;
constexpr int OS = 132;
constexpr int IMG_O = IMG_ST + 128 * RS;
constexpr int LDS_END = IMG_O + 64 * OS * 4;
static_assert(LDS_END <= LDS_BYTES, "retention LDS map");
typedef short v4i16_t __attribute__((ext_vector_type(4)));
__device__ __forceinline__ s16x4 tr4(LAS const char* p) { return __builtin_bit_cast(s16x4, __builtin_amdgcn_ds_read_tr16_b64_v4i16((LAS v4i16_t*)p)); }
__device__ __forceinline__ bf16x8 frag_tr(LAS const char* img, int stride, int k0, int c0, int lane) {
    const int g4 = lane >> 4, i = lane & 15, qq = i >> 2, p = i & 3, hh = g4 >> 1, nh = g4 & 1;
    LAS const char* a = img + (k0 + 8 * hh + qq) * stride + (c0 + 16 * nh + 4 * p) * 2;
    const s16x4 lo = tr4(a), hi = tr4(a + 4 * stride);
    return (bf16x8){lo[0], lo[1], lo[2], lo[3], hi[0], hi[1], hi[2], hi[3]};
}
__device__ __forceinline__ bf16x8 frag_row(LAS const char* img, int stride, int r0, int k0, int lane) {
    return *(const LAS bf16x8*)(img + (r0 + (lane & 31)) * stride + (k0 + 8 * (lane >> 5)) * 2);
}
__device__ __forceinline__ int crow(int r, int hi) { return (r & 3) + 8 * (r >> 2) + 4 * hi; }

template <bool APPLY>
__device__ __forceinline__ void unit(int bh, int g, const bf16_t* RQ, const bf16_t* RK, const bf16_t* RV, const bf16_t* SG, float* GST, bf16_t* MIX, LAS char* lds) {
    int tid_ = threadIdx.x; asm volatile("" : "+v"(tid_));
    const int tid = tid_, lane = tid & 63, hi = lane >> 5; const int w = __builtin_amdgcn_readfirstlane(tid >> 6);
    const int b = bh >> 2, h = bh & 3;
    const float l2g = log2f(1.0f - exp2f(-5.0f - (float)h));
    const float cd = exp2f(64.0f * l2g);
    const size_t row0 = (size_t)b * SEQ + (size_t)g * 512;
    u32x4 rq[2], rk[2], rv[2];
    auto issue = [&](int j) {
#pragma unroll
        for (int i = 0; i < 2; ++i) { const int p = tid + 512 * i, row = p >> 4, ch = p & 15; const size_t off = (row0 + j * 64 + row) * 512 + h * 128 + ch * 8;
            if (APPLY) rq[i] = *(const u32x4*)(RQ + off);
            rk[i] = *(const u32x4*)(RK + off); rv[i] = *(const u32x4*)(RV + off); }
    };
    const int db = w >> 1, eb0 = 2 * (w & 1);
    f32x16 S0 = f32x16{}, S1 = f32x16{};
    if (APPLY) {
        const float Gm = exp2f(512.0f * l2g);
        for (int gp = 0; gp < g; ++gp) {
            const float* src = GST + ((((size_t)(bh * 16 + gp) * 8 + w) * 2) * 16) * 64 + lane;
#pragma unroll
            for (int r = 0; r < 16; ++r) { S0[r] = S0[r] * Gm + src[r * 64]; S1[r] = S1[r] * Gm + src[(16 + r) * 64]; }
        }
    }
    issue(0);
    for (int j = 0; j < 8; ++j) {
#pragma unroll
        for (int i = 0; i < 2; ++i) { const int p = tid + 512 * i, row = p >> 4, ch = p & 15; const int o = row * RS + ch * 16;
            if (APPLY) { *(LAS u32x4*)(lds + IMG_Q + o) = rq[i]; *(LAS u32x4*)(lds + IMG_K + o) = rk[i]; }
            *(LAS u32x4*)(lds + IMG_V + o) = rv[i];
            const float kw = exp2f((float)(63 - row) * l2g);
            u32x4 kt;
#pragma unroll
            for (int e = 0; e < 4; ++e) kt[e] = cvtpk(bflo(rk[i][e]) * kw, bfhi(rk[i][e]) * kw);
            *(LAS u32x4*)(lds + IMG_KT + o) = kt; }
        if (APPLY) {
#pragma unroll
            for (int tile = 0; tile < 2; ++tile) { const f32x16& S = tile ? S1 : S0; const int e = (eb0 + tile) * 32 + (lane & 31);
#pragma unroll
                for (int g4 = 0; g4 < 4; ++g4) { const int d = db * 32 + 8 * g4 + 4 * hi; u32x2 v; v.x = cvtpk(S[4 * g4], S[4 * g4 + 1]); v.y = cvtpk(S[4 * g4 + 2], S[4 * g4 + 3]);
                    *(LAS u32x2*)(lds + IMG_ST + e * RS + d * 2) = v; } }
        }
        if (j + 1 < 8) issue(j + 1);
        LDS_WAIT(); __builtin_amdgcn_s_barrier();
        f32x16 oin = f32x16{}, oit = f32x16{};
        const int qb = w >> 2, eb = w & 3;
        if (APPLY) {
#pragma unroll
            for (int s = 0; s < 8; ++s) oin = __builtin_amdgcn_mfma_f32_32x32x16_bf16(frag_row(lds + IMG_Q, RS, qb * 32, s * 16, lane), frag_row(lds + IMG_ST, RS, eb * 32, s * 16, lane), oin, 0, 0, 0);
            if (w < 4) {
                const int tb = w >> 1, qb2 = w & 1; f32x16 sc = f32x16{};
#pragma unroll
                for (int s = 0; s < 8; ++s) sc = __builtin_amdgcn_mfma_f32_32x32x16_bf16(frag_row(lds + IMG_K, RS, tb * 32, s * 16, lane), frag_row(lds + IMG_Q, RS, qb2 * 32, s * 16, lane), sc, 0, 0, 0);
                const int q = qb2 * 32 + (lane & 31);
#pragma unroll
                for (int g4 = 0; g4 < 4; ++g4) { const int t0 = tb * 32 + 8 * g4 + 4 * hi; float pv4[4];
#pragma unroll
                    for (int e = 0; e < 4; ++e) { const int dd = q - (t0 + e); pv4[e] = sc[4 * g4 + e] * exp2f((float)(dd < 0 ? -dd : dd) * l2g); }
                    u32x2 v; v.x = cvtpk(pv4[0], pv4[1]); v.y = cvtpk(pv4[2], pv4[3]);
                    *(LAS u32x2*)(lds + IMG_P + q * PS + t0 * 2) = v; }
            }
            LDS_WAIT(); __builtin_amdgcn_s_barrier();
#pragma unroll
            for (int s = 0; s < 4; ++s) oit = __builtin_amdgcn_mfma_f32_32x32x16_bf16(frag_row(lds + IMG_P, PS, qb * 32, s * 16, lane), frag_tr(lds + IMG_V, RS, s * 16, eb * 32, lane), oit, 0, 0, 0);
#pragma unroll
            for (int r = 0; r < 16; ++r) { const int q = qb * 32 + crow(r, hi); const float qw = exp2f((float)(q + 1) * l2g);
                *(LAS float*)(lds + IMG_O + (q * OS + eb * 32 + (lane & 31)) * 4) = oit[r] + qw * oin[r]; }
        }
#pragma unroll
        for (int r = 0; r < 16; ++r) { S0[r] *= cd; S1[r] *= cd; }
#pragma unroll
        for (int s = 0; s < 4; ++s) { const bf16x8 a = frag_tr(lds + IMG_KT, RS, s * 16, db * 32, lane);
            S0 = __builtin_amdgcn_mfma_f32_32x32x16_bf16(a, frag_tr(lds + IMG_V, RS, s * 16, eb0 * 32, lane), S0, 0, 0, 0);
            S1 = __builtin_amdgcn_mfma_f32_32x32x16_bf16(a, frag_tr(lds + IMG_V, RS, s * 16, (eb0 + 1) * 32, lane), S1, 0, 0, 0); }
        LDS_WAIT(); __builtin_amdgcn_s_barrier();
        if (APPLY) {
#pragma unroll
            for (int rr = 0; rr < 8; ++rr) { const int q = w * 8 + rr; const f32x2 v = *(const LAS f32x2*)(lds + IMG_O + (q * OS + 2 * lane) * 4);
                const float mu = wave_sum(v.x + v.y) * (1.0f / 128.0f); const float dx = v.x - mu, dy = v.y - mu;
                const float var = wave_sum(dx * dx + dy * dy) * (1.0f / 128.0f); const float rstd = rsqrtf(var + GN_EPS);
                const size_t trow = row0 + j * 64 + q; const unsigned gw = *(const unsigned*)(SG + trow * 512 + h * 128 + 2 * lane);
                *(unsigned*)(MIX + trow * 1024 + h * 128 + 2 * lane) = cvtpk(dx * rstd * bflo(gw), dy * rstd * bfhi(gw)); }
        }
    }
    if (!APPLY) {
        float* dst = GST + ((((size_t)(bh * 16 + g) * 8 + w) * 2) * 16) * 64 + lane;
#pragma unroll
        for (int r = 0; r < 16; ++r) { dst[r * 64] = S0[r]; dst[(16 + r) * 64] = S1[r]; }
    }
    LDS_WAIT(); __builtin_amdgcn_s_barrier();
}
}


#define XB_TMO      128
#define XB_XCNT(j)  (256  + 64 * (j))
#define XB_XSUB(j)  (1280 + 64 * (j))
#define XB_XGEN(j)  (2304 + 64 * (j))
#define XB_TOP      3328
#define XB_TOPGEN   3392
#define XCD_BAR_WORDS 3456
#define XB_SPIN_CAP (1u << 18)
__device__ __forceinline__ unsigned xb_ld(unsigned* p)              { return __hip_atomic_load(p, __ATOMIC_RELAXED, __HIP_MEMORY_SCOPE_AGENT); }
__device__ __forceinline__ unsigned xb_add(unsigned* p, unsigned v) { return __hip_atomic_fetch_add(p, v, __ATOMIC_RELAXED, __HIP_MEMORY_SCOPE_AGENT); }
__device__ __forceinline__ unsigned xb_xcc_id() { return (unsigned)__builtin_amdgcn_s_getreg((3 << 11) | 20) & 0xFu; }
#define XB_SPIN(cond, bar) do { unsigned _sp = 0; while (cond) { __builtin_amdgcn_s_sleep(1); \
    if ((++_sp & 255u) == 0u) { if (xb_ld(&(bar)[XB_TMO])) break; if (_sp > XB_SPIN_CAP) { atomicAdd(&(bar)[XB_TMO], 1u); break; } } } } while (0)
struct XcdBarrier { unsigned* bar; unsigned x; volatile LAS unsigned* st; };
__device__ __forceinline__ XcdBarrier xcd_barrier_post(unsigned* bar, volatile LAS unsigned* st) {
    XcdBarrier b; b.bar = bar; b.x = xb_xcc_id(); b.st = st;
    if (threadIdx.x == 0) (void)xb_add(&bar[XB_XCNT(b.x)], 1u);
    return b;
}
__device__ __forceinline__ void xcd_barrier_complete(unsigned* bar, unsigned x, unsigned& nloc, unsigned& nx) {
    const unsigned G = gridDim.x * gridDim.y * gridDim.z;
    unsigned sum, cnt, mine, sp = 0u;
    for (;;) {
        sum = 0u; cnt = 0u; mine = 0u;
#pragma unroll
        for (unsigned j = 0; j < 16; ++j) { const unsigned c = xb_ld(&bar[XB_XCNT(j)]); sum += c; cnt += (c > 0u) ? 1u : 0u; mine = (j == x) ? c : mine; }
        if (sum == G) break;
        __builtin_amdgcn_s_sleep(1);
        if ((++sp & 255u) == 0u) { if (xb_ld(&bar[XB_TMO])) break; if (sp > XB_SPIN_CAP) { atomicAdd(&bar[XB_TMO], 1u); break; } }
    }
    nloc = mine > 0u ? mine : 1u; nx = cnt > 0u ? cnt : 1u;
}
__device__ __forceinline__ void xcd_barrier(const XcdBarrier& b) {
    asm volatile("s_waitcnt vmcnt(0)" ::: "memory");
    __syncthreads();
    if (threadIdx.x == 0) {
        unsigned* bar = b.bar;
        __builtin_amdgcn_s_waitcnt(0);
        unsigned nloc = b.st[0], nx = b.st[1];
        if (nloc == 0u) { xcd_barrier_complete(bar, b.x, nloc, nx); b.st[0] = nloc; b.st[1] = nx; }
        const unsigned old = xb_add(&bar[XB_XSUB(b.x)], 1u);
        const unsigned gen = old / nloc;
        if (old + 1u == (gen + 1u) * nloc) {
            __builtin_amdgcn_fence(__ATOMIC_RELEASE, "agent");
            asm volatile("s_waitcnt vmcnt(0)" ::: "memory");
            const unsigned og = xb_add(&bar[XB_TOP], 1u);
            const unsigned tg = og / nx;
            if (og + 1u == (tg + 1u) * nx) xb_add(&bar[XB_TOPGEN], 1u);
            else XB_SPIN(xb_ld(&bar[XB_TOPGEN]) == tg, bar);
            __builtin_amdgcn_fence(__ATOMIC_ACQUIRE, "agent");
            xb_add(&bar[XB_XGEN(b.x)], 1u);
            asm volatile("s_waitcnt vmcnt(0)" ::: "memory");
        } else {
            XB_SPIN(xb_ld(&bar[XB_XGEN(b.x)]) == gen, bar);
            __builtin_amdgcn_fence(__ATOMIC_ACQUIRE, "agent");
            asm volatile("s_waitcnt vmcnt(0)" ::: "memory");
        }
    }
    __syncthreads();
}

struct Frame {
    LAS unsigned char* lds; int tid, lane, wave, vcu, G;
};

__device__ __forceinline__ void tr_item(const float* __restrict__ W, int ldw, int k0, int n0, const float* __restrict__ gk, bf16_t* WT, int kind, LAS unsigned* scr, int lane) {
    const int nch = lane & 15, kq = lane >> 4;
    f32x4 a[8], b[8];
#pragma unroll
    for (int i = 0; i < 8; ++i) { const int kp = 4 * i + kq; const float* p = W + (size_t)(k0 + 2 * kp) * ldw + n0 + 4 * nch; a[i] = *(const f32x4*)p; b[i] = *(const f32x4*)(p + ldw); }
#pragma unroll
    for (int i = 0; i < 8; ++i) { const int kp = 4 * i + kq; float ga = 1.f, gb = 1.f; if (gk) { ga = gk[k0 + 2 * kp]; gb = gk[k0 + 2 * kp + 1]; }
#pragma unroll
        for (int e = 0; e < 4; ++e) scr[(4 * nch + e) * 36 + kp] = cvtpk(a[i][e] * ga, b[i][e] * gb); }
    LDS_WAIT(); asm volatile("" ::: "memory");
    const int c = lane & 7, nr = lane >> 3;
#pragma unroll
    for (int j = 0; j < 8; ++j) { const int n = nr + 8 * j; const u32x4 v = *(const LAS u32x4*)(scr + n * 36 + 4 * c);
        const int cn = n0 + n; const int row = (kind == 0) ? pos_inproj(cn) : (kind == 1) ? pos_plain(cn) : pos_w1(cn);
        *(u32x4*)(WT + (size_t)row * 1024 + k0 + 8 * c) = v; }
    LDS_WAIT(); asm volatile("" ::: "memory");
}

__global__ void __launch_bounds__(NTHREADS, 2) mk_fwd(Params P) {
    __builtin_assume(__builtin_amdgcn_workitem_id_y() == 0); __builtin_assume(__builtin_amdgcn_workitem_id_z() == 0);
    extern __shared__ __attribute__((aligned(16))) unsigned char lds_raw[];
    cg::grid_group grid = cg::this_grid();
    Frame F; F.lds = (LAS unsigned char*)lds_raw; F.tid = threadIdx.x; F.lane = F.tid & 63; F.wave = __builtin_amdgcn_readfirstlane(F.tid >> 6);
    F.G = gridDim.x; { const int bx = blockIdx.x; F.vcu = (F.G % 8 == 0) ? (bx % 8) * (F.G / 8) + bx / 8 : bx; }
    unsigned char* ws = P.ws;
    unsigned* ctl = (unsigned*)(ws + WS_CTL);
    float* ropec = (float*)(ws + WS_ROPEC); float* ropes = (float*)(ws + WS_ROPES);
    float* wr3 = (float*)(ws + WS_WR3); float* logf2 = (float*)(ws + WS_LOGF); float* F2 = (float*)(ws + WS_F2);
    int* ltok = (int*)(ws + WS_LTOK); float* lrstd = (float*)(ws + WS_LRSTD); int* inv = (int*)(ws + WS_INV); float* gates = (float*)(ws + WS_GATE);
    bf16_t* H1B = (bf16_t*)(ws + WS_H1B); bf16_t* WinT = (bf16_t*)(ws + WS_WINT); bf16_t* WoT = (bf16_t*)(ws + WS_WOT);
    bf16_t* W2T = (bf16_t*)(ws + WS_W2T); bf16_t* W1T = (bf16_t*)(ws + WS_W1T); bf16_t* Yb = (bf16_t*)(ws + WS_Y);
    bf16_t* U = (bf16_t*)(ws + WS_U); unsigned char* proj = ws + WS_PROJ;
    bf16_t* RQ = (bf16_t*)(proj); bf16_t* RK = (bf16_t*)(proj + PROJ_STRIDE); bf16_t* RV = (bf16_t*)(proj + 2 * PROJ_STRIDE); bf16_t* SG = (bf16_t*)(proj + 3 * PROJ_STRIDE);
    bf16_t* FQ = (bf16_t*)(proj + 4 * PROJ_STRIDE); bf16_t* FK = (bf16_t*)(proj + 5 * PROJ_STRIDE); bf16_t* FV = (bf16_t*)(proj + 6 * PROJ_STRIDE);
    float* GST = (float*)(ws + WS_GST); bf16_t* MIX = (bf16_t*)(ws + WS_MIX); bf16_t* Hb = (bf16_t*)(ws + WS_H);
    const int lo = P.ph_lo, hi_ph = P.ph_hi;
#ifndef MK_PHMASK
#define MK_PHMASK 0x1ff
#endif
#define IN(k) (((MK_PHMASK >> (k)) & 1) && lo <= (k) && (k) < hi_ph)
#define REP(k) for (int rep_ = 0; rep_ < ((MK_DUP == (k)) ? 2 : 1); ++rep_)
#ifndef MK_CG_MASK
#define MK_CG_MASK 0x01
#endif
#define SEAM(k) do { if (IN(k) && IN((k) + 1)) { if ((MK_CG_MASK >> (k)) & 1) grid.sync(); else xcd_barrier(xbar); } } while (0)
    const int gw = F.vcu * NWAVES + F.wave, NGW = F.G * NWAVES;
    volatile LAS unsigned* misc = (volatile LAS unsigned*)(F.lds + LDS_MISC);
    if (F.tid < 4) misc[F.tid] = 0u;
    __syncthreads();
    XcdBarrier xbar = xcd_barrier_post(ctl + CW_BAR, misc);

    if (IN(0)) REP(0) {
        LAS unsigned* scr = (LAS unsigned*)(F.lds + F.wave * 9216);
        LAS float* wfl = (LAS float*)(F.lds + 73728);
        for (int i = F.tid; i < 8192; i += NTHREADS) { const int hh = i & 7, k = i >> 3; wfl[hh * 1024 + k] = P.w_in[(size_t)k * INW + NPROJ + hh]; }
        constexpr int I_IN = 16 * 56, I_O = 16 * 16, I_1 = 32 * 16 * 32, I_2 = 32 * 16 * 16, NIT = I_IN + I_O + I_1 + I_2;
        for (int it = gw; it < NIT; it += NGW) {
            int r = it;
            if (r < I_IN) { tr_item(P.w_in, INW, 64 * (r / 56), 64 * (r % 56), nullptr, WinT, 0, scr, F.lane); continue; } r -= I_IN;
            if (r < I_O) { tr_item(P.w_out, 1024, 64 * (r / 16), 64 * (r % 16), nullptr, WoT, 1, scr, F.lane); continue; } r -= I_O;
            if (r < I_1) { const int e = r >> 9, rr = r & 511; tr_item(P.w1 + (size_t)e * 1024 * 2048, 2048, 64 * (rr / 32), 64 * (rr % 32), P.g_ffn, W1T + (size_t)e * 2048 * 1024, 2, scr, F.lane); continue; } r -= I_1;
            { const int e = r >> 8, rr = r & 255; tr_item(P.w2 + (size_t)e * 1024 * 1024, 1024, 64 * (rr / 16), 64 * (rr % 16), nullptr, W2T + (size_t)e * 1024 * 1024, 1, scr, F.lane); }
        }
        __syncthreads();
        for (int m = gw; m < T; m += NGW) {
            const f32x4* xr = (const f32x4*)(P.x + (size_t)m * DM) + F.lane; const f32x4* gr = (const f32x4*)P.g_mix + F.lane;
            f32x4 v[4]; float ss = 0.f;
#pragma unroll
            for (int j = 0; j < 4; ++j) { v[j] = xr[64 * j]; ss += (v[j].x * v[j].x + v[j].y * v[j].y) + (v[j].z * v[j].z + v[j].w * v[j].w); }
            const float rstd = rsqrtf(wave_sum(ss) * (1.0f / DM) + RMS_EPS);
            float z[8];
#pragma unroll
            for (int hh = 0; hh < 8; ++hh) z[hh] = 0.f;
            unsigned long long* o8 = (unsigned long long*)(U + (size_t)m * DM) + F.lane;
#pragma unroll
            for (int j = 0; j < 4; ++j) { v[j] = v[j] * rstd * gr[64 * j];
                o8[64 * j] = (unsigned long long)cvtpk(v[j].x, v[j].y) | ((unsigned long long)cvtpk(v[j].z, v[j].w) << 32);
#pragma unroll
                for (int hh = 0; hh < 8; ++hh) { const f32x4 w4 = *(const LAS f32x4*)(wfl + hh * 1024 + 4 * F.lane + 256 * j); z[hh] += (v[j].x * w4.x + v[j].y * w4.y) + (v[j].z * w4.z + v[j].w * w4.w); } }
#pragma unroll
            for (int hh = 0; hh < 8; ++hh) z[hh] = wave_sum(z[hh]);
            float zz = z[0];
#pragma unroll
            for (int hh = 1; hh < 8; ++hh) zz = (F.lane == hh) ? z[hh] : zz;
            if (F.lane < 8) { const float xx = zz + P.b_forget[F.lane]; const float lf = fminf(xx, 0.f) - log1pf(__expf(-fabsf(xx))); logf2[(size_t)m * 8 + F.lane] = lf * LOG2E; }
        }
        for (int idx = blockIdx.x * NTHREADS + F.tid; idx < SEQ * 64; idx += F.G * NTHREADS) {
            const int pos = idx >> 6, i = idx & 63; const float invf = exp2f(-(float)i * (13.287712379549449f / 64.0f));
            const float ang = (float)pos * invf; double tt = (double)ang * 0.15915494309189535; tt -= __builtin_rint(tt); const float tf = (float)tt;
            ropec[idx] = __builtin_amdgcn_cosf(tf); ropes[idx] = __builtin_amdgcn_sinf(tf);
        }
        for (int idx = blockIdx.x * NTHREADS + F.tid; idx < 32768; idx += F.G * NTHREADS) {
            const int s = idx & 3, e16 = (idx >> 2) & 15, half = (idx >> 6) & 1, kq = (idx >> 7) & 3, c = idx >> 9; const int k = 16 * c + 4 * kq + s, e = 16 * half + e16;
            wr3[idx] = P.w_router[k * 32 + e] * P.g_ffn[k];
        }
    }
    SEAM(0);

    if (IN(1)) {
        pg8::DenseOrder S; S.init(T, NPROJ, DM, F.G, (int)blockIdx.x, (MK_DUP == 1) ? 2 : 1);
        EpiInProj E{proj, ropec, ropes, ctl};
        pg8::gemm_phase<EpiInProj, pg8::DenseOrder, true, true>(F.lds, U, WinT, DM, S, E);
    }
    SEAM(1);

    if (IN(2)) REP(2) {
        for (int u = F.vcu; u < 256; u += F.G) ret::unit<false>(u >> 4, u & 15, RQ, RK, RV, SG, GST, MIX, (LAS char*)F.lds);
        for (int bh = F.vcu; bh < 32; bh += F.G) {
            const int b = bh >> 3, h = bh & 7; LAS double* sd = (LAS double*)F.lds;
            double loc[16]; double run = 0.0;
#pragma unroll
            for (int i = 0; i < 16; ++i) { run += (double)logf2[((size_t)b * SEQ + 16 * F.tid + i) * 8 + h]; loc[i] = run; }
            double incl = run;
#pragma unroll
            for (int o = 1; o < 64; o <<= 1) { const double t = __shfl_up(incl, o); if (F.lane >= o) incl += t; }
            __syncthreads();
            if (F.lane == 63) sd[F.wave] = incl;
            __syncthreads();
            double off = incl - run;
            for (int w2 = 0; w2 < F.wave; ++w2) off += sd[w2];
            LAS float* Fsl = (LAS float*)(F.lds + 4096);
#pragma unroll
            for (int i = 0; i < 16; ++i) { const float fv = (float)(off + loc[i]); F2[(size_t)bh * SEQ + 16 * F.tid + i] = fv; Fsl[16 * F.tid + i] = fv; }
            __syncthreads();
            if (F.tid < 32) { const int qb = F.tid, q0 = 256 * qb, NT = 4 * qb + 4;
                const float qn = __uint_as_float(ctl[CW_QN2 + bh * 2]) + __uint_as_float(ctl[CW_QN2 + bh * 2 + 1]), kn = __uint_as_float(ctl[CW_KN2 + bh * 2]) + __uint_as_float(ctl[CW_KN2 + bh * 2 + 1]);
                const float target = Fsl[q0] + PRUNE_TH + 2.0f * 1.0201f * sqrtf(qn * kn);
                int lo_ = 0, hi_ = NT - 4;
                while (lo_ < hi_) { const int mid = (lo_ + hi_) >> 1; if (Fsl[64 * mid + 63] >= target) lo_ = mid + 1; else hi_ = mid; }
                const int ts = lo_ & ~1, NS = NT - ts;
                ctl[CW_UTS + bh * 32 + qb] = (unsigned)ts; ctl[CW_UPOS + bh * 32 + qb] = atomicAdd(ctl + CW_BIN + (NS >> 1), 1u); }
            __syncthreads();
        }
    }
    SEAM(2);

    if (IN(3)) REP(3) {
        REP(31) for (int u = F.vcu; u < 256; u += F.G) ret::unit<true>(u >> 4, u & 15, RQ, RK, RV, SG, GST, MIX, (LAS char*)F.lds);
        LAS int* qst = (LAS int*)(F.lds + 120832); LAS int* qlist = qst + 128; LAS int* qsh = qst + 100;
        if (F.tid == 0) { int a = 0; for (int k = 64; k >= 2; --k) { qst[k] = a; a += (int)ctl[CW_BIN + k]; } }
        __syncthreads();
        for (int u = F.tid; u < 1024; u += NTHREADS) { const int ts = (int)ctl[CW_UTS + u], NS = 4 * (u & 31) + 4 - ts; qlist[qst[NS >> 1] + (int)ctl[CW_UPOS + u]] = u | (ts << 16); }
        __syncthreads();
        for (;;) {
            if (F.tid == 0) qsh[0] = (int)atomicAdd(ctl + CW_QHEAD, 1u);
            __syncthreads();
            int idx = qsh[0];
            if (idx >= ((MK_DUP == 30) ? 2048 : 1024)) break;
            idx &= 1023;
            const int uu = qlist[idx]; const int u = uu & 0xffff, ts = uu >> 16; const int bh = u >> 5, qb = u & 31;
            attn_body::attn_unit<8>(bh >> 3, bh & 7, qb, ts, FQ, FK, FV, MIX + 512, F2, (char*)lds_raw);
        }
    }
    SEAM(3);

    if (IN(4)) {
        pg8::DenseOrder S; S.init(T, DM, DM, F.G, (int)blockIdx.x, (MK_DUP == 4) ? 2 : 1);
        EpiOutProj E{P.x, H1B};
        pg8::gemm_phase<EpiOutProj, pg8::DenseOrder, true, true>(F.lds, MIX, WoT, DM, S, E);
    }
    SEAM(4);

    if (IN(5)) {
        LAS float* wl = (LAS float*)F.lds;
        LAS float* lg = (LAS float*)(F.lds + 131072);
        LAS float* ssb = (LAS float*)(F.lds + 131072 + 128 * 33 * 4);
        LAS int* ecnt = (LAS int*)(F.lds + 131072 + 128 * 33 * 4 + 512);
        LAS int* ebase = ecnt + 32;
        for (int i = F.tid; i < 8192; i += NTHREADS) ((LAS f32x4*)wl)[i] = ((const f32x4*)wr3)[i];
        for (int tb = blockIdx.x; tb < T / 128; tb += F.G) {
            if (F.tid < 32) ecnt[F.tid] = 0;
            __syncthreads();
            const int tok16 = F.lane & 15, kq = F.lane >> 4; const int tokw = tb * 128 + F.wave * 16 + tok16;
            const bf16_t* hrow = H1B + (size_t)tokw * DM + 4 * kq;
            f32x4 a0 = {0.f, 0.f, 0.f, 0.f}, a1 = {0.f, 0.f, 0.f, 0.f}; float ss = 0.f;
#pragma unroll 8
            for (int c = 0; c < 64; ++c) {
                const u32x2 hv = *(const u32x2*)(hrow + 16 * c); const float av[4] = {bflo(hv.x), bfhi(hv.x), bflo(hv.y), bfhi(hv.y)};
                const f32x4 w0 = *(const LAS f32x4*)(wl + (((c * 4 + kq) * 2 + 0) * 16 + tok16) * 4), w1 = *(const LAS f32x4*)(wl + (((c * 4 + kq) * 2 + 1) * 16 + tok16) * 4);
#pragma unroll
                for (int s = 0; s < 4; ++s) { ss += av[s] * av[s]; a0 = __builtin_amdgcn_mfma_f32_16x16x4f32(av[s], w0[s], a0, 0, 0, 0); a1 = __builtin_amdgcn_mfma_f32_16x16x4f32(av[s], w1[s], a1, 0, 0, 0); }
            }
            ss += __shfl_xor(ss, 16); ss += __shfl_xor(ss, 32);
            if (kq == 0) ssb[F.wave * 16 + tok16] = ss;
#pragma unroll
            for (int r = 0; r < 4; ++r) { const int tk = F.wave * 16 + kq * 4 + r; lg[tk * 33 + tok16] = a0[r]; lg[tk * 33 + 16 + tok16] = a1[r]; }
            __syncthreads();
            int esel[4] = {0, 0, 0, 0}, rank[4] = {0, 0, 0, 0}; float gsel[4] = {0.f, 0.f, 0.f, 0.f}; float rstd = 0.f;
            if (F.tid < 128) {
                rstd = rsqrtf(ssb[F.tid] * (1.0f / DM) + RMS_EPS);
                float l[32];
#pragma unroll
                for (int e = 0; e < 32; ++e) l[e] = lg[F.tid * 33 + e] * rstd + P.b_router[e];
                float vs[4];
#pragma unroll
                for (int k = 0; k < 4; ++k) { float best = -INFINITY; int bi = 0;
#pragma unroll
                    for (int e = 0; e < 32; ++e) { const bool bt = l[e] > best; best = bt ? l[e] : best; bi = bt ? e : bi; }
                    vs[k] = best; esel[k] = bi;
#pragma unroll
                    for (int e = 0; e < 32; ++e) l[e] = (e == bi) ? -INFINITY : l[e]; }
                float den = 0.f;
#pragma unroll
                for (int k = 0; k < 4; ++k) { gsel[k] = __expf(vs[k] - vs[0]); den += gsel[k]; }
#pragma unroll
                for (int k = 0; k < 4; ++k) { gsel[k] /= den; rank[k] = atomicAdd((int*)&ecnt[esel[k]], 1); }
            }
            __syncthreads();
            if (F.tid < 32) ebase[F.tid] = (int)atomicAdd(ctl + CW_CNT + F.tid, (unsigned)ecnt[F.tid]);
            __syncthreads();
            if (F.tid < 128) { const int tok = tb * 128 + F.tid;
#pragma unroll
                for (int k = 0; k < 4; ++k) { const int e = esel[k], slot = ebase[e] + rank[k];
                    ltok[(size_t)e * CAP + slot] = tok; lrstd[(size_t)e * CAP + slot] = rstd; inv[tok * 4 + k] = (e << 16) | slot; gates[tok * 4 + k] = gsel[k]; } }
            __syncthreads();
        }
    }
    SEAM(5);

    if (IN(6) || IN(7)) {
        LAS int* boff = (LAS int*)(F.lds + 131072); LAS int* cntl = boff + 64;
        if (F.tid == 0) { int a = 0; for (int e = 0; e < 32; ++e) { const int c = (int)ctl[CW_CNT + e]; cntl[e] = c; boff[e] = a; a += (c + 255) >> 8; } boff[32] = a; }
        __syncthreads();
        if (IN(6)) REP(6) {
            MoeOrder<8, true> S{boff, cntl, ltok, F.G, F.vcu};
            EpiMoe1 E{Hb, P.b1, lrstd, (const int*)(ctl + CW_CNT)};
            pg8::gemm_phase<EpiMoe1, MoeOrder<8, true>, true, true>(F.lds, H1B, W1T, DM, S, E);
        }
        SEAM(6);
        if (IN(7)) REP(7) {
            MoeOrder<4, false> S{boff, cntl, ltok, F.G, F.vcu};
            EpiMoe2 E{Yb, P.b2};
            pg8::gemm_phase<EpiMoe2, MoeOrder<4, false>, true, true>(F.lds, Hb, W2T, DM, S, E);
        }
    }
    SEAM(7);

    if (IN(8)) REP(8) {
        LAS int* boff = (LAS int*)(F.lds + 131072);
        __syncthreads();
        if (F.tid == 0) { int a = 0; for (int e = 0; e < 32; ++e) { const int c = (int)ctl[CW_CNT + e]; boff[e] = a; a += (c + 255) >> 8; } boff[32] = a; }
        __syncthreads();
        for (int m = gw; m < T; m += NGW) {
            float v[16];
            { const u32x4 a = *(const u32x4*)(H1B + (size_t)m * DM + 8 * F.lane), bq = *(const u32x4*)(H1B + (size_t)m * DM + 512 + 8 * F.lane);
#pragma unroll
              for (int e = 0; e < 4; ++e) { v[2 * e] = bflo(a[e]); v[2 * e + 1] = bfhi(a[e]); v[8 + 2 * e] = bflo(bq[e]); v[8 + 2 * e + 1] = bfhi(bq[e]); } }
#pragma unroll
            for (int k = 0; k < 4; ++k) { const int iv = inv[m * 4 + k]; const float gt = gates[m * 4 + k]; const int e = iv >> 16, slot = iv & 0xffff;
                const size_t yrow = (size_t)boff[e] * 256 + slot;
                const u32x4 a = *(const u32x4*)(Yb + yrow * DM + 8 * F.lane), bq = *(const u32x4*)(Yb + yrow * DM + 512 + 8 * F.lane);
#pragma unroll
                for (int q = 0; q < 4; ++q) { v[2 * q] += gt * bflo(a[q]); v[2 * q + 1] += gt * bfhi(a[q]); v[8 + 2 * q] += gt * bflo(bq[q]); v[8 + 2 * q + 1] += gt * bfhi(bq[q]); } }
            float ss = 0.f;
#pragma unroll
            for (int i = 0; i < 16; ++i) ss += v[i] * v[i];
            const float rstd = rsqrtf(wave_sum(ss) * (1.0f / DM) + RMS_EPS);
            const f32x4* gf = (const f32x4*)P.g_final; f32x4* op = (f32x4*)(P.out + (size_t)m * DM);
            const f32x4 g0 = gf[2 * F.lane], g1 = gf[2 * F.lane + 1], g2 = gf[128 + 2 * F.lane], g3 = gf[128 + 2 * F.lane + 1];
            op[2 * F.lane] = (f32x4){v[0], v[1], v[2], v[3]} * rstd * g0; op[2 * F.lane + 1] = (f32x4){v[4], v[5], v[6], v[7]} * rstd * g1;
            op[128 + 2 * F.lane] = (f32x4){v[8], v[9], v[10], v[11]} * rstd * g2; op[128 + 2 * F.lane + 1] = (f32x4){v[12], v[13], v[14], v[15]} * rstd * g3;
        }
    }
#undef IN
#undef SEAM
}

extern "C" void kernel_launch(void* const* d_in, const int* in_sizes, int n_in, void* d_out, int out_size, void* d_ws, size_t ws_size, hipStream_t stream) {
    static int grid = 0;
    if (grid == 0) {
        if (n_in != 13 || in_sizes[0] != T * DM || out_size != T * DM || ws_size < WS_END) { fprintf(stderr, "kernel_launch: unexpected shapes (n_in %d, in0 %d, out %d, ws %zu)\n", n_in, n_in > 0 ? in_sizes[0] : -1, out_size, ws_size); grid = -1; return; }
        int dev = 0, cus = 0, per_cu = 0;
        if (hipGetDevice(&dev) != hipSuccess || hipDeviceGetAttribute(&cus, hipDeviceAttributeMultiprocessorCount, dev) != hipSuccess) { fprintf(stderr, "kernel_launch: device query failed\n"); grid = -1; return; }
        if (hipFuncSetAttribute((const void*)mk_fwd, hipFuncAttributeMaxDynamicSharedMemorySize, LDS_BYTES) != hipSuccess) { fprintf(stderr, "kernel_launch: hipFuncSetAttribute failed\n"); grid = -1; return; }
        if (hipOccupancyMaxActiveBlocksPerMultiprocessor(&per_cu, (const void*)mk_fwd, NTHREADS, LDS_BYTES) != hipSuccess || per_cu < 1) { fprintf(stderr, "kernel_launch: occupancy query says %d\n", per_cu); per_cu = 1; }
        (void)hipGetLastError();
        grid = cus * 1;
        if (grid != 256) fprintf(stderr, "kernel_launch: %d CUs (built for 256)\n", grid);
    }
    if (grid < 0) return;
    (void)hipMemsetAsync((char*)d_ws + WS_CTL, 0, CTL_BYTES, stream);
    Params p{};
    const float** pin = (const float**)&p;
    for (int i = 0; i < 13; ++i) pin[i] = (const float*)d_in[i];
    p.out = (float*)d_out; p.ws = (unsigned char*)d_ws;
#if MK_N_LAUNCHES == 1
    p.ph_lo = 0; p.ph_hi = 9;
    void* args[] = {&p};
    hipError_t e = hipLaunchCooperativeKernel((const void*)mk_fwd, dim3(grid), dim3(NTHREADS), args, LDS_BYTES, stream);
    if (e != hipSuccess) fprintf(stderr, "kernel_launch: cooperative launch failed: %s (grid %d)\n", hipGetErrorString(e), grid);
#else
    for (int k = 0; k < 9; ++k) { p.ph_lo = k; p.ph_hi = k + 1; hipLaunchKernelGGL(mk_fwd, dim3(grid), dim3(NTHREADS), LDS_BYTES, stream, p); }
#endif
}
```

```cpp
#include <hip/hip_runtime.h>
#include <hip/hip_cooperative_groups.h>
#include <cstdio>
#include <cstdint>
namespace cg = cooperative_groups;

#ifndef MK_N_LAUNCHES
#define MK_N_LAUNCHES 1
#endif
#ifndef MK_DUP
#define MK_DUP -1
#endif
#ifndef MK_DIAG
#define MK_DIAG 0
#endif

#define LAS __attribute__((address_space(3)))
#define GAS __attribute__((address_space(1)))
typedef unsigned short bf16_t;
typedef short bf16x8 __attribute__((ext_vector_type(8)));
typedef short s16x4 __attribute__((ext_vector_type(4)));
typedef float f32x2 __attribute__((ext_vector_type(2)));
typedef float f32x4 __attribute__((ext_vector_type(4)));
typedef float f32x16 __attribute__((ext_vector_type(16)));
typedef unsigned u32x2 __attribute__((ext_vector_type(2)));
typedef unsigned u32x4 __attribute__((ext_vector_type(4)));
typedef __bf16 bf16x2_t __attribute__((ext_vector_type(2)));

constexpr int BATCH = 4, SEQ = 8192, DM = 1024, T = BATCH * SEQ;
constexpr int RH = 4, RD = 128, FH = 8, FD = 64;
constexpr int NPROJ = 3584, INW = 3592;
constexpr int NE = 32, TOPK = 4, DFF = 1024;
constexpr int CAP = T;
constexpr int NBMAX = (T * TOPK) / 256 + NE;
constexpr float RMS_EPS = 1e-5f, GN_EPS = 1e-5f;
constexpr float LOG2E = 1.4426950408889634f;
constexpr float PRUNE_TH = 40.0f;
constexpr float C2 = 0.125f * 1.4426950408889634f;
constexpr int NTHREADS = 512, NWAVES = 8;

constexpr size_t MiB = 1u << 20;
constexpr size_t WS_CTL = 0, CTL_BYTES = 1 * MiB;
constexpr size_t WS_ROPEC = 1 * MiB, WS_ROPES = 3 * MiB;
constexpr size_t WS_WR3 = 5 * MiB;
constexpr size_t WS_LOGF = 6 * MiB;
constexpr size_t WS_F2 = 7 * MiB;
constexpr size_t WS_LTOK = 8 * MiB;
constexpr size_t WS_LRSTD = 12 * MiB;
constexpr size_t WS_INV = 16 * MiB;
constexpr size_t WS_GATE = 17 * MiB;
constexpr size_t WS_H1B = 32 * MiB;
constexpr size_t WS_WINT = 96 * MiB;
constexpr size_t WS_WOT = 104 * MiB;
constexpr size_t WS_W2T = 112 * MiB;
constexpr size_t WS_W1T = 144 * MiB;
constexpr size_t WS_H1F8 = 208 * MiB;
constexpr size_t WS_U = 448 * MiB;
constexpr size_t WS_PROJ = 512 * MiB;
constexpr size_t PROJ_STRIDE = 32 * MiB;
constexpr size_t WS_GST = 736 * MiB;
constexpr size_t WS_MIX = 752 * MiB;
constexpr size_t WS_H = 448 * MiB;
constexpr size_t WS_Y = 584 * MiB;
constexpr size_t WS_END = 856 * MiB;
constexpr float W_SCALE = 128.0f, H_SCALE = 4.0f;
constexpr int CW_CNT = 0;
constexpr int CW_DIAG = 64;
constexpr int CW_QN2 = 128, CW_KN2 = 192;
constexpr int CW_BIN = 256;
constexpr int CW_QHEAD = 384;
constexpr int CW_UTS = 1024, CW_UPOS = 2048;
constexpr int CW_BAR = 4096;


constexpr int LDS_BYTES = 163840;
constexpr int LDS_MISC = LDS_BYTES - 16;

__device__ __forceinline__ unsigned cvtpk(float lo, float hi) { f32x2 v = {lo, hi}; bf16x2_t b = __builtin_convertvector(v, bf16x2_t); return __builtin_bit_cast(unsigned, b); }
__device__ __forceinline__ float bf2f(unsigned short h) { return __uint_as_float(((unsigned)h) << 16); }
__device__ __forceinline__ float bflo(unsigned w) { return __uint_as_float(w << 16); }
__device__ __forceinline__ float bfhi(unsigned w) { return __uint_as_float(w & 0xffff0000u); }
__device__ __forceinline__ float wave_sum(float v) {
#pragma unroll
    for (int o = 1; o < 64; o <<= 1) v += __shfl_xor(v, o);
    return v;
}
#define LDS_WAIT() asm volatile("s_waitcnt lgkmcnt(0)" ::: "memory")
#define VM_WAIT() asm volatile("s_waitcnt vmcnt(0)" ::: "memory")

struct Params {
    const float *x, *g_mix, *w_in, *b_forget, *w_out, *g_ffn, *w_router, *b_router, *w1, *b1, *w2, *b2, *g_final;
    float* out; unsigned char* ws; int ph_lo, ph_hi;
};

namespace pg8 {
constexpr int BM = 256, BK = 64, HALF = 128, HTB = HALF * BK * 2, STAGE_BYTES = 8 * HTB, NXCD = 8, WGM = 8;
__host__ __device__ __forceinline__ int lds_byte(int r, int c) { const int st = (r >> 4) * 2 + (c >> 5), rr = r & 15, cc = c & 31, ob = rr * 64 + cc * 2; return st * 1024 + (ob ^ (((ob >> 9) & 1) << 5)); }
__host__ __device__ __forceinline__ void stage_rc(int b, int& R, int& C) { const int st = b / 1024, sb = b % 1024, swz = sb ^ (((sb >> 9) & 1) << 5); R = (st >> 1) * 16 + swz / 64; C = (st & 1) * 32 + (swz % 64) / 2; }

struct Unit { int pm, pn, e, lb; };

struct DenseOrder {
    int nM, nN, nwg, G, c; int K; int dup;
    __device__ void init(int M, int N, int K_, int G_, int c_, int dup_ = 1) { nM = M / BM; nN = N / BM; nwg = nM * nN; G = G_; c = c_; K = K_; dup = dup_; }
    __device__ __forceinline__ bool next(int i, Unit& u) const {
        const long L = (long)i * G + c; if (L >= (long)nwg * dup) return false;
        int wgid = (int)(L % nwg); { const int q = nwg / NXCD, r = nwg % NXCD, xcd = wgid % NXCD, off = wgid / NXCD; wgid = (xcd < r ? xcd * (q + 1) : r * (q + 1) + (xcd - r) * q) + off; }
        const int nig = WGM * nN, gid = wgid / nig, fm = gid * WGM, gsz = (nM - fm) < WGM ? (nM - fm) : WGM;
        u.pm = fm + ((wgid % nig) % gsz); u.pn = (wgid % nig) / gsz; u.e = 0; u.lb = 0; return true;
    }
    __device__ __forceinline__ void aoffs(const Unit& u, unsigned (&ao)[2][2], const int (&R)[2], const int (&C)[2], int rowbytes) const {
#pragma unroll
        for (int h = 0; h < 2; ++h)
#pragma unroll
            for (int i = 0; i < 2; ++i) ao[h][i] = (unsigned)((u.pm * BM + h * HALF + R[i]) * rowbytes + C[i] * 2);
    }
};

typedef int v8i32 __attribute__((ext_vector_type(8)));
typedef int v4i32 __attribute__((ext_vector_type(4)));
template <class Epi, class Sched, bool ALIGN_EPI, bool SP2, int ES>
__device__ __forceinline__ void gemm_phase(LAS unsigned char* lds, const void* Abase, const void* Btbase, const int K, const Sched& S, const Epi& E) {
    const int tid = threadIdx.x, wid = __builtin_amdgcn_readfirstlane(tid >> 6), lane = tid & 63, wr = wid >> 2, wc = wid & 3, fr = lane & 15, fq = lane >> 4;
    const int rowbytes = K * ES;
    const int nt = rowbytes / 128;
    int RR[2], CC[2]; unsigned voffB[2];
#pragma unroll
    for (int i = 0; i < 2; ++i) { stage_rc(tid * 16 + i * 8192, RR[i], CC[i]); voffB[i] = (unsigned)(RR[i] * rowbytes + CC[i] * 2); }
    const size_t kstep = (size_t)128;
    const size_t hstep = (size_t)HALF * rowbytes;
    const size_t tstep = 2 * hstep;
    const unsigned ldsw = (unsigned)wid * 1024u;
    const int aoff = lds_byte(wr * 64 + fr, fq * 8), boff = lds_byte(wc * 32 + fr, fq * 8);
    const char* Ab = (const char*)Abase;
#define PG8_SA(b, h) (((b) * 2 + (h)) * HTB)
#define PG8_SB(b, h) ((4 + (b) * 2 + (h)) * HTB)
#define PG8_STAGE(bufoff, gbase, voff) do { _Pragma("unroll") for (int _i = 0; _i < 2; ++_i) \
        __builtin_amdgcn_global_load_lds((const unsigned*)((const char*)(gbase) + (voff)[_i]), (LAS unsigned*)(lds + (bufoff) + ldsw + _i * 8192), 16, 0, 0); } while (0)
#define PG8_STAGE_A(bufoff, kb, AO, h) do { _Pragma("unroll") for (int _i = 0; _i < 2; ++_i) \
        __builtin_amdgcn_global_load_lds((const unsigned*)(Ab + (kb) + (AO)[h][_i]), (LAS unsigned*)(lds + (bufoff) + ldsw + _i * 8192), 16, 0, 0); } while (0)
#define PG8_LDA(dst, b, h) do { _Pragma("unroll") for (int m = 0; m < 4; ++m) _Pragma("unroll") for (int k = 0; k < 2; ++k) dst[m][k] = *(const LAS bf16x8*)(lds + PG8_SA(b, h) + aoff + m * 2048 + k * 1024); } while (0)
#define PG8_LDB(dst, b, h) do { _Pragma("unroll") for (int n = 0; n < 2; ++n) _Pragma("unroll") for (int k = 0; k < 2; ++k) dst[n][k] = *(const LAS bf16x8*)(lds + PG8_SB(b, h) + boff + n * 2048 + k * 1024); } while (0)
#define PG8_F8(x) __builtin_shufflevector(__builtin_bit_cast(v4i32, (x)[0]), __builtin_bit_cast(v4i32, (x)[1]), 0, 1, 2, 3, 4, 5, 6, 7)
#define PG8_MMA(ai, bj, At, Bt) do { __builtin_amdgcn_s_setprio(1); _Pragma("unroll") for (int m = 0; m < 4; ++m) _Pragma("unroll") for (int n = 0; n < 2; ++n) { \
        if constexpr (ES == 2) { _Pragma("unroll") for (int k = 0; k < 2; ++k) acc[ai][bj][m][n] = __builtin_amdgcn_mfma_f32_16x16x32_bf16(Bt[n][k], At[m][k], acc[ai][bj][m][n], 0, 0, 0); } \
        else asm volatile("v_mfma_f32_16x16x128_f8f6f4 %0, %1, %2, %0" : "+v"(acc[ai][bj][m][n]) : "v"(PG8_F8(Bt[n])), "v"(PG8_F8(At[m]))); } \
        __builtin_amdgcn_s_setprio(0); } while (0)
#define PG8_WAIT_V(n) asm volatile("s_waitcnt vmcnt(" #n ")" ::: "memory")
#define PG8_WAIT_L(n) asm volatile("s_waitcnt lgkmcnt(" #n ")" ::: "memory")
#define PG8_BAR __builtin_amdgcn_s_barrier()
#define PG8_SCHED __builtin_amdgcn_sched_barrier(0)
    Unit cur, nxt; int ui = 0;
    if (!S.next(0, cur)) return;
    f32x4 acc[2][2][4][2];
#pragma unroll
    for (int a = 0; a < 2; ++a)
#pragma unroll
        for (int b = 0; b < 2; ++b)
#pragma unroll
            for (int m = 0; m < 4; ++m)
#pragma unroll
                for (int n = 0; n < 2; ++n) acc[a][b][m][n] = (f32x4){0.f, 0.f, 0.f, 0.f};
    bf16x8 At[4][2], B0[2][2], B1[2][2];
    unsigned aoC[2][2], aoN[2][2];
    S.aoffs(cur, aoC, RR, CC, rowbytes);
    const char* cB = (const char*)Btbase + (size_t)cur.pn * tstep;
    static_assert(SP2, "only the SP2 loop is kept");
    PG8_STAGE(PG8_SB(0, 0), cB, voffB); PG8_STAGE(PG8_SB(0, 1), cB + hstep, voffB); PG8_STAGE_A(PG8_SA(0, 0), 0, aoC, 0); PG8_STAGE_A(PG8_SA(0, 1), 0, aoC, 1);
    if (wr == 1) PG8_BAR;
    PG8_WAIT_V(2); PG8_BAR;
    PG8_STAGE(PG8_SB(1, 0), cB + kstep, voffB); PG8_STAGE_A(PG8_SA(1, 0), kstep, aoC, 0); PG8_STAGE(PG8_SB(1, 1), cB + hstep + kstep, voffB);
    PG8_WAIT_V(6); PG8_BAR;
    for (;;) {
        const bool has_next = S.next(ui + 1, nxt);
        if (has_next) S.aoffs(nxt, aoN, RR, CC, rowbytes);
        else {
#pragma unroll
            for (int h = 0; h < 2; ++h)
#pragma unroll
                for (int i = 0; i < 2; ++i) aoN[h][i] = aoC[h][i];
        }
        const char* nB = has_next ? (const char*)Btbase + (size_t)nxt.pn * tstep : cB;
#pragma unroll 1
        for (int t = 0; t < nt; t += 2) {
            const bool last = (t == nt - 2);
            const size_t kb1 = (size_t)(t + 1) * kstep;
            const size_t kb2 = last ? 0 : (size_t)(t + 2) * kstep, kb3 = kb2 + kstep;
            unsigned ao2[2][2];
#pragma unroll
            for (int h = 0; h < 2; ++h)
#pragma unroll
                for (int i = 0; i < 2; ++i) ao2[h][i] = last ? aoN[h][i] : aoC[h][i];
            const char* b2 = last ? nB : cB + (size_t)(t + 2) * kstep;
            const char* b3 = b2 + kstep;
            PG8_LDB(B0, 0, 0); PG8_LDB(B1, 0, 1); PG8_SCHED; PG8_LDA(At, 0, 0); PG8_STAGE_A(PG8_SA(1, 1), kb1, aoC, 1);
            PG8_WAIT_V(8); PG8_WAIT_L(0); PG8_BAR; PG8_MMA(0, 0, At, B0); PG8_MMA(0, 1, At, B1); PG8_BAR; PG8_SCHED;
            PG8_LDA(At, 0, 1); PG8_STAGE(PG8_SB(0, 0), b2, voffB); PG8_STAGE(PG8_SB(0, 1), b2 + hstep, voffB); PG8_STAGE_A(PG8_SA(0, 0), kb2, ao2, 0);
            PG8_WAIT_V(8); PG8_WAIT_L(0); PG8_BAR; PG8_MMA(1, 0, At, B0); PG8_MMA(1, 1, At, B1); PG8_BAR; PG8_SCHED;
            PG8_LDB(B0, 1, 0); PG8_LDB(B1, 1, 1); PG8_SCHED; PG8_LDA(At, 1, 0); PG8_STAGE_A(PG8_SA(0, 1), kb2, ao2, 1);
            PG8_WAIT_V(8); PG8_WAIT_L(0); PG8_BAR; PG8_MMA(0, 0, At, B0); PG8_MMA(0, 1, At, B1); PG8_BAR; PG8_SCHED;
            PG8_LDA(At, 1, 1); PG8_STAGE(PG8_SB(1, 0), b3, voffB); PG8_STAGE(PG8_SB(1, 1), b3 + hstep, voffB); PG8_STAGE_A(PG8_SA(1, 0), kb3, ao2, 0);
            PG8_WAIT_V(8); PG8_WAIT_L(0); PG8_BAR; PG8_MMA(1, 0, At, B0); PG8_MMA(1, 1, At, B1); PG8_BAR; PG8_SCHED;
        }
        if constexpr (ALIGN_EPI) { if (wr == 0) PG8_BAR; }
        if constexpr (ES == 1) asm volatile("s_nop 15\n\ts_nop 15" ::: "memory");
        E(acc, cur, wr, wc, fr, fq);
        if (!has_next) break;
#pragma unroll
        for (int a = 0; a < 2; ++a)
#pragma unroll
            for (int b = 0; b < 2; ++b)
#pragma unroll
                for (int m = 0; m < 4; ++m)
#pragma unroll
                    for (int n = 0; n < 2; ++n) acc[a][b][m][n] = (f32x4){0.f, 0.f, 0.f, 0.f};
        cur = nxt; cB = nB; ++ui;
#pragma unroll
        for (int h = 0; h < 2; ++h)
#pragma unroll
            for (int i = 0; i < 2; ++i) aoC[h][i] = aoN[h][i];
        if constexpr (ALIGN_EPI) { if (wr == 1) PG8_BAR; }
    }
    PG8_WAIT_V(0);
    if constexpr (!ALIGN_EPI) { if (wr == 0) PG8_BAR; }
    PG8_BAR;
#undef PG8_SA
#undef PG8_SB
#undef PG8_STAGE
#undef PG8_STAGE_A
#undef PG8_LDA
#undef PG8_LDB
#undef PG8_MMA
#undef PG8_F8
#undef PG8_WAIT_V
#undef PG8_WAIT_L
#undef PG8_BAR
#undef PG8_SCHED
}
}


__device__ __forceinline__ int perm32_pos(int t) { return 16 * ((t >> 2) & 1) + 4 * ((t >> 3) & 3) + (t & 3); }
__device__ __forceinline__ int pos_inproj(int c) {
    if (c < 1024) { const int hc = c & 127; return (c & ~127) | (32 * ((hc >> 4) & 3) + 16 * (hc >> 6) + (hc & 15)); }
    return (c & ~31) | perm32_pos(c & 31);
}
__device__ __forceinline__ int pos_plain(int c) { return (c & ~31) | perm32_pos(c & 31); }
__device__ __forceinline__ int pos_w1(int n) { const int jj = n & 1023, lin = n >> 10, pn = jj >> 7, tp = jj & 127; return pn * 256 + lin * 128 + ((tp & ~31) | perm32_pos(tp & 31)); }

struct EpiInProj {
    unsigned char* proj; const float* ropec; const float* ropes; unsigned* ctl;
    __device__ __forceinline__ void operator()(const f32x4 (&acc)[2][2][4][2], const pg8::Unit& u, int wr, int wc, int fr, int fq) const {
        const int type = u.pn >> 1; bf16_t* base = (bf16_t*)(proj + (size_t)type * PROJ_STRIDE);
        const int colh = (u.pn & 1) * 256;
        if (type < 2) {
            const float sc = (type == 1) ? 0.08838834764831845f : 1.0f;
            const int i0 = 16 * wc + 4 * fq;
#pragma unroll
            for (int ai = 0; ai < 2; ++ai)
#pragma unroll
                for (int m = 0; m < 4; ++m) {
                    const int row = u.pm * 256 + ai * 128 + wr * 64 + m * 16 + fr; const int pos = row & (SEQ - 1);
                    const f32x4 cs = *(const f32x4*)(ropec + pos * 64 + i0), sn = *(const f32x4*)(ropes + pos * 64 + i0);
#pragma unroll
                    for (int bj = 0; bj < 2; ++bj) {
                        const f32x4 x1 = acc[ai][bj][m][0], x2 = acc[ai][bj][m][1];
                        const f32x4 o1 = (x1 * cs - x2 * sn) * sc, o2 = (x1 * sn + x2 * cs) * sc;
                        bf16_t* dst = base + (size_t)row * 512 + colh + bj * 128 + i0;
                        u32x2 w1, w2; w1.x = cvtpk(o1[0], o1[1]); w1.y = cvtpk(o1[2], o1[3]); w2.x = cvtpk(o2[0], o2[1]); w2.y = cvtpk(o2[2], o2[3]);
                        *(u32x2*)dst = w1; *(u32x2*)(dst + 64) = w2;
                    }
                }
        } else {
            const float sc = (type == 4) ? C2 : 1.0f;
            float mx[2] = {0.f, 0.f};
#pragma unroll
            for (int ai = 0; ai < 2; ++ai)
#pragma unroll
                for (int m = 0; m < 4; ++m) {
                    const int row = u.pm * 256 + ai * 128 + wr * 64 + m * 16 + fr;
#pragma unroll
                    for (int bj = 0; bj < 2; ++bj) {
                        f32x4 v0 = acc[ai][bj][m][0] * sc, v1 = acc[ai][bj][m][1] * sc;
                        if (type == 4 || type == 5) { float ssq = (v0[0] * v0[0] + v0[1] * v0[1]) + (v0[2] * v0[2] + v0[3] * v0[3]) + (v1[0] * v1[0] + v1[1] * v1[1]) + (v1[2] * v1[2] + v1[3] * v1[3]);
                            ssq += __shfl_xor(ssq, 16); ssq += __shfl_xor(ssq, 32); mx[bj] = fmaxf(mx[bj], ssq); }
                        if (type == 3) {
#pragma unroll
                            for (int j = 0; j < 4; ++j) { v0[j] = v0[j] / (1.0f + __expf(-v0[j])); v1[j] = v1[j] / (1.0f + __expf(-v1[j])); }
                        }
                        u32x4 w; w.x = cvtpk(v0[0], v0[1]); w.y = cvtpk(v0[2], v0[3]); w.z = cvtpk(v1[0], v1[1]); w.w = cvtpk(v1[2], v1[3]);
                        *(u32x4*)(base + (size_t)row * 512 + colh + bj * 128 + wc * 32 + 8 * fq) = w;
                    }
                }
            if (type == 4 || type == 5) {
#pragma unroll
                for (int bj = 0; bj < 2; ++bj) { float v = mx[bj]; v = fmaxf(v, __shfl_xor(v, 1)); v = fmaxf(v, __shfl_xor(v, 2)); v = fmaxf(v, __shfl_xor(v, 4)); v = fmaxf(v, __shfl_xor(v, 8));
                    if ((threadIdx.x & 63) == 0) { const int bh = (u.pm >> 5) * 8 + (u.pn & 1) * 4 + bj * 2 + (wc >> 1);
                        atomicMax(ctl + ((type == 4) ? CW_QN2 : CW_KN2) + bh * 2 + (wc & 1), __float_as_uint(v)); } }
            }
        }
    }
};

__device__ __forceinline__ unsigned pk4_fp8(float a, float b, float c, float d) { int w = 0; w = __builtin_amdgcn_cvt_pk_fp8_f32(a, b, w, false); w = __builtin_amdgcn_cvt_pk_fp8_f32(c, d, w, true); return (unsigned)w; }
struct EpiOutProj {
    const float* x; bf16_t* h1b; unsigned char* h1f8;
    __device__ __forceinline__ void operator()(const f32x4 (&acc)[2][2][4][2], const pg8::Unit& u, int wr, int wc, int fr, int fq) const {
#pragma unroll
        for (int ai = 0; ai < 2; ++ai)
#pragma unroll
            for (int m = 0; m < 4; ++m) {
                const int row = u.pm * 256 + ai * 128 + wr * 64 + m * 16 + fr;
#pragma unroll
                for (int bj = 0; bj < 2; ++bj) {
                    const int col = u.pn * 256 + bj * 128 + wc * 32 + 8 * fq;
                    const f32x4 xa = *(const f32x4*)(x + (size_t)row * DM + col), xb = *(const f32x4*)(x + (size_t)row * DM + col + 4);
                    const f32x4 v0 = acc[ai][bj][m][0] + xa, v1 = acc[ai][bj][m][1] + xb;
                    u32x4 w; w.x = cvtpk(v0[0], v0[1]); w.y = cvtpk(v0[2], v0[3]); w.z = cvtpk(v1[0], v1[1]); w.w = cvtpk(v1[2], v1[3]);
                    *(u32x4*)(h1b + (size_t)row * DM + col) = w;
                    u32x2 w8; w8.x = pk4_fp8(v0[0], v0[1], v0[2], v0[3]); w8.y = pk4_fp8(v1[0], v1[1], v1[2], v1[3]);
                    *(u32x2*)(h1f8 + (size_t)row * DM + col) = w8;
                }
            }
    }
};

struct EpiMoe1 {
    unsigned char* H; const float* b1; const float* lrstd; const int* cnt;
    __device__ __forceinline__ void operator()(const f32x4 (&acc)[2][2][4][2], const pg8::Unit& u, int wr, int wc, int fr, int fq) const {
        const int e = u.e, pnl = u.pn - e * 8; const int cq = pnl * 128 + wc * 32 + 8 * fq;
        const float* bg = b1 + (size_t)e * 2048 + cq; const float* bl = bg + 1024;
        const f32x4 bg0 = *(const f32x4*)bg, bg1 = *(const f32x4*)(bg + 4), bl0 = *(const f32x4*)bl, bl1 = *(const f32x4*)(bl + 4);
        const int ce = cnt[e];
#pragma unroll
        for (int ai = 0; ai < 2; ++ai)
#pragma unroll
            for (int m = 0; m < 4; ++m) {
                const int rt = ai * 128 + wr * 64 + m * 16 + fr; const int slot = u.lb * 256 + rt;
                const float rs = (slot < ce) ? lrstd[(size_t)e * CAP + slot] * (1.0f / W_SCALE) : 0.f;
                f32x4 g0 = acc[ai][0][m][0] * rs + bg0, g1 = acc[ai][0][m][1] * rs + bg1, l0 = acc[ai][1][m][0] * rs + bl0, l1 = acc[ai][1][m][1] * rs + bl1;
                float o[8];
#pragma unroll
                for (int j = 0; j < 4; ++j) {
                    float g = fminf(g0[j], 7.0f), l = fminf(fmaxf(l0[j], -7.0f), 7.0f); o[j] = g / (1.0f + __expf(-1.702f * g)) * (l + 1.0f) * H_SCALE;
                    g = fminf(g1[j], 7.0f); l = fminf(fmaxf(l1[j], -7.0f), 7.0f); o[4 + j] = g / (1.0f + __expf(-1.702f * g)) * (l + 1.0f) * H_SCALE;
                }
                u32x2 w; w.x = pk4_fp8(o[0], o[1], o[2], o[3]); w.y = pk4_fp8(o[4], o[5], o[6], o[7]);
                *(u32x2*)(H + (size_t)(u.pm * 256 + rt) * DFF + cq) = w;
            }
    }
};

struct EpiMoe2 {
    bf16_t* Y; const float* b2;
    __device__ __forceinline__ void operator()(const f32x4 (&acc)[2][2][4][2], const pg8::Unit& u, int wr, int wc, int fr, int fq) const {
        const int e = u.e, pnl = u.pn - e * 4;
#pragma unroll
        for (int bj = 0; bj < 2; ++bj) {
            const int col = pnl * 256 + bj * 128 + wc * 32 + 8 * fq;
            const f32x4 ba = *(const f32x4*)(b2 + (size_t)e * DM + col), bb = *(const f32x4*)(b2 + (size_t)e * DM + col + 4);
#pragma unroll
            for (int ai = 0; ai < 2; ++ai)
#pragma unroll
                for (int m = 0; m < 4; ++m) {
                    const int rt = ai * 128 + wr * 64 + m * 16 + fr;
                    const f32x4 v0 = acc[ai][bj][m][0] * (1.0f / (W_SCALE * H_SCALE)) + ba, v1 = acc[ai][bj][m][1] * (1.0f / (W_SCALE * H_SCALE)) + bb;
                    u32x4 w; w.x = cvtpk(v0[0], v0[1]); w.y = cvtpk(v0[2], v0[3]); w.z = cvtpk(v1[0], v1[1]); w.w = cvtpk(v1[2], v1[3]);
                    *(u32x4*)(Y + (size_t)(u.pm * 256 + rt) * DM + col) = w;
                }
        }
    }
};

template <int NT, bool GATHER>
struct MoeOrder {
    const LAS int* boff;
    const LAS int* cntl;
    const int* ltok;
    int G, vcu;
    __device__ __forceinline__ bool next(int i, pg8::Unit& u) const {
        const int cpx = G >> 3, x = vcu / cpx, j = vcu % cpx, rpb = cpx / NT;
        const int rb = (i * 8 + x) * rpb + j / NT; const int nb = boff[32];
        if (rb >= nb) return false;
        int e = 0;
#pragma unroll 1
        for (int k = 1; k < 32; ++k) if (boff[k] <= rb) e = k;
        u.pm = rb; u.e = e; u.lb = rb - boff[e]; u.pn = e * NT + (j % NT); return true;
    }
    __device__ __forceinline__ void aoffs(const pg8::Unit& u, unsigned (&ao)[2][2], const int (&R)[2], const int (&C)[2], int rowbytes) const {
#pragma unroll
        for (int h = 0; h < 2; ++h)
#pragma unroll
            for (int i = 0; i < 2; ++i) {
                if constexpr (GATHER) {
                    const int slot = u.lb * 256 + h * 128 + R[i]; int tok = 0;
                    if (slot < cntl[u.e]) tok = ltok[(size_t)u.e * CAP + slot];
                    ao[h][i] = (unsigned)(tok * rowbytes + C[i] * 2);
                } else ao[h][i] = (unsigned)((u.pm * 256 + h * 128 + R[i]) * rowbytes + C[i] * 2);
            }
    }
};

namespace attn_body {
constexpr int NHEAD = FH, D = 64, PQ = 512, PO = 1024;
constexpr int NW = 8, QBLK = 32, QB = QBLK * NW, KVBLK = 64, NQB = SEQ / QB;
__device__ __forceinline__ int crow(int r, int hi) { return (r & 3) + 8 * (r >> 2) + 4 * hi; }
#define SBAR() __builtin_amdgcn_sched_barrier(0)
__device__ __forceinline__ void cmask(f32x16& p0, f32x16& p1, int jb, int qrel, int hi) {
    const float NEG = -INFINITY; int kb = 64 * jb + 4 * hi;
#pragma unroll
    for (int r = 0; r < 16; ++r) { int kv = kb + (r & 3) + 8 * (r >> 2); if (kv > qrel) p0[r] = NEG; if (kv + 32 > qrel) p1[r] = NEG; }
}
constexpr int NSLOT = 3, SLOTB = 8192;
constexpr int LDS_K = 0, LDS_V = NSLOT * SLOTB, LDS_WS = 2 * NSLOT * SLOTB, LDS_OST = LDS_WS + NW * 64 * 4, LDS_END = LDS_OST + NW * 4096;
constexpr int LDS_F = 86016, LDS_F_BYTES = SEQ * 4 + 1024;
static_assert(LDS_F >= LDS_END && LDS_F + LDS_F_BYTES <= LDS_BYTES, "attention LDS map");
__device__ __forceinline__ void glds16(const void* gsrc, unsigned lds_dst) { unsigned keep;
    asm volatile("s_mov_b32 %0, m0\n\ts_mov_b32 m0, %2\n\ts_nop 0\n\tglobal_load_lds_dwordx4 %1, off\n\ts_mov_b32 m0, %0" : "=&s"(keep) : "v"(gsrc), "s"(lds_dst) : "memory"); }
__device__ __forceinline__ float max3f(float a, float b, float c) { float r; asm("v_max3_f32 %0, %1, %2, %3" : "=v"(r) : "v"(a), "v"(b), "v"(c)); return r; }
__device__ __forceinline__ float max2f(float a, float b) { float r; asm("v_max_f32_e32 %0, %1, %2" : "=v"(r) : "v"(a), "v"(b)); return r; }
__device__ __forceinline__ float fadd_s(float a, float b) { float r; asm("v_add_f32_e32 %0, %1, %2" : "=v"(r) : "v"(a), "v"(b)); return r; }
__device__ __forceinline__ float fsub_s(float a, float b) { float r; asm("v_sub_f32_e32 %0, %1, %2" : "=v"(r) : "v"(a), "v"(b)); return r; }
#define WAIT_BAR(N) asm volatile("s_waitcnt vmcnt(" #N ") lgkmcnt(0)\n\ts_barrier" ::: "memory")

typedef LAS const char* lds_cptr;
typedef short v4i16_t __attribute__((ext_vector_type(4)));
__device__ __forceinline__ void kload8(bf16x8* kf, lds_cptr kp) {
    kf[0] = *(const LAS bf16x8*)(kp);        kf[1] = *(const LAS bf16x8*)(kp + 512);
    kf[2] = *(const LAS bf16x8*)(kp + 2048); kf[3] = *(const LAS bf16x8*)(kp + 2560);
    kf[4] = *(const LAS bf16x8*)(kp + 4096); kf[5] = *(const LAS bf16x8*)(kp + 4608);
    kf[6] = *(const LAS bf16x8*)(kp + 6144); kf[7] = *(const LAS bf16x8*)(kp + 6656);
}
__device__ __forceinline__ void kload2(bf16x8* kf, lds_cptr kp, int j) { kf[2 * j] = *(const LAS bf16x8*)(kp + j * 2048); kf[2 * j + 1] = *(const LAS bf16x8*)(kp + j * 2048 + 512); }
__device__ __forceinline__ s16x4 vtr(lds_cptr p) { return __builtin_bit_cast(s16x4, __builtin_amdgcn_ds_read_tr16_b64_v4i16((LAS v4i16_t*)p)); }
__device__ __forceinline__ float rowmax(const f32x16& p0, const f32x16& p1) {
    float a = max3f(p0[0], p0[1], p1[0]), b = max3f(p0[2], p0[3], p1[1]); a = max3f(a, p1[2], p1[3]);
#pragma unroll
    for (int r = 4; r < 16; r += 4) { a = max3f(a, p0[r], p0[r + 1]); b = max3f(b, p0[r + 2], p0[r + 3]); a = max3f(a, p1[r], p1[r + 1]); b = max3f(b, p1[r + 2], p1[r + 3]); }
    const float m = max2f(a, b);
    auto rr = __builtin_amdgcn_permlane32_swap(__float_as_uint(m), __float_as_uint(m), false, false);
    return max2f(__uint_as_float(rr[0]), __uint_as_float(rr[1]));
}
__device__ __forceinline__ void pv(f32x16* o, int vb, bf16x8 pa0, bf16x8 pa1, bf16x8 pa2, bf16x8 pa3) {
#pragma unroll
    for (int d0 = 0; d0 < 2; ++d0) { s16x4 lo[4], hi[4];
#pragma unroll
        for (int ks = 0; ks < 4; ++ks) {
            asm volatile("ds_read_b64_tr_b16 %0,%1 offset:%c2" : "=&v"(lo[ks]) : "v"(vb), "i"(d0 * 4096 + ks * 1024) : "memory");
            asm volatile("ds_read_b64_tr_b16 %0,%1 offset:%c2" : "=&v"(hi[ks]) : "v"(vb), "i"(d0 * 4096 + ks * 1024 + 512) : "memory"); }
        asm volatile("s_waitcnt lgkmcnt(0)" ::: "memory"); SBAR();
#define PK(k) (bf16x8){lo[k][0], lo[k][1], lo[k][2], lo[k][3], hi[k][0], hi[k][1], hi[k][2], hi[k][3]}
        o[d0] = __builtin_amdgcn_mfma_f32_32x32x16_bf16(pa0, PK(0), o[d0], 0, 0, 0);
        o[d0] = __builtin_amdgcn_mfma_f32_32x32x16_bf16(pa1, PK(1), o[d0], 0, 0, 0);
        o[d0] = __builtin_amdgcn_mfma_f32_32x32x16_bf16(pa2, PK(2), o[d0], 0, 0, 0);
        o[d0] = __builtin_amdgcn_mfma_f32_32x32x16_bf16(pa3, PK(3), o[d0], 0, 0, 0);
#undef PK
    }
}

template <int THRL> __device__ __forceinline__ void attn_unit(int b, int h, int qb, int ts, const bf16_t* Q, const bf16_t* __restrict__ K, const bf16_t* __restrict__ V, bf16_t* O, const float* __restrict__ F2, char* shm) {
    const int tid = threadIdx.x, lane = tid & 63, r32 = lane & 31, hi = lane >> 5; const int wid = __builtin_amdgcn_readfirstlane(tid >> 6);
    const long rowbase = (long)b * SEQ; const int q0 = qb * QB;
    const bf16_t* Qw = Q + (rowbase + q0 + wid * QBLK) * PQ + h * D;
    const bf16_t* Kh = K + (rowbase + (long)ts * KVBLK) * PQ + h * D, *Vh = V + (rowbase + (long)ts * KVBLK) * PQ + h * D;
    const unsigned lds0 = (unsigned)(uintptr_t)shm;
    float* wsf = (float*)(shm + LDS_WS) + wid * 64;
    { const f32x4* Fg = (const f32x4*)(F2 + (size_t)(b * NHEAD + h) * SEQ + (size_t)ts * KVBLK); LAS f32x4* Fl4 = (LAS f32x4*)((LAS char*)(lds_cptr)shm + LDS_F); const int n4 = (q0 + QB - ts * KVBLK) / 4;
      for (int p = tid; p < n4; p += NW * 64) Fl4[p] = Fg[p]; }
    const LAS float* Fl = (const LAS float*)((lds_cptr)shm + LDS_F);
    asm volatile("s_waitcnt vmcnt(0) lgkmcnt(0)" ::: "memory");
    const bf16_t* ksrc = Kh + (long)lane * PQ + wid * 8;
    const bf16_t* vsrc = Vh + (long)(16 * (wid & 3) + (lane >> 2)) * PQ + (wid >> 2) * 32 + (lane & 3) * 8;
    const unsigned kdst = lds0 + LDS_K + wid * 1024, vdst = lds0 + LDS_V + wid * 1024;
#define DMA_K(t, slot) glds16(ksrc + (long)(t) * KVBLK * PQ, (unsigned)__builtin_amdgcn_readfirstlane(kdst + (slot)))
#define DMA_V(t, slot) glds16(vsrc + (long)(t) * KVBLK * PQ, (unsigned)__builtin_amdgcn_readfirstlane(vdst + (slot)))
    const int vb0 = (int)(lds0 + LDS_V) + ((lane >> 4) & 1) * 32 + (lane & 3) * 8 + (4 * hi + ((lane & 15) >> 2)) * 64;
    bf16x8 kf[8];
    const lds_cptr shm3 = (lds_cptr)shm; const lds_cptr kp0 = shm3 + LDS_K + hi * 1024 + r32 * 16; const lds_cptr vp0 = shm3 + LDS_V + ((lane >> 4) & 1) * 32 + (lane & 3) * 8 + (4 * hi + ((lane & 15) >> 2)) * 64;
    const int NT = (q0 + QB) / KVBLK - ts;
    DMA_K(0, 0); DMA_V(0, 0); DMA_K(1, SLOTB);
    bf16x8 qr[4];
#pragma unroll
    for (int d0 = 0; d0 < 4; ++d0) qr[d0] = *reinterpret_cast<const bf16x8*>(&Qw[(long)r32 * PQ + d0 * 16 + hi * 8]);
    float mhat = 0.f, l_reg = 0.f, nm = 0.f; f32x16 o[2]; o[0] = f32x16{}; o[1] = f32x16{};
    f32x4 fa[4], fb[4];
#define FLD(tt) do { const LAS float* fp_ = Fl + 64 * (tt) + 4 * hi; _Pragma("unroll") for (int g_ = 0; g_ < 4; ++g_) { fa[g_] = *(const LAS f32x4*)(fp_ + 8 * g_); fb[g_] = *(const LAS f32x4*)(fp_ + 32 + 8 * g_); } } while (0)
#define CINIT(C0, C1) do { _Pragma("unroll") for (int g_ = 0; g_ < 4; ++g_) { _Pragma("unroll") for (int e_ = 0; e_ < 4; ++e_) { C0[4 * g_ + e_] = nm - fa[g_][e_]; C1[4 * g_ + e_] = nm - fb[g_][e_]; } } } while (0)
    const int qrel = wid * QBLK + r32;
#define CMASK(P0, P1, t) do { int jb_ = (t) - (NT - 4); if (jb_ >= 0) cmask(P0, P1, jb_, qrel, hi); } while (0)
    bool resc = false;
#define START(P0, P1) do { const float rm = rowmax(P0, P1); resc = false; \
    { const float dl = rm; mhat = fadd_s(mhat, dl); \
      _Pragma("unroll") for (int r = 0; r < 16; ++r) { P0[r] = fsub_s(P0[r], dl); P1[r] = fsub_s(P1[r], dl); } \
      nm = -mhat; } \
    _Pragma("unroll") for (int r = 0; r < 16; ++r) P0[r] = __builtin_amdgcn_exp2f(P0[r]); } while (0)
#define RESC() do { if (resc) { asm volatile("s_waitcnt lgkmcnt(0)" ::: "memory"); \
      _Pragma("unroll") for (int d_ = 0; d_ < 2; ++d_) _Pragma("unroll") for (int r = 0; r < 16; ++r) o[d_][r] *= wsf[crow(r, hi)]; } } while (0)
    f32x16 pA0, pA1, pB0, pB1;
    int sl_prev = 0, sl_cur = 0, sl_next = SLOTB;
#define ROT() do { sl_prev = sl_cur; sl_cur = sl_next; sl_next = (sl_next == (NSLOT - 1) * SLOTB) ? 0 : sl_next + SLOTB; } while (0)
    DMA_K(2, 2 * SLOTB);
    WAIT_BAR(3);
    FLD(0); CINIT(pA0, pA1);
    { const lds_cptr kb = shm3 + LDS_K + hi * 1024 + r32 * 16;
#pragma unroll
      for (int d0 = 0; d0 < 4; ++d0) { const bf16x8 b0 = *(const LAS bf16x8*)(kb + d0 * 2048); const bf16x8 b1 = *(const LAS bf16x8*)(kb + d0 * 2048 + 512);
          pA0 = __builtin_amdgcn_mfma_f32_32x32x16_bf16(b0, qr[d0], pA0, 0, 0, 0); pA1 = __builtin_amdgcn_mfma_f32_32x32x16_bf16(b1, qr[d0], pA1, 0, 0, 0); } }
    asm volatile("s_nop 15\n\ts_nop 7" : "+v"(pA0), "+v"(pA1)); CMASK(pA0, pA1, 0);
    START(pA0, pA1);
    _Pragma("unroll") for (int r = 0; r < 16; ++r) pA1[r] = __builtin_amdgcn_exp2f(pA1[r]);
    FLD(1);
    WAIT_BAR(0);
    DMA_K(3, 0); DMA_V(1, SLOTB);
    ROT();
    kload8(kf, kp0 + sl_cur);
    WAIT_BAR(2);
    s16x4 vlo[8], vhi[8]; u32x4 pw0, pw1, pw2, pw3;
#define PKW(P, B) cvtpk(P[B], P[B + 1])
#define PAF(k) __builtin_bit_cast(bf16x8, pw##k)
#define VFR(i) (bf16x8){vlo[i][0], vlo[i][1], vlo[i][2], vlo[i][3], vhi[i][0], vhi[i][1], vhi[i][2], vhi[i][3]}
#define PIN(x) asm volatile("" : "+v"(x))
#define MX3(a, b, c) __builtin_fmaxf(__builtin_fmaxf((a), (b)), (c))
#define GAPA(MF, A0, A1, A2, A3, W0, W1, PW) do { MF; sacc += A0; sacc += A1; sacc += A2; sacc += A3; PIN(sacc); W0; W1; PIN(PW); SBAR(); } while (0)
#define EX(v) __builtin_amdgcn_exp2f(v)
#define GAPB(MF, X, B) do { MF; X[B] = EX(X[B]); X[B + 1] = EX(X[B + 1]); X[B + 2] = EX(X[B + 2]); X[B + 3] = EX(X[B + 3]); PIN(X); SBAR(); } while (0)
#define VRD(i) do { vlo[i] = vtr(vp_ + (((i) >> 2) * 4096 + ((i) & 3) * 1024)); vhi[i] = vtr(vp_ + (((i) >> 2) * 4096 + ((i) & 3) * 1024 + 512)); } while (0)
#define KRD(G, j) do { if (G) { kload2(kf, kp0 + sl_next, j); SBAR(); } } while (0)
#define STEP(C0, C1, P0, P1, t, GK, GV, GL) do { SBAR(); \
    CINIT(C0, C1); SBAR(); \
    const lds_cptr vp_ = vp0 + sl_prev; \
    VRD(0); SBAR(); float sacc = (P0[0] + P0[1]); \
    GAPA(C0 = __builtin_amdgcn_mfma_f32_32x32x16_bf16(kf[0], qr[0], C0, 0, 0, 0), P0[2], P0[3], P0[4], P0[5],     pw0[0] = PKW(P0, 0), pw0[1] = PKW(P0, 2), pw0); \
    VRD(4); SBAR(); GAPA(C1 = __builtin_amdgcn_mfma_f32_32x32x16_bf16(kf[1], qr[0], C1, 0, 0, 0), P0[6], P0[7], P0[8], P0[9],     pw0[2] = PKW(P0, 4), pw0[3] = PKW(P0, 6), pw0); \
    VRD(1); SBAR(); GAPA(C0 = __builtin_amdgcn_mfma_f32_32x32x16_bf16(kf[2], qr[1], C0, 0, 0, 0),   P0[10], P0[11], P0[12], P0[13], pw1[0] = PKW(P0, 8), pw1[1] = PKW(P0, 10), pw1); \
    VRD(5); SBAR(); GAPA(C1 = __builtin_amdgcn_mfma_f32_32x32x16_bf16(kf[3], qr[1], C1, 0, 0, 0),   P0[14], P0[15], P1[0], P1[1],   pw1[2] = PKW(P0, 12), pw1[3] = PKW(P0, 14), pw1); \
    VRD(2); SBAR(); GAPA(C0 = __builtin_amdgcn_mfma_f32_32x32x16_bf16(kf[4], qr[2], C0, 0, 0, 0),   P1[2], P1[3], P1[4], P1[5],     pw2[0] = PKW(P1, 0), pw2[1] = PKW(P1, 2), pw2); \
    VRD(6); SBAR(); GAPA(C1 = __builtin_amdgcn_mfma_f32_32x32x16_bf16(kf[5], qr[2], C1, 0, 0, 0),   P1[6], P1[7], P1[8], P1[9],     pw2[2] = PKW(P1, 4), pw2[3] = PKW(P1, 6), pw2); \
    VRD(3); SBAR(); GAPA(C0 = __builtin_amdgcn_mfma_f32_32x32x16_bf16(kf[6], qr[3], C0, 0, 0, 0),   P1[10], P1[11], P1[12], P1[13], pw3[0] = PKW(P1, 8), pw3[1] = PKW(P1, 10), pw3); \
    VRD(7); SBAR(); GAPA(C1 = __builtin_amdgcn_mfma_f32_32x32x16_bf16(kf[7], qr[3], C1, 0, 0, 0),   P1[14], P1[15], 0.f, 0.f,       pw3[2] = PKW(P1, 12), pw3[3] = PKW(P1, 14), pw3); \
    l_reg += sacc; \
    if (GK) { DMA_K((t) + 3, sl_cur); } if (GV) { DMA_V((t) + 1, sl_next); } \
    CMASK(C0, C1, t); \
    { float a = MX3(C0[0], C0[1], C1[0]), b = MX3(C0[2], C0[3], C1[1]); a = MX3(a, C1[2], C1[3]); \
      _Pragma("unroll") for (int r = 4; r < 16; r += 4) { a = MX3(a, C0[r], C0[r + 1]); b = MX3(b, C0[r + 2], C0[r + 3]); a = MX3(a, C1[r], C1[r + 1]); b = MX3(b, C1[r + 2], C1[r + 3]); } \
      float rm = __builtin_fmaxf(a, b); { auto rr = __builtin_amdgcn_permlane32_swap(__float_as_uint(rm), __float_as_uint(rm), false, false); rm = __builtin_fmaxf(__uint_as_float(rr[0]), __uint_as_float(rr[1])); } \
      resc = false; \
      if (__builtin_expect(__any(rm > (float)THRL), 0)) { const float dl = __builtin_fmaxf(rm, 0.f); mhat += dl; \
        _Pragma("unroll") for (int r = 0; r < 16; ++r) { C0[r] -= dl; C1[r] -= dl; } \
        nm = -mhat; \
        const float f = __builtin_amdgcn_exp2f(-dl); l_reg *= f; if (hi == 0) wsf[r32] = f; resc = true; } } \
    SBAR(); \
    GAPB(o[0] = __builtin_amdgcn_mfma_f32_32x32x16_bf16(PAF(0), VFR(0), o[0], 0, 0, 0), C0, 0); \
    GAPB(o[1] = __builtin_amdgcn_mfma_f32_32x32x16_bf16(PAF(0), VFR(4), o[1], 0, 0, 0), C0, 4); \
    KRD(GL, 0); GAPB(o[0] = __builtin_amdgcn_mfma_f32_32x32x16_bf16(PAF(1), VFR(1), o[0], 0, 0, 0), C0, 8); \
    KRD(GL, 1); GAPB(o[1] = __builtin_amdgcn_mfma_f32_32x32x16_bf16(PAF(1), VFR(5), o[1], 0, 0, 0), C0, 12); \
    KRD(GL, 2); GAPB(o[0] = __builtin_amdgcn_mfma_f32_32x32x16_bf16(PAF(2), VFR(2), o[0], 0, 0, 0), C1, 0); \
    KRD(GL, 3); GAPB(o[1] = __builtin_amdgcn_mfma_f32_32x32x16_bf16(PAF(2), VFR(6), o[1], 0, 0, 0), C1, 4); \
    GAPB(o[0] = __builtin_amdgcn_mfma_f32_32x32x16_bf16(PAF(3), VFR(3), o[0], 0, 0, 0), C1, 8); \
    GAPB(o[1] = __builtin_amdgcn_mfma_f32_32x32x16_bf16(PAF(3), VFR(7), o[1], 0, 0, 0), C1, 12); \
    FLD((t) + 1); \
    } while (0)
    int t = 1;
#undef CMASK
#define CMASK(P0, P1, t) do { } while (0)
    for (; t + 5 < NT; t += 2) {
        STEP(pB0, pB1, pA0, pA1, t, true, true, true);     WAIT_BAR(2); RESC(); ROT();
        STEP(pA0, pA1, pB0, pB1, t + 1, true, true, true);   WAIT_BAR(2); RESC(); ROT();
    }
#undef CMASK
#define CMASK(P0, P1, t) do { int jb_ = (t) - (NT - 4); if (jb_ >= 0) cmask(P0, P1, jb_, qrel, hi); } while (0)
#define ENDW(tt) do { if ((tt) + 3 < NT) { WAIT_BAR(2); } else if ((tt) + 2 < NT) { WAIT_BAR(1); } else { WAIT_BAR(0); } } while (0)
    for (; t + 1 < NT; t += 2) {
        STEP(pB0, pB1, pA0, pA1, t, (t + 3 < NT), (t + 1 < NT), (t + 1 < NT));       ENDW(t);   RESC(); ROT();
        STEP(pA0, pA1, pB0, pB1, t + 1, (t + 4 < NT), (t + 2 < NT), (t + 2 < NT));     ENDW(t + 1); RESC(); ROT();
    }
    STEP(pB0, pB1, pA0, pA1, NT - 1, false, false, false); RESC();
    { float sacc = pB0[0] + pB0[1]; _Pragma("unroll") for (int r = 2; r < 16; ++r) sacc += pB0[r]; _Pragma("unroll") for (int r = 0; r < 16; ++r) sacc += pB1[r]; l_reg += sacc;
      pw0 = (u32x4){PKW(pB0, 0), PKW(pB0, 2), PKW(pB0, 4), PKW(pB0, 6)}; pw1 = (u32x4){PKW(pB0, 8), PKW(pB0, 10), PKW(pB0, 12), PKW(pB0, 14)}; pw2 = (u32x4){PKW(pB1, 0), PKW(pB1, 2), PKW(pB1, 4), PKW(pB1, 6)}; pw3 = (u32x4){PKW(pB1, 8), PKW(pB1, 10), PKW(pB1, 12), PKW(pB1, 14)};
      SBAR(); pv(o, vb0 + sl_cur, PAF(0), PAF(1), PAF(2), PAF(3)); }
#undef PKW
#undef PAF
#undef VFR
#undef PIN
#undef MX3
#undef GAPA
#undef GAPB
#undef EX
#undef VRD
#undef KRD
#undef STEP
#undef ENDW
    { auto rr = __builtin_amdgcn_permlane32_swap(__float_as_uint(l_reg), __float_as_uint(l_reg), false, false); l_reg = __uint_as_float(rr[0]) + __uint_as_float(rr[1]); }
    if (hi == 0) wsf[32 + r32] = l_reg; asm volatile("s_waitcnt lgkmcnt(0)" ::: "memory");
    float rli[16];
#pragma unroll
    for (int r = 0; r < 16; ++r) rli[r] = __builtin_amdgcn_rcpf(wsf[32 + crow(r, hi)]);
    bf16_t* Ow = O + (rowbase + q0 + wid * QBLK) * PO + h * D;
    { bf16_t* stg = (bf16_t*)(shm + LDS_OST) + wid * 2048;
#pragma unroll
      for (int r = 0; r < 16; ++r) { const int orow = crow(r, hi);
#pragma unroll
          for (int d0 = 0; d0 < 2; ++d0) { const float v = o[d0][r] * rli[r]; stg[orow * 64 + d0 * 32 + r32] = (bf16_t)(cvtpk(v, v) & 0xffffu); } }
      asm volatile("s_waitcnt lgkmcnt(0)" ::: "memory");
#pragma unroll
      for (int i = 0; i < 4; ++i) { const int row = i * 8 + (lane >> 3), ch = lane & 7; const u32x4 v = *(const u32x4*)(stg + row * 64 + ch * 8); *(u32x4*)(Ow + (long)row * PO + ch * 8) = v; } }
    asm volatile("s_waitcnt lgkmcnt(0)\n\ts_barrier" ::: "memory");
#undef DMA_K
#undef DMA_V
#undef CMASK
#undef START
#undef RESC
#undef ROT
#undef FLD
#undef CINIT
}
#undef SBAR
#undef WAIT_BAR
}

namespace ret {
constexpr int RS = 272;
constexpr int IMG_Q = 0, IMG_K = 64 * RS, IMG_KT = 2 * 64 * RS, IMG_V = 3 * 64 * RS;
constexpr int PS = 144;
constexpr int IMG_P = 4 * 64 * RS;
constexpr int IMG_ST = IMG_P + 64 * PS;
constexpr int OS = 132;
constexpr int IMG_O = IMG_ST + 128 * RS;
constexpr int LDS_END = IMG_O + 64 * OS * 4;
static_assert(LDS_END <= LDS_BYTES, "retention LDS map");
typedef short v4i16_t __attribute__((ext_vector_type(4)));
__device__ __forceinline__ s16x4 tr4(LAS const char* p) { return __builtin_bit_cast(s16x4, __builtin_amdgcn_ds_read_tr16_b64_v4i16((LAS v4i16_t*)p)); }
__device__ __forceinline__ bf16x8 frag_tr(LAS const char* img, int stride, int k0, int c0, int lane) {
    const int g4 = lane >> 4, i = lane & 15, qq = i >> 2, p = i & 3, hh = g4 >> 1, nh = g4 & 1;
    LAS const char* a = img + (k0 + 8 * hh + qq) * stride + (c0 + 16 * nh + 4 * p) * 2;
    const s16x4 lo = tr4(a), hi = tr4(a + 4 * stride);
    return (bf16x8){lo[0], lo[1], lo[2], lo[3], hi[0], hi[1], hi[2], hi[3]};
}
__device__ __forceinline__ bf16x8 frag_row(LAS const char* img, int stride, int r0, int k0, int lane) {
    return *(const LAS bf16x8*)(img + (r0 + (lane & 31)) * stride + (k0 + 8 * (lane >> 5)) * 2);
}
__device__ __forceinline__ int crow(int r, int hi) { return (r & 3) + 8 * (r >> 2) + 4 * hi; }

template <bool APPLY>
__device__ __forceinline__ void unit(int bh, int g, const bf16_t* RQ, const bf16_t* RK, const bf16_t* RV, const bf16_t* SG, float* GST, bf16_t* MIX, LAS char* lds) {
    int tid_ = threadIdx.x; asm volatile("" : "+v"(tid_));
    const int tid = tid_, lane = tid & 63, hi = lane >> 5; const int w = __builtin_amdgcn_readfirstlane(tid >> 6);
    const int b = bh >> 2, h = bh & 3;
    const float l2g = log2f(1.0f - exp2f(-5.0f - (float)h));
    const float cd = exp2f(64.0f * l2g);
    const size_t row0 = (size_t)b * SEQ + (size_t)g * 512;
    u32x4 rq[2], rk[2], rv[2];
    auto issue = [&](int j) {
#pragma unroll
        for (int i = 0; i < 2; ++i) { const int p = tid + 512 * i, row = p >> 4, ch = p & 15; const size_t off = (row0 + j * 64 + row) * 512 + h * 128 + ch * 8;
            if (APPLY) rq[i] = *(const u32x4*)(RQ + off);
            rk[i] = *(const u32x4*)(RK + off); rv[i] = *(const u32x4*)(RV + off); }
    };
    const int db = w >> 1, eb0 = 2 * (w & 1);
    f32x16 S0 = f32x16{}, S1 = f32x16{};
    if (APPLY) {
        const float Gm = exp2f(512.0f * l2g);
        for (int gp = 0; gp < g; ++gp) {
            const float* src = GST + ((((size_t)(bh * 16 + gp) * 8 + w) * 2) * 16) * 64 + lane;
#pragma unroll
            for (int r = 0; r < 16; ++r) { S0[r] = S0[r] * Gm + src[r * 64]; S1[r] = S1[r] * Gm + src[(16 + r) * 64]; }
        }
    }
    issue(0);
    for (int j = 0; j < 8; ++j) {
#pragma unroll
        for (int i = 0; i < 2; ++i) { const int p = tid + 512 * i, row = p >> 4, ch = p & 15; const int o = row * RS + ch * 16;
            if (APPLY) { *(LAS u32x4*)(lds + IMG_Q + o) = rq[i]; *(LAS u32x4*)(lds + IMG_K + o) = rk[i]; }
            *(LAS u32x4*)(lds + IMG_V + o) = rv[i];
            const float kw = exp2f((float)(63 - row) * l2g);
            u32x4 kt;
#pragma unroll
            for (int e = 0; e < 4; ++e) kt[e] = cvtpk(bflo(rk[i][e]) * kw, bfhi(rk[i][e]) * kw);
            *(LAS u32x4*)(lds + IMG_KT + o) = kt; }
        if (APPLY) {
#pragma unroll
            for (int tile = 0; tile < 2; ++tile) { const f32x16& S = tile ? S1 : S0; const int e = (eb0 + tile) * 32 + (lane & 31);
#pragma unroll
                for (int g4 = 0; g4 < 4; ++g4) { const int d = db * 32 + 8 * g4 + 4 * hi; u32x2 v; v.x = cvtpk(S[4 * g4], S[4 * g4 + 1]); v.y = cvtpk(S[4 * g4 + 2], S[4 * g4 + 3]);
                    *(LAS u32x2*)(lds + IMG_ST + e * RS + d * 2) = v; } }
        }
        if (j + 1 < 8) issue(j + 1);
        LDS_WAIT(); __builtin_amdgcn_s_barrier();
        f32x16 oin = f32x16{}, oit = f32x16{};
        const int qb = w >> 2, eb = w & 3;
        if (APPLY) {
#pragma unroll
            for (int s = 0; s < 8; ++s) oin = __builtin_amdgcn_mfma_f32_32x32x16_bf16(frag_row(lds + IMG_Q, RS, qb * 32, s * 16, lane), frag_row(lds + IMG_ST, RS, eb * 32, s * 16, lane), oin, 0, 0, 0);
            if (w < 4) {
                const int tb = w >> 1, qb2 = w & 1; f32x16 sc = f32x16{};
#pragma unroll
                for (int s = 0; s < 8; ++s) sc = __builtin_amdgcn_mfma_f32_32x32x16_bf16(frag_row(lds + IMG_K, RS, tb * 32, s * 16, lane), frag_row(lds + IMG_Q, RS, qb2 * 32, s * 16, lane), sc, 0, 0, 0);
                const int q = qb2 * 32 + (lane & 31);
#pragma unroll
                for (int g4 = 0; g4 < 4; ++g4) { const int t0 = tb * 32 + 8 * g4 + 4 * hi; float pv4[4];
#pragma unroll
                    for (int e = 0; e < 4; ++e) { const int dd = q - (t0 + e); pv4[e] = sc[4 * g4 + e] * exp2f((float)(dd < 0 ? -dd : dd) * l2g); }
                    u32x2 v; v.x = cvtpk(pv4[0], pv4[1]); v.y = cvtpk(pv4[2], pv4[3]);
                    *(LAS u32x2*)(lds + IMG_P + q * PS + t0 * 2) = v; }
            }
            LDS_WAIT(); __builtin_amdgcn_s_barrier();
#pragma unroll
            for (int s = 0; s < 4; ++s) oit = __builtin_amdgcn_mfma_f32_32x32x16_bf16(frag_row(lds + IMG_P, PS, qb * 32, s * 16, lane), frag_tr(lds + IMG_V, RS, s * 16, eb * 32, lane), oit, 0, 0, 0);
#pragma unroll
            for (int r = 0; r < 16; ++r) { const int q = qb * 32 + crow(r, hi); const float qw = exp2f((float)(q + 1) * l2g);
                *(LAS float*)(lds + IMG_O + (q * OS + eb * 32 + (lane & 31)) * 4) = oit[r] + qw * oin[r]; }
        }
#pragma unroll
        for (int r = 0; r < 16; ++r) { S0[r] *= cd; S1[r] *= cd; }
#pragma unroll
        for (int s = 0; s < 4; ++s) { const bf16x8 a = frag_tr(lds + IMG_KT, RS, s * 16, db * 32, lane);
            S0 = __builtin_amdgcn_mfma_f32_32x32x16_bf16(a, frag_tr(lds + IMG_V, RS, s * 16, eb0 * 32, lane), S0, 0, 0, 0);
            S1 = __builtin_amdgcn_mfma_f32_32x32x16_bf16(a, frag_tr(lds + IMG_V, RS, s * 16, (eb0 + 1) * 32, lane), S1, 0, 0, 0); }
        LDS_WAIT(); __builtin_amdgcn_s_barrier();
        if (APPLY) {
#pragma unroll
            for (int rr = 0; rr < 8; ++rr) { const int q = w * 8 + rr; const f32x2 v = *(const LAS f32x2*)(lds + IMG_O + (q * OS + 2 * lane) * 4);
                const float mu = wave_sum(v.x + v.y) * (1.0f / 128.0f); const float dx = v.x - mu, dy = v.y - mu;
                const float var = wave_sum(dx * dx + dy * dy) * (1.0f / 128.0f); const float rstd = rsqrtf(var + GN_EPS);
                const size_t trow = row0 + j * 64 + q; const unsigned gw = *(const unsigned*)(SG + trow * 512 + h * 128 + 2 * lane);
                *(unsigned*)(MIX + trow * 1024 + h * 128 + 2 * lane) = cvtpk(dx * rstd * bflo(gw), dy * rstd * bfhi(gw)); }
        }
    }
    if (!APPLY) {
        float* dst = GST + ((((size_t)(bh * 16 + g) * 8 + w) * 2) * 16) * 64 + lane;
#pragma unroll
        for (int r = 0; r < 16; ++r) { dst[r * 64] = S0[r]; dst[(16 + r) * 64] = S1[r]; }
    }
    LDS_WAIT(); __builtin_amdgcn_s_barrier();
}
}


#define XB_TMO      128
#define XB_XCNT(j)  (256  + 64 * (j))
#define XB_XSUB(j)  (1280 + 64 * (j))
#define XB_XGEN(j)  (2304 + 64 * (j))
#define XB_TOP      3328
#define XB_TOPGEN   3392
#define XCD_BAR_WORDS 3456
#define XB_SPIN_CAP (1u << 18)
__device__ __forceinline__ unsigned xb_ld(unsigned* p)              { return __hip_atomic_load(p, __ATOMIC_RELAXED, __HIP_MEMORY_SCOPE_AGENT); }
__device__ __forceinline__ unsigned xb_add(unsigned* p, unsigned v) { return __hip_atomic_fetch_add(p, v, __ATOMIC_RELAXED, __HIP_MEMORY_SCOPE_AGENT); }
__device__ __forceinline__ unsigned xb_xcc_id() { return (unsigned)__builtin_amdgcn_s_getreg((3 << 11) | 20) & 0xFu; }
#define XB_SPIN(cond, bar) do { unsigned _sp = 0; while (cond) { __builtin_amdgcn_s_sleep(1); \
    if ((++_sp & 255u) == 0u) { if (xb_ld(&(bar)[XB_TMO])) break; if (_sp > XB_SPIN_CAP) { atomicAdd(&(bar)[XB_TMO], 1u); break; } } } } while (0)
struct XcdBarrier { unsigned* bar; unsigned x; volatile LAS unsigned* st; };
__device__ __forceinline__ XcdBarrier xcd_barrier_post(unsigned* bar, volatile LAS unsigned* st) {
    XcdBarrier b; b.bar = bar; b.x = xb_xcc_id(); b.st = st;
    if (threadIdx.x == 0) (void)xb_add(&bar[XB_XCNT(b.x)], 1u);
    return b;
}
__device__ __forceinline__ void xcd_barrier_complete(unsigned* bar, unsigned x, unsigned& nloc, unsigned& nx) {
    const unsigned G = gridDim.x * gridDim.y * gridDim.z;
    unsigned sum, cnt, mine, sp = 0u;
    for (;;) {
        sum = 0u; cnt = 0u; mine = 0u;
#pragma unroll
        for (unsigned j = 0; j < 16; ++j) { const unsigned c = xb_ld(&bar[XB_XCNT(j)]); sum += c; cnt += (c > 0u) ? 1u : 0u; mine = (j == x) ? c : mine; }
        if (sum == G) break;
        __builtin_amdgcn_s_sleep(1);
        if ((++sp & 255u) == 0u) { if (xb_ld(&bar[XB_TMO])) break; if (sp > XB_SPIN_CAP) { atomicAdd(&bar[XB_TMO], 1u); break; } }
    }
    nloc = mine > 0u ? mine : 1u; nx = cnt > 0u ? cnt : 1u;
}
__device__ __forceinline__ void xcd_barrier(const XcdBarrier& b) {
    asm volatile("s_waitcnt vmcnt(0)" ::: "memory");
    __syncthreads();
    if (threadIdx.x == 0) {
        unsigned* bar = b.bar;
        __builtin_amdgcn_s_waitcnt(0);
        unsigned nloc = b.st[0], nx = b.st[1];
        if (nloc == 0u) { xcd_barrier_complete(bar, b.x, nloc, nx); b.st[0] = nloc; b.st[1] = nx; }
        const unsigned old = xb_add(&bar[XB_XSUB(b.x)], 1u);
        const unsigned gen = old / nloc;
        if (old + 1u == (gen + 1u) * nloc) {
            __builtin_amdgcn_fence(__ATOMIC_RELEASE, "agent");
            asm volatile("s_waitcnt vmcnt(0)" ::: "memory");
            const unsigned og = xb_add(&bar[XB_TOP], 1u);
            const unsigned tg = og / nx;
            if (og + 1u == (tg + 1u) * nx) xb_add(&bar[XB_TOPGEN], 1u);
            else XB_SPIN(xb_ld(&bar[XB_TOPGEN]) == tg, bar);
            __builtin_amdgcn_fence(__ATOMIC_ACQUIRE, "agent");
            xb_add(&bar[XB_XGEN(b.x)], 1u);
            asm volatile("s_waitcnt vmcnt(0)" ::: "memory");
        } else {
            XB_SPIN(xb_ld(&bar[XB_XGEN(b.x)]) == gen, bar);
            __builtin_amdgcn_fence(__ATOMIC_ACQUIRE, "agent");
            asm volatile("s_waitcnt vmcnt(0)" ::: "memory");
        }
    }
    __syncthreads();
}

struct Frame {
    LAS unsigned char* lds; int tid, lane, wave, vcu, G;
};

__device__ __forceinline__ void tr_item(const float* __restrict__ W, int ldw, int k0, int n0, const float* __restrict__ gk, bf16_t* WT, int kind, LAS unsigned* scr, int lane) {
    const int nch = lane & 15, kq = lane >> 4;
    f32x4 a[8], b[8];
#pragma unroll
    for (int i = 0; i < 8; ++i) { const int kp = 4 * i + kq; const float* p = W + (size_t)(k0 + 2 * kp) * ldw + n0 + 4 * nch; a[i] = *(const f32x4*)p; b[i] = *(const f32x4*)(p + ldw); }
#pragma unroll
    for (int i = 0; i < 8; ++i) { const int kp = 4 * i + kq; float ga = 1.f, gb = 1.f; if (gk) { ga = gk[k0 + 2 * kp]; gb = gk[k0 + 2 * kp + 1]; }
#pragma unroll
        for (int e = 0; e < 4; ++e) scr[(4 * nch + e) * 36 + kp] = cvtpk(a[i][e] * ga, b[i][e] * gb); }
    LDS_WAIT(); asm volatile("" ::: "memory");
    const int c = lane & 7, nr = lane >> 3;
#pragma unroll
    for (int j = 0; j < 8; ++j) { const int n = nr + 8 * j; const u32x4 v = *(const LAS u32x4*)(scr + n * 36 + 4 * c);
        const int cn = n0 + n; const int row = (kind == 0) ? pos_inproj(cn) : (kind == 1) ? pos_plain(cn) : pos_w1(cn);
        *(u32x4*)(WT + (size_t)row * 1024 + k0 + 8 * c) = v; }
    LDS_WAIT(); asm volatile("" ::: "memory");
}

__device__ __forceinline__ void tr_item8(const float* __restrict__ W, int ldw, int k0, int n0, const float* __restrict__ gk, unsigned char* WT, int kind, LAS unsigned* scr, int lane) {
    const int nch = lane & 15, kq4 = lane >> 4;
    f32x4 a[4][4];
#pragma unroll
    for (int i = 0; i < 4; ++i) { const int kq = 4 * i + kq4; const float* p = W + (size_t)(k0 + 4 * kq) * ldw + n0 + 4 * nch;
#pragma unroll
        for (int r = 0; r < 4; ++r) a[i][r] = *(const f32x4*)(p + (size_t)r * ldw); }
#pragma unroll
    for (int i = 0; i < 4; ++i) { const int kq = 4 * i + kq4; float g[4];
#pragma unroll
        for (int r = 0; r < 4; ++r) g[r] = (gk ? gk[k0 + 4 * kq + r] : 1.0f) * W_SCALE;
#pragma unroll
        for (int e = 0; e < 4; ++e) scr[(4 * nch + e) * 20 + kq] = pk4_fp8(a[i][0][e] * g[0], a[i][1][e] * g[1], a[i][2][e] * g[2], a[i][3][e] * g[3]); }
    LDS_WAIT(); asm volatile("" ::: "memory");
    const int c = lane & 3, nr = lane >> 2;
#pragma unroll
    for (int j = 0; j < 4; ++j) { const int n = nr + 16 * j; const u32x4 v = *(const LAS u32x4*)(scr + n * 20 + 4 * c);
        const int cn = n0 + n; const int row = (kind == 1) ? pos_plain(cn) : pos_w1(cn);
        *(u32x4*)(WT + (size_t)row * 1024 + k0 + 16 * c) = v; }
    LDS_WAIT(); asm volatile("" ::: "memory");
}

__global__ void __launch_bounds__(NTHREADS, 2) mk_fwd(Params P) {
    __builtin_assume(__builtin_amdgcn_workitem_id_y() == 0); __builtin_assume(__builtin_amdgcn_workitem_id_z() == 0);
    extern __shared__ __attribute__((aligned(16))) unsigned char lds_raw[];
    cg::grid_group grid = cg::this_grid();
    Frame F; F.lds = (LAS unsigned char*)lds_raw; F.tid = threadIdx.x; F.lane = F.tid & 63; F.wave = __builtin_amdgcn_readfirstlane(F.tid >> 6);
    F.G = gridDim.x; { const int bx = blockIdx.x; F.vcu = (F.G % 8 == 0) ? (bx % 8) * (F.G / 8) + bx / 8 : bx; }
    unsigned char* ws = P.ws;
    unsigned* ctl = (unsigned*)(ws + WS_CTL);
    float* ropec = (float*)(ws + WS_ROPEC); float* ropes = (float*)(ws + WS_ROPES);
    float* wr3 = (float*)(ws + WS_WR3); float* logf2 = (float*)(ws + WS_LOGF); float* F2 = (float*)(ws + WS_F2);
    int* ltok = (int*)(ws + WS_LTOK); float* lrstd = (float*)(ws + WS_LRSTD); int* inv = (int*)(ws + WS_INV); float* gates = (float*)(ws + WS_GATE);
    bf16_t* H1B = (bf16_t*)(ws + WS_H1B); bf16_t* WinT = (bf16_t*)(ws + WS_WINT); bf16_t* WoT = (bf16_t*)(ws + WS_WOT);
    unsigned char* W2T = ws + WS_W2T; unsigned char* W1T = ws + WS_W1T; bf16_t* Yb = (bf16_t*)(ws + WS_Y); unsigned char* H1F8 = ws + WS_H1F8;
    bf16_t* U = (bf16_t*)(ws + WS_U); unsigned char* proj = ws + WS_PROJ;
    bf16_t* RQ = (bf16_t*)(proj); bf16_t* RK = (bf16_t*)(proj + PROJ_STRIDE); bf16_t* RV = (bf16_t*)(proj + 2 * PROJ_STRIDE); bf16_t* SG = (bf16_t*)(proj + 3 * PROJ_STRIDE);
    bf16_t* FQ = (bf16_t*)(proj + 4 * PROJ_STRIDE); bf16_t* FK = (bf16_t*)(proj + 5 * PROJ_STRIDE); bf16_t* FV = (bf16_t*)(proj + 6 * PROJ_STRIDE);
    float* GST = (float*)(ws + WS_GST); bf16_t* MIX = (bf16_t*)(ws + WS_MIX); unsigned char* Hb = ws + WS_H;
    const int lo = P.ph_lo, hi_ph = P.ph_hi;
#ifndef MK_PHMASK
#define MK_PHMASK 0x1ff
#endif
#define IN(k) (((MK_PHMASK >> (k)) & 1) && lo <= (k) && (k) < hi_ph)
#define REP(k) for (int rep_ = 0; rep_ < ((MK_DUP == (k)) ? 2 : 1); ++rep_)
#ifndef MK_CG_MASK
#define MK_CG_MASK 0x01
#endif
#define SEAM(k) do { if (IN(k) && IN((k) + 1)) { if ((MK_CG_MASK >> (k)) & 1) grid.sync(); else xcd_barrier(xbar); } } while (0)
    const int gw = F.vcu * NWAVES + F.wave, NGW = F.G * NWAVES;
    volatile LAS unsigned* misc = (volatile LAS unsigned*)(F.lds + LDS_MISC);
    if (F.tid < 4) misc[F.tid] = 0u;
    __syncthreads();
    XcdBarrier xbar = xcd_barrier_post(ctl + CW_BAR, misc);

    if (IN(0)) REP(0) {
        LAS unsigned* scr = (LAS unsigned*)(F.lds + F.wave * 9216);
        LAS float* wfl = (LAS float*)(F.lds + 73728);
        for (int i = F.tid; i < 8192; i += NTHREADS) { const int hh = i & 7, k = i >> 3; wfl[hh * 1024 + k] = P.w_in[(size_t)k * INW + NPROJ + hh]; }
        constexpr int I_IN = 16 * 56, I_O = 16 * 16, I_1 = 32 * 16 * 32, I_2 = 32 * 16 * 16, NIT = I_IN + I_O + I_1 + I_2;
        for (int it = gw; it < NIT; it += NGW) {
            int r = it;
            if (r < I_IN) { tr_item(P.w_in, INW, 64 * (r / 56), 64 * (r % 56), nullptr, WinT, 0, scr, F.lane); continue; } r -= I_IN;
            if (r < I_O) { tr_item(P.w_out, 1024, 64 * (r / 16), 64 * (r % 16), nullptr, WoT, 1, scr, F.lane); continue; } r -= I_O;
            if (r < I_1) { const int e = r >> 9, rr = r & 511; tr_item8(P.w1 + (size_t)e * 1024 * 2048, 2048, 64 * (rr / 32), 64 * (rr % 32), P.g_ffn, W1T + (size_t)e * 2048 * 1024, 2, scr, F.lane); continue; } r -= I_1;
            { const int e = r >> 8, rr = r & 255; tr_item8(P.w2 + (size_t)e * 1024 * 1024, 1024, 64 * (rr / 16), 64 * (rr % 16), nullptr, W2T + (size_t)e * 1024 * 1024, 1, scr, F.lane); }
        }
        __syncthreads();
        for (int m = gw; m < T; m += NGW) {
            const f32x4* xr = (const f32x4*)(P.x + (size_t)m * DM) + F.lane; const f32x4* gr = (const f32x4*)P.g_mix + F.lane;
            f32x4 v[4]; float ss = 0.f;
#pragma unroll
            for (int j = 0; j < 4; ++j) { v[j] = xr[64 * j]; ss += (v[j].x * v[j].x + v[j].y * v[j].y) + (v[j].z * v[j].z + v[j].w * v[j].w); }
            const float rstd = rsqrtf(wave_sum(ss) * (1.0f / DM) + RMS_EPS);
            float z[8];
#pragma unroll
            for (int hh = 0; hh < 8; ++hh) z[hh] = 0.f;
            unsigned long long* o8 = (unsigned long long*)(U + (size_t)m * DM) + F.lane;
#pragma unroll
            for (int j = 0; j < 4; ++j) { v[j] = v[j] * rstd * gr[64 * j];
                o8[64 * j] = (unsigned long long)cvtpk(v[j].x, v[j].y) | ((unsigned long long)cvtpk(v[j].z, v[j].w) << 32);
#pragma unroll
                for (int hh = 0; hh < 8; ++hh) { const f32x4 w4 = *(const LAS f32x4*)(wfl + hh * 1024 + 4 * F.lane + 256 * j); z[hh] += (v[j].x * w4.x + v[j].y * w4.y) + (v[j].z * w4.z + v[j].w * w4.w); } }
#pragma unroll
            for (int hh = 0; hh < 8; ++hh) z[hh] = wave_sum(z[hh]);
            float zz = z[0];
#pragma unroll
            for (int hh = 1; hh < 8; ++hh) zz = (F.lane == hh) ? z[hh] : zz;
            if (F.lane < 8) { const float xx = zz + P.b_forget[F.lane]; const float lf = fminf(xx, 0.f) - log1pf(__expf(-fabsf(xx))); logf2[(size_t)m * 8 + F.lane] = lf * LOG2E; }
        }
        for (int idx = blockIdx.x * NTHREADS + F.tid; idx < SEQ * 64; idx += F.G * NTHREADS) {
            const int pos = idx >> 6, i = idx & 63; const float invf = exp2f(-(float)i * (13.287712379549449f / 64.0f));
            const float ang = (float)pos * invf; double tt = (double)ang * 0.15915494309189535; tt -= __builtin_rint(tt); const float tf = (float)tt;
            ropec[idx] = __builtin_amdgcn_cosf(tf); ropes[idx] = __builtin_amdgcn_sinf(tf);
        }
        for (int idx = blockIdx.x * NTHREADS + F.tid; idx < 32768; idx += F.G * NTHREADS) {
            const int s = idx & 3, e16 = (idx >> 2) & 15, half = (idx >> 6) & 1, kq = (idx >> 7) & 3, c = idx >> 9; const int k = 16 * c + 4 * kq + s, e = 16 * half + e16;
            wr3[idx] = P.w_router[k * 32 + e] * P.g_ffn[k];
        }
    }
    SEAM(0);

    if (IN(1)) {
        pg8::DenseOrder S; S.init(T, NPROJ, DM, F.G, (int)blockIdx.x, (MK_DUP == 1) ? 2 : 1);
        EpiInProj E{proj, ropec, ropes, ctl};
        pg8::gemm_phase<EpiInProj, pg8::DenseOrder, true, true, 2>(F.lds, U, WinT, DM, S, E);
    }
    SEAM(1);

    if (IN(2)) REP(2) {
        for (int u = F.vcu; u < 256; u += F.G) ret::unit<false>(u >> 4, u & 15, RQ, RK, RV, SG, GST, MIX, (LAS char*)F.lds);
        for (int bh = F.vcu; bh < 32; bh += F.G) {
            const int b = bh >> 3, h = bh & 7; LAS double* sd = (LAS double*)F.lds;
            double loc[16]; double run = 0.0;
#pragma unroll
            for (int i = 0; i < 16; ++i) { run += (double)logf2[((size_t)b * SEQ + 16 * F.tid + i) * 8 + h]; loc[i] = run; }
            double incl = run;
#pragma unroll
            for (int o = 1; o < 64; o <<= 1) { const double t = __shfl_up(incl, o); if (F.lane >= o) incl += t; }
            __syncthreads();
            if (F.lane == 63) sd[F.wave] = incl;
            __syncthreads();
            double off = incl - run;
            for (int w2 = 0; w2 < F.wave; ++w2) off += sd[w2];
            LAS float* Fsl = (LAS float*)(F.lds + 4096);
#pragma unroll
            for (int i = 0; i < 16; ++i) { const float fv = (float)(off + loc[i]); F2[(size_t)bh * SEQ + 16 * F.tid + i] = fv; Fsl[16 * F.tid + i] = fv; }
            __syncthreads();
            if (F.tid < 32) { const int qb = F.tid, q0 = 256 * qb, NT = 4 * qb + 4;
                const float qn = __uint_as_float(ctl[CW_QN2 + bh * 2]) + __uint_as_float(ctl[CW_QN2 + bh * 2 + 1]), kn = __uint_as_float(ctl[CW_KN2 + bh * 2]) + __uint_as_float(ctl[CW_KN2 + bh * 2 + 1]);
                const float target = Fsl[q0] + PRUNE_TH + 2.0f * 1.0201f * sqrtf(qn * kn);
                int lo_ = 0, hi_ = NT - 4;
                while (lo_ < hi_) { const int mid = (lo_ + hi_) >> 1; if (Fsl[64 * mid + 63] >= target) lo_ = mid + 1; else hi_ = mid; }
                const int ts = lo_ & ~1, NS = NT - ts;
                ctl[CW_UTS + bh * 32 + qb] = (unsigned)ts; ctl[CW_UPOS + bh * 32 + qb] = atomicAdd(ctl + CW_BIN + (NS >> 1), 1u); }
            __syncthreads();
        }
    }
    SEAM(2);

    if (IN(3)) REP(3) {
        REP(31) for (int u = F.vcu; u < 256; u += F.G) ret::unit<true>(u >> 4, u & 15, RQ, RK, RV, SG, GST, MIX, (LAS char*)F.lds);
        LAS int* qst = (LAS int*)(F.lds + 120832); LAS int* qlist = qst + 128; LAS int* qsh = qst + 100;
        if (F.tid == 0) { int a = 0; for (int k = 64; k >= 2; --k) { qst[k] = a; a += (int)ctl[CW_BIN + k]; } }
        __syncthreads();
        for (int u = F.tid; u < 1024; u += NTHREADS) { const int ts = (int)ctl[CW_UTS + u], NS = 4 * (u & 31) + 4 - ts; qlist[qst[NS >> 1] + (int)ctl[CW_UPOS + u]] = u | (ts << 16); }
        __syncthreads();
        for (;;) {
            if (F.tid == 0) qsh[0] = (int)atomicAdd(ctl + CW_QHEAD, 1u);
            __syncthreads();
            int idx = qsh[0];
            if (idx >= ((MK_DUP == 30) ? 2048 : 1024)) break;
            idx &= 1023;
            const int uu = qlist[idx]; const int u = uu & 0xffff, ts = uu >> 16; const int bh = u >> 5, qb = u & 31;
            attn_body::attn_unit<8>(bh >> 3, bh & 7, qb, ts, FQ, FK, FV, MIX + 512, F2, (char*)lds_raw);
        }
    }
    SEAM(3);

    if (IN(4)) {
        pg8::DenseOrder S; S.init(T, DM, DM, F.G, (int)blockIdx.x, (MK_DUP == 4) ? 2 : 1);
        EpiOutProj E{P.x, H1B, H1F8};
        pg8::gemm_phase<EpiOutProj, pg8::DenseOrder, true, true, 2>(F.lds, MIX, WoT, DM, S, E);
    }
    SEAM(4);

    if (IN(5)) {
        LAS float* wl = (LAS float*)F.lds;
        LAS float* lg = (LAS float*)(F.lds + 131072);
        LAS float* ssb = (LAS float*)(F.lds + 131072 + 128 * 33 * 4);
        LAS int* ecnt = (LAS int*)(F.lds + 131072 + 128 * 33 * 4 + 512);
        LAS int* ebase = ecnt + 32;
        for (int i = F.tid; i < 8192; i += NTHREADS) ((LAS f32x4*)wl)[i] = ((const f32x4*)wr3)[i];
        for (int tb = blockIdx.x; tb < T / 128; tb += F.G) {
            if (F.tid < 32) ecnt[F.tid] = 0;
            __syncthreads();
            const int tok16 = F.lane & 15, kq = F.lane >> 4; const int tokw = tb * 128 + F.wave * 16 + tok16;
            const bf16_t* hrow = H1B + (size_t)tokw * DM + 4 * kq;
            f32x4 a0 = {0.f, 0.f, 0.f, 0.f}, a1 = {0.f, 0.f, 0.f, 0.f}; float ss = 0.f;
#pragma unroll 8
            for (int c = 0; c < 64; ++c) {
                const u32x2 hv = *(const u32x2*)(hrow + 16 * c); const float av[4] = {bflo(hv.x), bfhi(hv.x), bflo(hv.y), bfhi(hv.y)};
                const f32x4 w0 = *(const LAS f32x4*)(wl + (((c * 4 + kq) * 2 + 0) * 16 + tok16) * 4), w1 = *(const LAS f32x4*)(wl + (((c * 4 + kq) * 2 + 1) * 16 + tok16) * 4);
#pragma unroll
                for (int s = 0; s < 4; ++s) { ss += av[s] * av[s]; a0 = __builtin_amdgcn_mfma_f32_16x16x4f32(av[s], w0[s], a0, 0, 0, 0); a1 = __builtin_amdgcn_mfma_f32_16x16x4f32(av[s], w1[s], a1, 0, 0, 0); }
            }
            ss += __shfl_xor(ss, 16); ss += __shfl_xor(ss, 32);
            if (kq == 0) ssb[F.wave * 16 + tok16] = ss;
#pragma unroll
            for (int r = 0; r < 4; ++r) { const int tk = F.wave * 16 + kq * 4 + r; lg[tk * 33 + tok16] = a0[r]; lg[tk * 33 + 16 + tok16] = a1[r]; }
            __syncthreads();
            int esel[4] = {0, 0, 0, 0}, rank[4] = {0, 0, 0, 0}; float gsel[4] = {0.f, 0.f, 0.f, 0.f}; float rstd = 0.f;
            if (F.tid < 128) {
                rstd = rsqrtf(ssb[F.tid] * (1.0f / DM) + RMS_EPS);
                float l[32];
#pragma unroll
                for (int e = 0; e < 32; ++e) l[e] = lg[F.tid * 33 + e] * rstd + P.b_router[e];
                float vs[4];
#pragma unroll
                for (int k = 0; k < 4; ++k) { float best = -INFINITY; int bi = 0;
#pragma unroll
                    for (int e = 0; e < 32; ++e) { const bool bt = l[e] > best; best = bt ? l[e] : best; bi = bt ? e : bi; }
                    vs[k] = best; esel[k] = bi;
#pragma unroll
                    for (int e = 0; e < 32; ++e) l[e] = (e == bi) ? -INFINITY : l[e]; }
                float den = 0.f;
#pragma unroll
                for (int k = 0; k < 4; ++k) { gsel[k] = __expf(vs[k] - vs[0]); den += gsel[k]; }
#pragma unroll
                for (int k = 0; k < 4; ++k) { gsel[k] /= den; rank[k] = atomicAdd((int*)&ecnt[esel[k]], 1); }
            }
            __syncthreads();
            if (F.tid < 32) ebase[F.tid] = (int)atomicAdd(ctl + CW_CNT + F.tid, (unsigned)ecnt[F.tid]);
            __syncthreads();
            if (F.tid < 128) { const int tok = tb * 128 + F.tid;
#pragma unroll
                for (int k = 0; k < 4; ++k) { const int e = esel[k], slot = ebase[e] + rank[k];
                    ltok[(size_t)e * CAP + slot] = tok; lrstd[(size_t)e * CAP + slot] = rstd; inv[tok * 4 + k] = (e << 16) | slot; gates[tok * 4 + k] = gsel[k]; } }
            __syncthreads();
        }
    }
    SEAM(5);

    if (IN(6) || IN(7)) {
        LAS int* boff = (LAS int*)(F.lds + 131072); LAS int* cntl = boff + 64;
        if (F.tid == 0) { int a = 0; for (int e = 0; e < 32; ++e) { const int c = (int)ctl[CW_CNT + e]; cntl[e] = c; boff[e] = a; a += (c + 255) >> 8; } boff[32] = a; }
        __syncthreads();
        if (IN(6)) REP(6) {
            MoeOrder<8, true> S{boff, cntl, ltok, F.G, F.vcu};
            EpiMoe1 E{Hb, P.b1, lrstd, (const int*)(ctl + CW_CNT)};
            pg8::gemm_phase<EpiMoe1, MoeOrder<8, true>, true, true, 1>(F.lds, H1F8, W1T, DM, S, E);
        }
        SEAM(6);
        if (IN(7)) REP(7) {
            MoeOrder<4, false> S{boff, cntl, ltok, F.G, F.vcu};
            EpiMoe2 E{Yb, P.b2};
            pg8::gemm_phase<EpiMoe2, MoeOrder<4, false>, true, true, 1>(F.lds, Hb, W2T, DM, S, E);
        }
    }
    SEAM(7);

    if (IN(8)) REP(8) {
        LAS int* boff = (LAS int*)(F.lds + 131072);
        __syncthreads();
        if (F.tid == 0) { int a = 0; for (int e = 0; e < 32; ++e) { const int c = (int)ctl[CW_CNT + e]; boff[e] = a; a += (c + 255) >> 8; } boff[32] = a; }
        __syncthreads();
        for (int m = gw; m < T; m += NGW) {
            float v[16];
            { const u32x4 a = *(const u32x4*)(H1B + (size_t)m * DM + 8 * F.lane), bq = *(const u32x4*)(H1B + (size_t)m * DM + 512 + 8 * F.lane);
#pragma unroll
              for (int e = 0; e < 4; ++e) { v[2 * e] = bflo(a[e]); v[2 * e + 1] = bfhi(a[e]); v[8 + 2 * e] = bflo(bq[e]); v[8 + 2 * e + 1] = bfhi(bq[e]); } }
#pragma unroll
            for (int k = 0; k < 4; ++k) { const int iv = inv[m * 4 + k]; const float gt = gates[m * 4 + k]; const int e = iv >> 16, slot = iv & 0xffff;
                const size_t yrow = (size_t)boff[e] * 256 + slot;
                const u32x4 a = *(const u32x4*)(Yb + yrow * DM + 8 * F.lane), bq = *(const u32x4*)(Yb + yrow * DM + 512 + 8 * F.lane);
#pragma unroll
                for (int q = 0; q < 4; ++q) { v[2 * q] += gt * bflo(a[q]); v[2 * q + 1] += gt * bfhi(a[q]); v[8 + 2 * q] += gt * bflo(bq[q]); v[8 + 2 * q + 1] += gt * bfhi(bq[q]); } }
            float ss = 0.f;
#pragma unroll
            for (int i = 0; i < 16; ++i) ss += v[i] * v[i];
            const float rstd = rsqrtf(wave_sum(ss) * (1.0f / DM) + RMS_EPS);
            const f32x4* gf = (const f32x4*)P.g_final; f32x4* op = (f32x4*)(P.out + (size_t)m * DM);
            const f32x4 g0 = gf[2 * F.lane], g1 = gf[2 * F.lane + 1], g2 = gf[128 + 2 * F.lane], g3 = gf[128 + 2 * F.lane + 1];
            op[2 * F.lane] = (f32x4){v[0], v[1], v[2], v[3]} * rstd * g0; op[2 * F.lane + 1] = (f32x4){v[4], v[5], v[6], v[7]} * rstd * g1;
            op[128 + 2 * F.lane] = (f32x4){v[8], v[9], v[10], v[11]} * rstd * g2; op[128 + 2 * F.lane + 1] = (f32x4){v[12], v[13], v[14], v[15]} * rstd * g3;
        }
    }
#undef IN
#undef SEAM
}

extern "C" void kernel_launch(void* const* d_in, const int* in_sizes, int n_in, void* d_out, int out_size, void* d_ws, size_t ws_size, hipStream_t stream) {
    static int grid = 0;
    if (grid == 0) {
        if (n_in != 13 || in_sizes[0] != T * DM || out_size != T * DM || ws_size < WS_END) { fprintf(stderr, "kernel_launch: unexpected shapes (n_in %d, in0 %d, out %d, ws %zu)\n", n_in, n_in > 0 ? in_sizes[0] : -1, out_size, ws_size); grid = -1; return; }
        int dev = 0, cus = 0, per_cu = 0;
        if (hipGetDevice(&dev) != hipSuccess || hipDeviceGetAttribute(&cus, hipDeviceAttributeMultiprocessorCount, dev) != hipSuccess) { fprintf(stderr, "kernel_launch: device query failed\n"); grid = -1; return; }
        if (hipFuncSetAttribute((const void*)mk_fwd, hipFuncAttributeMaxDynamicSharedMemorySize, LDS_BYTES) != hipSuccess) { fprintf(stderr, "kernel_launch: hipFuncSetAttribute failed\n"); grid = -1; return; }
        if (hipOccupancyMaxActiveBlocksPerMultiprocessor(&per_cu, (const void*)mk_fwd, NTHREADS, LDS_BYTES) != hipSuccess || per_cu < 1) { fprintf(stderr, "kernel_launch: occupancy query says %d\n", per_cu); per_cu = 1; }
        (void)hipGetLastError();
        grid = cus * 1;
        if (grid != 256) fprintf(stderr, "kernel_launch: %d CUs (built for 256)\n", grid);
    }
    if (grid < 0) return;
    (void)hipMemsetAsync((char*)d_ws + WS_CTL, 0, CTL_BYTES, stream);
    Params p{};
    const float** pin = (const float**)&p;
    for (int i = 0; i < 13; ++i) pin[i] = (const float*)d_in[i];
    p.out = (float*)d_out; p.ws = (unsigned char*)d_ws;
#if MK_N_LAUNCHES == 1
    p.ph_lo = 0; p.ph_hi = 9;
    void* args[] = {&p};
    hipError_t e = hipLaunchCooperativeKernel((const void*)mk_fwd, dim3(grid), dim3(NTHREADS), args, LDS_BYTES, stream);
    if (e != hipSuccess) fprintf(stderr, "kernel_launch: cooperative launch failed: %s (grid %d)\n", hipGetErrorString(e), grid);
#else
    for (int k = 0; k < 9; ++k) { p.ph_lo = k; p.ph_hi = k + 1; hipLaunchKernelGGL(mk_fwd, dim3(grid), dim3(NTHREADS), LDS_BYTES, stream, p); }
#endif
}
```

```cpp
#include <hip/hip_runtime.h>
#include <hip/hip_cooperative_groups.h>
#include <cstdio>
#include <cstdint>
namespace cg = cooperative_groups;

#ifndef MK_N_LAUNCHES
#define MK_N_LAUNCHES 1
#endif
#ifndef MK_DUP
#define MK_DUP -1
#endif
#ifndef MK_DIAG
#define MK_DIAG 0
#endif

#define LAS __attribute__((address_space(3)))
#define GAS __attribute__((address_space(1)))
typedef unsigned short bf16_t;
typedef short bf16x8 __attribute__((ext_vector_type(8)));
typedef short s16x4 __attribute__((ext_vector_type(4)));
typedef float f32x2 __attribute__((ext_vector_type(2)));
typedef float f32x4 __attribute__((ext_vector_type(4)));
typedef float f32x16 __attribute__((ext_vector_type(16)));
typedef unsigned u32x2 __attribute__((ext_vector_type(2)));
typedef unsigned u32x4 __attribute__((ext_vector_type(4)));
typedef __bf16 bf16x2_t __attribute__((ext_vector_type(2)));

constexpr int BATCH = 4, SEQ = 8192, DM = 1024, T = BATCH * SEQ;
constexpr int RH = 4, RD = 128, FH = 8, FD = 64;
constexpr int NPROJ = 3584, INW = 3592;
constexpr int NE = 32, TOPK = 4, DFF = 1024;
constexpr int CAP = T;
constexpr int NBMAX = (T * TOPK) / 256 + NE;
constexpr float RMS_EPS = 1e-5f, GN_EPS = 1e-5f;
constexpr float LOG2E = 1.4426950408889634f;
constexpr float PRUNE_TH = 40.0f;
constexpr float C2 = 0.125f * 1.4426950408889634f;
constexpr int NTHREADS = 512, NWAVES = 8;

constexpr size_t MiB = 1u << 20;
constexpr size_t WS_CTL = 0, CTL_BYTES = 1 * MiB;
constexpr size_t WS_ROPEC = 1 * MiB, WS_ROPES = 3 * MiB;
constexpr size_t WS_WR3 = 5 * MiB;
constexpr size_t WS_LOGF = 6 * MiB;
constexpr size_t WS_F2 = 7 * MiB;
constexpr size_t WS_LTOK = 8 * MiB;
constexpr size_t WS_LRSTD = 12 * MiB;
constexpr size_t WS_INV = 16 * MiB;
constexpr size_t WS_GATE = 17 * MiB;
constexpr size_t WS_H1B = 32 * MiB;
constexpr size_t WS_WINT = 96 * MiB;
constexpr size_t WS_WOT = 104 * MiB;
constexpr size_t WS_W2T = 112 * MiB;
constexpr size_t WS_W1T = 144 * MiB;
constexpr size_t WS_H1F8 = 208 * MiB;
constexpr size_t WS_U = 448 * MiB;
constexpr size_t WS_PROJ = 512 * MiB;
constexpr size_t PROJ_STRIDE = 32 * MiB;
constexpr size_t WS_GST = 736 * MiB;
constexpr size_t WS_MIX = 752 * MiB;
constexpr size_t WS_H = 448 * MiB;
constexpr size_t WS_Y = 584 * MiB;
constexpr size_t WS_END = 856 * MiB;
constexpr float W_SCALE = 128.0f, H_SCALE = 4.0f, Y_SCALE = 16.0f;
constexpr int CW_CNT = 0;
constexpr int CW_DIAG = 64;
constexpr int CW_QN2 = 128, CW_KN2 = 192;
constexpr int CW_BIN = 256;
constexpr int CW_QHEAD = 384;
constexpr int CW_UTS = 1024, CW_UPOS = 2048;
constexpr int CW_BAR = 4096;


constexpr int LDS_BYTES = 163840;
constexpr int LDS_MISC = LDS_BYTES - 16;

__device__ __forceinline__ unsigned cvtpk(float lo, float hi) { f32x2 v = {lo, hi}; bf16x2_t b = __builtin_convertvector(v, bf16x2_t); return __builtin_bit_cast(unsigned, b); }
__device__ __forceinline__ float bf2f(unsigned short h) { return __uint_as_float(((unsigned)h) << 16); }
__device__ __forceinline__ float bflo(unsigned w) { return __uint_as_float(w << 16); }
__device__ __forceinline__ float bfhi(unsigned w) { return __uint_as_float(w & 0xffff0000u); }
__device__ __forceinline__ float wave_sum(float v) {
#pragma unroll
    for (int o = 1; o < 64; o <<= 1) v += __shfl_xor(v, o);
    return v;
}
#define LDS_WAIT() asm volatile("s_waitcnt lgkmcnt(0)" ::: "memory")
#define VM_WAIT() asm volatile("s_waitcnt vmcnt(0)" ::: "memory")

struct Params {
    const float *x, *g_mix, *w_in, *b_forget, *w_out, *g_ffn, *w_router, *b_router, *w1, *b1, *w2, *b2, *g_final;
    float* out; unsigned char* ws; int ph_lo, ph_hi;
};

namespace pg8 {
constexpr int BM = 256, BK = 64, HALF = 128, HTB = HALF * BK * 2, STAGE_BYTES = 8 * HTB, NXCD = 8, WGM = 8;
__host__ __device__ __forceinline__ int lds_byte(int r, int c) { const int st = (r >> 4) * 2 + (c >> 5), rr = r & 15, cc = c & 31, ob = rr * 64 + cc * 2; return st * 1024 + (ob ^ (((ob >> 9) & 1) << 5)); }
__host__ __device__ __forceinline__ void stage_rc(int b, int& R, int& C) { const int st = b / 1024, sb = b % 1024, swz = sb ^ (((sb >> 9) & 1) << 5); R = (st >> 1) * 16 + swz / 64; C = (st & 1) * 32 + (swz % 64) / 2; }

struct Unit { int pm, pn, e, lb, idx; };

struct DenseOrder {
    int nM, nN, nwg, G, c; int K; int dup;
    __device__ void init(int M, int N, int K_, int G_, int c_, int dup_ = 1) { nM = M / BM; nN = N / BM; nwg = nM * nN; G = G_; c = c_; K = K_; dup = dup_; }
    __device__ __forceinline__ bool next(int i, Unit& u) const {
        const long L = (long)i * G + c; if (L >= (long)nwg * dup) return false;
        int wgid = (int)(L % nwg); { const int q = nwg / NXCD, r = nwg % NXCD, xcd = wgid % NXCD, off = wgid / NXCD; wgid = (xcd < r ? xcd * (q + 1) : r * (q + 1) + (xcd - r) * q) + off; }
        const int nig = WGM * nN, gid = wgid / nig, fm = gid * WGM, gsz = (nM - fm) < WGM ? (nM - fm) : WGM;
        u.pm = fm + ((wgid % nig) % gsz); u.pn = (wgid % nig) / gsz; u.e = 0; u.lb = 0; u.idx = i; return true;
    }
    __device__ __forceinline__ void aoffs(const Unit& u, unsigned (&ao)[2][2], const int (&R)[2], const int (&C)[2], int rowbytes) const {
#pragma unroll
        for (int h = 0; h < 2; ++h)
#pragma unroll
            for (int i = 0; i < 2; ++i) ao[h][i] = (unsigned)((u.pm * BM + h * HALF + R[i]) * rowbytes + C[i] * 2);
    }
};

typedef int v8i32 __attribute__((ext_vector_type(8)));
typedef int v4i32 __attribute__((ext_vector_type(4)));
template <class Epi, class Sched, bool ALIGN_EPI, bool SP2, int ES>
__device__ __forceinline__ void gemm_phase(LAS unsigned char* lds, const void* Abase, const void* Btbase, const int K, const Sched& S, const Epi& E) {
    const int tid = threadIdx.x, wid = __builtin_amdgcn_readfirstlane(tid >> 6), lane = tid & 63, wr = wid >> 2, wc = wid & 3, fr = lane & 15, fq = lane >> 4;
    const int rowbytes = K * ES;
    const int nt = rowbytes / 128;
    int RR[2], CC[2]; unsigned voffB[2];
#pragma unroll
    for (int i = 0; i < 2; ++i) { stage_rc(tid * 16 + i * 8192, RR[i], CC[i]); voffB[i] = (unsigned)(RR[i] * rowbytes + CC[i] * 2); }
    const size_t kstep = (size_t)128;
    const size_t hstep = (size_t)HALF * rowbytes;
    const size_t tstep = 2 * hstep;
    const unsigned ldsw = (unsigned)wid * 1024u;
    const int aoff = lds_byte(wr * 64 + fr, fq * 8), boff = lds_byte(wc * 32 + fr, fq * 8);
    const char* Ab = (const char*)Abase;
#define PG8_SA(b, h) (((b) * 2 + (h)) * HTB)
#define PG8_SB(b, h) ((4 + (b) * 2 + (h)) * HTB)
#define PG8_STAGE(bufoff, gbase, voff) do { _Pragma("unroll") for (int _i = 0; _i < 2; ++_i) \
        __builtin_amdgcn_global_load_lds((const unsigned*)((const char*)(gbase) + (voff)[_i]), (LAS unsigned*)(lds + (bufoff) + ldsw + _i * 8192), 16, 0, 0); } while (0)
#define PG8_STAGE_A(bufoff, kb, AO, h) do { _Pragma("unroll") for (int _i = 0; _i < 2; ++_i) \
        __builtin_amdgcn_global_load_lds((const unsigned*)(Ab + (kb) + (AO)[h][_i]), (LAS unsigned*)(lds + (bufoff) + ldsw + _i * 8192), 16, 0, 0); } while (0)
#define PG8_LDA(dst, b, h) do { _Pragma("unroll") for (int m = 0; m < 4; ++m) _Pragma("unroll") for (int k = 0; k < 2; ++k) dst[m][k] = *(const LAS bf16x8*)(lds + PG8_SA(b, h) + aoff + m * 2048 + k * 1024); } while (0)
#define PG8_LDB(dst, b, h) do { _Pragma("unroll") for (int n = 0; n < 2; ++n) _Pragma("unroll") for (int k = 0; k < 2; ++k) dst[n][k] = *(const LAS bf16x8*)(lds + PG8_SB(b, h) + boff + n * 2048 + k * 1024); } while (0)
#define PG8_F8(x) __builtin_shufflevector(__builtin_bit_cast(v4i32, (x)[0]), __builtin_bit_cast(v4i32, (x)[1]), 0, 1, 2, 3, 4, 5, 6, 7)
#define PG8_MMA(ai, bj, At, Bt) do { __builtin_amdgcn_s_setprio(1); _Pragma("unroll") for (int m = 0; m < 4; ++m) _Pragma("unroll") for (int n = 0; n < 2; ++n) { \
        if constexpr (ES == 2) { _Pragma("unroll") for (int k = 0; k < 2; ++k) acc[ai][bj][m][n] = __builtin_amdgcn_mfma_f32_16x16x32_bf16(Bt[n][k], At[m][k], acc[ai][bj][m][n], 0, 0, 0); } \
        else asm volatile("v_mfma_f32_16x16x128_f8f6f4 %0, %1, %2, %0" : "+v"(acc[ai][bj][m][n]) : "v"(PG8_F8(Bt[n])), "v"(PG8_F8(At[m]))); } \
        __builtin_amdgcn_s_setprio(0); } while (0)
#define PG8_WAIT_V(n) asm volatile("s_waitcnt vmcnt(" #n ")" ::: "memory")
#define PG8_WAIT_L(n) asm volatile("s_waitcnt lgkmcnt(" #n ")" ::: "memory")
#define PG8_BAR __builtin_amdgcn_s_barrier()
#define PG8_SCHED __builtin_amdgcn_sched_barrier(0)
    Unit cur, nxt; int ui = 0;
    if (!S.next(0, cur)) return;
    f32x4 acc[2][2][4][2];
#pragma unroll
    for (int a = 0; a < 2; ++a)
#pragma unroll
        for (int b = 0; b < 2; ++b)
#pragma unroll
            for (int m = 0; m < 4; ++m)
#pragma unroll
                for (int n = 0; n < 2; ++n) acc[a][b][m][n] = (f32x4){0.f, 0.f, 0.f, 0.f};
    bf16x8 At[4][2], B0[2][2], B1[2][2];
    unsigned aoC[2][2], aoN[2][2];
    S.aoffs(cur, aoC, RR, CC, rowbytes);
    const char* cB = (const char*)Btbase + (size_t)cur.pn * tstep;
    static_assert(SP2, "only the SP2 loop is kept");
    PG8_STAGE(PG8_SB(0, 0), cB, voffB); PG8_STAGE(PG8_SB(0, 1), cB + hstep, voffB); PG8_STAGE_A(PG8_SA(0, 0), 0, aoC, 0); PG8_STAGE_A(PG8_SA(0, 1), 0, aoC, 1);
    if (wr == 1) PG8_BAR;
    PG8_WAIT_V(2); PG8_BAR;
    PG8_STAGE(PG8_SB(1, 0), cB + kstep, voffB); PG8_STAGE_A(PG8_SA(1, 0), kstep, aoC, 0); PG8_STAGE(PG8_SB(1, 1), cB + hstep + kstep, voffB);
    PG8_WAIT_V(6); PG8_BAR;
    for (;;) {
        const bool has_next = S.next(ui + 1, nxt);
        if (has_next) S.aoffs(nxt, aoN, RR, CC, rowbytes);
        else {
#pragma unroll
            for (int h = 0; h < 2; ++h)
#pragma unroll
                for (int i = 0; i < 2; ++i) aoN[h][i] = aoC[h][i];
        }
        const char* nB = has_next ? (const char*)Btbase + (size_t)nxt.pn * tstep : cB;
#pragma unroll 1
        for (int t = 0; t < nt; t += 2) {
            const bool last = (t == nt - 2);
            const size_t kb1 = (size_t)(t + 1) * kstep;
            const size_t kb2 = last ? 0 : (size_t)(t + 2) * kstep, kb3 = kb2 + kstep;
            unsigned ao2[2][2];
#pragma unroll
            for (int h = 0; h < 2; ++h)
#pragma unroll
                for (int i = 0; i < 2; ++i) ao2[h][i] = last ? aoN[h][i] : aoC[h][i];
            const char* b2 = last ? nB : cB + (size_t)(t + 2) * kstep;
            const char* b3 = b2 + kstep;
            PG8_LDB(B0, 0, 0); PG8_LDB(B1, 0, 1); PG8_SCHED; PG8_LDA(At, 0, 0); PG8_STAGE_A(PG8_SA(1, 1), kb1, aoC, 1);
            PG8_WAIT_V(8); PG8_WAIT_L(0); PG8_BAR; PG8_MMA(0, 0, At, B0); PG8_MMA(0, 1, At, B1); PG8_BAR; PG8_SCHED;
            PG8_LDA(At, 0, 1); PG8_STAGE(PG8_SB(0, 0), b2, voffB); PG8_STAGE(PG8_SB(0, 1), b2 + hstep, voffB); PG8_STAGE_A(PG8_SA(0, 0), kb2, ao2, 0);
            PG8_WAIT_V(8); PG8_WAIT_L(0); PG8_BAR; PG8_MMA(1, 0, At, B0); PG8_MMA(1, 1, At, B1); PG8_BAR; PG8_SCHED;
            PG8_LDB(B0, 1, 0); PG8_LDB(B1, 1, 1); PG8_SCHED; PG8_LDA(At, 1, 0); PG8_STAGE_A(PG8_SA(0, 1), kb2, ao2, 1);
            PG8_WAIT_V(8); PG8_WAIT_L(0); PG8_BAR; PG8_MMA(0, 0, At, B0); PG8_MMA(0, 1, At, B1); PG8_BAR; PG8_SCHED;
            PG8_LDA(At, 1, 1); PG8_STAGE(PG8_SB(1, 0), b3, voffB); PG8_STAGE(PG8_SB(1, 1), b3 + hstep, voffB); PG8_STAGE_A(PG8_SA(1, 0), kb3, ao2, 0);
            PG8_WAIT_V(8); PG8_WAIT_L(0); PG8_BAR; PG8_MMA(1, 0, At, B0); PG8_MMA(1, 1, At, B1); PG8_BAR; PG8_SCHED;
        }
        if constexpr (ALIGN_EPI) { if (wr == 0) PG8_BAR; }
        if constexpr (ES == 1) asm volatile("s_nop 15\n\ts_nop 15" ::: "memory");
        E(acc, cur, wr, wc, fr, fq);
        if (!has_next) break;
#pragma unroll
        for (int a = 0; a < 2; ++a)
#pragma unroll
            for (int b = 0; b < 2; ++b)
#pragma unroll
                for (int m = 0; m < 4; ++m)
#pragma unroll
                    for (int n = 0; n < 2; ++n) acc[a][b][m][n] = (f32x4){0.f, 0.f, 0.f, 0.f};
        cur = nxt; cB = nB; ++ui;
#pragma unroll
        for (int h = 0; h < 2; ++h)
#pragma unroll
            for (int i = 0; i < 2; ++i) aoC[h][i] = aoN[h][i];
        if constexpr (ALIGN_EPI) { if (wr == 1) PG8_BAR; }
    }
    PG8_WAIT_V(0);
    if constexpr (!ALIGN_EPI) { if (wr == 0) PG8_BAR; }
    PG8_BAR;
#undef PG8_SA
#undef PG8_SB
#undef PG8_STAGE
#undef PG8_STAGE_A
#undef PG8_LDA
#undef PG8_LDB
#undef PG8_MMA
#undef PG8_F8
#undef PG8_WAIT_V
#undef PG8_WAIT_L
#undef PG8_BAR
#undef PG8_SCHED
}
}


__device__ __forceinline__ int perm32_pos(int t) { return 16 * ((t >> 2) & 1) + 4 * ((t >> 3) & 3) + (t & 3); }
__device__ __forceinline__ int pos_inproj(int c) {
    if (c < 1024) { const int hc = c & 127; return (c & ~127) | (32 * ((hc >> 4) & 3) + 16 * (hc >> 6) + (hc & 15)); }
    return (c & ~31) | perm32_pos(c & 31);
}
__device__ __forceinline__ int pos_plain(int c) { return (c & ~31) | perm32_pos(c & 31); }
__device__ __forceinline__ int pos_w1(int n) { const int jj = n & 1023, lin = n >> 10, pn = jj >> 7, tp = jj & 127; return pn * 256 + lin * 128 + ((tp & ~31) | perm32_pos(tp & 31)); }

struct EpiInProj {
    unsigned char* proj; const float* ropec; const float* ropes; unsigned* ctl;
    __device__ __forceinline__ void operator()(const f32x4 (&acc)[2][2][4][2], const pg8::Unit& u, int wr, int wc, int fr, int fq) const {
        const int type = u.pn >> 1; bf16_t* base = (bf16_t*)(proj + (size_t)type * PROJ_STRIDE);
        const int colh = (u.pn & 1) * 256;
        if (type < 2) {
            const float sc = (type == 1) ? 0.08838834764831845f : 1.0f;
            const int i0 = 16 * wc + 4 * fq;
#pragma unroll
            for (int ai = 0; ai < 2; ++ai)
#pragma unroll
                for (int m = 0; m < 4; ++m) {
                    const int row = u.pm * 256 + ai * 128 + wr * 64 + m * 16 + fr; const int pos = row & (SEQ - 1);
                    const f32x4 cs = *(const f32x4*)(ropec + pos * 64 + i0), sn = *(const f32x4*)(ropes + pos * 64 + i0);
#pragma unroll
                    for (int bj = 0; bj < 2; ++bj) {
                        const f32x4 x1 = acc[ai][bj][m][0], x2 = acc[ai][bj][m][1];
                        const f32x4 o1 = (x1 * cs - x2 * sn) * sc, o2 = (x1 * sn + x2 * cs) * sc;
                        bf16_t* dst = base + (size_t)row * 512 + colh + bj * 128 + i0;
                        u32x2 w1, w2; w1.x = cvtpk(o1[0], o1[1]); w1.y = cvtpk(o1[2], o1[3]); w2.x = cvtpk(o2[0], o2[1]); w2.y = cvtpk(o2[2], o2[3]);
                        *(u32x2*)dst = w1; *(u32x2*)(dst + 64) = w2;
                    }
                }
        } else {
            const float sc = (type == 4) ? C2 : 1.0f;
            float mx[2] = {0.f, 0.f};
#pragma unroll
            for (int ai = 0; ai < 2; ++ai)
#pragma unroll
                for (int m = 0; m < 4; ++m) {
                    const int row = u.pm * 256 + ai * 128 + wr * 64 + m * 16 + fr;
#pragma unroll
                    for (int bj = 0; bj < 2; ++bj) {
                        f32x4 v0 = acc[ai][bj][m][0] * sc, v1 = acc[ai][bj][m][1] * sc;
                        if (type == 4 || type == 5) { float ssq = (v0[0] * v0[0] + v0[1] * v0[1]) + (v0[2] * v0[2] + v0[3] * v0[3]) + (v1[0] * v1[0] + v1[1] * v1[1]) + (v1[2] * v1[2] + v1[3] * v1[3]);
                            ssq += __shfl_xor(ssq, 16); ssq += __shfl_xor(ssq, 32); mx[bj] = fmaxf(mx[bj], ssq); }
                        if (type == 3) {
#pragma unroll
                            for (int j = 0; j < 4; ++j) { v0[j] = v0[j] * __builtin_amdgcn_rcpf(1.0f + __builtin_amdgcn_exp2f(-LOG2E * v0[j])); v1[j] = v1[j] * __builtin_amdgcn_rcpf(1.0f + __builtin_amdgcn_exp2f(-LOG2E * v1[j])); }
                        }
                        u32x4 w; w.x = cvtpk(v0[0], v0[1]); w.y = cvtpk(v0[2], v0[3]); w.z = cvtpk(v1[0], v1[1]); w.w = cvtpk(v1[2], v1[3]);
                        *(u32x4*)(base + (size_t)row * 512 + colh + bj * 128 + wc * 32 + 8 * fq) = w;
                    }
                }
            if (type == 4 || type == 5) {
#pragma unroll
                for (int bj = 0; bj < 2; ++bj) { float v = mx[bj]; v = fmaxf(v, __shfl_xor(v, 1)); v = fmaxf(v, __shfl_xor(v, 2)); v = fmaxf(v, __shfl_xor(v, 4)); v = fmaxf(v, __shfl_xor(v, 8));
                    if ((threadIdx.x & 63) == 0) { const int bh = (u.pm >> 5) * 8 + (u.pn & 1) * 4 + bj * 2 + (wc >> 1);
                        atomicMax(ctl + ((type == 4) ? CW_QN2 : CW_KN2) + bh * 2 + (wc & 1), __float_as_uint(v)); } }
            }
        }
    }
};

__device__ __forceinline__ unsigned pk4_fp8(float a, float b, float c, float d) { int w = 0; w = __builtin_amdgcn_cvt_pk_fp8_f32(a, b, w, false); w = __builtin_amdgcn_cvt_pk_fp8_f32(c, d, w, true); return (unsigned)w; }
struct EpiOutProj {
    const float* x; bf16_t* h1b; unsigned char* h1f8;
    __device__ __forceinline__ void operator()(const f32x4 (&acc)[2][2][4][2], const pg8::Unit& u, int wr, int wc, int fr, int fq) const {
#pragma unroll
        for (int ai = 0; ai < 2; ++ai)
#pragma unroll
            for (int m = 0; m < 4; ++m) {
                const int row = u.pm * 256 + ai * 128 + wr * 64 + m * 16 + fr;
#pragma unroll
                for (int bj = 0; bj < 2; ++bj) {
                    const int col = u.pn * 256 + bj * 128 + wc * 32 + 8 * fq;
                    const f32x4 xa = *(const f32x4*)(x + (size_t)row * DM + col), xb = *(const f32x4*)(x + (size_t)row * DM + col + 4);
                    const f32x4 v0 = acc[ai][bj][m][0] + xa, v1 = acc[ai][bj][m][1] + xb;
                    u32x4 w; w.x = cvtpk(v0[0], v0[1]); w.y = cvtpk(v0[2], v0[3]); w.z = cvtpk(v1[0], v1[1]); w.w = cvtpk(v1[2], v1[3]);
                    *(u32x4*)(h1b + (size_t)row * DM + col) = w;
                    u32x2 w8; w8.x = pk4_fp8(v0[0], v0[1], v0[2], v0[3]); w8.y = pk4_fp8(v1[0], v1[1], v1[2], v1[3]);
                    *(u32x2*)(h1f8 + (size_t)row * DM + col) = w8;
                }
            }
    }
};

struct EpiMoe1 {
    unsigned char* H; const float* b1; const float* lrstd; const int* cnt;
    __device__ __forceinline__ void operator()(const f32x4 (&acc)[2][2][4][2], const pg8::Unit& u, int wr, int wc, int fr, int fq) const {
        const int e = u.e, pnl = u.pn - e * 8; const int cq = pnl * 128 + wc * 32 + 8 * fq;
        const float* bg = b1 + (size_t)e * 2048 + cq; const float* bl = bg + 1024;
        const f32x4 bg0 = *(const f32x4*)bg, bg1 = *(const f32x4*)(bg + 4), bl0 = *(const f32x4*)bl, bl1 = *(const f32x4*)(bl + 4);
        const int ce = cnt[e];
#pragma unroll
        for (int ai = 0; ai < 2; ++ai)
#pragma unroll
            for (int m = 0; m < 4; ++m) {
                const int rt = ai * 128 + wr * 64 + m * 16 + fr; const int slot = u.lb * 256 + rt;
                const float rs = (slot < ce) ? lrstd[(size_t)e * CAP + slot] * (1.0f / W_SCALE) : 0.f;
                f32x4 g0 = acc[ai][0][m][0] * rs + bg0, g1 = acc[ai][0][m][1] * rs + bg1, l0 = acc[ai][1][m][0] * rs + bl0, l1 = acc[ai][1][m][1] * rs + bl1;
                float o[8];
#pragma unroll
                for (int j = 0; j < 4; ++j) {
                    float g = fminf(g0[j], 7.0f), l = fminf(fmaxf(l0[j], -7.0f), 7.0f); o[j] = g * __builtin_amdgcn_rcpf(1.0f + __builtin_amdgcn_exp2f(-1.702f * LOG2E * g)) * (l * H_SCALE + H_SCALE);
                    g = fminf(g1[j], 7.0f); l = fminf(fmaxf(l1[j], -7.0f), 7.0f); o[4 + j] = g * __builtin_amdgcn_rcpf(1.0f + __builtin_amdgcn_exp2f(-1.702f * LOG2E * g)) * (l * H_SCALE + H_SCALE);
                }
                u32x2 w; w.x = pk4_fp8(o[0], o[1], o[2], o[3]); w.y = pk4_fp8(o[4], o[5], o[6], o[7]);
                *(u32x2*)(H + (size_t)(u.pm * 256 + rt) * DFF + cq) = w;
            }
    }
};

struct EpiMoe2 {
    unsigned char* Y; const float* b2;
    __device__ __forceinline__ void operator()(const f32x4 (&acc)[2][2][4][2], const pg8::Unit& u, int wr, int wc, int fr, int fq) const {
        const int e = u.e, pnl = u.pn - e * 4;
#pragma unroll
        for (int bj = 0; bj < 2; ++bj) {
            const int col = pnl * 256 + bj * 128 + wc * 32 + 8 * fq;
            const f32x4 ba = *(const f32x4*)(b2 + (size_t)e * DM + col), bb = *(const f32x4*)(b2 + (size_t)e * DM + col + 4);
#pragma unroll
            for (int ai = 0; ai < 2; ++ai)
#pragma unroll
                for (int m = 0; m < 4; ++m) {
                    const int rt = ai * 128 + wr * 64 + m * 16 + fr;
                    const f32x4 v0 = acc[ai][bj][m][0] * (Y_SCALE / (W_SCALE * H_SCALE)) + ba * Y_SCALE, v1 = acc[ai][bj][m][1] * (Y_SCALE / (W_SCALE * H_SCALE)) + bb * Y_SCALE;
                    u32x2 w; w.x = pk4_fp8(v0[0], v0[1], v0[2], v0[3]); w.y = pk4_fp8(v1[0], v1[1], v1[2], v1[3]);
                    *(u32x2*)(Y + (size_t)(u.pm * 256 + rt) * DM + col) = w;
                }
        }
    }
};

template <int NT, bool GATHER>
struct MoeOrder {
    const LAS int* boff;
    const LAS int* cntl;
    const LAS int* tokl;
    int G, vcu;
    __device__ __forceinline__ bool next(int i, pg8::Unit& u) const {
        const int cpx = G >> 3, x = vcu / cpx, j = vcu % cpx, rpb = cpx / NT;
        const int rb = (i * 8 + x) * rpb + j / NT; const int nb = boff[32];
        if (rb >= nb) return false;
        int e = 0;
#pragma unroll 1
        for (int k = 1; k < 32; ++k) if (boff[k] <= rb) e = k;
        u.pm = rb; u.e = e; u.lb = rb - boff[e]; u.pn = e * NT + (j % NT); u.idx = i; return true;
    }
    __device__ __forceinline__ void aoffs(const pg8::Unit& u, unsigned (&ao)[2][2], const int (&R)[2], const int (&C)[2], int rowbytes) const {
#pragma unroll
        for (int h = 0; h < 2; ++h)
#pragma unroll
            for (int i = 0; i < 2; ++i) {
                if constexpr (GATHER) {
                    const int tok = tokl[u.idx * 256 + h * 128 + R[i]];
                    ao[h][i] = (unsigned)(tok * rowbytes + C[i] * 2);
                } else ao[h][i] = (unsigned)((u.pm * 256 + h * 128 + R[i]) * rowbytes + C[i] * 2);
            }
    }
};

namespace attn_body {
constexpr int NHEAD = FH, D = 64, PQ = 512, PO = 1024;
constexpr int NW = 8, QBLK = 32, QB = QBLK * NW, KVBLK = 64, NQB = SEQ / QB;
__device__ __forceinline__ int crow(int r, int hi) { return (r & 3) + 8 * (r >> 2) + 4 * hi; }
#define SBAR() __builtin_amdgcn_sched_barrier(0)
__device__ __forceinline__ void cmask(f32x16& p0, f32x16& p1, int jb, int qrel, int hi) {
    const float NEG = -INFINITY; int kb = 64 * jb + 4 * hi;
#pragma unroll
    for (int r = 0; r < 16; ++r) { int kv = kb + (r & 3) + 8 * (r >> 2); if (kv > qrel) p0[r] = NEG; if (kv + 32 > qrel) p1[r] = NEG; }
}
constexpr int NSLOT = 3, SLOTB = 8192;
constexpr int LDS_K = 0, LDS_V = NSLOT * SLOTB, LDS_WS = 2 * NSLOT * SLOTB, LDS_OST = LDS_WS + NW * 64 * 4, LDS_END = LDS_OST + NW * 4096;
constexpr int LDS_F = 86016, LDS_F_BYTES = SEQ * 4 + 1024;
static_assert(LDS_F >= LDS_END && LDS_F + LDS_F_BYTES <= LDS_BYTES, "attention LDS map");
__device__ __forceinline__ void glds16(const void* gsrc, unsigned lds_dst) { unsigned keep;
    asm volatile("s_mov_b32 %0, m0\n\ts_mov_b32 m0, %2\n\ts_nop 0\n\tglobal_load_lds_dwordx4 %1, off\n\ts_mov_b32 m0, %0" : "=&s"(keep) : "v"(gsrc), "s"(lds_dst) : "memory"); }
__device__ __forceinline__ float max3f(float a, float b, float c) { float r; asm("v_max3_f32 %0, %1, %2, %3" : "=v"(r) : "v"(a), "v"(b), "v"(c)); return r; }
__device__ __forceinline__ float max2f(float a, float b) { float r; asm("v_max_f32_e32 %0, %1, %2" : "=v"(r) : "v"(a), "v"(b)); return r; }
__device__ __forceinline__ float fadd_s(float a, float b) { float r; asm("v_add_f32_e32 %0, %1, %2" : "=v"(r) : "v"(a), "v"(b)); return r; }
__device__ __forceinline__ float fsub_s(float a, float b) { float r; asm("v_sub_f32_e32 %0, %1, %2" : "=v"(r) : "v"(a), "v"(b)); return r; }
#define WAIT_BAR(N) asm volatile("s_waitcnt vmcnt(" #N ") lgkmcnt(0)\n\ts_barrier" ::: "memory")

typedef LAS const char* lds_cptr;
typedef short v4i16_t __attribute__((ext_vector_type(4)));
__device__ __forceinline__ void kload8(bf16x8* kf, lds_cptr kp) {
    kf[0] = *(const LAS bf16x8*)(kp);        kf[1] = *(const LAS bf16x8*)(kp + 512);
    kf[2] = *(const LAS bf16x8*)(kp + 2048); kf[3] = *(const LAS bf16x8*)(kp + 2560);
    kf[4] = *(const LAS bf16x8*)(kp + 4096); kf[5] = *(const LAS bf16x8*)(kp + 4608);
    kf[6] = *(const LAS bf16x8*)(kp + 6144); kf[7] = *(const LAS bf16x8*)(kp + 6656);
}
__device__ __forceinline__ void kload2(bf16x8* kf, lds_cptr kp, int j) { kf[2 * j] = *(const LAS bf16x8*)(kp + j * 2048); kf[2 * j + 1] = *(const LAS bf16x8*)(kp + j * 2048 + 512); }
__device__ __forceinline__ s16x4 vtr(lds_cptr p) { return __builtin_bit_cast(s16x4, __builtin_amdgcn_ds_read_tr16_b64_v4i16((LAS v4i16_t*)p)); }
__device__ __forceinline__ float rowmax(const f32x16& p0, const f32x16& p1) {
    float a = max3f(p0[0], p0[1], p1[0]), b = max3f(p0[2], p0[3], p1[1]); a = max3f(a, p1[2], p1[3]);
#pragma unroll
    for (int r = 4; r < 16; r += 4) { a = max3f(a, p0[r], p0[r + 1]); b = max3f(b, p0[r + 2], p0[r + 3]); a = max3f(a, p1[r], p1[r + 1]); b = max3f(b, p1[r + 2], p1[r + 3]); }
    const float m = max2f(a, b);
    auto rr = __builtin_amdgcn_permlane32_swap(__float_as_uint(m), __float_as_uint(m), false, false);
    return max2f(__uint_as_float(rr[0]), __uint_as_float(rr[1]));
}
__device__ __forceinline__ void pv(f32x16* o, int vb, bf16x8 pa0, bf16x8 pa1, bf16x8 pa2, bf16x8 pa3) {
#pragma unroll
    for (int d0 = 0; d0 < 2; ++d0) { s16x4 lo[4], hi[4];
#pragma unroll
        for (int ks = 0; ks < 4; ++ks) {
            asm volatile("ds_read_b64_tr_b16 %0,%1 offset:%c2" : "=&v"(lo[ks]) : "v"(vb), "i"(d0 * 4096 + ks * 1024) : "memory");
            asm volatile("ds_read_b64_tr_b16 %0,%1 offset:%c2" : "=&v"(hi[ks]) : "v"(vb), "i"(d0 * 4096 + ks * 1024 + 512) : "memory"); }
        asm volatile("s_waitcnt lgkmcnt(0)" ::: "memory"); SBAR();
#define PK(k) (bf16x8){lo[k][0], lo[k][1], lo[k][2], lo[k][3], hi[k][0], hi[k][1], hi[k][2], hi[k][3]}
        o[d0] = __builtin_amdgcn_mfma_f32_32x32x16_bf16(pa0, PK(0), o[d0], 0, 0, 0);
        o[d0] = __builtin_amdgcn_mfma_f32_32x32x16_bf16(pa1, PK(1), o[d0], 0, 0, 0);
        o[d0] = __builtin_amdgcn_mfma_f32_32x32x16_bf16(pa2, PK(2), o[d0], 0, 0, 0);
        o[d0] = __builtin_amdgcn_mfma_f32_32x32x16_bf16(pa3, PK(3), o[d0], 0, 0, 0);
#undef PK
    }
}

template <int THRL> __device__ __forceinline__ void attn_unit(int b, int h, int qb, int ts, const bf16_t* Q, const bf16_t* __restrict__ K, const bf16_t* __restrict__ V, bf16_t* O, const float* __restrict__ F2, char* shm) {
    const int tid = threadIdx.x, lane = tid & 63, r32 = lane & 31, hi = lane >> 5; const int wid = __builtin_amdgcn_readfirstlane(tid >> 6);
    const long rowbase = (long)b * SEQ; const int q0 = qb * QB;
    const bf16_t* Qw = Q + (rowbase + q0 + wid * QBLK) * PQ + h * D;
    const bf16_t* Kh = K + (rowbase + (long)ts * KVBLK) * PQ + h * D, *Vh = V + (rowbase + (long)ts * KVBLK) * PQ + h * D;
    const unsigned lds0 = (unsigned)(uintptr_t)shm;
    float* wsf = (float*)(shm + LDS_WS) + wid * 64;
    { const f32x4* Fg = (const f32x4*)(F2 + (size_t)(b * NHEAD + h) * SEQ + (size_t)ts * KVBLK); LAS f32x4* Fl4 = (LAS f32x4*)((LAS char*)(lds_cptr)shm + LDS_F); const int n4 = (q0 + QB - ts * KVBLK) / 4;
      for (int p = tid; p < n4; p += NW * 64) Fl4[p] = Fg[p]; }
    const LAS float* Fl = (const LAS float*)((lds_cptr)shm + LDS_F);
    asm volatile("s_waitcnt vmcnt(0) lgkmcnt(0)" ::: "memory");
    const bf16_t* ksrc = Kh + (long)lane * PQ + wid * 8;
    const bf16_t* vsrc = Vh + (long)(16 * (wid & 3) + (lane >> 2)) * PQ + (wid >> 2) * 32 + (lane & 3) * 8;
    const unsigned kdst = lds0 + LDS_K + wid * 1024, vdst = lds0 + LDS_V + wid * 1024;
#define DMA_K(t, slot) glds16(ksrc + (long)(t) * KVBLK * PQ, (unsigned)__builtin_amdgcn_readfirstlane(kdst + (slot)))
#define DMA_V(t, slot) glds16(vsrc + (long)(t) * KVBLK * PQ, (unsigned)__builtin_amdgcn_readfirstlane(vdst + (slot)))
    const int vb0 = (int)(lds0 + LDS_V) + ((lane >> 4) & 1) * 32 + (lane & 3) * 8 + (4 * hi + ((lane & 15) >> 2)) * 64;
    bf16x8 kf[8];
    const lds_cptr shm3 = (lds_cptr)shm; const lds_cptr kp0 = shm3 + LDS_K + hi * 1024 + r32 * 16; const lds_cptr vp0 = shm3 + LDS_V + ((lane >> 4) & 1) * 32 + (lane & 3) * 8 + (4 * hi + ((lane & 15) >> 2)) * 64;
    const int NT = (q0 + QB) / KVBLK - ts;
    DMA_K(0, 0); DMA_V(0, 0); DMA_K(1, SLOTB);
    bf16x8 qr[4];
#pragma unroll
    for (int d0 = 0; d0 < 4; ++d0) qr[d0] = *reinterpret_cast<const bf16x8*>(&Qw[(long)r32 * PQ + d0 * 16 + hi * 8]);
    float mhat = 0.f, l_reg = 0.f, nm = 0.f; f32x16 o[2]; o[0] = f32x16{}; o[1] = f32x16{};
    f32x4 fa[4], fb[4];
#define FLD(tt) do { const LAS float* fp_ = Fl + 64 * (tt) + 4 * hi; _Pragma("unroll") for (int g_ = 0; g_ < 4; ++g_) { fa[g_] = *(const LAS f32x4*)(fp_ + 8 * g_); fb[g_] = *(const LAS f32x4*)(fp_ + 32 + 8 * g_); } } while (0)
#define CINIT(C0, C1) do { _Pragma("unroll") for (int g_ = 0; g_ < 4; ++g_) { _Pragma("unroll") for (int e_ = 0; e_ < 4; ++e_) { C0[4 * g_ + e_] = nm - fa[g_][e_]; C1[4 * g_ + e_] = nm - fb[g_][e_]; } } } while (0)
    const int qrel = wid * QBLK + r32;
#define CMASK(P0, P1, t) do { int jb_ = (t) - (NT - 4); if (jb_ >= 0) cmask(P0, P1, jb_, qrel, hi); } while (0)
    bool resc = false;
#define START(P0, P1) do { const float rm = rowmax(P0, P1); resc = false; \
    { const float dl = rm; mhat = fadd_s(mhat, dl); \
      _Pragma("unroll") for (int r = 0; r < 16; ++r) { P0[r] = fsub_s(P0[r], dl); P1[r] = fsub_s(P1[r], dl); } \
      nm = -mhat; } \
    _Pragma("unroll") for (int r = 0; r < 16; ++r) P0[r] = __builtin_amdgcn_exp2f(P0[r]); } while (0)
#define RESC() do { if (resc) { asm volatile("s_waitcnt lgkmcnt(0)" ::: "memory"); \
      _Pragma("unroll") for (int d_ = 0; d_ < 2; ++d_) _Pragma("unroll") for (int r = 0; r < 16; ++r) o[d_][r] *= wsf[crow(r, hi)]; } } while (0)
    f32x16 pA0, pA1, pB0, pB1;
    int sl_prev = 0, sl_cur = 0, sl_next = SLOTB;
#define ROT() do { sl_prev = sl_cur; sl_cur = sl_next; sl_next = (sl_next == (NSLOT - 1) * SLOTB) ? 0 : sl_next + SLOTB; } while (0)
    DMA_K(2, 2 * SLOTB);
    WAIT_BAR(3);
    FLD(0); CINIT(pA0, pA1);
    { const lds_cptr kb = shm3 + LDS_K + hi * 1024 + r32 * 16;
#pragma unroll
      for (int d0 = 0; d0 < 4; ++d0) { const bf16x8 b0 = *(const LAS bf16x8*)(kb + d0 * 2048); const bf16x8 b1 = *(const LAS bf16x8*)(kb + d0 * 2048 + 512);
          pA0 = __builtin_amdgcn_mfma_f32_32x32x16_bf16(b0, qr[d0], pA0, 0, 0, 0); pA1 = __builtin_amdgcn_mfma_f32_32x32x16_bf16(b1, qr[d0], pA1, 0, 0, 0); } }
    asm volatile("s_nop 15\n\ts_nop 7" : "+v"(pA0), "+v"(pA1)); CMASK(pA0, pA1, 0);
    START(pA0, pA1);
    _Pragma("unroll") for (int r = 0; r < 16; ++r) pA1[r] = __builtin_amdgcn_exp2f(pA1[r]);
    FLD(1);
    WAIT_BAR(0);
    DMA_K(3, 0); DMA_V(1, SLOTB);
    ROT();
    kload8(kf, kp0 + sl_cur);
    WAIT_BAR(2);
    s16x4 vlo[8], vhi[8]; u32x4 pw0, pw1, pw2, pw3;
#define PKW(P, B) cvtpk(P[B], P[B + 1])
#define PAF(k) __builtin_bit_cast(bf16x8, pw##k)
#define VFR(i) (bf16x8){vlo[i][0], vlo[i][1], vlo[i][2], vlo[i][3], vhi[i][0], vhi[i][1], vhi[i][2], vhi[i][3]}
#define PIN(x) asm volatile("" : "+v"(x))
#define MX3(a, b, c) __builtin_fmaxf(__builtin_fmaxf((a), (b)), (c))
#define GAPA(MF, A0, A1, A2, A3, W0, W1, PW) do { MF; sacc += A0; sacc += A1; sacc += A2; sacc += A3; PIN(sacc); W0; W1; PIN(PW); SBAR(); } while (0)
#define EX(v) __builtin_amdgcn_exp2f(v)
#define GAPB(MF, X, B) do { MF; X[B] = EX(X[B]); X[B + 1] = EX(X[B + 1]); X[B + 2] = EX(X[B + 2]); X[B + 3] = EX(X[B + 3]); PIN(X); SBAR(); } while (0)
#define VRD(i) do { vlo[i] = vtr(vp_ + (((i) >> 2) * 4096 + ((i) & 3) * 1024)); vhi[i] = vtr(vp_ + (((i) >> 2) * 4096 + ((i) & 3) * 1024 + 512)); } while (0)
#define KRD(G, j) do { if (G) { kload2(kf, kp0 + sl_next, j); SBAR(); } } while (0)
#define STEP(C0, C1, P0, P1, t, GK, GV, GL) do { SBAR(); \
    CINIT(C0, C1); SBAR(); \
    const lds_cptr vp_ = vp0 + sl_prev; \
    VRD(0); SBAR(); float sacc = (P0[0] + P0[1]); \
    GAPA(C0 = __builtin_amdgcn_mfma_f32_32x32x16_bf16(kf[0], qr[0], C0, 0, 0, 0), P0[2], P0[3], P0[4], P0[5],     pw0[0] = PKW(P0, 0), pw0[1] = PKW(P0, 2), pw0); \
    VRD(4); SBAR(); GAPA(C1 = __builtin_amdgcn_mfma_f32_32x32x16_bf16(kf[1], qr[0], C1, 0, 0, 0), P0[6], P0[7], P0[8], P0[9],     pw0[2] = PKW(P0, 4), pw0[3] = PKW(P0, 6), pw0); \
    VRD(1); SBAR(); GAPA(C0 = __builtin_amdgcn_mfma_f32_32x32x16_bf16(kf[2], qr[1], C0, 0, 0, 0),   P0[10], P0[11], P0[12], P0[13], pw1[0] = PKW(P0, 8), pw1[1] = PKW(P0, 10), pw1); \
    VRD(5); SBAR(); GAPA(C1 = __builtin_amdgcn_mfma_f32_32x32x16_bf16(kf[3], qr[1], C1, 0, 0, 0),   P0[14], P0[15], P1[0], P1[1],   pw1[2] = PKW(P0, 12), pw1[3] = PKW(P0, 14), pw1); \
    VRD(2); SBAR(); GAPA(C0 = __builtin_amdgcn_mfma_f32_32x32x16_bf16(kf[4], qr[2], C0, 0, 0, 0),   P1[2], P1[3], P1[4], P1[5],     pw2[0] = PKW(P1, 0), pw2[1] = PKW(P1, 2), pw2); \
    VRD(6); SBAR(); GAPA(C1 = __builtin_amdgcn_mfma_f32_32x32x16_bf16(kf[5], qr[2], C1, 0, 0, 0),   P1[6], P1[7], P1[8], P1[9],     pw2[2] = PKW(P1, 4), pw2[3] = PKW(P1, 6), pw2); \
    VRD(3); SBAR(); GAPA(C0 = __builtin_amdgcn_mfma_f32_32x32x16_bf16(kf[6], qr[3], C0, 0, 0, 0),   P1[10], P1[11], P1[12], P1[13], pw3[0] = PKW(P1, 8), pw3[1] = PKW(P1, 10), pw3); \
    VRD(7); SBAR(); GAPA(C1 = __builtin_amdgcn_mfma_f32_32x32x16_bf16(kf[7], qr[3], C1, 0, 0, 0),   P1[14], P1[15], 0.f, 0.f,       pw3[2] = PKW(P1, 12), pw3[3] = PKW(P1, 14), pw3); \
    l_reg += sacc; \
    if (GK) { DMA_K((t) + 3, sl_cur); } if (GV) { DMA_V((t) + 1, sl_next); } \
    CMASK(C0, C1, t); \
    { float a = MX3(C0[0], C0[1], C1[0]), b = MX3(C0[2], C0[3], C1[1]); a = MX3(a, C1[2], C1[3]); \
      _Pragma("unroll") for (int r = 4; r < 16; r += 4) { a = MX3(a, C0[r], C0[r + 1]); b = MX3(b, C0[r + 2], C0[r + 3]); a = MX3(a, C1[r], C1[r + 1]); b = MX3(b, C1[r + 2], C1[r + 3]); } \
      float rm = __builtin_fmaxf(a, b); { auto rr = __builtin_amdgcn_permlane32_swap(__float_as_uint(rm), __float_as_uint(rm), false, false); rm = __builtin_fmaxf(__uint_as_float(rr[0]), __uint_as_float(rr[1])); } \
      resc = false; \
      if (__builtin_expect(__any(rm > (float)THRL), 0)) { const float dl = __builtin_fmaxf(rm, 0.f); mhat += dl; \
        _Pragma("unroll") for (int r = 0; r < 16; ++r) { C0[r] -= dl; C1[r] -= dl; } \
        nm = -mhat; \
        const float f = __builtin_amdgcn_exp2f(-dl); l_reg *= f; if (hi == 0) wsf[r32] = f; resc = true; } } \
    SBAR(); \
    GAPB(o[0] = __builtin_amdgcn_mfma_f32_32x32x16_bf16(PAF(0), VFR(0), o[0], 0, 0, 0), C0, 0); \
    GAPB(o[1] = __builtin_amdgcn_mfma_f32_32x32x16_bf16(PAF(0), VFR(4), o[1], 0, 0, 0), C0, 4); \
    KRD(GL, 0); GAPB(o[0] = __builtin_amdgcn_mfma_f32_32x32x16_bf16(PAF(1), VFR(1), o[0], 0, 0, 0), C0, 8); \
    KRD(GL, 1); GAPB(o[1] = __builtin_amdgcn_mfma_f32_32x32x16_bf16(PAF(1), VFR(5), o[1], 0, 0, 0), C0, 12); \
    KRD(GL, 2); GAPB(o[0] = __builtin_amdgcn_mfma_f32_32x32x16_bf16(PAF(2), VFR(2), o[0], 0, 0, 0), C1, 0); \
    KRD(GL, 3); GAPB(o[1] = __builtin_amdgcn_mfma_f32_32x32x16_bf16(PAF(2), VFR(6), o[1], 0, 0, 0), C1, 4); \
    GAPB(o[0] = __builtin_amdgcn_mfma_f32_32x32x16_bf16(PAF(3), VFR(3), o[0], 0, 0, 0), C1, 8); \
    GAPB(o[1] = __builtin_amdgcn_mfma_f32_32x32x16_bf16(PAF(3), VFR(7), o[1], 0, 0, 0), C1, 12); \
    FLD((t) + 1); \
    } while (0)
    int t = 1;
#undef CMASK
#define CMASK(P0, P1, t) do { } while (0)
    for (; t + 5 < NT; t += 2) {
        STEP(pB0, pB1, pA0, pA1, t, true, true, true);     WAIT_BAR(2); RESC(); ROT();
        STEP(pA0, pA1, pB0, pB1, t + 1, true, true, true);   WAIT_BAR(2); RESC(); ROT();
    }
#undef CMASK
#define CMASK(P0, P1, t) do { int jb_ = (t) - (NT - 4); if (jb_ >= 0) cmask(P0, P1, jb_, qrel, hi); } while (0)
#define ENDW(tt) do { if ((tt) + 3 < NT) { WAIT_BAR(2); } else if ((tt) + 2 < NT) { WAIT_BAR(1); } else { WAIT_BAR(0); } } while (0)
    for (; t + 1 < NT; t += 2) {
        STEP(pB0, pB1, pA0, pA1, t, (t + 3 < NT), (t + 1 < NT), (t + 1 < NT));       ENDW(t);   RESC(); ROT();
        STEP(pA0, pA1, pB0, pB1, t + 1, (t + 4 < NT), (t + 2 < NT), (t + 2 < NT));     ENDW(t + 1); RESC(); ROT();
    }
    STEP(pB0, pB1, pA0, pA1, NT - 1, false, false, false); RESC();
    { float sacc = pB0[0] + pB0[1]; _Pragma("unroll") for (int r = 2; r < 16; ++r) sacc += pB0[r]; _Pragma("unroll") for (int r = 0; r < 16; ++r) sacc += pB1[r]; l_reg += sacc;
      pw0 = (u32x4){PKW(pB0, 0), PKW(pB0, 2), PKW(pB0, 4), PKW(pB0, 6)}; pw1 = (u32x4){PKW(pB0, 8), PKW(pB0, 10), PKW(pB0, 12), PKW(pB0, 14)}; pw2 = (u32x4){PKW(pB1, 0), PKW(pB1, 2), PKW(pB1, 4), PKW(pB1, 6)}; pw3 = (u32x4){PKW(pB1, 8), PKW(pB1, 10), PKW(pB1, 12), PKW(pB1, 14)};
      SBAR(); pv(o, vb0 + sl_cur, PAF(0), PAF(1), PAF(2), PAF(3)); }
#undef PKW
#undef PAF
#undef VFR
#undef PIN
#undef MX3
#undef GAPA
#undef GAPB
#undef EX
#undef VRD
#undef KRD
#undef STEP
#undef ENDW
    { auto rr = __builtin_amdgcn_permlane32_swap(__float_as_uint(l_reg), __float_as_uint(l_reg), false, false); l_reg = __uint_as_float(rr[0]) + __uint_as_float(rr[1]); }
    if (hi == 0) wsf[32 + r32] = l_reg; asm volatile("s_waitcnt lgkmcnt(0)" ::: "memory");
    float rli[16];
#pragma unroll
    for (int r = 0; r < 16; ++r) rli[r] = __builtin_amdgcn_rcpf(wsf[32 + crow(r, hi)]);
    bf16_t* Ow = O + (rowbase + q0 + wid * QBLK) * PO + h * D;
    { bf16_t* stg = (bf16_t*)(shm + LDS_OST) + wid * 2048;
#pragma unroll
      for (int r = 0; r < 16; ++r) { const int orow = crow(r, hi);
#pragma unroll
          for (int d0 = 0; d0 < 2; ++d0) { const float v = o[d0][r] * rli[r]; stg[orow * 64 + d0 * 32 + r32] = (bf16_t)(cvtpk(v, v) & 0xffffu); } }
      asm volatile("s_waitcnt lgkmcnt(0)" ::: "memory");
#pragma unroll
      for (int i = 0; i < 4; ++i) { const int row = i * 8 + (lane >> 3), ch = lane & 7; const u32x4 v = *(const u32x4*)(stg + row * 64 + ch * 8); *(u32x4*)(Ow + (long)row * PO + ch * 8) = v; } }
    asm volatile("s_waitcnt lgkmcnt(0)\n\ts_barrier" ::: "memory");
#undef DMA_K
#undef DMA_V
#undef CMASK
#undef START
#undef RESC
#undef ROT
#undef FLD
#undef CINIT
}
#undef SBAR
#undef WAIT_BAR
}

namespace ret {
constexpr int RS = 272;
constexpr int IMG_Q = 0, IMG_K = 64 * RS, IMG_KT = 2 * 64 * RS, IMG_V = 3 * 64 * RS;
constexpr int PS = 144;
constexpr int IMG_P = 4 * 64 * RS;
constexpr int IMG_ST = IMG_P + 64 * PS;
constexpr int OS = 132;
constexpr int IMG_O = IMG_ST + 128 * RS;
constexpr int LDS_END = IMG_O + 64 * OS * 4;
static_assert(LDS_END <= LDS_BYTES, "retention LDS map");
typedef short v4i16_t __attribute__((ext_vector_type(4)));
__device__ __forceinline__ s16x4 tr4(LAS const char* p) { return __builtin_bit_cast(s16x4, __builtin_amdgcn_ds_read_tr16_b64_v4i16((LAS v4i16_t*)p)); }
__device__ __forceinline__ bf16x8 frag_tr(LAS const char* img, int stride, int k0, int c0, int lane) {
    const int g4 = lane >> 4, i = lane & 15, qq = i >> 2, p = i & 3, hh = g4 >> 1, nh = g4 & 1;
    LAS const char* a = img + (k0 + 8 * hh + qq) * stride + (c0 + 16 * nh + 4 * p) * 2;
    const s16x4 lo = tr4(a), hi = tr4(a + 4 * stride);
    return (bf16x8){lo[0], lo[1], lo[2], lo[3], hi[0], hi[1], hi[2], hi[3]};
}
__device__ __forceinline__ bf16x8 frag_row(LAS const char* img, int stride, int r0, int k0, int lane) {
    return *(const LAS bf16x8*)(img + (r0 + (lane & 31)) * stride + (k0 + 8 * (lane >> 5)) * 2);
}
__device__ __forceinline__ int crow(int r, int hi) { return (r & 3) + 8 * (r >> 2) + 4 * hi; }

template <bool APPLY>
__device__ __forceinline__ void unit(int bh, int g, const bf16_t* RQ, const bf16_t* RK, const bf16_t* RV, const bf16_t* SG, float* GST, bf16_t* MIX, LAS char* lds) {
    int tid_ = threadIdx.x; asm volatile("" : "+v"(tid_));
    const int tid = tid_, lane = tid & 63, hi = lane >> 5; const int w = __builtin_amdgcn_readfirstlane(tid >> 6);
    const int b = bh >> 2, h = bh & 3;
    const float l2g = log2f(1.0f - exp2f(-5.0f - (float)h));
    const float cd = exp2f(64.0f * l2g);
    const size_t row0 = (size_t)b * SEQ + (size_t)g * 512;
    u32x4 rq[2], rk[2], rv[2];
    auto issue = [&](int j) {
#pragma unroll
        for (int i = 0; i < 2; ++i) { const int p = tid + 512 * i, row = p >> 4, ch = p & 15; const size_t off = (row0 + j * 64 + row) * 512 + h * 128 + ch * 8;
            if (APPLY) rq[i] = *(const u32x4*)(RQ + off);
            rk[i] = *(const u32x4*)(RK + off); rv[i] = *(const u32x4*)(RV + off); }
    };
    const int db = w >> 1, eb0 = 2 * (w & 1);
    f32x16 S0 = f32x16{}, S1 = f32x16{};
    if (APPLY) {
        const float Gm = exp2f(512.0f * l2g);
        for (int gp = 0; gp < g; ++gp) {
            const float* src = GST + ((((size_t)(bh * 16 + gp) * 8 + w) * 2) * 16) * 64 + lane;
#pragma unroll
            for (int r = 0; r < 16; ++r) { S0[r] = S0[r] * Gm + src[r * 64]; S1[r] = S1[r] * Gm + src[(16 + r) * 64]; }
        }
    }
    issue(0);
    for (int j = 0; j < 8; ++j) {
#pragma unroll
        for (int i = 0; i < 2; ++i) { const int p = tid + 512 * i, row = p >> 4, ch = p & 15; const int o = row * RS + ch * 16;
            if (APPLY) { *(LAS u32x4*)(lds + IMG_Q + o) = rq[i]; *(LAS u32x4*)(lds + IMG_K + o) = rk[i]; }
            *(LAS u32x4*)(lds + IMG_V + o) = rv[i];
            const float kw = exp2f((float)(63 - row) * l2g);
            u32x4 kt;
#pragma unroll
            for (int e = 0; e < 4; ++e) kt[e] = cvtpk(bflo(rk[i][e]) * kw, bfhi(rk[i][e]) * kw);
            *(LAS u32x4*)(lds + IMG_KT + o) = kt; }
        if (APPLY) {
#pragma unroll
            for (int tile = 0; tile < 2; ++tile) { const f32x16& S = tile ? S1 : S0; const int e = (eb0 + tile) * 32 + (lane & 31);
#pragma unroll
                for (int g4 = 0; g4 < 4; ++g4) { const int d = db * 32 + 8 * g4 + 4 * hi; u32x2 v; v.x = cvtpk(S[4 * g4], S[4 * g4 + 1]); v.y = cvtpk(S[4 * g4 + 2], S[4 * g4 + 3]);
                    *(LAS u32x2*)(lds + IMG_ST + e * RS + d * 2) = v; } }
        }
        if (j + 1 < 8) issue(j + 1);
        LDS_WAIT(); __builtin_amdgcn_s_barrier();
        f32x16 oin = f32x16{}, oit = f32x16{};
        const int qb = w >> 2, eb = w & 3;
        if (APPLY) {
#pragma unroll
            for (int s = 0; s < 8; ++s) oin = __builtin_amdgcn_mfma_f32_32x32x16_bf16(frag_row(lds + IMG_Q, RS, qb * 32, s * 16, lane), frag_row(lds + IMG_ST, RS, eb * 32, s * 16, lane), oin, 0, 0, 0);
            if (w < 4) {
                const int tb = w >> 1, qb2 = w & 1; f32x16 sc = f32x16{};
#pragma unroll
                for (int s = 0; s < 8; ++s) sc = __builtin_amdgcn_mfma_f32_32x32x16_bf16(frag_row(lds + IMG_K, RS, tb * 32, s * 16, lane), frag_row(lds + IMG_Q, RS, qb2 * 32, s * 16, lane), sc, 0, 0, 0);
                const int q = qb2 * 32 + (lane & 31);
#pragma unroll
                for (int g4 = 0; g4 < 4; ++g4) { const int t0 = tb * 32 + 8 * g4 + 4 * hi; float pv4[4];
#pragma unroll
                    for (int e = 0; e < 4; ++e) { const int dd = q - (t0 + e); pv4[e] = sc[4 * g4 + e] * exp2f((float)(dd < 0 ? -dd : dd) * l2g); }
                    u32x2 v; v.x = cvtpk(pv4[0], pv4[1]); v.y = cvtpk(pv4[2], pv4[3]);
                    *(LAS u32x2*)(lds + IMG_P + q * PS + t0 * 2) = v; }
            }
            LDS_WAIT(); __builtin_amdgcn_s_barrier();
#pragma unroll
            for (int s = 0; s < 4; ++s) oit = __builtin_amdgcn_mfma_f32_32x32x16_bf16(frag_row(lds + IMG_P, PS, qb * 32, s * 16, lane), frag_tr(lds + IMG_V, RS, s * 16, eb * 32, lane), oit, 0, 0, 0);
#pragma unroll
            for (int r = 0; r < 16; ++r) { const int q = qb * 32 + crow(r, hi); const float qw = exp2f((float)(q + 1) * l2g);
                *(LAS float*)(lds + IMG_O + (q * OS + eb * 32 + (lane & 31)) * 4) = oit[r] + qw * oin[r]; }
        }
#pragma unroll
        for (int r = 0; r < 16; ++r) { S0[r] *= cd; S1[r] *= cd; }
#pragma unroll
        for (int s = 0; s < 4; ++s) { const bf16x8 a = frag_tr(lds + IMG_KT, RS, s * 16, db * 32, lane);
            S0 = __builtin_amdgcn_mfma_f32_32x32x16_bf16(a, frag_tr(lds + IMG_V, RS, s * 16, eb0 * 32, lane), S0, 0, 0, 0);
            S1 = __builtin_amdgcn_mfma_f32_32x32x16_bf16(a, frag_tr(lds + IMG_V, RS, s * 16, (eb0 + 1) * 32, lane), S1, 0, 0, 0); }
        LDS_WAIT(); __builtin_amdgcn_s_barrier();
        if (APPLY) {
            { const int q = tid >> 3, sg = tid & 7; const LAS f32x4* op = (const LAS f32x4*)(lds + IMG_O + (q * OS + sg * 16) * 4);
              f32x4 x0 = op[0], x1 = op[1], x2 = op[2], x3 = op[3];
              float s1 = ((x0.x + x0.y) + (x0.z + x0.w)) + ((x1.x + x1.y) + (x1.z + x1.w)) + ((x2.x + x2.y) + (x2.z + x2.w)) + ((x3.x + x3.y) + (x3.z + x3.w));
              s1 += __shfl_xor(s1, 1); s1 += __shfl_xor(s1, 2); s1 += __shfl_xor(s1, 4);
              const float mu = s1 * (1.0f / 128.0f); x0 = x0 - mu; x1 = x1 - mu; x2 = x2 - mu; x3 = x3 - mu;
              float s2 = ((x0.x * x0.x + x0.y * x0.y) + (x0.z * x0.z + x0.w * x0.w)) + ((x1.x * x1.x + x1.y * x1.y) + (x1.z * x1.z + x1.w * x1.w)) + ((x2.x * x2.x + x2.y * x2.y) + (x2.z * x2.z + x2.w * x2.w)) + ((x3.x * x3.x + x3.y * x3.y) + (x3.z * x3.z + x3.w * x3.w));
              s2 += __shfl_xor(s2, 1); s2 += __shfl_xor(s2, 2); s2 += __shfl_xor(s2, 4);
              const float rstd = rsqrtf(s2 * (1.0f / 128.0f) + GN_EPS);
              const size_t trow = row0 + j * 64 + q; const u32x4 g0 = *(const u32x4*)(SG + trow * 512 + h * 128 + sg * 16), g1 = *(const u32x4*)(SG + trow * 512 + h * 128 + sg * 16 + 8);
              u32x4 o0, o1;
              o0.x = cvtpk(x0.x * rstd * bflo(g0.x), x0.y * rstd * bfhi(g0.x)); o0.y = cvtpk(x0.z * rstd * bflo(g0.y), x0.w * rstd * bfhi(g0.y));
              o0.z = cvtpk(x1.x * rstd * bflo(g0.z), x1.y * rstd * bfhi(g0.z)); o0.w = cvtpk(x1.z * rstd * bflo(g0.w), x1.w * rstd * bfhi(g0.w));
              o1.x = cvtpk(x2.x * rstd * bflo(g1.x), x2.y * rstd * bfhi(g1.x)); o1.y = cvtpk(x2.z * rstd * bflo(g1.y), x2.w * rstd * bfhi(g1.y));
              o1.z = cvtpk(x3.x * rstd * bflo(g1.z), x3.y * rstd * bfhi(g1.z)); o1.w = cvtpk(x3.z * rstd * bflo(g1.w), x3.w * rstd * bfhi(g1.w));
              *(u32x4*)(MIX + trow * 1024 + h * 128 + sg * 16) = o0; *(u32x4*)(MIX + trow * 1024 + h * 128 + sg * 16 + 8) = o1; }
        }
    }
    if (!APPLY) {
        float* dst = GST + ((((size_t)(bh * 16 + g) * 8 + w) * 2) * 16) * 64 + lane;
#pragma unroll
        for (int r = 0; r < 16; ++r) { dst[r * 64] = S0[r]; dst[(16 + r) * 64] = S1[r]; }
    }
    LDS_WAIT(); __builtin_amdgcn_s_barrier();
}
}


#define XB_TMO      128
#define XB_XCNT(j)  (256  + 64 * (j))
#define XB_XSUB(j)  (1280 + 64 * (j))
#define XB_XGEN(j)  (2304 + 64 * (j))
#define XB_TOP      3328
#define XB_TOPGEN   3392
#define XCD_BAR_WORDS 3456
#define XB_SPIN_CAP (1u << 18)
__device__ __forceinline__ unsigned xb_ld(unsigned* p)              { return __hip_atomic_load(p, __ATOMIC_RELAXED, __HIP_MEMORY_SCOPE_AGENT); }
__device__ __forceinline__ unsigned xb_add(unsigned* p, unsigned v) { return __hip_atomic_fetch_add(p, v, __ATOMIC_RELAXED, __HIP_MEMORY_SCOPE_AGENT); }
__device__ __forceinline__ unsigned xb_xcc_id() { return (unsigned)__builtin_amdgcn_s_getreg((3 << 11) | 20) & 0xFu; }
#define XB_SPIN(cond, bar) do { unsigned _sp = 0; while (cond) { __builtin_amdgcn_s_sleep(1); \
    if ((++_sp & 255u) == 0u) { if (xb_ld(&(bar)[XB_TMO])) break; if (_sp > XB_SPIN_CAP) { atomicAdd(&(bar)[XB_TMO], 1u); break; } } } } while (0)
struct XcdBarrier { unsigned* bar; unsigned x; volatile LAS unsigned* st; };
__device__ __forceinline__ XcdBarrier xcd_barrier_post(unsigned* bar, volatile LAS unsigned* st) {
    XcdBarrier b; b.bar = bar; b.x = xb_xcc_id(); b.st = st;
    if (threadIdx.x == 0) (void)xb_add(&bar[XB_XCNT(b.x)], 1u);
    return b;
}
__device__ __forceinline__ void xcd_barrier_complete(unsigned* bar, unsigned x, unsigned& nloc, unsigned& nx) {
    const unsigned G = gridDim.x * gridDim.y * gridDim.z;
    unsigned sum, cnt, mine, sp = 0u;
    for (;;) {
        sum = 0u; cnt = 0u; mine = 0u;
#pragma unroll
        for (unsigned j = 0; j < 16; ++j) { const unsigned c = xb_ld(&bar[XB_XCNT(j)]); sum += c; cnt += (c > 0u) ? 1u : 0u; mine = (j == x) ? c : mine; }
        if (sum == G) break;
        __builtin_amdgcn_s_sleep(1);
        if ((++sp & 255u) == 0u) { if (xb_ld(&bar[XB_TMO])) break; if (sp > XB_SPIN_CAP) { atomicAdd(&bar[XB_TMO], 1u); break; } }
    }
    nloc = mine > 0u ? mine : 1u; nx = cnt > 0u ? cnt : 1u;
}
__device__ __forceinline__ void xcd_barrier(const XcdBarrier& b) {
    asm volatile("s_waitcnt vmcnt(0)" ::: "memory");
    __syncthreads();
    if (threadIdx.x == 0) {
        unsigned* bar = b.bar;
        __builtin_amdgcn_s_waitcnt(0);
        unsigned nloc = b.st[0], nx = b.st[1];
        if (nloc == 0u) { xcd_barrier_complete(bar, b.x, nloc, nx); b.st[0] = nloc; b.st[1] = nx; }
        const unsigned old = xb_add(&bar[XB_XSUB(b.x)], 1u);
        const unsigned gen = old / nloc;
        if (old + 1u == (gen + 1u) * nloc) {
            __builtin_amdgcn_fence(__ATOMIC_RELEASE, "agent");
            asm volatile("s_waitcnt vmcnt(0)" ::: "memory");
            const unsigned og = xb_add(&bar[XB_TOP], 1u);
            const unsigned tg = og / nx;
            if (og + 1u == (tg + 1u) * nx) xb_add(&bar[XB_TOPGEN], 1u);
            else XB_SPIN(xb_ld(&bar[XB_TOPGEN]) == tg, bar);
            __builtin_amdgcn_fence(__ATOMIC_ACQUIRE, "agent");
            xb_add(&bar[XB_XGEN(b.x)], 1u);
            asm volatile("s_waitcnt vmcnt(0)" ::: "memory");
        } else {
            XB_SPIN(xb_ld(&bar[XB_XGEN(b.x)]) == gen, bar);
            __builtin_amdgcn_fence(__ATOMIC_ACQUIRE, "agent");
            asm volatile("s_waitcnt vmcnt(0)" ::: "memory");
        }
    }
    __syncthreads();
}

struct Frame {
    LAS unsigned char* lds; int tid, lane, wave, vcu, G;
};

__device__ __forceinline__ void tr_item(const float* __restrict__ W, int ldw, int k0, int n0, const float* __restrict__ gk, bf16_t* WT, int kind, LAS unsigned* scr, int lane) {
    const int nch = lane & 15, kq = lane >> 4;
    f32x4 a[8], b[8];
#pragma unroll
    for (int i = 0; i < 8; ++i) { const int kp = 4 * i + kq; const float* p = W + (size_t)(k0 + 2 * kp) * ldw + n0 + 4 * nch; a[i] = *(const f32x4*)p; b[i] = *(const f32x4*)(p + ldw); }
#pragma unroll
    for (int i = 0; i < 8; ++i) { const int kp = 4 * i + kq; float ga = 1.f, gb = 1.f; if (gk) { ga = gk[k0 + 2 * kp]; gb = gk[k0 + 2 * kp + 1]; }
#pragma unroll
        for (int e = 0; e < 4; ++e) scr[(4 * nch + e) * 36 + kp] = cvtpk(a[i][e] * ga, b[i][e] * gb); }
    LDS_WAIT(); asm volatile("" ::: "memory");
    const int c = lane & 7, nr = lane >> 3;
#pragma unroll
    for (int j = 0; j < 8; ++j) { const int n = nr + 8 * j; const u32x4 v = *(const LAS u32x4*)(scr + n * 36 + 4 * c);
        const int cn = n0 + n; const int row = (kind == 0) ? pos_inproj(cn) : (kind == 1) ? pos_plain(cn) : pos_w1(cn);
        *(u32x4*)(WT + (size_t)row * 1024 + k0 + 8 * c) = v; }
    LDS_WAIT(); asm volatile("" ::: "memory");
}

__device__ __forceinline__ void tr_item8(const float* __restrict__ W, int ldw, int k0, int n0, const float* __restrict__ gk, unsigned char* WT, int kind, LAS unsigned* scr, int lane) {
    const int nch = lane & 15, kq4 = lane >> 4;
    f32x4 a[4][4];
#pragma unroll
    for (int i = 0; i < 4; ++i) { const int kq = 4 * i + kq4; const float* p = W + (size_t)(k0 + 4 * kq) * ldw + n0 + 4 * nch;
#pragma unroll
        for (int r = 0; r < 4; ++r) a[i][r] = *(const f32x4*)(p + (size_t)r * ldw); }
#pragma unroll
    for (int i = 0; i < 4; ++i) { const int kq = 4 * i + kq4; float g[4];
#pragma unroll
        for (int r = 0; r < 4; ++r) g[r] = (gk ? gk[k0 + 4 * kq + r] : 1.0f) * W_SCALE;
#pragma unroll
        for (int e = 0; e < 4; ++e) scr[(4 * nch + e) * 20 + kq] = pk4_fp8(a[i][0][e] * g[0], a[i][1][e] * g[1], a[i][2][e] * g[2], a[i][3][e] * g[3]); }
    LDS_WAIT(); asm volatile("" ::: "memory");
    const int c = lane & 3, nr = lane >> 2;
#pragma unroll
    for (int j = 0; j < 4; ++j) { const int n = nr + 16 * j; const u32x4 v = *(const LAS u32x4*)(scr + n * 20 + 4 * c);
        const int cn = n0 + n; const int row = (kind == 1) ? pos_plain(cn) : pos_w1(cn);
        *(u32x4*)(WT + (size_t)row * 1024 + k0 + 16 * c) = v; }
    LDS_WAIT(); asm volatile("" ::: "memory");
}

__global__ void __launch_bounds__(NTHREADS, 2) mk_fwd(Params P) {
    __builtin_assume(__builtin_amdgcn_workitem_id_y() == 0); __builtin_assume(__builtin_amdgcn_workitem_id_z() == 0);
    extern __shared__ __attribute__((aligned(16))) unsigned char lds_raw[];
    cg::grid_group grid = cg::this_grid();
    Frame F; F.lds = (LAS unsigned char*)lds_raw; F.tid = threadIdx.x; F.lane = F.tid & 63; F.wave = __builtin_amdgcn_readfirstlane(F.tid >> 6);
    F.G = gridDim.x; { const int bx = blockIdx.x; F.vcu = (F.G % 8 == 0) ? (bx % 8) * (F.G / 8) + bx / 8 : bx; }
    unsigned char* ws = P.ws;
    unsigned* ctl = (unsigned*)(ws + WS_CTL);
    float* ropec = (float*)(ws + WS_ROPEC); float* ropes = (float*)(ws + WS_ROPES);
    float* wr3 = (float*)(ws + WS_WR3); float* logf2 = (float*)(ws + WS_LOGF); float* F2 = (float*)(ws + WS_F2);
    int* ltok = (int*)(ws + WS_LTOK); float* lrstd = (float*)(ws + WS_LRSTD); int* inv = (int*)(ws + WS_INV); float* gates = (float*)(ws + WS_GATE);
    bf16_t* H1B = (bf16_t*)(ws + WS_H1B); bf16_t* WinT = (bf16_t*)(ws + WS_WINT); bf16_t* WoT = (bf16_t*)(ws + WS_WOT);
    unsigned char* W2T = ws + WS_W2T; unsigned char* W1T = ws + WS_W1T; unsigned char* Yb = ws + WS_Y; unsigned char* H1F8 = ws + WS_H1F8;
    bf16_t* U = (bf16_t*)(ws + WS_U); unsigned char* proj = ws + WS_PROJ;
    bf16_t* RQ = (bf16_t*)(proj); bf16_t* RK = (bf16_t*)(proj + PROJ_STRIDE); bf16_t* RV = (bf16_t*)(proj + 2 * PROJ_STRIDE); bf16_t* SG = (bf16_t*)(proj + 3 * PROJ_STRIDE);
    bf16_t* FQ = (bf16_t*)(proj + 4 * PROJ_STRIDE); bf16_t* FK = (bf16_t*)(proj + 5 * PROJ_STRIDE); bf16_t* FV = (bf16_t*)(proj + 6 * PROJ_STRIDE);
    float* GST = (float*)(ws + WS_GST); bf16_t* MIX = (bf16_t*)(ws + WS_MIX); unsigned char* Hb = ws + WS_H;
    const int lo = P.ph_lo, hi_ph = P.ph_hi;
#ifndef MK_PHMASK
#define MK_PHMASK 0x1ff
#endif
#define IN(k) (((MK_PHMASK >> (k)) & 1) && lo <= (k) && (k) < hi_ph)
#define REP(k) for (int rep_ = 0; rep_ < ((MK_DUP == (k)) ? 2 : 1); ++rep_)
#ifndef MK_CG_MASK
#define MK_CG_MASK 0x01
#endif
#define SEAM(k) do { if (IN(k) && IN((k) + 1)) { if ((MK_CG_MASK >> (k)) & 1) grid.sync(); else xcd_barrier(xbar); } } while (0)
    const int gw = F.vcu * NWAVES + F.wave, NGW = F.G * NWAVES;
    volatile LAS unsigned* misc = (volatile LAS unsigned*)(F.lds + LDS_MISC);
    if (F.tid < 4) misc[F.tid] = 0u;
    __syncthreads();
    XcdBarrier xbar = xcd_barrier_post(ctl + CW_BAR, misc);

    if (IN(0)) REP(0) {
        LAS unsigned* scr = (LAS unsigned*)(F.lds + F.wave * 9216);
        LAS float* wfl = (LAS float*)(F.lds + 73728);
        for (int i = F.tid; i < 8192; i += NTHREADS) { const int hh = i & 7, k = i >> 3; wfl[hh * 1024 + k] = P.w_in[(size_t)k * INW + NPROJ + hh]; }
        constexpr int I_IN = 16 * 56, I_O = 16 * 16, I_1 = 32 * 16 * 32, I_2 = 32 * 16 * 16, NIT = I_IN + I_O + I_1 + I_2;
        for (int it = gw; it < NIT; it += NGW) {
            int r = it;
            if (r < I_IN) { tr_item(P.w_in, INW, 64 * (r / 56), 64 * (r % 56), nullptr, WinT, 0, scr, F.lane); continue; } r -= I_IN;
            if (r < I_O) { tr_item(P.w_out, 1024, 64 * (r / 16), 64 * (r % 16), nullptr, WoT, 1, scr, F.lane); continue; } r -= I_O;
            if (r < I_1) { const int e = r >> 9, rr = r & 511; tr_item8(P.w1 + (size_t)e * 1024 * 2048, 2048, 64 * (rr / 32), 64 * (rr % 32), P.g_ffn, W1T + (size_t)e * 2048 * 1024, 2, scr, F.lane); continue; } r -= I_1;
            { const int e = r >> 8, rr = r & 255; tr_item8(P.w2 + (size_t)e * 1024 * 1024, 1024, 64 * (rr / 16), 64 * (rr % 16), nullptr, W2T + (size_t)e * 1024 * 1024, 1, scr, F.lane); }
        }
        __syncthreads();
        for (int m = gw; m < T; m += NGW) {
            const f32x4* xr = (const f32x4*)(P.x + (size_t)m * DM) + F.lane; const f32x4* gr = (const f32x4*)P.g_mix + F.lane;
            f32x4 v[4]; float ss = 0.f;
#pragma unroll
            for (int j = 0; j < 4; ++j) { v[j] = xr[64 * j]; ss += (v[j].x * v[j].x + v[j].y * v[j].y) + (v[j].z * v[j].z + v[j].w * v[j].w); }
            const float rstd = rsqrtf(wave_sum(ss) * (1.0f / DM) + RMS_EPS);
            float z[8];
#pragma unroll
            for (int hh = 0; hh < 8; ++hh) z[hh] = 0.f;
            unsigned long long* o8 = (unsigned long long*)(U + (size_t)m * DM) + F.lane;
#pragma unroll
            for (int j = 0; j < 4; ++j) { v[j] = v[j] * rstd * gr[64 * j];
                o8[64 * j] = (unsigned long long)cvtpk(v[j].x, v[j].y) | ((unsigned long long)cvtpk(v[j].z, v[j].w) << 32);
#pragma unroll
                for (int hh = 0; hh < 8; ++hh) { const f32x4 w4 = *(const LAS f32x4*)(wfl + hh * 1024 + 4 * F.lane + 256 * j); z[hh] += (v[j].x * w4.x + v[j].y * w4.y) + (v[j].z * w4.z + v[j].w * w4.w); } }
#pragma unroll
            for (int hh = 0; hh < 8; ++hh) z[hh] = wave_sum(z[hh]);
            float zz = z[0];
#pragma unroll
            for (int hh = 1; hh < 8; ++hh) zz = (F.lane == hh) ? z[hh] : zz;
            if (F.lane < 8) { const float xx = zz + P.b_forget[F.lane]; const float lf = fminf(xx, 0.f) - log1pf(__expf(-fabsf(xx))); logf2[(size_t)m * 8 + F.lane] = lf * LOG2E; }
        }
        for (int idx = blockIdx.x * NTHREADS + F.tid; idx < SEQ * 64; idx += F.G * NTHREADS) {
            const int pos = idx >> 6, i = idx & 63; const float invf = exp2f(-(float)i * (13.287712379549449f / 64.0f));
            const float ang = (float)pos * invf; double tt = (double)ang * 0.15915494309189535; tt -= __builtin_rint(tt); const float tf = (float)tt;
            ropec[idx] = __builtin_amdgcn_cosf(tf); ropes[idx] = __builtin_amdgcn_sinf(tf);
        }
        for (int idx = blockIdx.x * NTHREADS + F.tid; idx < 32768; idx += F.G * NTHREADS) {
            const int s = idx & 3, e16 = (idx >> 2) & 15, half = (idx >> 6) & 1, kq = (idx >> 7) & 3, c = idx >> 9; const int k = 16 * c + 4 * kq + s, e = 16 * half + e16;
            wr3[idx] = P.w_router[k * 32 + e] * P.g_ffn[k];
        }
    }
    SEAM(0);

    if (IN(1)) {
        pg8::DenseOrder S; S.init(T, NPROJ, DM, F.G, (int)blockIdx.x, (MK_DUP == 1) ? 2 : 1);
        EpiInProj E{proj, ropec, ropes, ctl};
        pg8::gemm_phase<EpiInProj, pg8::DenseOrder, true, true, 2>(F.lds, U, WinT, DM, S, E);
    }
    SEAM(1);

    if (IN(2)) REP(2) {
        for (int u = F.vcu; u < 256; u += F.G) ret::unit<false>(u >> 4, u & 15, RQ, RK, RV, SG, GST, MIX, (LAS char*)F.lds);
        for (int bh = F.vcu; bh < 32; bh += F.G) {
            const int b = bh >> 3, h = bh & 7; LAS double* sd = (LAS double*)F.lds;
            double loc[16]; double run = 0.0;
#pragma unroll
            for (int i = 0; i < 16; ++i) { run += (double)logf2[((size_t)b * SEQ + 16 * F.tid + i) * 8 + h]; loc[i] = run; }
            double incl = run;
#pragma unroll
            for (int o = 1; o < 64; o <<= 1) { const double t = __shfl_up(incl, o); if (F.lane >= o) incl += t; }
            __syncthreads();
            if (F.lane == 63) sd[F.wave] = incl;
            __syncthreads();
            double off = incl - run;
            for (int w2 = 0; w2 < F.wave; ++w2) off += sd[w2];
            LAS float* Fsl = (LAS float*)(F.lds + 4096);
#pragma unroll
            for (int i = 0; i < 16; ++i) { const float fv = (float)(off + loc[i]); F2[(size_t)bh * SEQ + 16 * F.tid + i] = fv; Fsl[16 * F.tid + i] = fv; }
            __syncthreads();
            if (F.tid < 32) { const int qb = F.tid, q0 = 256 * qb, NT = 4 * qb + 4;
                const float qn = __uint_as_float(ctl[CW_QN2 + bh * 2]) + __uint_as_float(ctl[CW_QN2 + bh * 2 + 1]), kn = __uint_as_float(ctl[CW_KN2 + bh * 2]) + __uint_as_float(ctl[CW_KN2 + bh * 2 + 1]);
                const float target = Fsl[q0] + PRUNE_TH + 2.0f * 1.0201f * sqrtf(qn * kn);
                int lo_ = 0, hi_ = NT - 4;
                while (lo_ < hi_) { const int mid = (lo_ + hi_) >> 1; if (Fsl[64 * mid + 63] >= target) lo_ = mid + 1; else hi_ = mid; }
                const int ts = lo_ & ~1, NS = NT - ts;
                ctl[CW_UTS + bh * 32 + qb] = (unsigned)ts; ctl[CW_UPOS + bh * 32 + qb] = atomicAdd(ctl + CW_BIN + (NS >> 1), 1u); }
            __syncthreads();
        }
    }
    SEAM(2);

    if (IN(3)) REP(3) {
        REP(31) for (int u = F.vcu; u < 256; u += F.G) ret::unit<true>(u >> 4, u & 15, RQ, RK, RV, SG, GST, MIX, (LAS char*)F.lds);
        LAS int* qst = (LAS int*)(F.lds + 120832); LAS int* qlist = qst + 128; LAS int* qsh = qst + 100;
        if (F.tid == 0) { int a = 0; for (int k = 64; k >= 2; --k) { qst[k] = a; a += (int)ctl[CW_BIN + k]; } }
        __syncthreads();
        for (int u = F.tid; u < 1024; u += NTHREADS) { const int ts = (int)ctl[CW_UTS + u], NS = 4 * (u & 31) + 4 - ts; qlist[qst[NS >> 1] + (int)ctl[CW_UPOS + u]] = u | (ts << 16); }
        __syncthreads();
        for (;;) {
            if (F.tid == 0) qsh[0] = (int)atomicAdd(ctl + CW_QHEAD, 1u);
            __syncthreads();
            int idx = qsh[0];
            if (idx >= ((MK_DUP == 30) ? 2048 : 1024)) break;
            idx &= 1023;
            const int uu = qlist[idx]; const int u = uu & 0xffff, ts = uu >> 16; const int bh = u >> 5, qb = u & 31;
            attn_body::attn_unit<8>(bh >> 3, bh & 7, qb, ts, FQ, FK, FV, MIX + 512, F2, (char*)lds_raw);
        }
    }
    SEAM(3);

    if (IN(4)) {
        pg8::DenseOrder S; S.init(T, DM, DM, F.G, (int)blockIdx.x, (MK_DUP == 4) ? 2 : 1);
        EpiOutProj E{P.x, H1B, H1F8};
        pg8::gemm_phase<EpiOutProj, pg8::DenseOrder, true, true, 2>(F.lds, MIX, WoT, DM, S, E);
    }
    SEAM(4);

    if (IN(5)) {
        LAS float* wl = (LAS float*)F.lds;
        LAS float* lg = (LAS float*)(F.lds + 131072);
        LAS float* ssb = (LAS float*)(F.lds + 131072 + 128 * 33 * 4);
        LAS int* ecnt = (LAS int*)(F.lds + 131072 + 128 * 33 * 4 + 512);
        LAS int* ebase = ecnt + 32;
        for (int i = F.tid; i < 8192; i += NTHREADS) ((LAS f32x4*)wl)[i] = ((const f32x4*)wr3)[i];
        for (int tb = blockIdx.x; tb < T / 128; tb += F.G) {
            if (F.tid < 32) ecnt[F.tid] = 0;
            __syncthreads();
            const int tok16 = F.lane & 15, kq = F.lane >> 4; const int tokw = tb * 128 + F.wave * 16 + tok16;
            const bf16_t* hrow = H1B + (size_t)tokw * DM + 4 * kq;
            f32x4 a0 = {0.f, 0.f, 0.f, 0.f}, a1 = {0.f, 0.f, 0.f, 0.f}; float ss = 0.f;
#pragma unroll 8
            for (int c = 0; c < 64; ++c) {
                const u32x2 hv = *(const u32x2*)(hrow + 16 * c); const float av[4] = {bflo(hv.x), bfhi(hv.x), bflo(hv.y), bfhi(hv.y)};
                const f32x4 w0 = *(const LAS f32x4*)(wl + (((c * 4 + kq) * 2 + 0) * 16 + tok16) * 4), w1 = *(const LAS f32x4*)(wl + (((c * 4 + kq) * 2 + 1) * 16 + tok16) * 4);
#pragma unroll
                for (int s = 0; s < 4; ++s) { ss += av[s] * av[s]; a0 = __builtin_amdgcn_mfma_f32_16x16x4f32(av[s], w0[s], a0, 0, 0, 0); a1 = __builtin_amdgcn_mfma_f32_16x16x4f32(av[s], w1[s], a1, 0, 0, 0); }
            }
            ss += __shfl_xor(ss, 16); ss += __shfl_xor(ss, 32);
            if (kq == 0) ssb[F.wave * 16 + tok16] = ss;
#pragma unroll
            for (int r = 0; r < 4; ++r) { const int tk = F.wave * 16 + kq * 4 + r; lg[tk * 33 + tok16] = a0[r]; lg[tk * 33 + 16 + tok16] = a1[r]; }
            __syncthreads();
            int esel[4] = {0, 0, 0, 0}, rank[4] = {0, 0, 0, 0}; float gsel[4] = {0.f, 0.f, 0.f, 0.f}; float rstd = 0.f;
            if (F.tid < 128) {
                rstd = rsqrtf(ssb[F.tid] * (1.0f / DM) + RMS_EPS);
                float l[32];
#pragma unroll
                for (int e = 0; e < 32; ++e) l[e] = lg[F.tid * 33 + e] * rstd + P.b_router[e];
                float vs[4];
#pragma unroll
                for (int k = 0; k < 4; ++k) { float best = -INFINITY; int bi = 0;
#pragma unroll
                    for (int e = 0; e < 32; ++e) { const bool bt = l[e] > best; best = bt ? l[e] : best; bi = bt ? e : bi; }
                    vs[k] = best; esel[k] = bi;
#pragma unroll
                    for (int e = 0; e < 32; ++e) l[e] = (e == bi) ? -INFINITY : l[e]; }
                float den = 0.f;
#pragma unroll
                for (int k = 0; k < 4; ++k) { gsel[k] = __expf(vs[k] - vs[0]); den += gsel[k]; }
#pragma unroll
                for (int k = 0; k < 4; ++k) { gsel[k] /= den; rank[k] = atomicAdd((int*)&ecnt[esel[k]], 1); }
            }
            __syncthreads();
            if (F.tid < 32) ebase[F.tid] = (int)atomicAdd(ctl + CW_CNT + F.tid, (unsigned)ecnt[F.tid]);
            __syncthreads();
            if (F.tid < 128) { const int tok = tb * 128 + F.tid;
#pragma unroll
                for (int k = 0; k < 4; ++k) { const int e = esel[k], slot = ebase[e] + rank[k];
                    ltok[(size_t)e * CAP + slot] = tok; lrstd[(size_t)e * CAP + slot] = rstd; inv[tok * 4 + k] = (e << 16) | slot; gates[tok * 4 + k] = gsel[k]; } }
            __syncthreads();
        }
    }
    SEAM(5);

    if (IN(6) || IN(7)) {
        LAS int* boff = (LAS int*)(F.lds + 131072); LAS int* cntl = boff + 64;
        if (F.tid == 0) { int a = 0; for (int e = 0; e < 32; ++e) { const int c = (int)ctl[CW_CNT + e]; cntl[e] = c; boff[e] = a; a += (c + 255) >> 8; } boff[32] = a; }
        __syncthreads();
        LAS int* tokl = (LAS int*)(F.lds + 131072 + 1024);
        if (IN(6)) {
            MoeOrder<8, true> S0{boff, cntl, tokl, F.G, F.vcu};
            for (int p = 0; p < 9; ++p) { const int i = 2 * p + (F.tid >> 8), r = F.tid & 255; pg8::Unit u;
                if (S0.next(i, u)) { const int slot = u.lb * 256 + r; tokl[i * 256 + r] = (slot < cntl[u.e]) ? ltok[(size_t)u.e * CAP + slot] : 0; } }
            __syncthreads();
        }
        if (IN(6)) REP(6) {
            MoeOrder<8, true> S{boff, cntl, tokl, F.G, F.vcu};
            EpiMoe1 E{Hb, P.b1, lrstd, (const int*)(ctl + CW_CNT)};
            pg8::gemm_phase<EpiMoe1, MoeOrder<8, true>, true, true, 1>(F.lds, H1F8, W1T, DM, S, E);
        }
        SEAM(6);
        if (IN(7)) REP(7) {
            MoeOrder<4, false> S{boff, cntl, tokl, F.G, F.vcu};
            EpiMoe2 E{Yb, P.b2};
            pg8::gemm_phase<EpiMoe2, MoeOrder<4, false>, true, true, 1>(F.lds, Hb, W2T, DM, S, E);
        }
    }
    SEAM(7);

    if (IN(8)) REP(8) {
        LAS int* boff = (LAS int*)(F.lds + 131072);
        __syncthreads();
        if (F.tid == 0) { int a = 0; for (int e = 0; e < 32; ++e) { const int c = (int)ctl[CW_CNT + e]; boff[e] = a; a += (c + 255) >> 8; } boff[32] = a; }
        __syncthreads();
        for (int m = gw; m < T; m += NGW) {
            float v[16];
            { const u32x4 a = *(const u32x4*)(H1B + (size_t)m * DM + 8 * F.lane), bq = *(const u32x4*)(H1B + (size_t)m * DM + 512 + 8 * F.lane);
#pragma unroll
              for (int e = 0; e < 4; ++e) { v[2 * e] = bflo(a[e]); v[2 * e + 1] = bfhi(a[e]); v[8 + 2 * e] = bflo(bq[e]); v[8 + 2 * e + 1] = bfhi(bq[e]); } }
#pragma unroll
            for (int k = 0; k < 4; ++k) { const int iv = inv[m * 4 + k]; const float gt = gates[m * 4 + k]; const int e = iv >> 16, slot = iv & 0xffff;
                const size_t yrow = (size_t)boff[e] * 256 + slot;
                const u32x2 a = *(const u32x2*)(Yb + yrow * DM + 8 * F.lane), bq = *(const u32x2*)(Yb + yrow * DM + 512 + 8 * F.lane); const float gs = gt * (1.0f / Y_SCALE);
#pragma unroll
                for (int q = 0; q < 2; ++q) { const f32x2 a0 = __builtin_amdgcn_cvt_pk_f32_fp8((int)a[q], false), a1 = __builtin_amdgcn_cvt_pk_f32_fp8((int)a[q], true), b0 = __builtin_amdgcn_cvt_pk_f32_fp8((int)bq[q], false), b1 = __builtin_amdgcn_cvt_pk_f32_fp8((int)bq[q], true);
                    v[4 * q] += gs * a0.x; v[4 * q + 1] += gs * a0.y; v[4 * q + 2] += gs * a1.x; v[4 * q + 3] += gs * a1.y;
                    v[8 + 4 * q] += gs * b0.x; v[8 + 4 * q + 1] += gs * b0.y; v[8 + 4 * q + 2] += gs * b1.x; v[8 + 4 * q + 3] += gs * b1.y; } }
            float ss = 0.f;
#pragma unroll
            for (int i = 0; i < 16; ++i) ss += v[i] * v[i];
            const float rstd = rsqrtf(wave_sum(ss) * (1.0f / DM) + RMS_EPS);
            const f32x4* gf = (const f32x4*)P.g_final; f32x4* op = (f32x4*)(P.out + (size_t)m * DM);
            const f32x4 g0 = gf[2 * F.lane], g1 = gf[2 * F.lane + 1], g2 = gf[128 + 2 * F.lane], g3 = gf[128 + 2 * F.lane + 1];
            op[2 * F.lane] = (f32x4){v[0], v[1], v[2], v[3]} * rstd * g0; op[2 * F.lane + 1] = (f32x4){v[4], v[5], v[6], v[7]} * rstd * g1;
            op[128 + 2 * F.lane] = (f32x4){v[8], v[9], v[10], v[11]} * rstd * g2; op[128 + 2 * F.lane + 1] = (f32x4){v[12], v[13], v[14], v[15]} * rstd * g3;
        }
    }
#undef IN
#undef SEAM
}

extern "C" void kernel_launch(void* const* d_in, const int* in_sizes, int n_in, void* d_out, int out_size, void* d_ws, size_t ws_size, hipStream_t stream) {
    static int grid = 0;
    if (grid == 0) {
        if (n_in != 13 || in_sizes[0] != T * DM || out_size != T * DM || ws_size < WS_END) { fprintf(stderr, "kernel_launch: unexpected shapes (n_in %d, in0 %d, out %d, ws %zu)\n", n_in, n_in > 0 ? in_sizes[0] : -1, out_size, ws_size); grid = -1; return; }
        int dev = 0, cus = 0, per_cu = 0;
        if (hipGetDevice(&dev) != hipSuccess || hipDeviceGetAttribute(&cus, hipDeviceAttributeMultiprocessorCount, dev) != hipSuccess) { fprintf(stderr, "kernel_launch: device query failed\n"); grid = -1; return; }
        if (hipFuncSetAttribute((const void*)mk_fwd, hipFuncAttributeMaxDynamicSharedMemorySize, LDS_BYTES) != hipSuccess) { fprintf(stderr, "kernel_launch: hipFuncSetAttribute failed\n"); grid = -1; return; }
        if (hipOccupancyMaxActiveBlocksPerMultiprocessor(&per_cu, (const void*)mk_fwd, NTHREADS, LDS_BYTES) != hipSuccess || per_cu < 1) { fprintf(stderr, "kernel_launch: occupancy query says %d\n", per_cu); per_cu = 1; }
        (void)hipGetLastError();
        grid = cus * 1;
        if (grid != 256) fprintf(stderr, "kernel_launch: %d CUs (built for 256)\n", grid);
    }
    if (grid < 0) return;
    (void)hipMemsetAsync((char*)d_ws + WS_CTL, 0, CTL_BYTES, stream);
    Params p{};
    const float** pin = (const float**)&p;
    for (int i = 0; i < 13; ++i) pin[i] = (const float*)d_in[i];
    p.out = (float*)d_out; p.ws = (unsigned char*)d_ws;
#if MK_N_LAUNCHES == 1
    p.ph_lo = 0; p.ph_hi = 9;
    void* args[] = {&p};
    hipError_t e = hipLaunchCooperativeKernel((const void*)mk_fwd, dim3(grid), dim3(NTHREADS), args, LDS_BYTES, stream);
    if (e != hipSuccess) fprintf(stderr, "kernel_launch: cooperative launch failed: %s (grid %d)\n", hipGetErrorString(e), grid);
#else
    for (int k = 0; k < 9; ++k) { p.ph_lo = k; p.ph_hi = k + 1; hipLaunchKernelGGL(mk_fwd, dim3(grid), dim3(NTHREADS), LDS_BYTES, stream, p); }
#endif
}
```

```cpp
#include <hip/hip_runtime.h>
#include <hip/hip_cooperative_groups.h>
#include <cstdio>
#include <cstdint>
namespace cg = cooperative_groups;

#ifndef MK_N_LAUNCHES
#define MK_N_LAUNCHES 1
#endif
#ifndef MK_DUP
#define MK_DUP -1
#endif
#ifndef MK_DIAG
#define MK_DIAG 0
#endif

#define LAS __attribute__((address_space(3)))
#define GAS __attribute__((address_space(1)))
typedef unsigned short bf16_t;
typedef short bf16x8 __attribute__((ext_vector_type(8)));
typedef short s16x4 __attribute__((ext_vector_type(4)));
typedef float f32x2 __attribute__((ext_vector_type(2)));
typedef float f32x4 __attribute__((ext_vector_type(4)));
typedef float f32x16 __attribute__((ext_vector_type(16)));
typedef unsigned u32x2 __attribute__((ext_vector_type(2)));
typedef unsigned u32x4 __attribute__((ext_vector_type(4)));
typedef __bf16 bf16x2_t __attribute__((ext_vector_type(2)));

constexpr int BATCH = 4, SEQ = 8192, DM = 1024, T = BATCH * SEQ;
constexpr int RH = 4, RD = 128, FH = 8, FD = 64;
constexpr int NPROJ = 3584, INW = 3592;
constexpr int NE = 32, TOPK = 4, DFF = 1024;
constexpr int CAP = T;
constexpr int NBMAX = (T * TOPK) / 256 + NE;
constexpr float RMS_EPS = 1e-5f, GN_EPS = 1e-5f;
constexpr float LOG2E = 1.4426950408889634f;
constexpr float PRUNE_TH = 40.0f;
constexpr float C2 = 0.125f * 1.4426950408889634f;
constexpr int NTHREADS = 512, NWAVES = 8;

constexpr size_t MiB = 1u << 20;
constexpr size_t WS_CTL = 0, CTL_BYTES = 1 * MiB;
constexpr size_t WS_ROPEC = 1 * MiB, WS_ROPES = 3 * MiB;
constexpr size_t WS_WR3 = 5 * MiB;
constexpr size_t WS_LOGF = 6 * MiB;
constexpr size_t WS_F2 = 7 * MiB;
constexpr size_t WS_LTOK = 8 * MiB;
constexpr size_t WS_LRSTD = 12 * MiB;
constexpr size_t WS_INV = 16 * MiB;
constexpr size_t WS_GATE = 17 * MiB;
constexpr size_t WS_H1B = 32 * MiB;
constexpr size_t WS_WINT = 96 * MiB;
constexpr size_t WS_WOT = 104 * MiB;
constexpr size_t WS_W2T = 112 * MiB;
constexpr size_t WS_W1T = 144 * MiB;
constexpr size_t WS_H1F8 = 208 * MiB;
constexpr size_t WS_U = 448 * MiB;
constexpr size_t WS_PROJ = 512 * MiB;
constexpr size_t PROJ_STRIDE = 32 * MiB;
constexpr size_t WS_GST = 736 * MiB;
constexpr size_t WS_MIX = 752 * MiB;
constexpr size_t WS_H = 448 * MiB;
constexpr size_t WS_Y = 584 * MiB;
constexpr size_t WS_END = 856 * MiB;
constexpr float W_SCALE = 128.0f, H_SCALE = 4.0f, Y_SCALE = 16.0f;
constexpr int CW_CNT = 0;
constexpr int CW_DIAG = 64;
constexpr int CW_QN2 = 128, CW_KN2 = 192;
constexpr int CW_BIN = 256;
constexpr int CW_QHEAD = 384;
constexpr int CW_UTS = 1024, CW_UPOS = 2048;
constexpr int CW_BAR = 4096;


constexpr int LDS_BYTES = 163840;
constexpr int LDS_MISC = LDS_BYTES - 16;

__device__ __forceinline__ unsigned cvtpk(float lo, float hi) { f32x2 v = {lo, hi}; bf16x2_t b = __builtin_convertvector(v, bf16x2_t); return __builtin_bit_cast(unsigned, b); }
__device__ __forceinline__ float bf2f(unsigned short h) { return __uint_as_float(((unsigned)h) << 16); }
__device__ __forceinline__ float bflo(unsigned w) { return __uint_as_float(w << 16); }
__device__ __forceinline__ float bfhi(unsigned w) { return __uint_as_float(w & 0xffff0000u); }
__device__ __forceinline__ float wave_sum(float v) {
#pragma unroll
    for (int o = 1; o < 64; o <<= 1) v += __shfl_xor(v, o);
    return v;
}
#define LDS_WAIT() asm volatile("s_waitcnt lgkmcnt(0)" ::: "memory")
#define VM_WAIT() asm volatile("s_waitcnt vmcnt(0)" ::: "memory")

struct Params {
    const float *x, *g_mix, *w_in, *b_forget, *w_out, *g_ffn, *w_router, *b_router, *w1, *b1, *w2, *b2, *g_final;
    float* out; unsigned char* ws; int ph_lo, ph_hi;
};

namespace pg8 {
constexpr int BM = 256, BK = 64, HALF = 128, HTB = HALF * BK * 2, STAGE_BYTES = 8 * HTB, NXCD = 8, WGM = 8;
__host__ __device__ __forceinline__ int lds_byte(int r, int c) { const int st = (r >> 4) * 2 + (c >> 5), rr = r & 15, cc = c & 31, ob = rr * 64 + cc * 2; return st * 1024 + (ob ^ (((ob >> 9) & 1) << 5)); }
__host__ __device__ __forceinline__ void stage_rc(int b, int& R, int& C) { const int st = b / 1024, sb = b % 1024, swz = sb ^ (((sb >> 9) & 1) << 5); R = (st >> 1) * 16 + swz / 64; C = (st & 1) * 32 + (swz % 64) / 2; }

struct Unit { int pm, pn, e, lb, idx; };

struct DenseOrder {
    int nM, nN, nwg, G, c; int K; int dup;
    __device__ void init(int M, int N, int K_, int G_, int c_, int dup_ = 1) { nM = M / BM; nN = N / BM; nwg = nM * nN; G = G_; c = c_; K = K_; dup = dup_; }
    __device__ __forceinline__ bool next(int i, Unit& u) const {
        const long L = (long)i * G + c; if (L >= (long)nwg * dup) return false;
        int wgid = (int)(L % nwg); { const int q = nwg / NXCD, r = nwg % NXCD, xcd = wgid % NXCD, off = wgid / NXCD; wgid = (xcd < r ? xcd * (q + 1) : r * (q + 1) + (xcd - r) * q) + off; }
        const int nig = WGM * nN, gid = wgid / nig, fm = gid * WGM, gsz = (nM - fm) < WGM ? (nM - fm) : WGM;
        u.pm = fm + ((wgid % nig) % gsz); u.pn = (wgid % nig) / gsz; u.e = 0; u.lb = 0; u.idx = i; return true;
    }
    __device__ __forceinline__ void aoffs(const Unit& u, unsigned (&ao)[2][2], const int (&R)[2], const int (&C)[2], int rowbytes) const {
#pragma unroll
        for (int h = 0; h < 2; ++h)
#pragma unroll
            for (int i = 0; i < 2; ++i) ao[h][i] = (unsigned)((u.pm * BM + h * HALF + R[i]) * rowbytes + C[i] * 2);
    }
};

typedef int v8i32 __attribute__((ext_vector_type(8)));
typedef int v4i32 __attribute__((ext_vector_type(4)));
template <class Epi, class Sched, bool ALIGN_EPI, bool SP2, int ES>
__device__ __forceinline__ void gemm_phase(LAS unsigned char* lds, const void* Abase, const void* Btbase, const int K, const Sched& S, const Epi& E) {
    const int tid = threadIdx.x, wid = __builtin_amdgcn_readfirstlane(tid >> 6), lane = tid & 63, wr = wid >> 2, wc = wid & 3, fr = lane & 15, fq = lane >> 4;
    const int rowbytes = K * ES;
    const int nt = rowbytes / 128;
    int RR[2], CC[2]; unsigned voffB[2];
#pragma unroll
    for (int i = 0; i < 2; ++i) { stage_rc(tid * 16 + i * 8192, RR[i], CC[i]); voffB[i] = (unsigned)(RR[i] * rowbytes + CC[i] * 2); }
    const size_t kstep = (size_t)128;
    const size_t hstep = (size_t)HALF * rowbytes;
    const size_t tstep = 2 * hstep;
    const unsigned ldsw = (unsigned)wid * 1024u;
    const int aoff = lds_byte(wr * 64 + fr, fq * 8), boff = lds_byte(wc * 32 + fr, fq * 8);
    const char* Ab = (const char*)Abase;
#define PG8_SA(b, h) (((b) * 2 + (h)) * HTB)
#define PG8_SB(b, h) ((4 + (b) * 2 + (h)) * HTB)
#define PG8_STAGE(bufoff, gbase, voff) do { _Pragma("unroll") for (int _i = 0; _i < 2; ++_i) \
        __builtin_amdgcn_global_load_lds((const unsigned*)((const char*)(gbase) + (voff)[_i]), (LAS unsigned*)(lds + (bufoff) + ldsw + _i * 8192), 16, 0, 0); } while (0)
#define PG8_STAGE_A(bufoff, kb, AO, h) do { _Pragma("unroll") for (int _i = 0; _i < 2; ++_i) \
        __builtin_amdgcn_global_load_lds((const unsigned*)(Ab + (kb) + (AO)[h][_i]), (LAS unsigned*)(lds + (bufoff) + ldsw + _i * 8192), 16, 0, 0); } while (0)
#define PG8_LDA(dst, b, h) do { _Pragma("unroll") for (int m = 0; m < 4; ++m) _Pragma("unroll") for (int k = 0; k < 2; ++k) dst[m][k] = *(const LAS bf16x8*)(lds + PG8_SA(b, h) + aoff + m * 2048 + k * 1024); } while (0)
#define PG8_LDB(dst, b, h) do { _Pragma("unroll") for (int n = 0; n < 2; ++n) _Pragma("unroll") for (int k = 0; k < 2; ++k) dst[n][k] = *(const LAS bf16x8*)(lds + PG8_SB(b, h) + boff + n * 2048 + k * 1024); } while (0)
#define PG8_F8(x) __builtin_shufflevector(__builtin_bit_cast(v4i32, (x)[0]), __builtin_bit_cast(v4i32, (x)[1]), 0, 1, 2, 3, 4, 5, 6, 7)
#define PG8_MMA(ai, bj, At, Bt) do { __builtin_amdgcn_s_setprio(1); _Pragma("unroll") for (int m = 0; m < 4; ++m) _Pragma("unroll") for (int n = 0; n < 2; ++n) { \
        if constexpr (ES == 2) { _Pragma("unroll") for (int k = 0; k < 2; ++k) acc[ai][bj][m][n] = __builtin_amdgcn_mfma_f32_16x16x32_bf16(Bt[n][k], At[m][k], acc[ai][bj][m][n], 0, 0, 0); } \
        else asm volatile("v_mfma_f32_16x16x128_f8f6f4 %0, %1, %2, %0" : "+v"(acc[ai][bj][m][n]) : "v"(PG8_F8(Bt[n])), "v"(PG8_F8(At[m]))); } \
        __builtin_amdgcn_s_setprio(0); } while (0)
#define PG8_WAIT_V(n) asm volatile("s_waitcnt vmcnt(" #n ")" ::: "memory")
#define PG8_WAIT_L(n) asm volatile("s_waitcnt lgkmcnt(" #n ")" ::: "memory")
#define PG8_BAR __builtin_amdgcn_s_barrier()
#define PG8_SCHED __builtin_amdgcn_sched_barrier(0)
    Unit cur, nxt; int ui = 0;
    if (!S.next(0, cur)) return;
    f32x4 acc[2][2][4][2];
#pragma unroll
    for (int a = 0; a < 2; ++a)
#pragma unroll
        for (int b = 0; b < 2; ++b)
#pragma unroll
            for (int m = 0; m < 4; ++m)
#pragma unroll
                for (int n = 0; n < 2; ++n) acc[a][b][m][n] = (f32x4){0.f, 0.f, 0.f, 0.f};
    bf16x8 At[4][2], B0[2][2], B1[2][2];
    unsigned aoC[2][2], aoN[2][2];
    S.aoffs(cur, aoC, RR, CC, rowbytes);
    const char* cB = (const char*)Btbase + (size_t)cur.pn * tstep;
    static_assert(SP2, "only the SP2 loop is kept");
    PG8_STAGE(PG8_SB(0, 0), cB, voffB); PG8_STAGE(PG8_SB(0, 1), cB + hstep, voffB); PG8_STAGE_A(PG8_SA(0, 0), 0, aoC, 0); PG8_STAGE_A(PG8_SA(0, 1), 0, aoC, 1);
    if (wr == 1) PG8_BAR;
    PG8_WAIT_V(2); PG8_BAR;
    PG8_STAGE(PG8_SB(1, 0), cB + kstep, voffB); PG8_STAGE_A(PG8_SA(1, 0), kstep, aoC, 0); PG8_STAGE(PG8_SB(1, 1), cB + hstep + kstep, voffB);
    PG8_WAIT_V(6); PG8_BAR;
    for (;;) {
        const bool has_next = S.next(ui + 1, nxt);
        if (has_next) S.aoffs(nxt, aoN, RR, CC, rowbytes);
        else {
#pragma unroll
            for (int h = 0; h < 2; ++h)
#pragma unroll
                for (int i = 0; i < 2; ++i) aoN[h][i] = aoC[h][i];
        }
        const char* nB = has_next ? (const char*)Btbase + (size_t)nxt.pn * tstep : cB;
#pragma unroll 1
        for (int t = 0; t < nt; t += 2) {
            const bool last = (t == nt - 2);
            const size_t kb1 = (size_t)(t + 1) * kstep;
            const size_t kb2 = last ? 0 : (size_t)(t + 2) * kstep, kb3 = kb2 + kstep;
            unsigned ao2[2][2];
#pragma unroll
            for (int h = 0; h < 2; ++h)
#pragma unroll
                for (int i = 0; i < 2; ++i) ao2[h][i] = last ? aoN[h][i] : aoC[h][i];
            const char* b2 = last ? nB : cB + (size_t)(t + 2) * kstep;
            const char* b3 = b2 + kstep;
            PG8_LDB(B0, 0, 0); PG8_LDB(B1, 0, 1); PG8_SCHED; PG8_LDA(At, 0, 0); PG8_STAGE_A(PG8_SA(1, 1), kb1, aoC, 1);
            PG8_WAIT_V(8); PG8_WAIT_L(0); PG8_BAR; PG8_MMA(0, 0, At, B0); PG8_MMA(0, 1, At, B1); PG8_BAR; PG8_SCHED;
            PG8_LDA(At, 0, 1); PG8_STAGE(PG8_SB(0, 0), b2, voffB); PG8_STAGE(PG8_SB(0, 1), b2 + hstep, voffB); PG8_STAGE_A(PG8_SA(0, 0), kb2, ao2, 0);
            PG8_WAIT_V(8); PG8_WAIT_L(0); PG8_BAR; PG8_MMA(1, 0, At, B0); PG8_MMA(1, 1, At, B1); PG8_BAR; PG8_SCHED;
            PG8_LDB(B0, 1, 0); PG8_LDB(B1, 1, 1); PG8_SCHED; PG8_LDA(At, 1, 0); PG8_STAGE_A(PG8_SA(0, 1), kb2, ao2, 1);
            PG8_WAIT_V(8); PG8_WAIT_L(0); PG8_BAR; PG8_MMA(0, 0, At, B0); PG8_MMA(0, 1, At, B1); PG8_BAR; PG8_SCHED;
            PG8_LDA(At, 1, 1); PG8_STAGE(PG8_SB(1, 0), b3, voffB); PG8_STAGE(PG8_SB(1, 1), b3 + hstep, voffB); PG8_STAGE_A(PG8_SA(1, 0), kb3, ao2, 0);
            PG8_WAIT_V(8); PG8_WAIT_L(0); PG8_BAR; PG8_MMA(1, 0, At, B0); PG8_MMA(1, 1, At, B1); PG8_BAR; PG8_SCHED;
        }
        if constexpr (ALIGN_EPI) { if (wr == 0) PG8_BAR; }
        if constexpr (ES == 1) asm volatile("s_nop 15\n\ts_nop 15" ::: "memory");
        E(acc, cur, wr, wc, fr, fq);
        if (!has_next) break;
#pragma unroll
        for (int a = 0; a < 2; ++a)
#pragma unroll
            for (int b = 0; b < 2; ++b)
#pragma unroll
                for (int m = 0; m < 4; ++m)
#pragma unroll
                    for (int n = 0; n < 2; ++n) acc[a][b][m][n] = (f32x4){0.f, 0.f, 0.f, 0.f};
        cur = nxt; cB = nB; ++ui;
#pragma unroll
        for (int h = 0; h < 2; ++h)
#pragma unroll
            for (int i = 0; i < 2; ++i) aoC[h][i] = aoN[h][i];
        if constexpr (ALIGN_EPI) { if (wr == 1) PG8_BAR; }
    }
    PG8_WAIT_V(0);
    if constexpr (!ALIGN_EPI) { if (wr == 0) PG8_BAR; }
    PG8_BAR;
#undef PG8_SA
#undef PG8_SB
#undef PG8_STAGE
#undef PG8_STAGE_A
#undef PG8_LDA
#undef PG8_LDB
#undef PG8_MMA
#undef PG8_F8
#undef PG8_WAIT_V
#undef PG8_WAIT_L
#undef PG8_BAR
#undef PG8_SCHED
}
}


__device__ __forceinline__ int perm32_pos(int t) { return 16 * ((t >> 2) & 1) + 4 * ((t >> 3) & 3) + (t & 3); }
__device__ __forceinline__ int pos_inproj(int c) {
    if (c < 1024) { const int hc = c & 127; return (c & ~127) | (32 * ((hc >> 4) & 3) + 16 * (hc >> 6) + (hc & 15)); }
    return (c & ~31) | perm32_pos(c & 31);
}
__device__ __forceinline__ int pos_plain(int c) { return (c & ~31) | perm32_pos(c & 31); }
__device__ __forceinline__ int pos_w1(int n) { const int jj = n & 1023, lin = n >> 10, pn = jj >> 7, tp = jj & 127; return pn * 256 + lin * 128 + ((tp & ~31) | perm32_pos(tp & 31)); }

struct EpiInProj {
    unsigned char* proj; const float* ropec; const float* ropes; unsigned* ctl;
    __device__ __forceinline__ void operator()(const f32x4 (&acc)[2][2][4][2], const pg8::Unit& u, int wr, int wc, int fr, int fq) const {
        const int type = u.pn >> 1; bf16_t* base = (bf16_t*)(proj + (size_t)type * PROJ_STRIDE);
        const int colh = (u.pn & 1) * 256;
        if (type < 2) {
            const float sc = (type == 1) ? 0.08838834764831845f : 1.0f;
            const int i0 = 16 * wc + 4 * fq;
#pragma unroll
            for (int ai = 0; ai < 2; ++ai)
#pragma unroll
                for (int m = 0; m < 4; ++m) {
                    const int row = u.pm * 256 + ai * 128 + wr * 64 + m * 16 + fr; const int pos = row & (SEQ - 1);
                    const f32x4 cs = *(const f32x4*)(ropec + pos * 64 + i0), sn = *(const f32x4*)(ropes + pos * 64 + i0);
#pragma unroll
                    for (int bj = 0; bj < 2; ++bj) {
                        const f32x4 x1 = acc[ai][bj][m][0], x2 = acc[ai][bj][m][1];
                        const f32x4 o1 = (x1 * cs - x2 * sn) * sc, o2 = (x1 * sn + x2 * cs) * sc;
                        bf16_t* dst = base + (size_t)row * 512 + colh + bj * 128 + i0;
                        u32x2 w1, w2; w1.x = cvtpk(o1[0], o1[1]); w1.y = cvtpk(o1[2], o1[3]); w2.x = cvtpk(o2[0], o2[1]); w2.y = cvtpk(o2[2], o2[3]);
                        *(u32x2*)dst = w1; *(u32x2*)(dst + 64) = w2;
                    }
                }
        } else {
            const float sc = (type == 4) ? C2 : 1.0f;
            float mx[2] = {0.f, 0.f};
#pragma unroll
            for (int ai = 0; ai < 2; ++ai)
#pragma unroll
                for (int m = 0; m < 4; ++m) {
                    const int row = u.pm * 256 + ai * 128 + wr * 64 + m * 16 + fr;
#pragma unroll
                    for (int bj = 0; bj < 2; ++bj) {
                        f32x4 v0 = acc[ai][bj][m][0] * sc, v1 = acc[ai][bj][m][1] * sc;
                        if (type == 4 || type == 5) { float ssq = (v0[0] * v0[0] + v0[1] * v0[1]) + (v0[2] * v0[2] + v0[3] * v0[3]) + (v1[0] * v1[0] + v1[1] * v1[1]) + (v1[2] * v1[2] + v1[3] * v1[3]);
                            ssq += __shfl_xor(ssq, 16); ssq += __shfl_xor(ssq, 32); mx[bj] = fmaxf(mx[bj], ssq); }
                        if (type == 3) {
#pragma unroll
                            for (int j = 0; j < 4; ++j) { v0[j] = v0[j] * __builtin_amdgcn_rcpf(1.0f + __builtin_amdgcn_exp2f(-LOG2E * v0[j])); v1[j] = v1[j] * __builtin_amdgcn_rcpf(1.0f + __builtin_amdgcn_exp2f(-LOG2E * v1[j])); }
                        }
                        u32x4 w; w.x = cvtpk(v0[0], v0[1]); w.y = cvtpk(v0[2], v0[3]); w.z = cvtpk(v1[0], v1[1]); w.w = cvtpk(v1[2], v1[3]);
                        *(u32x4*)(base + (size_t)row * 512 + colh + bj * 128 + wc * 32 + 8 * fq) = w;
                    }
                }
            if (type == 4 || type == 5) {
#pragma unroll
                for (int bj = 0; bj < 2; ++bj) { float v = mx[bj]; v = fmaxf(v, __shfl_xor(v, 1)); v = fmaxf(v, __shfl_xor(v, 2)); v = fmaxf(v, __shfl_xor(v, 4)); v = fmaxf(v, __shfl_xor(v, 8));
                    if ((threadIdx.x & 63) == 0) { const int bh = (u.pm >> 5) * 8 + (u.pn & 1) * 4 + bj * 2 + (wc >> 1);
                        atomicMax(ctl + ((type == 4) ? CW_QN2 : CW_KN2) + bh * 2 + (wc & 1), __float_as_uint(v)); } }
            }
        }
    }
};

__device__ __forceinline__ unsigned pk4_fp8(float a, float b, float c, float d) { int w = 0; w = __builtin_amdgcn_cvt_pk_fp8_f32(a, b, w, false); w = __builtin_amdgcn_cvt_pk_fp8_f32(c, d, w, true); return (unsigned)w; }
struct EpiOutProj {
    const float* x; bf16_t* h1b; unsigned char* h1f8;
    __device__ __forceinline__ void operator()(const f32x4 (&acc)[2][2][4][2], const pg8::Unit& u, int wr, int wc, int fr, int fq) const {
#pragma unroll
        for (int ai = 0; ai < 2; ++ai)
#pragma unroll
            for (int m = 0; m < 4; ++m) {
                const int row = u.pm * 256 + ai * 128 + wr * 64 + m * 16 + fr;
#pragma unroll
                for (int bj = 0; bj < 2; ++bj) {
                    const int col = u.pn * 256 + bj * 128 + wc * 32 + 8 * fq;
                    const f32x4 xa = *(const f32x4*)(x + (size_t)row * DM + col), xb = *(const f32x4*)(x + (size_t)row * DM + col + 4);
                    const f32x4 v0 = acc[ai][bj][m][0] + xa, v1 = acc[ai][bj][m][1] + xb;
                    u32x4 w; w.x = cvtpk(v0[0], v0[1]); w.y = cvtpk(v0[2], v0[3]); w.z = cvtpk(v1[0], v1[1]); w.w = cvtpk(v1[2], v1[3]);
                    *(u32x4*)(h1b + (size_t)row * DM + col) = w;
                    u32x2 w8; w8.x = pk4_fp8(v0[0], v0[1], v0[2], v0[3]); w8.y = pk4_fp8(v1[0], v1[1], v1[2], v1[3]);
                    *(u32x2*)(h1f8 + (size_t)row * DM + col) = w8;
                }
            }
    }
};

struct EpiMoe1 {
    unsigned char* H; const LAS unsigned* tokr; const LAS bf16_t* biasl;
    __device__ __forceinline__ void operator()(const f32x4 (&acc)[2][2][4][2], const pg8::Unit& u, int wr, int wc, int fr, int fq) const {
        const int e = u.e, pnl = u.pn - e * 8; const int cl = wc * 32 + 8 * fq, cq = pnl * 128 + cl;
        const u32x4 bgw = *(const LAS u32x4*)(biasl + u.idx * 256 + cl), blw = *(const LAS u32x4*)(biasl + u.idx * 256 + 128 + cl);
        const f32x4 bg0 = {bflo(bgw.x), bfhi(bgw.x), bflo(bgw.y), bfhi(bgw.y)}, bg1 = {bflo(bgw.z), bfhi(bgw.z), bflo(bgw.w), bfhi(bgw.w)};
        const f32x4 bl0 = {bflo(blw.x), bfhi(blw.x), bflo(blw.y), bfhi(blw.y)}, bl1 = {bflo(blw.z), bfhi(blw.z), bflo(blw.w), bfhi(blw.w)};
#pragma unroll
        for (int ai = 0; ai < 2; ++ai)
#pragma unroll
            for (int m = 0; m < 4; ++m) {
                const int rt = ai * 128 + wr * 64 + m * 16 + fr;
                const float rs = bfhi(tokr[u.idx * 256 + rt]) * (1.0f / W_SCALE);
                f32x4 g0 = acc[ai][0][m][0] * rs + bg0, g1 = acc[ai][0][m][1] * rs + bg1, l0 = acc[ai][1][m][0] * rs + bl0, l1 = acc[ai][1][m][1] * rs + bl1;
                float o[8];
#pragma unroll
                for (int j = 0; j < 4; ++j) {
                    float g = fminf(g0[j], 7.0f), l = fminf(fmaxf(l0[j], -7.0f), 7.0f); o[j] = g * __builtin_amdgcn_rcpf(1.0f + __builtin_amdgcn_exp2f(-1.702f * LOG2E * g)) * (l * H_SCALE + H_SCALE);
                    g = fminf(g1[j], 7.0f); l = fminf(fmaxf(l1[j], -7.0f), 7.0f); o[4 + j] = g * __builtin_amdgcn_rcpf(1.0f + __builtin_amdgcn_exp2f(-1.702f * LOG2E * g)) * (l * H_SCALE + H_SCALE);
                }
                u32x2 w; w.x = pk4_fp8(o[0], o[1], o[2], o[3]); w.y = pk4_fp8(o[4], o[5], o[6], o[7]);
                *(u32x2*)(H + (size_t)(u.pm * 256 + rt) * DFF + cq) = w;
            }
    }
};

struct EpiNull { float* sink;
    __device__ __forceinline__ void operator()(const f32x4 (&acc)[2][2][4][2], const pg8::Unit& u, int wr, int wc, int fr, int fq) const {
        float s = 0.f;
#pragma unroll
        for (int ai = 0; ai < 2; ++ai)
#pragma unroll
            for (int bj = 0; bj < 2; ++bj)
#pragma unroll
                for (int m = 0; m < 4; ++m)
#pragma unroll
                    for (int n = 0; n < 2; ++n) s += acc[ai][bj][m][n][0];
        if (s == 123.456f) sink[0] = s;
    }
};
struct EpiMoe2 {
    unsigned char* Y; const LAS bf16_t* biasl;
    __device__ __forceinline__ void operator()(const f32x4 (&acc)[2][2][4][2], const pg8::Unit& u, int wr, int wc, int fr, int fq) const {
        const int e = u.e, pnl = u.pn - e * 4;
#pragma unroll
        for (int bj = 0; bj < 2; ++bj) {
            const int cl = bj * 128 + wc * 32 + 8 * fq, col = pnl * 256 + cl;
            const u32x4 bw = *(const LAS u32x4*)(biasl + u.idx * 256 + cl);
            const f32x4 ba = {bflo(bw.x), bfhi(bw.x), bflo(bw.y), bfhi(bw.y)}, bb = {bflo(bw.z), bfhi(bw.z), bflo(bw.w), bfhi(bw.w)};
#pragma unroll
            for (int ai = 0; ai < 2; ++ai)
#pragma unroll
                for (int m = 0; m < 4; ++m) {
                    const int rt = ai * 128 + wr * 64 + m * 16 + fr;
                    const f32x4 v0 = acc[ai][bj][m][0] * (Y_SCALE / (W_SCALE * H_SCALE)) + ba * Y_SCALE, v1 = acc[ai][bj][m][1] * (Y_SCALE / (W_SCALE * H_SCALE)) + bb * Y_SCALE;
                    u32x2 w; w.x = pk4_fp8(v0[0], v0[1], v0[2], v0[3]); w.y = pk4_fp8(v1[0], v1[1], v1[2], v1[3]);
                    *(u32x2*)(Y + (size_t)(u.pm * 256 + rt) * DM + col) = w;
                }
        }
    }
};

template <int NT, bool GATHER>
struct MoeOrder {
    const LAS int* boff;
    const LAS int* cntl;
    const LAS unsigned* tokl;
    int G, vcu;
    __device__ __forceinline__ bool next(int i, pg8::Unit& u) const {
        const int cpx = G >> 3, x = vcu / cpx, j = vcu % cpx, rpb = cpx / NT;
        const int rb = (i * 8 + x) * rpb + j / NT; const int nb = boff[32];
        if (rb >= nb) return false;
        int e = 0;
#pragma unroll 1
        for (int k = 1; k < 32; ++k) if (boff[k] <= rb) e = k;
        u.pm = rb; u.e = e; u.lb = rb - boff[e]; u.pn = e * NT + (j % NT); u.idx = i; return true;
    }
    __device__ __forceinline__ void aoffs(const pg8::Unit& u, unsigned (&ao)[2][2], const int (&R)[2], const int (&C)[2], int rowbytes) const {
#pragma unroll
        for (int h = 0; h < 2; ++h)
#pragma unroll
            for (int i = 0; i < 2; ++i) {
                if constexpr (GATHER) {
                    const int tok = (int)(tokl[u.idx * 256 + h * 128 + R[i]] & 0xffffu);
                    ao[h][i] = (unsigned)(tok * rowbytes + C[i] * 2);
                } else ao[h][i] = (unsigned)((u.pm * 256 + h * 128 + R[i]) * rowbytes + C[i] * 2);
            }
    }
};

namespace attn_body {
constexpr int NHEAD = FH, D = 64, PQ = 512, PO = 1024;
constexpr int NW = 8, QBLK = 32, QB = QBLK * NW, KVBLK = 64, NQB = SEQ / QB;
__device__ __forceinline__ int crow(int r, int hi) { return (r & 3) + 8 * (r >> 2) + 4 * hi; }
#define SBAR() __builtin_amdgcn_sched_barrier(0)
__device__ __forceinline__ void cmask(f32x16& p0, f32x16& p1, int jb, int qrel, int hi) {
    const float NEG = -INFINITY; int kb = 64 * jb + 4 * hi;
#pragma unroll
    for (int r = 0; r < 16; ++r) { int kv = kb + (r & 3) + 8 * (r >> 2); if (kv > qrel) p0[r] = NEG; if (kv + 32 > qrel) p1[r] = NEG; }
}
constexpr int NSLOT = 3, SLOTB = 8192;
constexpr int LDS_K = 0, LDS_V = NSLOT * SLOTB, LDS_WS = 2 * NSLOT * SLOTB, LDS_OST = LDS_WS + NW * 64 * 4, LDS_END = LDS_OST + NW * 4096;
constexpr int LDS_F = 86016, LDS_F_BYTES = SEQ * 4 + 1024;
static_assert(LDS_F >= LDS_END && LDS_F + LDS_F_BYTES <= LDS_BYTES, "attention LDS map");
__device__ __forceinline__ void glds16(const void* gsrc, unsigned lds_dst) { unsigned keep;
    asm volatile("s_mov_b32 %0, m0\n\ts_mov_b32 m0, %2\n\ts_nop 0\n\tglobal_load_lds_dwordx4 %1, off\n\ts_mov_b32 m0, %0" : "=&s"(keep) : "v"(gsrc), "s"(lds_dst) : "memory"); }
__device__ __forceinline__ float max3f(float a, float b, float c) { float r; asm("v_max3_f32 %0, %1, %2, %3" : "=v"(r) : "v"(a), "v"(b), "v"(c)); return r; }
__device__ __forceinline__ float max2f(float a, float b) { float r; asm("v_max_f32_e32 %0, %1, %2" : "=v"(r) : "v"(a), "v"(b)); return r; }
__device__ __forceinline__ float fadd_s(float a, float b) { float r; asm("v_add_f32_e32 %0, %1, %2" : "=v"(r) : "v"(a), "v"(b)); return r; }
__device__ __forceinline__ float fsub_s(float a, float b) { float r; asm("v_sub_f32_e32 %0, %1, %2" : "=v"(r) : "v"(a), "v"(b)); return r; }
#define WAIT_BAR(N) asm volatile("s_waitcnt vmcnt(" #N ") lgkmcnt(0)\n\ts_barrier" ::: "memory")

typedef LAS const char* lds_cptr;
typedef short v4i16_t __attribute__((ext_vector_type(4)));
__device__ __forceinline__ void kload8(bf16x8* kf, lds_cptr kp) {
    kf[0] = *(const LAS bf16x8*)(kp);        kf[1] = *(const LAS bf16x8*)(kp + 512);
    kf[2] = *(const LAS bf16x8*)(kp + 2048); kf[3] = *(const LAS bf16x8*)(kp + 2560);
    kf[4] = *(const LAS bf16x8*)(kp + 4096); kf[5] = *(const LAS bf16x8*)(kp + 4608);
    kf[6] = *(const LAS bf16x8*)(kp + 6144); kf[7] = *(const LAS bf16x8*)(kp + 6656);
}
__device__ __forceinline__ void kload2(bf16x8* kf, lds_cptr kp, int j) { kf[2 * j] = *(const LAS bf16x8*)(kp + j * 2048); kf[2 * j + 1] = *(const LAS bf16x8*)(kp + j * 2048 + 512); }
__device__ __forceinline__ s16x4 vtr(lds_cptr p) { return __builtin_bit_cast(s16x4, __builtin_amdgcn_ds_read_tr16_b64_v4i16((LAS v4i16_t*)p)); }
__device__ __forceinline__ float rowmax(const f32x16& p0, const f32x16& p1) {
    float a = max3f(p0[0], p0[1], p1[0]), b = max3f(p0[2], p0[3], p1[1]); a = max3f(a, p1[2], p1[3]);
#pragma unroll
    for (int r = 4; r < 16; r += 4) { a = max3f(a, p0[r], p0[r + 1]); b = max3f(b, p0[r + 2], p0[r + 3]); a = max3f(a, p1[r], p1[r + 1]); b = max3f(b, p1[r + 2], p1[r + 3]); }
    const float m = max2f(a, b);
    auto rr = __builtin_amdgcn_permlane32_swap(__float_as_uint(m), __float_as_uint(m), false, false);
    return max2f(__uint_as_float(rr[0]), __uint_as_float(rr[1]));
}
__device__ __forceinline__ void pv(f32x16* o, int vb, bf16x8 pa0, bf16x8 pa1, bf16x8 pa2, bf16x8 pa3) {
#pragma unroll
    for (int d0 = 0; d0 < 2; ++d0) { s16x4 lo[4], hi[4];
#pragma unroll
        for (int ks = 0; ks < 4; ++ks) {
            asm volatile("ds_read_b64_tr_b16 %0,%1 offset:%c2" : "=&v"(lo[ks]) : "v"(vb), "i"(d0 * 4096 + ks * 1024) : "memory");
            asm volatile("ds_read_b64_tr_b16 %0,%1 offset:%c2" : "=&v"(hi[ks]) : "v"(vb), "i"(d0 * 4096 + ks * 1024 + 512) : "memory"); }
        asm volatile("s_waitcnt lgkmcnt(0)" ::: "memory"); SBAR();
#define PK(k) (bf16x8){lo[k][0], lo[k][1], lo[k][2], lo[k][3], hi[k][0], hi[k][1], hi[k][2], hi[k][3]}
        o[d0] = __builtin_amdgcn_mfma_f32_32x32x16_bf16(pa0, PK(0), o[d0], 0, 0, 0);
        o[d0] = __builtin_amdgcn_mfma_f32_32x32x16_bf16(pa1, PK(1), o[d0], 0, 0, 0);
        o[d0] = __builtin_amdgcn_mfma_f32_32x32x16_bf16(pa2, PK(2), o[d0], 0, 0, 0);
        o[d0] = __builtin_amdgcn_mfma_f32_32x32x16_bf16(pa3, PK(3), o[d0], 0, 0, 0);
#undef PK
    }
}

template <int THRL> __device__ __forceinline__ void attn_unit(int b, int h, int qb, int ts, const bf16_t* Q, const bf16_t* __restrict__ K, const bf16_t* __restrict__ V, bf16_t* O, const float* __restrict__ F2, char* shm) {
    const int tid = threadIdx.x, lane = tid & 63, r32 = lane & 31, hi = lane >> 5; const int wid = __builtin_amdgcn_readfirstlane(tid >> 6);
    const long rowbase = (long)b * SEQ; const int q0 = qb * QB;
    const bf16_t* Qw = Q + (rowbase + q0 + wid * QBLK) * PQ + h * D;
    const bf16_t* Kh = K + (rowbase + (long)ts * KVBLK) * PQ + h * D, *Vh = V + (rowbase + (long)ts * KVBLK) * PQ + h * D;
    const unsigned lds0 = (unsigned)(uintptr_t)shm;
    float* wsf = (float*)(shm + LDS_WS) + wid * 64;
    { const f32x4* Fg = (const f32x4*)(F2 + (size_t)(b * NHEAD + h) * SEQ + (size_t)ts * KVBLK); LAS f32x4* Fl4 = (LAS f32x4*)((LAS char*)(lds_cptr)shm + LDS_F); const int n4 = (q0 + QB - ts * KVBLK) / 4;
      for (int p = tid; p < n4; p += NW * 64) Fl4[p] = Fg[p]; }
    const LAS float* Fl = (const LAS float*)((lds_cptr)shm + LDS_F);
    asm volatile("s_waitcnt vmcnt(0) lgkmcnt(0)" ::: "memory");
    const bf16_t* ksrc = Kh + (long)lane * PQ + wid * 8;
    const bf16_t* vsrc = Vh + (long)(16 * (wid & 3) + (lane >> 2)) * PQ + (wid >> 2) * 32 + (lane & 3) * 8;
    const unsigned kdst = lds0 + LDS_K + wid * 1024, vdst = lds0 + LDS_V + wid * 1024;
#define DMA_K(t, slot) glds16(ksrc + (long)(t) * KVBLK * PQ, (unsigned)__builtin_amdgcn_readfirstlane(kdst + (slot)))
#define DMA_V(t, slot) glds16(vsrc + (long)(t) * KVBLK * PQ, (unsigned)__builtin_amdgcn_readfirstlane(vdst + (slot)))
    const int vb0 = (int)(lds0 + LDS_V) + ((lane >> 4) & 1) * 32 + (lane & 3) * 8 + (4 * hi + ((lane & 15) >> 2)) * 64;
    bf16x8 kf[8];
    const lds_cptr shm3 = (lds_cptr)shm; const lds_cptr kp0 = shm3 + LDS_K + hi * 1024 + r32 * 16; const lds_cptr vp0 = shm3 + LDS_V + ((lane >> 4) & 1) * 32 + (lane & 3) * 8 + (4 * hi + ((lane & 15) >> 2)) * 64;
    const int NT = (q0 + QB) / KVBLK - ts;
    DMA_K(0, 0); DMA_V(0, 0); DMA_K(1, SLOTB);
    bf16x8 qr[4];
#pragma unroll
    for (int d0 = 0; d0 < 4; ++d0) qr[d0] = *reinterpret_cast<const bf16x8*>(&Qw[(long)r32 * PQ + d0 * 16 + hi * 8]);
    float mhat = 0.f, l_reg = 0.f, nm = 0.f; f32x16 o[2]; o[0] = f32x16{}; o[1] = f32x16{};
    f32x4 fa[4], fb[4];
#define FLD(tt) do { const LAS float* fp_ = Fl + 64 * (tt) + 4 * hi; _Pragma("unroll") for (int g_ = 0; g_ < 4; ++g_) { fa[g_] = *(const LAS f32x4*)(fp_ + 8 * g_); fb[g_] = *(const LAS f32x4*)(fp_ + 32 + 8 * g_); } } while (0)
#define CINIT(C0, C1) do { _Pragma("unroll") for (int g_ = 0; g_ < 4; ++g_) { _Pragma("unroll") for (int e_ = 0; e_ < 4; ++e_) { C0[4 * g_ + e_] = nm - fa[g_][e_]; C1[4 * g_ + e_] = nm - fb[g_][e_]; } } } while (0)
    const int qrel = wid * QBLK + r32;
#define CMASK(P0, P1, t) do { int jb_ = (t) - (NT - 4); if (jb_ >= 0) cmask(P0, P1, jb_, qrel, hi); } while (0)
    bool resc = false;
#define START(P0, P1) do { const float rm = rowmax(P0, P1); resc = false; \
    { const float dl = rm; mhat = fadd_s(mhat, dl); \
      _Pragma("unroll") for (int r = 0; r < 16; ++r) { P0[r] = fsub_s(P0[r], dl); P1[r] = fsub_s(P1[r], dl); } \
      nm = -mhat; } \
    _Pragma("unroll") for (int r = 0; r < 16; ++r) P0[r] = __builtin_amdgcn_exp2f(P0[r]); } while (0)
#define RESC() do { if (resc) { asm volatile("s_waitcnt lgkmcnt(0)" ::: "memory"); \
      _Pragma("unroll") for (int d_ = 0; d_ < 2; ++d_) _Pragma("unroll") for (int r = 0; r < 16; ++r) o[d_][r] *= wsf[crow(r, hi)]; } } while (0)
    f32x16 pA0, pA1, pB0, pB1;
    int sl_prev = 0, sl_cur = 0, sl_next = SLOTB;
#define ROT() do { sl_prev = sl_cur; sl_cur = sl_next; sl_next = (sl_next == (NSLOT - 1) * SLOTB) ? 0 : sl_next + SLOTB; } while (0)
    DMA_K(2, 2 * SLOTB);
    WAIT_BAR(3);
    FLD(0); CINIT(pA0, pA1);
    { const lds_cptr kb = shm3 + LDS_K + hi * 1024 + r32 * 16;
#pragma unroll
      for (int d0 = 0; d0 < 4; ++d0) { const bf16x8 b0 = *(const LAS bf16x8*)(kb + d0 * 2048); const bf16x8 b1 = *(const LAS bf16x8*)(kb + d0 * 2048 + 512);
          pA0 = __builtin_amdgcn_mfma_f32_32x32x16_bf16(b0, qr[d0], pA0, 0, 0, 0); pA1 = __builtin_amdgcn_mfma_f32_32x32x16_bf16(b1, qr[d0], pA1, 0, 0, 0); } }
    asm volatile("s_nop 15\n\ts_nop 7" : "+v"(pA0), "+v"(pA1)); CMASK(pA0, pA1, 0);
    START(pA0, pA1);
    _Pragma("unroll") for (int r = 0; r < 16; ++r) pA1[r] = __builtin_amdgcn_exp2f(pA1[r]);
    FLD(1);
    WAIT_BAR(0);
    DMA_K(3, 0); DMA_V(1, SLOTB);
    ROT();
    kload8(kf, kp0 + sl_cur);
    WAIT_BAR(2);
    s16x4 vlo[8], vhi[8]; u32x4 pw0, pw1, pw2, pw3;
#define PKW(P, B) cvtpk(P[B], P[B + 1])
#define PAF(k) __builtin_bit_cast(bf16x8, pw##k)
#define VFR(i) (bf16x8){vlo[i][0], vlo[i][1], vlo[i][2], vlo[i][3], vhi[i][0], vhi[i][1], vhi[i][2], vhi[i][3]}
#define PIN(x) asm volatile("" : "+v"(x))
#define MX3(a, b, c) __builtin_fmaxf(__builtin_fmaxf((a), (b)), (c))
#define GAPA(MF, A0, A1, A2, A3, W0, W1, PW) do { MF; sacc += A0; sacc += A1; sacc += A2; sacc += A3; PIN(sacc); W0; W1; PIN(PW); SBAR(); } while (0)
#define EX(v) __builtin_amdgcn_exp2f(v)
#define GAPB(MF, X, B) do { MF; X[B] = EX(X[B]); X[B + 1] = EX(X[B + 1]); X[B + 2] = EX(X[B + 2]); X[B + 3] = EX(X[B + 3]); PIN(X); SBAR(); } while (0)
#define VRD(i) do { vlo[i] = vtr(vp_ + (((i) >> 2) * 4096 + ((i) & 3) * 1024)); vhi[i] = vtr(vp_ + (((i) >> 2) * 4096 + ((i) & 3) * 1024 + 512)); } while (0)
#define KRD(G, j) do { if (G) { kload2(kf, kp0 + sl_next, j); SBAR(); } } while (0)
#define STEP(C0, C1, P0, P1, t, GK, GV, GL) do { SBAR(); \
    CINIT(C0, C1); SBAR(); \
    const lds_cptr vp_ = vp0 + sl_prev; \
    VRD(0); SBAR(); float sacc = (P0[0] + P0[1]); \
    GAPA(C0 = __builtin_amdgcn_mfma_f32_32x32x16_bf16(kf[0], qr[0], C0, 0, 0, 0), P0[2], P0[3], P0[4], P0[5],     pw0[0] = PKW(P0, 0), pw0[1] = PKW(P0, 2), pw0); \
    VRD(4); SBAR(); GAPA(C1 = __builtin_amdgcn_mfma_f32_32x32x16_bf16(kf[1], qr[0], C1, 0, 0, 0), P0[6], P0[7], P0[8], P0[9],     pw0[2] = PKW(P0, 4), pw0[3] = PKW(P0, 6), pw0); \
    VRD(1); SBAR(); GAPA(C0 = __builtin_amdgcn_mfma_f32_32x32x16_bf16(kf[2], qr[1], C0, 0, 0, 0),   P0[10], P0[11], P0[12], P0[13], pw1[0] = PKW(P0, 8), pw1[1] = PKW(P0, 10), pw1); \
    VRD(5); SBAR(); GAPA(C1 = __builtin_amdgcn_mfma_f32_32x32x16_bf16(kf[3], qr[1], C1, 0, 0, 0),   P0[14], P0[15], P1[0], P1[1],   pw1[2] = PKW(P0, 12), pw1[3] = PKW(P0, 14), pw1); \
    VRD(2); SBAR(); GAPA(C0 = __builtin_amdgcn_mfma_f32_32x32x16_bf16(kf[4], qr[2], C0, 0, 0, 0),   P1[2], P1[3], P1[4], P1[5],     pw2[0] = PKW(P1, 0), pw2[1] = PKW(P1, 2), pw2); \
    VRD(6); SBAR(); GAPA(C1 = __builtin_amdgcn_mfma_f32_32x32x16_bf16(kf[5], qr[2], C1, 0, 0, 0),   P1[6], P1[7], P1[8], P1[9],     pw2[2] = PKW(P1, 4), pw2[3] = PKW(P1, 6), pw2); \
    VRD(3); SBAR(); GAPA(C0 = __builtin_amdgcn_mfma_f32_32x32x16_bf16(kf[6], qr[3], C0, 0, 0, 0),   P1[10], P1[11], P1[12], P1[13], pw3[0] = PKW(P1, 8), pw3[1] = PKW(P1, 10), pw3); \
    VRD(7); SBAR(); GAPA(C1 = __builtin_amdgcn_mfma_f32_32x32x16_bf16(kf[7], qr[3], C1, 0, 0, 0),   P1[14], P1[15], 0.f, 0.f,       pw3[2] = PKW(P1, 12), pw3[3] = PKW(P1, 14), pw3); \
    l_reg += sacc; \
    if (GK) { DMA_K((t) + 3, sl_cur); } if (GV) { DMA_V((t) + 1, sl_next); } \
    CMASK(C0, C1, t); \
    { float a = MX3(C0[0], C0[1], C1[0]), b = MX3(C0[2], C0[3], C1[1]); a = MX3(a, C1[2], C1[3]); \
      _Pragma("unroll") for (int r = 4; r < 16; r += 4) { a = MX3(a, C0[r], C0[r + 1]); b = MX3(b, C0[r + 2], C0[r + 3]); a = MX3(a, C1[r], C1[r + 1]); b = MX3(b, C1[r + 2], C1[r + 3]); } \
      float rm = __builtin_fmaxf(a, b); { auto rr = __builtin_amdgcn_permlane32_swap(__float_as_uint(rm), __float_as_uint(rm), false, false); rm = __builtin_fmaxf(__uint_as_float(rr[0]), __uint_as_float(rr[1])); } \
      resc = false; \
      if (__builtin_expect(__any(rm > (float)THRL), 0)) { const float dl = __builtin_fmaxf(rm, 0.f); mhat += dl; \
        _Pragma("unroll") for (int r = 0; r < 16; ++r) { C0[r] -= dl; C1[r] -= dl; } \
        nm = -mhat; \
        const float f = __builtin_amdgcn_exp2f(-dl); l_reg *= f; if (hi == 0) wsf[r32] = f; resc = true; } } \
    SBAR(); \
    GAPB(o[0] = __builtin_amdgcn_mfma_f32_32x32x16_bf16(PAF(0), VFR(0), o[0], 0, 0, 0), C0, 0); \
    GAPB(o[1] = __builtin_amdgcn_mfma_f32_32x32x16_bf16(PAF(0), VFR(4), o[1], 0, 0, 0), C0, 4); \
    KRD(GL, 0); GAPB(o[0] = __builtin_amdgcn_mfma_f32_32x32x16_bf16(PAF(1), VFR(1), o[0], 0, 0, 0), C0, 8); \
    KRD(GL, 1); GAPB(o[1] = __builtin_amdgcn_mfma_f32_32x32x16_bf16(PAF(1), VFR(5), o[1], 0, 0, 0), C0, 12); \
    KRD(GL, 2); GAPB(o[0] = __builtin_amdgcn_mfma_f32_32x32x16_bf16(PAF(2), VFR(2), o[0], 0, 0, 0), C1, 0); \
    KRD(GL, 3); GAPB(o[1] = __builtin_amdgcn_mfma_f32_32x32x16_bf16(PAF(2), VFR(6), o[1], 0, 0, 0), C1, 4); \
    GAPB(o[0] = __builtin_amdgcn_mfma_f32_32x32x16_bf16(PAF(3), VFR(3), o[0], 0, 0, 0), C1, 8); \
    GAPB(o[1] = __builtin_amdgcn_mfma_f32_32x32x16_bf16(PAF(3), VFR(7), o[1], 0, 0, 0), C1, 12); \
    FLD((t) + 1); \
    } while (0)
    int t = 1;
#undef CMASK
#define CMASK(P0, P1, t) do { } while (0)
    for (; t + 5 < NT; t += 2) {
        STEP(pB0, pB1, pA0, pA1, t, true, true, true);     WAIT_BAR(2); RESC(); ROT();
        STEP(pA0, pA1, pB0, pB1, t + 1, true, true, true);   WAIT_BAR(2); RESC(); ROT();
    }
#undef CMASK
#define CMASK(P0, P1, t) do { int jb_ = (t) - (NT - 4); if (jb_ >= 0) cmask(P0, P1, jb_, qrel, hi); } while (0)
#define ENDW(tt) do { if ((tt) + 3 < NT) { WAIT_BAR(2); } else if ((tt) + 2 < NT) { WAIT_BAR(1); } else { WAIT_BAR(0); } } while (0)
    for (; t + 1 < NT; t += 2) {
        STEP(pB0, pB1, pA0, pA1, t, (t + 3 < NT), (t + 1 < NT), (t + 1 < NT));       ENDW(t);   RESC(); ROT();
        STEP(pA0, pA1, pB0, pB1, t + 1, (t + 4 < NT), (t + 2 < NT), (t + 2 < NT));     ENDW(t + 1); RESC(); ROT();
    }
    STEP(pB0, pB1, pA0, pA1, NT - 1, false, false, false); RESC();
    { float sacc = pB0[0] + pB0[1]; _Pragma("unroll") for (int r = 2; r < 16; ++r) sacc += pB0[r]; _Pragma("unroll") for (int r = 0; r < 16; ++r) sacc += pB1[r]; l_reg += sacc;
      pw0 = (u32x4){PKW(pB0, 0), PKW(pB0, 2), PKW(pB0, 4), PKW(pB0, 6)}; pw1 = (u32x4){PKW(pB0, 8), PKW(pB0, 10), PKW(pB0, 12), PKW(pB0, 14)}; pw2 = (u32x4){PKW(pB1, 0), PKW(pB1, 2), PKW(pB1, 4), PKW(pB1, 6)}; pw3 = (u32x4){PKW(pB1, 8), PKW(pB1, 10), PKW(pB1, 12), PKW(pB1, 14)};
      SBAR(); pv(o, vb0 + sl_cur, PAF(0), PAF(1), PAF(2), PAF(3)); }
#undef PKW
#undef PAF
#undef VFR
#undef PIN
#undef MX3
#undef GAPA
#undef GAPB
#undef EX
#undef VRD
#undef KRD
#undef STEP
#undef ENDW
    { auto rr = __builtin_amdgcn_permlane32_swap(__float_as_uint(l_reg), __float_as_uint(l_reg), false, false); l_reg = __uint_as_float(rr[0]) + __uint_as_float(rr[1]); }
    if (hi == 0) wsf[32 + r32] = l_reg; asm volatile("s_waitcnt lgkmcnt(0)" ::: "memory");
    float rli[16];
#pragma unroll
    for (int r = 0; r < 16; ++r) rli[r] = __builtin_amdgcn_rcpf(wsf[32 + crow(r, hi)]);
    bf16_t* Ow = O + (rowbase + q0 + wid * QBLK) * PO + h * D;
    { bf16_t* stg = (bf16_t*)(shm + LDS_OST) + wid * 2048;
#pragma unroll
      for (int r = 0; r < 16; ++r) { const int orow = crow(r, hi);
#pragma unroll
          for (int d0 = 0; d0 < 2; ++d0) { const float v = o[d0][r] * rli[r]; stg[orow * 64 + d0 * 32 + r32] = (bf16_t)(cvtpk(v, v) & 0xffffu); } }
      asm volatile("s_waitcnt lgkmcnt(0)" ::: "memory");
#pragma unroll
      for (int i = 0; i < 4; ++i) { const int row = i * 8 + (lane >> 3), ch = lane & 7; const u32x4 v = *(const u32x4*)(stg + row * 64 + ch * 8); *(u32x4*)(Ow + (long)row * PO + ch * 8) = v; } }
    asm volatile("s_waitcnt lgkmcnt(0)\n\ts_barrier" ::: "memory");
#undef DMA_K
#undef DMA_V
#undef CMASK
#undef START
#undef RESC
#undef ROT
#undef FLD
#undef CINIT
}
#undef SBAR
#undef WAIT_BAR
}

namespace ret {
constexpr int RS = 272;
constexpr int IMG_Q = 0, IMG_K = 64 * RS, IMG_KT = 2 * 64 * RS, IMG_V = 3 * 64 * RS;
constexpr int PS = 144;
constexpr int IMG_P = 4 * 64 * RS;
constexpr int IMG_ST = IMG_P + 64 * PS;
constexpr int OS = 132;
constexpr int IMG_O = IMG_ST + 128 * RS;
constexpr int LDS_END = IMG_O + 64 * OS * 4;
static_assert(LDS_END <= LDS_BYTES, "retention LDS map");
typedef short v4i16_t __attribute__((ext_vector_type(4)));
__device__ __forceinline__ s16x4 tr4(LAS const char* p) { return __builtin_bit_cast(s16x4, __builtin_amdgcn_ds_read_tr16_b64_v4i16((LAS v4i16_t*)p)); }
__device__ __forceinline__ bf16x8 frag_tr(LAS const char* img, int stride, int k0, int c0, int lane) {
    const int g4 = lane >> 4, i = lane & 15, qq = i >> 2, p = i & 3, hh = g4 >> 1, nh = g4 & 1;
    LAS const char* a = img + (k0 + 8 * hh + qq) * stride + (c0 + 16 * nh + 4 * p) * 2;
    const s16x4 lo = tr4(a), hi = tr4(a + 4 * stride);
    return (bf16x8){lo[0], lo[1], lo[2], lo[3], hi[0], hi[1], hi[2], hi[3]};
}
__device__ __forceinline__ bf16x8 frag_row(LAS const char* img, int stride, int r0, int k0, int lane) {
    return *(const LAS bf16x8*)(img + (r0 + (lane & 31)) * stride + (k0 + 8 * (lane >> 5)) * 2);
}
__device__ __forceinline__ int crow(int r, int hi) { return (r & 3) + 8 * (r >> 2) + 4 * hi; }

template <bool APPLY>
__device__ __forceinline__ void unit(int bh, int g, const bf16_t* RQ, const bf16_t* RK, const bf16_t* RV, const bf16_t* SG, float* GST, bf16_t* MIX, LAS char* lds) {
    int tid_ = threadIdx.x; asm volatile("" : "+v"(tid_));
    const int tid = tid_, lane = tid & 63, hi = lane >> 5; const int w = __builtin_amdgcn_readfirstlane(tid >> 6);
    const int b = bh >> 2, h = bh & 3;
    const float l2g = log2f(1.0f - exp2f(-5.0f - (float)h));
    const float cd = exp2f(64.0f * l2g);
    const size_t row0 = (size_t)b * SEQ + (size_t)g * 512;
    u32x4 rq[2], rk[2], rv[2];
    auto issue = [&](int j) {
#pragma unroll
        for (int i = 0; i < 2; ++i) { const int p = tid + 512 * i, row = p >> 4, ch = p & 15; const size_t off = (row0 + j * 64 + row) * 512 + h * 128 + ch * 8;
            if (APPLY) rq[i] = *(const u32x4*)(RQ + off);
            rk[i] = *(const u32x4*)(RK + off); rv[i] = *(const u32x4*)(RV + off); }
    };
    const int db = w >> 1, eb0 = 2 * (w & 1);
    f32x16 S0 = f32x16{}, S1 = f32x16{};
    if (APPLY) {
        const float Gm = exp2f(512.0f * l2g);
        for (int gp = 0; gp < g; ++gp) {
            const float* src = GST + ((((size_t)(bh * 16 + gp) * 8 + w) * 2) * 16) * 64 + lane;
#pragma unroll
            for (int r = 0; r < 16; ++r) { S0[r] = S0[r] * Gm + src[r * 64]; S1[r] = S1[r] * Gm + src[(16 + r) * 64]; }
        }
    }
    issue(0);
    for (int j = 0; j < 8; ++j) {
#pragma unroll
        for (int i = 0; i < 2; ++i) { const int p = tid + 512 * i, row = p >> 4, ch = p & 15; const int o = row * RS + ch * 16;
            if (APPLY) { *(LAS u32x4*)(lds + IMG_Q + o) = rq[i]; *(LAS u32x4*)(lds + IMG_K + o) = rk[i]; }
            *(LAS u32x4*)(lds + IMG_V + o) = rv[i];
            const float kw = exp2f((float)(63 - row) * l2g);
            u32x4 kt;
#pragma unroll
            for (int e = 0; e < 4; ++e) kt[e] = cvtpk(bflo(rk[i][e]) * kw, bfhi(rk[i][e]) * kw);
            *(LAS u32x4*)(lds + IMG_KT + o) = kt; }
        if (APPLY) {
#pragma unroll
            for (int tile = 0; tile < 2; ++tile) { const f32x16& S = tile ? S1 : S0; const int e = (eb0 + tile) * 32 + (lane & 31);
#pragma unroll
                for (int g4 = 0; g4 < 4; ++g4) { const int d = db * 32 + 8 * g4 + 4 * hi; u32x2 v; v.x = cvtpk(S[4 * g4], S[4 * g4 + 1]); v.y = cvtpk(S[4 * g4 + 2], S[4 * g4 + 3]);
                    *(LAS u32x2*)(lds + IMG_ST + e * RS + d * 2) = v; } }
        }
        if (j + 1 < 8) issue(j + 1);
        LDS_WAIT(); __builtin_amdgcn_s_barrier();
        f32x16 oin = f32x16{}, oit = f32x16{};
        const int qb = w >> 2, eb = w & 3;
        if (APPLY) {
#pragma unroll
            for (int s = 0; s < 8; ++s) oin = __builtin_amdgcn_mfma_f32_32x32x16_bf16(frag_row(lds + IMG_Q, RS, qb * 32, s * 16, lane), frag_row(lds + IMG_ST, RS, eb * 32, s * 16, lane), oin, 0, 0, 0);
            if (w < 4) {
                const int tb = w >> 1, qb2 = w & 1; f32x16 sc = f32x16{};
#pragma unroll
                for (int s = 0; s < 8; ++s) sc = __builtin_amdgcn_mfma_f32_32x32x16_bf16(frag_row(lds + IMG_K, RS, tb * 32, s * 16, lane), frag_row(lds + IMG_Q, RS, qb2 * 32, s * 16, lane), sc, 0, 0, 0);
                const int q = qb2 * 32 + (lane & 31);
#pragma unroll
                for (int g4 = 0; g4 < 4; ++g4) { const int t0 = tb * 32 + 8 * g4 + 4 * hi; float pv4[4];
#pragma unroll
                    for (int e = 0; e < 4; ++e) { const int dd = q - (t0 + e); pv4[e] = sc[4 * g4 + e] * exp2f((float)(dd < 0 ? -dd : dd) * l2g); }
                    u32x2 v; v.x = cvtpk(pv4[0], pv4[1]); v.y = cvtpk(pv4[2], pv4[3]);
                    *(LAS u32x2*)(lds + IMG_P + q * PS + t0 * 2) = v; }
            }
            LDS_WAIT(); __builtin_amdgcn_s_barrier();
#pragma unroll
            for (int s = 0; s < 4; ++s) oit = __builtin_amdgcn_mfma_f32_32x32x16_bf16(frag_row(lds + IMG_P, PS, qb * 32, s * 16, lane), frag_tr(lds + IMG_V, RS, s * 16, eb * 32, lane), oit, 0, 0, 0);
#pragma unroll
            for (int r = 0; r < 16; ++r) { const int q = qb * 32 + crow(r, hi); const float qw = exp2f((float)(q + 1) * l2g);
                *(LAS float*)(lds + IMG_O + (q * OS + eb * 32 + (lane & 31)) * 4) = oit[r] + qw * oin[r]; }
        }
#pragma unroll
        for (int r = 0; r < 16; ++r) { S0[r] *= cd; S1[r] *= cd; }
#pragma unroll
        for (int s = 0; s < 4; ++s) { const bf16x8 a = frag_tr(lds + IMG_KT, RS, s * 16, db * 32, lane);
            S0 = __builtin_amdgcn_mfma_f32_32x32x16_bf16(a, frag_tr(lds + IMG_V, RS, s * 16, eb0 * 32, lane), S0, 0, 0, 0);
            S1 = __builtin_amdgcn_mfma_f32_32x32x16_bf16(a, frag_tr(lds + IMG_V, RS, s * 16, (eb0 + 1) * 32, lane), S1, 0, 0, 0); }
        LDS_WAIT(); __builtin_amdgcn_s_barrier();
        if (APPLY) {
            { const int q = tid >> 3, sg = tid & 7; const LAS f32x4* op = (const LAS f32x4*)(lds + IMG_O + (q * OS + sg * 16) * 4);
              f32x4 x0 = op[0], x1 = op[1], x2 = op[2], x3 = op[3];
              float s1 = ((x0.x + x0.y) + (x0.z + x0.w)) + ((x1.x + x1.y) + (x1.z + x1.w)) + ((x2.x + x2.y) + (x2.z + x2.w)) + ((x3.x + x3.y) + (x3.z + x3.w));
              s1 += __shfl_xor(s1, 1); s1 += __shfl_xor(s1, 2); s1 += __shfl_xor(s1, 4);
              const float mu = s1 * (1.0f / 128.0f); x0 = x0 - mu; x1 = x1 - mu; x2 = x2 - mu; x3 = x3 - mu;
              float s2 = ((x0.x * x0.x + x0.y * x0.y) + (x0.z * x0.z + x0.w * x0.w)) + ((x1.x * x1.x + x1.y * x1.y) + (x1.z * x1.z + x1.w * x1.w)) + ((x2.x * x2.x + x2.y * x2.y) + (x2.z * x2.z + x2.w * x2.w)) + ((x3.x * x3.x + x3.y * x3.y) + (x3.z * x3.z + x3.w * x3.w));
              s2 += __shfl_xor(s2, 1); s2 += __shfl_xor(s2, 2); s2 += __shfl_xor(s2, 4);
              const float rstd = rsqrtf(s2 * (1.0f / 128.0f) + GN_EPS);
              const size_t trow = row0 + j * 64 + q; const u32x4 g0 = *(const u32x4*)(SG + trow * 512 + h * 128 + sg * 16), g1 = *(const u32x4*)(SG + trow * 512 + h * 128 + sg * 16 + 8);
              u32x4 o0, o1;
              o0.x = cvtpk(x0.x * rstd * bflo(g0.x), x0.y * rstd * bfhi(g0.x)); o0.y = cvtpk(x0.z * rstd * bflo(g0.y), x0.w * rstd * bfhi(g0.y));
              o0.z = cvtpk(x1.x * rstd * bflo(g0.z), x1.y * rstd * bfhi(g0.z)); o0.w = cvtpk(x1.z * rstd * bflo(g0.w), x1.w * rstd * bfhi(g0.w));
              o1.x = cvtpk(x2.x * rstd * bflo(g1.x), x2.y * rstd * bfhi(g1.x)); o1.y = cvtpk(x2.z * rstd * bflo(g1.y), x2.w * rstd * bfhi(g1.y));
              o1.z = cvtpk(x3.x * rstd * bflo(g1.z), x3.y * rstd * bfhi(g1.z)); o1.w = cvtpk(x3.z * rstd * bflo(g1.w), x3.w * rstd * bfhi(g1.w));
              *(u32x4*)(MIX + trow * 1024 + h * 128 + sg * 16) = o0; *(u32x4*)(MIX + trow * 1024 + h * 128 + sg * 16 + 8) = o1; }
        }
    }
    if (!APPLY) {
        float* dst = GST + ((((size_t)(bh * 16 + g) * 8 + w) * 2) * 16) * 64 + lane;
#pragma unroll
        for (int r = 0; r < 16; ++r) { dst[r * 64] = S0[r]; dst[(16 + r) * 64] = S1[r]; }
    }
    LDS_WAIT(); __builtin_amdgcn_s_barrier();
}
}


#define XB_TMO      128
#define XB_XCNT(j)  (256  + 64 * (j))
#define XB_XSUB(j)  (1280 + 64 * (j))
#define XB_XGEN(j)  (2304 + 64 * (j))
#define XB_TOP      3328
#define XB_TOPGEN   3392
#define XCD_BAR_WORDS 3456
#define XB_SPIN_CAP (1u << 18)
__device__ __forceinline__ unsigned xb_ld(unsigned* p)              { return __hip_atomic_load(p, __ATOMIC_RELAXED, __HIP_MEMORY_SCOPE_AGENT); }
__device__ __forceinline__ unsigned xb_add(unsigned* p, unsigned v) { return __hip_atomic_fetch_add(p, v, __ATOMIC_RELAXED, __HIP_MEMORY_SCOPE_AGENT); }
__device__ __forceinline__ unsigned xb_xcc_id() { return (unsigned)__builtin_amdgcn_s_getreg((3 << 11) | 20) & 0xFu; }
#define XB_SPIN(cond, bar) do { unsigned _sp = 0; while (cond) { __builtin_amdgcn_s_sleep(1); \
    if ((++_sp & 255u) == 0u) { if (xb_ld(&(bar)[XB_TMO])) break; if (_sp > XB_SPIN_CAP) { atomicAdd(&(bar)[XB_TMO], 1u); break; } } } } while (0)
struct XcdBarrier { unsigned* bar; unsigned x; volatile LAS unsigned* st; };
__device__ __forceinline__ XcdBarrier xcd_barrier_post(unsigned* bar, volatile LAS unsigned* st) {
    XcdBarrier b; b.bar = bar; b.x = xb_xcc_id(); b.st = st;
    if (threadIdx.x == 0) (void)xb_add(&bar[XB_XCNT(b.x)], 1u);
    return b;
}
__device__ __forceinline__ void xcd_barrier_complete(unsigned* bar, unsigned x, unsigned& nloc, unsigned& nx) {
    const unsigned G = gridDim.x * gridDim.y * gridDim.z;
    unsigned sum, cnt, mine, sp = 0u;
    for (;;) {
        sum = 0u; cnt = 0u; mine = 0u;
#pragma unroll
        for (unsigned j = 0; j < 16; ++j) { const unsigned c = xb_ld(&bar[XB_XCNT(j)]); sum += c; cnt += (c > 0u) ? 1u : 0u; mine = (j == x) ? c : mine; }
        if (sum == G) break;
        __builtin_amdgcn_s_sleep(1);
        if ((++sp & 255u) == 0u) { if (xb_ld(&bar[XB_TMO])) break; if (sp > XB_SPIN_CAP) { atomicAdd(&bar[XB_TMO], 1u); break; } }
    }
    nloc = mine > 0u ? mine : 1u; nx = cnt > 0u ? cnt : 1u;
}
__device__ __forceinline__ void xcd_barrier(const XcdBarrier& b) {
    asm volatile("s_waitcnt vmcnt(0)" ::: "memory");
    __syncthreads();
    if (threadIdx.x == 0) {
        unsigned* bar = b.bar;
        __builtin_amdgcn_s_waitcnt(0);
        unsigned nloc = b.st[0], nx = b.st[1];
        if (nloc == 0u) { xcd_barrier_complete(bar, b.x, nloc, nx); b.st[0] = nloc; b.st[1] = nx; }
        const unsigned old = xb_add(&bar[XB_XSUB(b.x)], 1u);
        const unsigned gen = old / nloc;
        if (old + 1u == (gen + 1u) * nloc) {
            __builtin_amdgcn_fence(__ATOMIC_RELEASE, "agent");
            asm volatile("s_waitcnt vmcnt(0)" ::: "memory");
            const unsigned og = xb_add(&bar[XB_TOP], 1u);
            const unsigned tg = og / nx;
            if (og + 1u == (tg + 1u) * nx) xb_add(&bar[XB_TOPGEN], 1u);
            else XB_SPIN(xb_ld(&bar[XB_TOPGEN]) == tg, bar);
            __builtin_amdgcn_fence(__ATOMIC_ACQUIRE, "agent");
            xb_add(&bar[XB_XGEN(b.x)], 1u);
            asm volatile("s_waitcnt vmcnt(0)" ::: "memory");
        } else {
            XB_SPIN(xb_ld(&bar[XB_XGEN(b.x)]) == gen, bar);
            __builtin_amdgcn_fence(__ATOMIC_ACQUIRE, "agent");
            asm volatile("s_waitcnt vmcnt(0)" ::: "memory");
        }
    }
    __syncthreads();
}

struct Frame {
    LAS unsigned char* lds; int tid, lane, wave, vcu, G;
    __device__ __forceinline__ void refresh() { int t = threadIdx.x; asm volatile("" : "+v"(t)); tid = t; lane = t & 63; }
};

__device__ __forceinline__ void tr_item(const float* __restrict__ W, int ldw, int k0, int n0, const float* __restrict__ gk, bf16_t* WT, int kind, LAS unsigned* scr, int lane) {
    const int nch = lane & 15, kq = lane >> 4;
    f32x4 a[8], b[8];
#pragma unroll
    for (int i = 0; i < 8; ++i) { const int kp = 4 * i + kq; const float* p = W + (size_t)(k0 + 2 * kp) * ldw + n0 + 4 * nch; a[i] = *(const f32x4*)p; b[i] = *(const f32x4*)(p + ldw); }
#pragma unroll
    for (int i = 0; i < 8; ++i) { const int kp = 4 * i + kq; float ga = 1.f, gb = 1.f; if (gk) { ga = gk[k0 + 2 * kp]; gb = gk[k0 + 2 * kp + 1]; }
#pragma unroll
        for (int e = 0; e < 4; ++e) scr[(4 * nch + e) * 36 + kp] = cvtpk(a[i][e] * ga, b[i][e] * gb); }
    LDS_WAIT(); asm volatile("" ::: "memory");
    const int c = lane & 7, nr = lane >> 3;
#pragma unroll
    for (int j = 0; j < 8; ++j) { const int n = nr + 8 * j; const u32x4 v = *(const LAS u32x4*)(scr + n * 36 + 4 * c);
        const int cn = n0 + n; const int row = (kind == 0) ? pos_inproj(cn) : (kind == 1) ? pos_plain(cn) : pos_w1(cn);
        *(u32x4*)(WT + (size_t)row * 1024 + k0 + 8 * c) = v; }
    LDS_WAIT(); asm volatile("" ::: "memory");
}

struct Tr8Item { const float* W; unsigned char* WT; const float* gk; int ldw, k0, n0, kind; };
__device__ __forceinline__ Tr8Item tr8_decode(int r, const Params& P, unsigned char* W1T, unsigned char* W2T) {
    constexpr int I_1 = 32 * 16 * 32; Tr8Item t;
    if (r < I_1) { const int e = r >> 9, rr = r & 511; t.W = P.w1 + (size_t)e * 1024 * 2048; t.ldw = 2048; t.k0 = 64 * (rr / 32); t.n0 = 64 * (rr % 32); t.gk = P.g_ffn; t.WT = W1T + (size_t)e * 2048 * 1024; t.kind = 2; }
    else { r -= I_1; const int e = r >> 8, rr = r & 255; t.W = P.w2 + (size_t)e * 1024 * 1024; t.ldw = 1024; t.k0 = 64 * (rr / 16); t.n0 = 64 * (rr % 16); t.gk = nullptr; t.WT = W2T + (size_t)e * 1024 * 1024; t.kind = 1; }
    return t;
}
__device__ __forceinline__ void tr8_load(const Tr8Item& t, f32x4 (&a)[4][4], int lane) {
    const int nch = lane & 15, kq4 = lane >> 4;
#pragma unroll
    for (int i = 0; i < 4; ++i) { const int kq = 4 * i + kq4; const float* p = t.W + (size_t)(t.k0 + 4 * kq) * t.ldw + t.n0 + 4 * nch;
#pragma unroll
        for (int r = 0; r < 4; ++r) a[i][r] = __builtin_nontemporal_load((const f32x4*)(p + (size_t)r * t.ldw)); }
}
__device__ __forceinline__ void tr8_proc(const Tr8Item& t, const f32x4 (&a)[4][4], LAS unsigned* scr, int lane) {
    const int nch = lane & 15, kq4 = lane >> 4;
#pragma unroll
    for (int i = 0; i < 4; ++i) { const int kq = 4 * i + kq4; float g[4];
#pragma unroll
        for (int r = 0; r < 4; ++r) g[r] = (t.gk ? t.gk[t.k0 + 4 * kq + r] : 1.0f) * W_SCALE;
#pragma unroll
        for (int e = 0; e < 4; ++e) scr[(4 * nch + e) * 20 + kq] = pk4_fp8(a[i][0][e] * g[0], a[i][1][e] * g[1], a[i][2][e] * g[2], a[i][3][e] * g[3]); }
    LDS_WAIT(); asm volatile("" ::: "memory");
    const int c = lane & 3, nr = lane >> 2;
#pragma unroll
    for (int j = 0; j < 4; ++j) { const int n = nr + 16 * j; const u32x4 v = *(const LAS u32x4*)(scr + n * 20 + 4 * c);
        const int cn = t.n0 + n; const int row = (t.kind == 1) ? pos_plain(cn) : pos_w1(cn);
        *(u32x4*)(t.WT + (size_t)row * 1024 + t.k0 + 16 * c) = v; }
    LDS_WAIT(); asm volatile("" ::: "memory");
}

__global__ void __launch_bounds__(NTHREADS, 2) mk_fwd(Params P) {
    __builtin_assume(__builtin_amdgcn_workitem_id_y() == 0); __builtin_assume(__builtin_amdgcn_workitem_id_z() == 0);
    extern __shared__ __attribute__((aligned(16))) unsigned char lds_raw[];
    cg::grid_group grid = cg::this_grid();
    Frame F; F.lds = (LAS unsigned char*)lds_raw; F.tid = threadIdx.x; F.lane = F.tid & 63; F.wave = __builtin_amdgcn_readfirstlane(F.tid >> 6);
    F.G = gridDim.x; { const int bx = blockIdx.x; F.vcu = (F.G % 8 == 0) ? (bx % 8) * (F.G / 8) + bx / 8 : bx; }
    unsigned char* ws = P.ws;
    unsigned* ctl = (unsigned*)(ws + WS_CTL);
    float* ropec = (float*)(ws + WS_ROPEC); float* ropes = (float*)(ws + WS_ROPES);
    float* wr3 = (float*)(ws + WS_WR3); float* logf2 = (float*)(ws + WS_LOGF); float* F2 = (float*)(ws + WS_F2);
    int* ltok = (int*)(ws + WS_LTOK); float* lrstd = (float*)(ws + WS_LRSTD); int* inv = (int*)(ws + WS_INV); float* gates = (float*)(ws + WS_GATE);
    bf16_t* H1B = (bf16_t*)(ws + WS_H1B); bf16_t* WinT = (bf16_t*)(ws + WS_WINT); bf16_t* WoT = (bf16_t*)(ws + WS_WOT);
    unsigned char* W2T = ws + WS_W2T; unsigned char* W1T = ws + WS_W1T; unsigned char* Yb = ws + WS_Y; unsigned char* H1F8 = ws + WS_H1F8;
    bf16_t* U = (bf16_t*)(ws + WS_U); unsigned char* proj = ws + WS_PROJ;
    bf16_t* RQ = (bf16_t*)(proj); bf16_t* RK = (bf16_t*)(proj + PROJ_STRIDE); bf16_t* RV = (bf16_t*)(proj + 2 * PROJ_STRIDE); bf16_t* SG = (bf16_t*)(proj + 3 * PROJ_STRIDE);
    bf16_t* FQ = (bf16_t*)(proj + 4 * PROJ_STRIDE); bf16_t* FK = (bf16_t*)(proj + 5 * PROJ_STRIDE); bf16_t* FV = (bf16_t*)(proj + 6 * PROJ_STRIDE);
    float* GST = (float*)(ws + WS_GST); bf16_t* MIX = (bf16_t*)(ws + WS_MIX); unsigned char* Hb = ws + WS_H;
    const int lo = P.ph_lo, hi_ph = P.ph_hi;
#ifndef MK_PHMASK
#define MK_PHMASK 0x1ff
#endif
#define IN(k) (((MK_PHMASK >> (k)) & 1) && lo <= (k) && (k) < hi_ph)
#define REP(k) for (int rep_ = 0; rep_ < ((MK_DUP == (k)) ? 2 : 1); ++rep_)
#ifndef MK_CG_MASK
#define MK_CG_MASK 0x01
#endif
#define SEAM(k) do { if (IN(k) && IN((k) + 1)) { if ((MK_CG_MASK >> (k)) & 1) grid.sync(); else xcd_barrier(xbar); } } while (0)
    const int gw = F.vcu * NWAVES + F.wave, NGW = F.G * NWAVES;
    volatile LAS unsigned* misc = (volatile LAS unsigned*)(F.lds + LDS_MISC);
    if (F.tid < 4) misc[F.tid] = 0u;
    __syncthreads();
    XcdBarrier xbar = xcd_barrier_post(ctl + CW_BAR, misc);

    if (IN(0)) REP(0) {
        F.refresh();
        LAS unsigned* scr = (LAS unsigned*)(F.lds + F.wave * 9216);
        LAS float* wfl = (LAS float*)(F.lds + 73728);
        for (int i = F.tid; i < 8192; i += NTHREADS) { const int hh = i & 7, k = i >> 3; wfl[hh * 1024 + k] = P.w_in[(size_t)k * INW + NPROJ + hh]; }
        constexpr int I_IN = 16 * 56, I_O = 16 * 16, I_8 = 32 * 16 * 32 + 32 * 16 * 16;
        for (int it = gw; it < I_IN + I_O; it += NGW) {
            if (it < I_IN) tr_item(P.w_in, INW, 64 * (it / 56), 64 * (it % 56), nullptr, WinT, 0, scr, F.lane);
            else { const int r = it - I_IN; tr_item(P.w_out, 1024, 64 * (r / 16), 64 * (r % 16), nullptr, WoT, 1, scr, F.lane); }
        }
        {
            f32x4 ra[4][4], rb[4][4]; int it = gw;
            if (it < I_8) { Tr8Item ta = tr8_decode(it, P, W1T, W2T); tr8_load(ta, ra, F.lane);
                for (;;) {
                    const int itb = it + NGW; const bool hb = itb < I_8; Tr8Item tb = ta;
                    if (hb) { tb = tr8_decode(itb, P, W1T, W2T); tr8_load(tb, rb, F.lane); }
                    tr8_proc(ta, ra, scr, F.lane);
                    if (!hb) break;
                    it = itb + NGW; const bool ha = it < I_8;
                    if (ha) { ta = tr8_decode(it, P, W1T, W2T); tr8_load(ta, ra, F.lane); }
                    tr8_proc(tb, rb, scr, F.lane);
                    if (!ha) break;
                }
            }
        }
        __syncthreads();
        {
            const f32x4* gr = (const f32x4*)P.g_mix + F.lane;
            f32x4 v[4], vn[4]; int m = gw;
            if (m < T) {
                { const f32x4* xr = (const f32x4*)(P.x + (size_t)m * DM) + F.lane;
#pragma unroll
                  for (int j = 0; j < 4; ++j) v[j] = __builtin_nontemporal_load(xr + 64 * j); }
                for (;;) {
                    const int mn = m + NGW; const bool hn = mn < T;
                    if (hn) { const f32x4* xr = (const f32x4*)(P.x + (size_t)mn * DM) + F.lane;
#pragma unroll
                        for (int j = 0; j < 4; ++j) vn[j] = __builtin_nontemporal_load(xr + 64 * j); }
                    float ss = 0.f;
#pragma unroll
                    for (int j = 0; j < 4; ++j) ss += (v[j].x * v[j].x + v[j].y * v[j].y) + (v[j].z * v[j].z + v[j].w * v[j].w);
                    const float rstd = rsqrtf(wave_sum(ss) * (1.0f / DM) + RMS_EPS);
                    float z[8];
#pragma unroll
                    for (int hh = 0; hh < 8; ++hh) z[hh] = 0.f;
                    unsigned long long* o8 = (unsigned long long*)(U + (size_t)m * DM) + F.lane;
#pragma unroll
                    for (int j = 0; j < 4; ++j) { v[j] = v[j] * rstd * gr[64 * j];
                        o8[64 * j] = (unsigned long long)cvtpk(v[j].x, v[j].y) | ((unsigned long long)cvtpk(v[j].z, v[j].w) << 32);
#pragma unroll
                        for (int hh = 0; hh < 8; ++hh) { const f32x4 w4 = *(const LAS f32x4*)(wfl + hh * 1024 + 4 * F.lane + 256 * j); z[hh] += (v[j].x * w4.x + v[j].y * w4.y) + (v[j].z * w4.z + v[j].w * w4.w); } }
#pragma unroll
                    for (int hh = 0; hh < 8; ++hh) z[hh] = wave_sum(z[hh]);
                    float zz = z[0];
#pragma unroll
                    for (int hh = 1; hh < 8; ++hh) zz = (F.lane == hh) ? z[hh] : zz;
                    if (F.lane < 8) { const float xx = zz + P.b_forget[F.lane]; const float lf = fminf(xx, 0.f) - log1pf(__expf(-fabsf(xx))); logf2[(size_t)m * 8 + F.lane] = lf * LOG2E; }
                    if (!hn) break;
                    m = mn;
#pragma unroll
                    for (int j = 0; j < 4; ++j) v[j] = vn[j];
                }
            }
        }
        for (int idx = blockIdx.x * NTHREADS + F.tid; idx < SEQ * 64; idx += F.G * NTHREADS) {
            const int pos = idx >> 6, i = idx & 63; const float invf = exp2f(-(float)i * (13.287712379549449f / 64.0f));
            const float ang = (float)pos * invf; double tt = (double)ang * 0.15915494309189535; tt -= __builtin_rint(tt); const float tf = (float)tt;
            ropec[idx] = __builtin_amdgcn_cosf(tf); ropes[idx] = __builtin_amdgcn_sinf(tf);
        }
        for (int idx = blockIdx.x * NTHREADS + F.tid; idx < 32768; idx += F.G * NTHREADS) {
            const int s = idx & 3, e16 = (idx >> 2) & 15, half = (idx >> 6) & 1, kq = (idx >> 7) & 3, c = idx >> 9; const int k = 16 * c + 4 * kq + s, e = 16 * half + e16;
            wr3[idx] = P.w_router[k * 32 + e] * P.g_ffn[k];
        }
    }
    SEAM(0);

    if (IN(1)) {
        F.refresh();
        pg8::DenseOrder S; S.init(T, NPROJ, DM, F.G, (int)blockIdx.x, (MK_DUP == 1) ? 2 : 1);
        EpiInProj E{proj, ropec, ropes, ctl};
        pg8::gemm_phase<EpiInProj, pg8::DenseOrder, true, true, 2>(F.lds, U, WinT, DM, S, E);
    }
    SEAM(1);

    if (IN(2)) REP(2) {
        F.refresh();
        for (int u = F.vcu; u < 256; u += F.G) ret::unit<false>(u >> 4, u & 15, RQ, RK, RV, SG, GST, MIX, (LAS char*)F.lds);
        for (int bh = F.vcu; bh < 32; bh += F.G) {
            const int b = bh >> 3, h = bh & 7; LAS double* sd = (LAS double*)F.lds;
            double loc[16]; double run = 0.0;
#pragma unroll
            for (int i = 0; i < 16; ++i) { run += (double)logf2[((size_t)b * SEQ + 16 * F.tid + i) * 8 + h]; loc[i] = run; }
            double incl = run;
#pragma unroll
            for (int o = 1; o < 64; o <<= 1) { const double t = __shfl_up(incl, o); if (F.lane >= o) incl += t; }
            __syncthreads();
            if (F.lane == 63) sd[F.wave] = incl;
            __syncthreads();
            double off = incl - run;
            for (int w2 = 0; w2 < F.wave; ++w2) off += sd[w2];
            LAS float* Fsl = (LAS float*)(F.lds + 4096);
#pragma unroll
            for (int i = 0; i < 16; ++i) { const float fv = (float)(off + loc[i]); F2[(size_t)bh * SEQ + 16 * F.tid + i] = fv; Fsl[16 * F.tid + i] = fv; }
            __syncthreads();
            if (F.tid < 32) { const int qb = F.tid, q0 = 256 * qb, NT = 4 * qb + 4;
                const float qn = __uint_as_float(ctl[CW_QN2 + bh * 2]) + __uint_as_float(ctl[CW_QN2 + bh * 2 + 1]), kn = __uint_as_float(ctl[CW_KN2 + bh * 2]) + __uint_as_float(ctl[CW_KN2 + bh * 2 + 1]);
                const float target = Fsl[q0] + PRUNE_TH + 2.0f * 1.0201f * sqrtf(qn * kn);
                int lo_ = 0, hi_ = NT - 4;
                while (lo_ < hi_) { const int mid = (lo_ + hi_) >> 1; if (Fsl[64 * mid + 63] >= target) lo_ = mid + 1; else hi_ = mid; }
                const int ts = lo_ & ~1, NS = NT - ts;
                ctl[CW_UTS + bh * 32 + qb] = (unsigned)ts; ctl[CW_UPOS + bh * 32 + qb] = atomicAdd(ctl + CW_BIN + (NS >> 1), 1u); }
            __syncthreads();
        }
    }
    SEAM(2);

    if (IN(3)) REP(3) {
        F.refresh();
        REP(31) for (int u = F.vcu; u < 256; u += F.G) ret::unit<true>(u >> 4, u & 15, RQ, RK, RV, SG, GST, MIX, (LAS char*)F.lds);
        LAS int* qst = (LAS int*)(F.lds + 120832); LAS int* qlist = qst + 128; LAS int* qsh = qst + 100;
        if (F.tid == 0) { int a = 0; for (int k = 64; k >= 2; --k) { qst[k] = a; a += (int)ctl[CW_BIN + k]; } }
        __syncthreads();
        for (int u = F.tid; u < 1024; u += NTHREADS) { const int ts = (int)ctl[CW_UTS + u], NS = 4 * (u & 31) + 4 - ts; qlist[qst[NS >> 1] + (int)ctl[CW_UPOS + u]] = u | (ts << 16); }
        __syncthreads();
        for (;;) {
            if (F.tid == 0) qsh[0] = (int)atomicAdd(ctl + CW_QHEAD, 1u);
            __syncthreads();
            int idx = qsh[0];
            if (idx >= ((MK_DUP == 30) ? 2048 : 1024)) break;
            idx &= 1023;
            const int uu = qlist[idx]; const int u = uu & 0xffff, ts = uu >> 16; const int bh = u >> 5, qb = u & 31;
            attn_body::attn_unit<8>(bh >> 3, bh & 7, qb, ts, FQ, FK, FV, MIX + 512, F2, (char*)lds_raw);
        }
    }
    SEAM(3);

    if (IN(4)) {
        F.refresh();
        pg8::DenseOrder S; S.init(T, DM, DM, F.G, (int)blockIdx.x, (MK_DUP == 4) ? 2 : 1);
        EpiOutProj E{P.x, H1B, H1F8};
        pg8::gemm_phase<EpiOutProj, pg8::DenseOrder, true, true, 2>(F.lds, MIX, WoT, DM, S, E);
    }
    SEAM(4);

    if (IN(5)) {
        F.refresh();
        LAS float* wl = (LAS float*)F.lds;
        LAS float* lg = (LAS float*)(F.lds + 131072);
        LAS float* ssb = (LAS float*)(F.lds + 131072 + 128 * 33 * 4);
        LAS int* ecnt = (LAS int*)(F.lds + 131072 + 128 * 33 * 4 + 512);
        LAS int* ebase = ecnt + 32;
        for (int i = F.tid; i < 8192; i += NTHREADS) ((LAS f32x4*)wl)[i] = ((const f32x4*)wr3)[i];
        for (int tb = blockIdx.x; tb < T / 128; tb += F.G) {
            if (F.tid < 32) ecnt[F.tid] = 0;
            __syncthreads();
            const int tok16 = F.lane & 15, kq = F.lane >> 4; const int tokw = tb * 128 + F.wave * 16 + tok16;
            const bf16_t* hrow = H1B + (size_t)tokw * DM + 4 * kq;
            f32x4 a0 = {0.f, 0.f, 0.f, 0.f}, a1 = {0.f, 0.f, 0.f, 0.f}; float ss = 0.f;
#pragma unroll 8
            for (int c = 0; c < 64; ++c) {
                const u32x2 hv = *(const u32x2*)(hrow + 16 * c); const float av[4] = {bflo(hv.x), bfhi(hv.x), bflo(hv.y), bfhi(hv.y)};
                const f32x4 w0 = *(const LAS f32x4*)(wl + (((c * 4 + kq) * 2 + 0) * 16 + tok16) * 4), w1 = *(const LAS f32x4*)(wl + (((c * 4 + kq) * 2 + 1) * 16 + tok16) * 4);
#pragma unroll
                for (int s = 0; s < 4; ++s) { ss += av[s] * av[s]; a0 = __builtin_amdgcn_mfma_f32_16x16x4f32(av[s], w0[s], a0, 0, 0, 0); a1 = __builtin_amdgcn_mfma_f32_16x16x4f32(av[s], w1[s], a1, 0, 0, 0); }
            }
            ss += __shfl_xor(ss, 16); ss += __shfl_xor(ss, 32);
            if (kq == 0) ssb[F.wave * 16 + tok16] = ss;
#pragma unroll
            for (int r = 0; r < 4; ++r) { const int tk = F.wave * 16 + kq * 4 + r; lg[tk * 33 + tok16] = a0[r]; lg[tk * 33 + 16 + tok16] = a1[r]; }
            __syncthreads();
            int esel[4] = {0, 0, 0, 0}, rank[4] = {0, 0, 0, 0}; float gsel[4] = {0.f, 0.f, 0.f, 0.f}; float rstd = 0.f;
            if (F.tid < 128) {
                rstd = rsqrtf(ssb[F.tid] * (1.0f / DM) + RMS_EPS);
                float l[32];
#pragma unroll
                for (int e = 0; e < 32; ++e) l[e] = lg[F.tid * 33 + e] * rstd + P.b_router[e];
                float vs[4];
#pragma unroll
                for (int k = 0; k < 4; ++k) { float best = -INFINITY; int bi = 0;
#pragma unroll
                    for (int e = 0; e < 32; ++e) { const bool bt = l[e] > best; best = bt ? l[e] : best; bi = bt ? e : bi; }
                    vs[k] = best; esel[k] = bi;
#pragma unroll
                    for (int e = 0; e < 32; ++e) l[e] = (e == bi) ? -INFINITY : l[e]; }
                float den = 0.f;
#pragma unroll
                for (int k = 0; k < 4; ++k) { gsel[k] = __expf(vs[k] - vs[0]); den += gsel[k]; }
#pragma unroll
                for (int k = 0; k < 4; ++k) { gsel[k] /= den; rank[k] = atomicAdd((int*)&ecnt[esel[k]], 1); }
            }
            __syncthreads();
            if (F.tid < 32) ebase[F.tid] = (int)atomicAdd(ctl + CW_CNT + F.tid, (unsigned)ecnt[F.tid]);
            __syncthreads();
            if (F.tid < 128) { const int tok = tb * 128 + F.tid;
#pragma unroll
                for (int k = 0; k < 4; ++k) { const int e = esel[k], slot = ebase[e] + rank[k];
                    ltok[(size_t)e * CAP + slot] = tok; lrstd[(size_t)e * CAP + slot] = rstd; inv[tok * 4 + k] = (e << 16) | slot; gates[tok * 4 + k] = gsel[k]; } }
            __syncthreads();
        }
    }
    SEAM(5);

    if (IN(6) || IN(7)) {
        F.refresh();
        LAS int* boff = (LAS int*)(F.lds + 131072); LAS int* cntl = boff + 64;
        if (F.tid == 0) { int a = 0; for (int e = 0; e < 32; ++e) { const int c = (int)ctl[CW_CNT + e]; cntl[e] = c; boff[e] = a; a += (c + 255) >> 8; } boff[32] = a; }
        __syncthreads();
        LAS unsigned* tokl = (LAS unsigned*)(F.lds + 131072 + 1024);
        LAS bf16_t* biasl = (LAS bf16_t*)(F.lds + 131072 + 1024 + 17408);
        if (IN(6)) {
            MoeOrder<8, true> S0{boff, cntl, tokl, F.G, F.vcu};
            for (int p = 0; p < 9; ++p) { const int i = 2 * p + (F.tid >> 8), r = F.tid & 255; pg8::Unit u;
                if (i < 17 && S0.next(i, u)) { const int slot = u.lb * 256 + r; unsigned w = 0u;
                    if (slot < cntl[u.e]) w = (unsigned)ltok[(size_t)u.e * CAP + slot] | (cvtpk(0.f, lrstd[(size_t)u.e * CAP + slot]) & 0xffff0000u);
                    tokl[i * 256 + r] = w;
                    const int pnl = u.pn - u.e * 8; const float bv = P.b1[(size_t)u.e * 2048 + ((r < 128) ? (pnl * 128 + r) : (1024 + pnl * 128 + r - 128))];
                    biasl[i * 256 + r] = (bf16_t)(cvtpk(bv, bv) & 0xffffu); } }
            __syncthreads();
        }
        if (IN(6)) REP(6) {
        F.refresh();
            MoeOrder<8, true> S{boff, cntl, tokl, F.G, F.vcu};
            EpiMoe1 E{Hb, tokl, biasl};
            pg8::gemm_phase<EpiMoe1, MoeOrder<8, true>, true, true, 1>(F.lds, H1F8, W1T, DM, S, E);
        }
#if MK_DUP == 60
        if (IN(6)) { MoeOrder<8, true> S{boff, cntl, tokl, F.G, F.vcu}; EpiNull E{(float*)(ws + WS_GST)};
            pg8::gemm_phase<EpiNull, MoeOrder<8, true>, true, true, 1>(F.lds, H1F8, W1T, DM, S, E); }
#elif MK_DUP == 61
        if (IN(6)) { MoeOrder<8, false> S{boff, cntl, tokl, F.G, F.vcu}; EpiNull E{(float*)(ws + WS_GST)};
            pg8::gemm_phase<EpiNull, MoeOrder<8, false>, true, true, 1>(F.lds, H1F8, W1T, DM, S, E); }
#endif
        SEAM(6);
        if (IN(7)) {
            __syncthreads();
            MoeOrder<4, false> S0{boff, cntl, tokl, F.G, F.vcu};
            for (int p = 0; p < 5; ++p) { const int i = 2 * p + (F.tid >> 8), r = F.tid & 255; pg8::Unit u;
                if (i < 17 && S0.next(i, u)) { const int pnl = u.pn - u.e * 4; const float bv = P.b2[(size_t)u.e * DM + pnl * 256 + r]; biasl[i * 256 + r] = (bf16_t)(cvtpk(bv, bv) & 0xffffu); } }
            __syncthreads();
        }
        if (IN(7)) REP(7) {
        F.refresh();
            MoeOrder<4, false> S{boff, cntl, tokl, F.G, F.vcu};
            EpiMoe2 E{Yb, biasl};
            pg8::gemm_phase<EpiMoe2, MoeOrder<4, false>, true, true, 1>(F.lds, Hb, W2T, DM, S, E);
        }
    }
    SEAM(7);

    if (IN(8)) REP(8) {
        F.refresh();
        LAS int* boff = (LAS int*)(F.lds + 131072);
        __syncthreads();
        if (F.tid == 0) { int a = 0; for (int e = 0; e < 32; ++e) { const int c = (int)ctl[CW_CNT + e]; boff[e] = a; a += (c + 255) >> 8; } boff[32] = a; }
        __syncthreads();
        for (int m = gw; m < T; m += NGW) {
            float v[16];
            { const u32x4 a = *(const u32x4*)(H1B + (size_t)m * DM + 8 * F.lane), bq = *(const u32x4*)(H1B + (size_t)m * DM + 512 + 8 * F.lane);
#pragma unroll
              for (int e = 0; e < 4; ++e) { v[2 * e] = bflo(a[e]); v[2 * e + 1] = bfhi(a[e]); v[8 + 2 * e] = bflo(bq[e]); v[8 + 2 * e + 1] = bfhi(bq[e]); } }
#pragma unroll
            for (int k = 0; k < 4; ++k) { const int iv = inv[m * 4 + k]; const float gt = gates[m * 4 + k]; const int e = iv >> 16, slot = iv & 0xffff;
                const size_t yrow = (size_t)boff[e] * 256 + slot;
                const u32x2 a = *(const u32x2*)(Yb + yrow * DM + 8 * F.lane), bq = *(const u32x2*)(Yb + yrow * DM + 512 + 8 * F.lane); const float gs = gt * (1.0f / Y_SCALE);
#pragma unroll
                for (int q = 0; q < 2; ++q) { const f32x2 a0 = __builtin_amdgcn_cvt_pk_f32_fp8((int)a[q], false), a1 = __builtin_amdgcn_cvt_pk_f32_fp8((int)a[q], true), b0 = __builtin_amdgcn_cvt_pk_f32_fp8((int)bq[q], false), b1 = __builtin_amdgcn_cvt_pk_f32_fp8((int)bq[q], true);
                    v[4 * q] += gs * a0.x; v[4 * q + 1] += gs * a0.y; v[4 * q + 2] += gs * a1.x; v[4 * q + 3] += gs * a1.y;
                    v[8 + 4 * q] += gs * b0.x; v[8 + 4 * q + 1] += gs * b0.y; v[8 + 4 * q + 2] += gs * b1.x; v[8 + 4 * q + 3] += gs * b1.y; } }
            float ss = 0.f;
#pragma unroll
            for (int i = 0; i < 16; ++i) ss += v[i] * v[i];
            const float rstd = rsqrtf(wave_sum(ss) * (1.0f / DM) + RMS_EPS);
            const f32x4* gf = (const f32x4*)P.g_final; f32x4* op = (f32x4*)(P.out + (size_t)m * DM);
            const f32x4 g0 = gf[2 * F.lane], g1 = gf[2 * F.lane + 1], g2 = gf[128 + 2 * F.lane], g3 = gf[128 + 2 * F.lane + 1];
            op[2 * F.lane] = (f32x4){v[0], v[1], v[2], v[3]} * rstd * g0; op[2 * F.lane + 1] = (f32x4){v[4], v[5], v[6], v[7]} * rstd * g1;
            op[128 + 2 * F.lane] = (f32x4){v[8], v[9], v[10], v[11]} * rstd * g2; op[128 + 2 * F.lane + 1] = (f32x4){v[12], v[13], v[14], v[15]} * rstd * g3;
        }
    }
#undef IN
#undef SEAM
}

extern "C" void kernel_launch(void* const* d_in, const int* in_sizes, int n_in, void* d_out, int out_size, void* d_ws, size_t ws_size, hipStream_t stream) {
    static int grid = 0;
    if (grid == 0) {
        if (n_in != 13 || in_sizes[0] != T * DM || out_size != T * DM || ws_size < WS_END) { fprintf(stderr, "kernel_launch: unexpected shapes (n_in %d, in0 %d, out %d, ws %zu)\n", n_in, n_in > 0 ? in_sizes[0] : -1, out_size, ws_size); grid = -1; return; }
        int dev = 0, cus = 0, per_cu = 0;
        if (hipGetDevice(&dev) != hipSuccess || hipDeviceGetAttribute(&cus, hipDeviceAttributeMultiprocessorCount, dev) != hipSuccess) { fprintf(stderr, "kernel_launch: device query failed\n"); grid = -1; return; }
        if (hipFuncSetAttribute((const void*)mk_fwd, hipFuncAttributeMaxDynamicSharedMemorySize, LDS_BYTES) != hipSuccess) { fprintf(stderr, "kernel_launch: hipFuncSetAttribute failed\n"); grid = -1; return; }
        if (hipOccupancyMaxActiveBlocksPerMultiprocessor(&per_cu, (const void*)mk_fwd, NTHREADS, LDS_BYTES) != hipSuccess || per_cu < 1) { fprintf(stderr, "kernel_launch: occupancy query says %d\n", per_cu); per_cu = 1; }
        (void)hipGetLastError();
        grid = cus * 1;
        if (grid != 256) fprintf(stderr, "kernel_launch: %d CUs (built for 256)\n", grid);
    }
    if (grid < 0) return;
    (void)hipMemsetAsync((char*)d_ws + WS_CTL, 0, CTL_BYTES, stream);
    Params p{};
    const float** pin = (const float**)&p;
    for (int i = 0; i < 13; ++i) pin[i] = (const float*)d_in[i];
    p.out = (float*)d_out; p.ws = (unsigned char*)d_ws;
#if MK_N_LAUNCHES == 1
    p.ph_lo = 0; p.ph_hi = 9;
    void* args[] = {&p};
    hipError_t e = hipLaunchCooperativeKernel((const void*)mk_fwd, dim3(grid), dim3(NTHREADS), args, LDS_BYTES, stream);
    if (e != hipSuccess) fprintf(stderr, "kernel_launch: cooperative launch failed: %s (grid %d)\n", hipGetErrorString(e), grid);
#else
    for (int k = 0; k < 9; ++k) { p.ph_lo = k; p.ph_hi = k + 1; hipLaunchKernelGGL(mk_fwd, dim3(grid), dim3(NTHREADS), LDS_BYTES, stream, p); }
#endif
}
```

```cpp
#include <hip/hip_runtime.h>
#include <hip/hip_cooperative_groups.h>
#include <cstdio>
#include <cstdint>
namespace cg = cooperative_groups;

#ifndef MK_N_LAUNCHES
#define MK_N_LAUNCHES 1
#endif
#ifndef MK_DUP
#define MK_DUP -1
#endif
#ifndef MK_DIAG
#define MK_DIAG 0
#endif

#define LAS __attribute__((address_space(3)))
#define GAS __attribute__((address_space(1)))
typedef unsigned short bf16_t;
typedef short bf16x8 __attribute__((ext_vector_type(8)));
typedef short s16x4 __attribute__((ext_vector_type(4)));
typedef float f32x2 __attribute__((ext_vector_type(2)));
typedef float f32x4 __attribute__((ext_vector_type(4)));
typedef float f32x16 __attribute__((ext_vector_type(16)));
typedef unsigned u32x2 __attribute__((ext_vector_type(2)));
typedef unsigned u32x4 __attribute__((ext_vector_type(4)));
typedef __bf16 bf16x2_t __attribute__((ext_vector_type(2)));

constexpr int BATCH = 4, SEQ = 8192, DM = 1024, T = BATCH * SEQ;
constexpr int RH = 4, RD = 128, FH = 8, FD = 64;
constexpr int NPROJ = 3584, INW = 3592;
constexpr int NE = 32, TOPK = 4, DFF = 1024;
constexpr int CAP = T;
constexpr int NBMAX = (T * TOPK) / 256 + NE;
constexpr float RMS_EPS = 1e-5f, GN_EPS = 1e-5f;
constexpr float LOG2E = 1.4426950408889634f;
constexpr float PRUNE_TH = 40.0f;
constexpr float C2 = 0.125f * 1.4426950408889634f;
constexpr int NTHREADS = 512, NWAVES = 8;

constexpr size_t MiB = 1u << 20;
constexpr size_t WS_CTL = 0, CTL_BYTES = 32768;
constexpr size_t WS_ROPEC = 1 * MiB, WS_ROPES = 3 * MiB;
constexpr size_t WS_WR3 = 5 * MiB;
constexpr size_t WS_LOGF = 6 * MiB;
constexpr size_t WS_F2 = 7 * MiB;
constexpr size_t WS_FA = 20 * MiB;
constexpr size_t WS_LTOK = 8 * MiB;
constexpr size_t WS_LRSTD = 12 * MiB;
constexpr size_t WS_INV = 16 * MiB;
constexpr size_t WS_GATE = 17 * MiB;
constexpr size_t WS_ONES = 19 * MiB;
constexpr size_t WS_IRS1 = 18 * MiB;
constexpr size_t WS_H1B = 32 * MiB;
constexpr size_t WS_WINT = 96 * MiB;
constexpr size_t WS_WOT = 104 * MiB;
constexpr size_t WS_W2T = 112 * MiB;
constexpr size_t WS_W1T = 144 * MiB;
constexpr size_t WS_H1F8 = 208 * MiB;
constexpr size_t WS_U = 448 * MiB;
constexpr size_t WS_PROJ = 512 * MiB;
constexpr size_t PROJ_STRIDE = 32 * MiB;
constexpr size_t WS_GST = 736 * MiB;
constexpr size_t WS_MIX = 752 * MiB;
constexpr size_t WS_H = 448 * MiB;
constexpr size_t WS_Y = 584 * MiB;
constexpr size_t WS_END = 856 * MiB;
constexpr float W_SCALE = 128.0f, H_SCALE = 4.0f, Y_SCALE = 16.0f, MIX_SCALE = 4.0f;
constexpr int CW_CNT = 0;
constexpr int CW_DIAG = 64;
constexpr int CW_QN2 = 128, CW_KN2 = 192;
constexpr int CW_BIN = 256;
constexpr int CW_QHEAD = 384;
constexpr int CW_SCAN = 448;
constexpr int CW_GDONE = 512;
constexpr int CW_UTS = 1024, CW_UPOS = 2048;
constexpr int CW_BAR = 4096;


constexpr int LDS_BYTES = 163840;
constexpr int LDS_MISC = LDS_BYTES - 16;

__device__ __forceinline__ unsigned cvtpk(float lo, float hi) { f32x2 v = {lo, hi}; bf16x2_t b = __builtin_convertvector(v, bf16x2_t); return __builtin_bit_cast(unsigned, b); }
__device__ __forceinline__ float bf2f(unsigned short h) { return __uint_as_float(((unsigned)h) << 16); }
__device__ __forceinline__ float bflo(unsigned w) { return __uint_as_float(w << 16); }
__device__ __forceinline__ float bfhi(unsigned w) { return __uint_as_float(w & 0xffff0000u); }
__device__ __forceinline__ float wave_sum(float v) {
#pragma unroll
    for (int o = 1; o < 64; o <<= 1) v += __shfl_xor(v, o);
    return v;
}
template <int CTRL> __device__ __forceinline__ float dpp_mov(float v) { return __int_as_float(__builtin_amdgcn_update_dpp(0, __float_as_int(v), CTRL, 0xF, 0xF, true)); }
__device__ __forceinline__ float row16_sum(float v) {
    v += dpp_mov<0xB1>(v);
    v += dpp_mov<0x4E>(v);
    v += dpp_mov<0x141>(v);
    v += dpp_mov<0x140>(v);
    return v; }
__device__ __forceinline__ float wave_sum_dpp(float v) {
    v = row16_sum(v);
    const float r0 = __int_as_float(__builtin_amdgcn_readlane(__float_as_int(v), 0)), r1 = __int_as_float(__builtin_amdgcn_readlane(__float_as_int(v), 16));
    const float r2 = __int_as_float(__builtin_amdgcn_readlane(__float_as_int(v), 32)), r3 = __int_as_float(__builtin_amdgcn_readlane(__float_as_int(v), 48));
    return (r0 + r1) + (r2 + r3); }
#define LDS_WAIT() asm volatile("s_waitcnt lgkmcnt(0)" ::: "memory")
#define VM_WAIT() asm volatile("s_waitcnt vmcnt(0)" ::: "memory")

struct Params {
    const float *x, *g_mix, *w_in, *b_forget, *w_out, *g_ffn, *w_router, *b_router, *w1, *b1, *w2, *b2, *g_final;
    float* out; unsigned char* ws; int ph_lo, ph_hi;
};

namespace pg8 {
constexpr int BM = 256, BK = 64, HALF = 128, HTB = HALF * BK * 2, STAGE_BYTES = 8 * HTB, NXCD = 8, WGM = 8;
__host__ __device__ __forceinline__ int lds_byte(int r, int c) { const int st = (r >> 4) * 2 + (c >> 5), rr = r & 15, cc = c & 31, ob = rr * 64 + cc * 2; return st * 1024 + (ob ^ (((ob >> 9) & 1) << 5)); }
__host__ __device__ __forceinline__ void stage_rc(int b, int& R, int& C) { const int st = b / 1024, sb = b % 1024, swz = sb ^ (((sb >> 9) & 1) << 5); R = (st >> 1) * 16 + swz / 64; C = (st & 1) * 32 + (swz % 64) / 2; }

struct Unit { int pm, pn, e, lb, idx; };

template <int NM, int NN>
struct DenseOrder {
    static constexpr int nM = NM, nN = NN, nwg = NM * NN;
    int G, c; int K; int dup; int i0, i1;
    __device__ void init(int M, int N, int K_, int G_, int c_, int dup_ = 1) { (void)M; (void)N; G = G_; c = c_; K = K_; dup = dup_; i0 = 0; i1 = 1 << 30; }
    __device__ __forceinline__ bool next(int i_, Unit& u) const {
        const int i = i_ + i0; if (i >= i1) return false;
        const int L = i * G + c; if (L >= nwg * dup) return false;
        int wgid = L % nwg; { constexpr int q = nwg / NXCD, r = nwg % NXCD; const int xcd = wgid % NXCD, off = wgid / NXCD; wgid = (xcd < r ? xcd * (q + 1) : r * (q + 1) + (xcd - r) * q) + off; }
        static_assert(NM % WGM == 0, "row-tile groups are full");
        constexpr int nig = WGM * nN; const int gid = wgid / nig, fm = gid * WGM;
        u.pm = fm + ((wgid % nig) % WGM); u.pn = (wgid % nig) / WGM; u.e = 0; u.lb = 0; u.idx = i; return true;
    }
    __device__ __forceinline__ void aoffs(const Unit& u, unsigned (&ao)[2][2], const int (&R)[2], const int (&C)[2], int rowbytes) const {
#pragma unroll
        for (int h = 0; h < 2; ++h)
#pragma unroll
            for (int i = 0; i < 2; ++i) ao[h][i] = (unsigned)((u.pm * BM + h * HALF + R[i]) * rowbytes + C[i] * 2);
    }
};

typedef int v8i32 __attribute__((ext_vector_type(8)));
typedef int v4i32 __attribute__((ext_vector_type(4)));
template <class Epi, class Sched, bool ALIGN_EPI, bool SP2, int ES>
__device__ __forceinline__ void gemm_phase(LAS unsigned char* lds, const void* Abase, const void* Btbase, const int K, const Sched& S, const Epi& E) {
    const int tid = threadIdx.x, wid = __builtin_amdgcn_readfirstlane(tid >> 6), lane = tid & 63, wr = wid >> 2, wc = wid & 3, fr = lane & 15, fq = lane >> 4;
    const int rowbytes = K * ES;
    const int nt = rowbytes / 128;
    int RR[2], CC[2]; unsigned voffB[2];
#pragma unroll
    for (int i = 0; i < 2; ++i) { stage_rc(tid * 16 + i * 8192, RR[i], CC[i]); voffB[i] = (unsigned)(RR[i] * rowbytes + CC[i] * 2); }
    const size_t kstep = (size_t)128;
    const size_t hstep = (size_t)HALF * rowbytes;
    const size_t tstep = 2 * hstep;
    const unsigned ldsw = (unsigned)wid * 1024u;
    const int aoff = lds_byte(wr * 64 + fr, fq * 8), boff = lds_byte(wc * 32 + fr, fq * 8);
    const char* Ab = (const char*)Abase;
#define PG8_SA(b, h) (((b) * 2 + (h)) * HTB)
#define PG8_SB(b, h) ((4 + (b) * 2 + (h)) * HTB)
#define PG8_STAGE(bufoff, gbase, voff) do { _Pragma("unroll") for (int _i = 0; _i < 2; ++_i) \
        __builtin_amdgcn_global_load_lds((const unsigned*)((const char*)(gbase) + (voff)[_i]), (LAS unsigned*)(lds + (bufoff) + ldsw + _i * 8192), 16, 0, 0); } while (0)
#define PG8_STAGE_A(bufoff, kb, AO, h) do { _Pragma("unroll") for (int _i = 0; _i < 2; ++_i) \
        __builtin_amdgcn_global_load_lds((const unsigned*)(Ab + (kb) + (AO)[h][_i]), (LAS unsigned*)(lds + (bufoff) + ldsw + _i * 8192), 16, 0, 0); } while (0)
#define PG8_LDA(dst, b, h) do { _Pragma("unroll") for (int m = 0; m < 4; ++m) _Pragma("unroll") for (int k = 0; k < 2; ++k) dst[m][k] = *(const LAS bf16x8*)(lds + PG8_SA(b, h) + aoff + m * 2048 + k * 1024); } while (0)
#define PG8_LDB(dst, b, h) do { _Pragma("unroll") for (int n = 0; n < 2; ++n) _Pragma("unroll") for (int k = 0; k < 2; ++k) dst[n][k] = *(const LAS bf16x8*)(lds + PG8_SB(b, h) + boff + n * 2048 + k * 1024); } while (0)
#define PG8_F8(x) __builtin_shufflevector(__builtin_bit_cast(v4i32, (x)[0]), __builtin_bit_cast(v4i32, (x)[1]), 0, 1, 2, 3, 4, 5, 6, 7)
#define PG8_MMA(ai, bj, At, Bt) do { __builtin_amdgcn_s_setprio(1); _Pragma("unroll") for (int m = 0; m < 4; ++m) _Pragma("unroll") for (int n = 0; n < 2; ++n) { \
        if constexpr (ES == 2) { _Pragma("unroll") for (int k = 0; k < 2; ++k) acc[ai][bj][m][n] = __builtin_amdgcn_mfma_f32_16x16x32_bf16(Bt[n][k], At[m][k], acc[ai][bj][m][n], 0, 0, 0); } \
        else asm volatile("v_mfma_f32_16x16x128_f8f6f4 %0, %1, %2, %0" : "+v"(acc[ai][bj][m][n]) : "v"(PG8_F8(Bt[n])), "v"(PG8_F8(At[m]))); } \
        __builtin_amdgcn_s_setprio(0); } while (0)
#define PG8_WAIT_V(n) asm volatile("s_waitcnt vmcnt(" #n ")" ::: "memory")
#define PG8_WAIT_L(n) asm volatile("s_waitcnt lgkmcnt(" #n ")" ::: "memory")
#define PG8_BAR __builtin_amdgcn_s_barrier()
#define PG8_SCHED __builtin_amdgcn_sched_barrier(0)
    Unit cur, nxt; int ui = 0;
    if (!S.next(0, cur)) return;
    f32x4 acc[2][2][4][2];
#define PG8_ZERO() do { _Pragma("unroll") for (int a = 0; a < 2; ++a) _Pragma("unroll") for (int b = 0; b < 2; ++b) _Pragma("unroll") for (int m = 0; m < 4; ++m) _Pragma("unroll") for (int n = 0; n < 2; ++n) { \
        f32x2 z0_, z1_; asm volatile("v_mov_b64 %0, 0" : "=v"(z0_)); asm volatile("v_mov_b64 %0, 0" : "=v"(z1_)); acc[a][b][m][n] = (f32x4){z0_.x, z0_.y, z1_.x, z1_.y}; } } while (0)
    PG8_ZERO();
    bf16x8 At[4][2], B0[2][2], B1[2][2];
    unsigned aoC[2][2], aoN[2][2];
    S.aoffs(cur, aoC, RR, CC, rowbytes);
    const char* cB = (const char*)Btbase + (size_t)cur.pn * tstep;
    static_assert(SP2, "only the SP2 loop is kept");
    PG8_STAGE(PG8_SB(0, 0), cB, voffB); PG8_STAGE(PG8_SB(0, 1), cB + hstep, voffB); PG8_STAGE_A(PG8_SA(0, 0), 0, aoC, 0); PG8_STAGE_A(PG8_SA(0, 1), 0, aoC, 1);
    if (wr == 1) PG8_BAR;
    PG8_WAIT_V(2); PG8_BAR;
    PG8_STAGE(PG8_SB(1, 0), cB + kstep, voffB); PG8_STAGE_A(PG8_SA(1, 0), kstep, aoC, 0); PG8_STAGE(PG8_SB(1, 1), cB + hstep + kstep, voffB);
    PG8_WAIT_V(6); PG8_BAR;
    for (;;) {
        const bool has_next = S.next(ui + 1, nxt);
        if (has_next) S.aoffs(nxt, aoN, RR, CC, rowbytes);
        else {
#pragma unroll
            for (int h = 0; h < 2; ++h)
#pragma unroll
                for (int i = 0; i < 2; ++i) aoN[h][i] = aoC[h][i];
        }
        const char* nB = has_next ? (const char*)Btbase + (size_t)nxt.pn * tstep : cB;
#pragma unroll 1
        for (int t = 0; t < nt; t += 2) {
            const bool last = (t == nt - 2);
            const size_t kb1 = (size_t)(t + 1) * kstep;
            const size_t kb2 = last ? 0 : (size_t)(t + 2) * kstep, kb3 = kb2 + kstep;
            unsigned ao2[2][2];
#pragma unroll
            for (int h = 0; h < 2; ++h)
#pragma unroll
                for (int i = 0; i < 2; ++i) ao2[h][i] = last ? aoN[h][i] : aoC[h][i];
            const char* b2 = last ? nB : cB + (size_t)(t + 2) * kstep;
            const char* b3 = b2 + kstep;
            PG8_LDB(B0, 0, 0); PG8_LDB(B1, 0, 1); PG8_SCHED; PG8_LDA(At, 0, 0); PG8_STAGE_A(PG8_SA(1, 1), kb1, aoC, 1);
            PG8_WAIT_V(8); PG8_WAIT_L(0); PG8_BAR; PG8_MMA(0, 0, At, B0); PG8_MMA(0, 1, At, B1); PG8_BAR; PG8_SCHED;
            PG8_LDA(At, 0, 1); PG8_STAGE(PG8_SB(0, 0), b2, voffB); PG8_STAGE(PG8_SB(0, 1), b2 + hstep, voffB); PG8_STAGE_A(PG8_SA(0, 0), kb2, ao2, 0);
            PG8_WAIT_V(8); PG8_WAIT_L(0); PG8_BAR; PG8_MMA(1, 0, At, B0); PG8_MMA(1, 1, At, B1); PG8_BAR; PG8_SCHED;
            PG8_LDB(B0, 1, 0); PG8_LDB(B1, 1, 1); PG8_SCHED; PG8_LDA(At, 1, 0); PG8_STAGE_A(PG8_SA(0, 1), kb2, ao2, 1);
            PG8_WAIT_V(8); PG8_WAIT_L(0); PG8_BAR; PG8_MMA(0, 0, At, B0); PG8_MMA(0, 1, At, B1); PG8_BAR; PG8_SCHED;
            PG8_LDA(At, 1, 1); PG8_STAGE(PG8_SB(1, 0), b3, voffB); PG8_STAGE(PG8_SB(1, 1), b3 + hstep, voffB); PG8_STAGE_A(PG8_SA(1, 0), kb3, ao2, 0);
            PG8_WAIT_V(8); PG8_WAIT_L(0); PG8_BAR; PG8_MMA(1, 0, At, B0); PG8_MMA(1, 1, At, B1); PG8_BAR; PG8_SCHED;
        }
        if constexpr (ALIGN_EPI) { if (wr == 0) PG8_BAR; }
        if constexpr (ES == 1) asm volatile("s_nop 15\n\ts_nop 15" ::: "memory");
        E(acc, cur, wr, wc, fr, fq);
        if (!has_next) break;
        PG8_ZERO();
        cur = nxt; cB = nB; ++ui;
#pragma unroll
        for (int h = 0; h < 2; ++h)
#pragma unroll
            for (int i = 0; i < 2; ++i) aoC[h][i] = aoN[h][i];
        if constexpr (ALIGN_EPI) { if (wr == 1) PG8_BAR; }
    }
    PG8_WAIT_V(0);
    if constexpr (!ALIGN_EPI) { if (wr == 0) PG8_BAR; }
    PG8_BAR;
#undef PG8_ZERO
#undef PG8_SA
#undef PG8_SB
#undef PG8_STAGE
#undef PG8_STAGE_A
#undef PG8_LDA
#undef PG8_LDB
#undef PG8_MMA
#undef PG8_F8
#undef PG8_WAIT_V
#undef PG8_WAIT_L
#undef PG8_BAR
#undef PG8_SCHED
}
}


__device__ __forceinline__ int perm32_pos(int t) { return 16 * ((t >> 2) & 1) + 4 * ((t >> 3) & 3) + (t & 3); }
__device__ __forceinline__ int pos_inproj(int c) {
    if (c < 1024) { const int hc = c & 127; return (c & ~127) | (32 * ((hc >> 4) & 3) + 16 * (hc >> 6) + (hc & 15)); }
    return (c & ~31) | perm32_pos(c & 31);
}
__device__ __forceinline__ int pos_plain(int c) { return (c & ~31) | perm32_pos(c & 31); }
__device__ __forceinline__ int pos_wide(int c) { const int t = c & 255; return (c & ~255) | (128 * ((t >> 3) & 1) + 32 * (t >> 6) + 16 * ((t >> 2) & 1) + 4 * ((t >> 4) & 3) + (t & 3)); }
__device__ __forceinline__ int pos_w1(int n) { const int jj = n & 1023, lin = n >> 10, pn = jj >> 7, tp = jj & 127; return pn * 256 + lin * 128 + ((tp & ~31) | perm32_pos(tp & 31)); }

struct EpiInProj {
    unsigned char* proj; const float* ropec; const float* ropes; unsigned* ctl;
    __device__ __forceinline__ void operator()(const f32x4 (&acc)[2][2][4][2], const pg8::Unit& u, int wr, int wc, int fr, int fq) const {
        const int type = u.pn >> 1; bf16_t* base = (bf16_t*)(proj + (size_t)type * PROJ_STRIDE);
        const int colh = (u.pn & 1) * 256;
        if (type < 2) {
            const float sc = (type == 1) ? 0.08838834764831845f : 1.0f;
            const int i0 = 16 * wc + 4 * fq;
#pragma unroll
            for (int ai = 0; ai < 2; ++ai)
#pragma unroll
                for (int m = 0; m < 4; ++m) {
                    const int row = u.pm * 256 + ai * 128 + wr * 64 + m * 16 + fr; const int pos = row & (SEQ - 1);
                    const f32x4 cs = *(const f32x4*)(ropec + pos * 64 + i0), sn = *(const f32x4*)(ropes + pos * 64 + i0);
#pragma unroll
                    for (int bj = 0; bj < 2; ++bj) {
                        const f32x4 x1 = acc[ai][bj][m][0], x2 = acc[ai][bj][m][1];
                        const f32x4 o1 = (x1 * cs - x2 * sn) * sc, o2 = (x1 * sn + x2 * cs) * sc;
                        bf16_t* dst = base + (size_t)row * 512 + colh + bj * 128 + i0;
                        u32x2 w1, w2; w1.x = cvtpk(o1[0], o1[1]); w1.y = cvtpk(o1[2], o1[3]); w2.x = cvtpk(o2[0], o2[1]); w2.y = cvtpk(o2[2], o2[3]);
                        *(u32x2*)dst = w1; *(u32x2*)(dst + 64) = w2;
                    }
                }
        } else {
            const float sc = (type == 4) ? C2 : 1.0f;
            float mx[2] = {0.f, 0.f};
#pragma unroll
            for (int ai = 0; ai < 2; ++ai)
#pragma unroll
                for (int m = 0; m < 4; ++m) {
                    const int row = u.pm * 256 + ai * 128 + wr * 64 + m * 16 + fr;
#pragma unroll
                    for (int bj = 0; bj < 2; ++bj) {
                        f32x4 v0 = acc[ai][bj][m][0] * sc, v1 = acc[ai][bj][m][1] * sc;
                        if (type == 4 || type == 5) { float ssq = (v0[0] * v0[0] + v0[1] * v0[1]) + (v0[2] * v0[2] + v0[3] * v0[3]) + (v1[0] * v1[0] + v1[1] * v1[1]) + (v1[2] * v1[2] + v1[3] * v1[3]);
                            ssq += __shfl_xor(ssq, 16); ssq += __shfl_xor(ssq, 32); mx[bj] = fmaxf(mx[bj], ssq); }
                        if (type == 3) {
#pragma unroll
                            for (int j = 0; j < 4; ++j) { v0[j] = v0[j] * __builtin_amdgcn_rcpf(1.0f + __builtin_amdgcn_exp2f(-LOG2E * v0[j])); v1[j] = v1[j] * __builtin_amdgcn_rcpf(1.0f + __builtin_amdgcn_exp2f(-LOG2E * v1[j])); }
                        }
                        u32x4 w; w.x = cvtpk(v0[0], v0[1]); w.y = cvtpk(v0[2], v0[3]); w.z = cvtpk(v1[0], v1[1]); w.w = cvtpk(v1[2], v1[3]);
                        __builtin_nontemporal_store(w, (u32x4*)(base + (size_t)row * 512 + colh + bj * 128 + wc * 32 + 8 * fq));
                    }
                }
            if (type == 4 || type == 5) {
#pragma unroll
                for (int bj = 0; bj < 2; ++bj) { float v = mx[bj]; v = fmaxf(v, __shfl_xor(v, 1)); v = fmaxf(v, __shfl_xor(v, 2)); v = fmaxf(v, __shfl_xor(v, 4)); v = fmaxf(v, __shfl_xor(v, 8));
                    if ((threadIdx.x & 63) == 0) { const int bh = (u.pm >> 5) * 8 + (u.pn & 1) * 4 + bj * 2 + (wc >> 1);
                        atomicMax(ctl + ((type == 4) ? CW_QN2 : CW_KN2) + bh * 2 + (wc & 1), __float_as_uint(v)); } }
            }
        }
    }
};

__device__ __forceinline__ unsigned pk4_fp8(float a, float b, float c, float d) { int w = 0; w = __builtin_amdgcn_cvt_pk_fp8_f32(a, b, w, false); w = __builtin_amdgcn_cvt_pk_fp8_f32(c, d, w, true); return (unsigned)w; }
struct EpiOutProj {
    const bf16_t* U; const float* irs1; const float* g_mix; bf16_t* h1b; unsigned char* h1f8;
    __device__ __forceinline__ void operator()(const f32x4 (&acc)[2][2][4][2], const pg8::Unit& u, int wr, int wc, int fr, int fq) const {
        const int col = u.pn * 256 + 64 * wc + 16 * fq;
        f32x4 gi[2][2];
#pragma unroll
        for (int q = 0; q < 4; ++q) { f32x4 g = *(const f32x4*)(g_mix + col + 4 * q);
#pragma unroll
            for (int j = 0; j < 4; ++j) g[j] = __builtin_amdgcn_rcpf(g[j]);
            gi[q >> 1][q & 1] = g; }
#pragma unroll
        for (int ai = 0; ai < 2; ++ai) {
            u32x4 uw[4][2]; float ir[4];
#pragma unroll
            for (int m = 0; m < 4; ++m) { const int row = u.pm * 256 + ai * 128 + wr * 64 + m * 16 + fr; ir[m] = irs1[row];
                uw[m][0] = *(const u32x4*)(U + (size_t)row * DM + col); uw[m][1] = *(const u32x4*)(U + (size_t)row * DM + col + 8); }
#pragma unroll
            for (int m = 0; m < 4; ++m) {
                const int row = u.pm * 256 + ai * 128 + wr * 64 + m * 16 + fr; const float s = ir[m]; u32x4 wf8;
#pragma unroll
                for (int bj = 0; bj < 2; ++bj) { const u32x4 w4 = uw[m][bj];
                    const f32x4 xa = {bflo(w4.x), bfhi(w4.x), bflo(w4.y), bfhi(w4.y)}, xb = {bflo(w4.z), bfhi(w4.z), bflo(w4.w), bfhi(w4.w)};
                    const f32x4 v0 = acc[ai][bj][m][0] * (1.0f / (MIX_SCALE * W_SCALE)) + xa * gi[bj][0] * s, v1 = acc[ai][bj][m][1] * (1.0f / (MIX_SCALE * W_SCALE)) + xb * gi[bj][1] * s;
                    u32x4 w; w.x = cvtpk(v0[0], v0[1]); w.y = cvtpk(v0[2], v0[3]); w.z = cvtpk(v1[0], v1[1]); w.w = cvtpk(v1[2], v1[3]);
                    *(u32x4*)(h1b + (size_t)row * DM + col + 8 * bj) = w;
                    wf8[2 * bj] = pk4_fp8(v0[0], v0[1], v0[2], v0[3]); wf8[2 * bj + 1] = pk4_fp8(v1[0], v1[1], v1[2], v1[3]); }
                *(u32x4*)(h1f8 + (size_t)row * DM + col) = wf8;
            }
            asm volatile("" ::: "memory");
        }
    }
};

struct EpiMoe1 {
    unsigned char* H; const LAS unsigned* tokr; const LAS bf16_t* biasl;
    __device__ __forceinline__ void operator()(const f32x4 (&acc)[2][2][4][2], const pg8::Unit& u, int wr, int wc, int fr, int fq) const {
        const int e = u.e, pnl = u.pn - e * 8; const int cl = wc * 32 + 8 * fq, cq = pnl * 128 + cl;
        const u32x4 bgw = *(const LAS u32x4*)(biasl + u.idx * 256 + cl), blw = *(const LAS u32x4*)(biasl + u.idx * 256 + 128 + cl);
        constexpr float K1 = 1.702f * LOG2E;
        const f32x4 bg0 = (f32x4){bflo(bgw.x), bfhi(bgw.x), bflo(bgw.y), bfhi(bgw.y)} * K1, bg1 = (f32x4){bflo(bgw.z), bfhi(bgw.z), bflo(bgw.w), bfhi(bgw.w)} * K1;
        const f32x4 bl0 = {bflo(blw.x), bfhi(blw.x), bflo(blw.y), bfhi(blw.y)}, bl1 = {bflo(blw.z), bfhi(blw.z), bflo(blw.w), bfhi(blw.w)};
#pragma unroll
        for (int ai = 0; ai < 2; ++ai)
#pragma unroll
            for (int m = 0; m < 4; ++m) {
                const int rt = ai * 128 + wr * 64 + m * 16 + fr;
                const float rs = bfhi(tokr[u.idx * 256 + rt]) * (1.0f / W_SCALE);
                const float rk = rs * K1; float o[8];
                const f32x2 rk2 = {rk, rk}, rs2 = {rs, rs}, hk2 = {H_SCALE / K1, H_SCALE / K1}, one2 = {1.0f, 1.0f};
#pragma unroll
                for (int hh = 0; hh < 2; ++hh)
#pragma unroll
                    for (int jp = 0; jp < 2; ++jp) {
                        const f32x4 ag = acc[ai][0][m][hh], al = acc[ai][1][m][hh], bgv = hh ? bg1 : bg0, blv = hh ? bl1 : bl0;
                        const f32x2 ag2 = {ag[2 * jp], ag[2 * jp + 1]}, al2 = {al[2 * jp], al[2 * jp + 1]}, bg2 = {bgv[2 * jp], bgv[2 * jp + 1]}, bl2 = {blv[2 * jp], blv[2 * jp + 1]};
                        f32x2 gk = __builtin_elementwise_fma(ag2, rk2, bg2);
                        gk.x = __builtin_fminf(gk.x, 7.0f * K1); gk.y = __builtin_fminf(gk.y, 7.0f * K1);
                        f32x2 ex = {__builtin_amdgcn_exp2f(-gk.x), __builtin_amdgcn_exp2f(-gk.y)};
                        ex = ex + one2;
                        const f32x2 rc = {__builtin_amdgcn_rcpf(ex.x), __builtin_amdgcn_rcpf(ex.y)};
                        const f32x2 sg = gk * rc;
                        f32x2 l = __builtin_elementwise_fma(al2, rs2, bl2);
                        l.x = __builtin_fminf(__builtin_fmaxf(l.x, -7.0f), 7.0f); l.y = __builtin_fminf(__builtin_fmaxf(l.y, -7.0f), 7.0f);
                        const f32x2 ov = sg * __builtin_elementwise_fma(l, hk2, hk2);
                        o[4 * hh + 2 * jp] = ov.x; o[4 * hh + 2 * jp + 1] = ov.y;
                    }
                u32x2 w; w.x = pk4_fp8(o[0], o[1], o[2], o[3]); w.y = pk4_fp8(o[4], o[5], o[6], o[7]);
                *(u32x2*)(H + (size_t)(u.pm * 256 + rt) * DFF + cq) = w;
            }
    }
};

struct EpiNull { float* sink;
    __device__ __forceinline__ void operator()(const f32x4 (&acc)[2][2][4][2], const pg8::Unit& u, int wr, int wc, int fr, int fq) const {
        float s = 0.f;
#pragma unroll
        for (int ai = 0; ai < 2; ++ai)
#pragma unroll
            for (int bj = 0; bj < 2; ++bj)
#pragma unroll
                for (int m = 0; m < 4; ++m)
#pragma unroll
                    for (int n = 0; n < 2; ++n) s += acc[ai][bj][m][n][0];
        if (s == 123.456f) sink[0] = s;
    }
};
struct EpiMoe2 {
    unsigned char* Y; const LAS bf16_t* biasl;
    __device__ __forceinline__ void operator()(const f32x4 (&acc)[2][2][4][2], const pg8::Unit& u, int wr, int wc, int fr, int fq) const {
        const int e = u.e, pnl = u.pn - e * 4; const int cl = 64 * wc + 16 * fq, col = pnl * 256 + cl;
        const u32x4 bw0 = *(const LAS u32x4*)(biasl + u.idx * 256 + cl), bw1 = *(const LAS u32x4*)(biasl + u.idx * 256 + cl + 8);
        f32x4 bb[2][2];
        bb[0][0] = (f32x4){bflo(bw0.x), bfhi(bw0.x), bflo(bw0.y), bfhi(bw0.y)} * Y_SCALE; bb[0][1] = (f32x4){bflo(bw0.z), bfhi(bw0.z), bflo(bw0.w), bfhi(bw0.w)} * Y_SCALE;
        bb[1][0] = (f32x4){bflo(bw1.x), bfhi(bw1.x), bflo(bw1.y), bfhi(bw1.y)} * Y_SCALE; bb[1][1] = (f32x4){bflo(bw1.z), bfhi(bw1.z), bflo(bw1.w), bfhi(bw1.w)} * Y_SCALE;
#pragma unroll
        for (int ai = 0; ai < 2; ++ai)
#pragma unroll
            for (int m = 0; m < 4; ++m) {
                const int rt = ai * 128 + wr * 64 + m * 16 + fr; u32x4 w;
#pragma unroll
                for (int bj = 0; bj < 2; ++bj) { const f32x4 v0 = acc[ai][bj][m][0] * (Y_SCALE / (W_SCALE * H_SCALE)) + bb[bj][0], v1 = acc[ai][bj][m][1] * (Y_SCALE / (W_SCALE * H_SCALE)) + bb[bj][1];
                    w[2 * bj] = pk4_fp8(v0[0], v0[1], v0[2], v0[3]); w[2 * bj + 1] = pk4_fp8(v1[0], v1[1], v1[2], v1[3]); }
                *(u32x4*)(Y + (size_t)(u.pm * 256 + rt) * DM + col) = w;
            }
    }
};

template <int NT, bool GATHER>
struct MoeOrder {
    const LAS int* boff;
    const LAS int* cntl;
    const LAS unsigned* tokl;
    int G, vcu;
    __device__ __forceinline__ bool next(int i, pg8::Unit& u) const {
        int x, j, rpb;
        if (G == 256) { x = vcu >> 5; j = vcu & 31; rpb = 32 / NT; }
        else { const int cpx = G >> 3; x = vcu / cpx; j = vcu % cpx; rpb = cpx / NT; }
        const int rb = (i * 8 + x) * rpb + j / NT; const int nb = boff[32];
        if (rb >= nb) return false;
        const int bk = boff[__lane_id() & 31]; const int e = __builtin_popcount((unsigned)__ballot(bk <= rb)) - 1;
        u.pm = rb; u.e = e; u.lb = rb - boff[e]; u.pn = e * NT + (j % NT); u.idx = i; return true;
    }
    __device__ __forceinline__ void aoffs(const pg8::Unit& u, unsigned (&ao)[2][2], const int (&R)[2], const int (&C)[2], int rowbytes) const {
#pragma unroll
        for (int h = 0; h < 2; ++h)
#pragma unroll
            for (int i = 0; i < 2; ++i) {
                if constexpr (GATHER) {
                    const int tok = (int)(tokl[u.idx * 256 + h * 128 + R[i]] & 0xffffu);
                    ao[h][i] = (unsigned)(tok * rowbytes + C[i] * 2);
                } else ao[h][i] = (unsigned)((u.pm * 256 + h * 128 + R[i]) * rowbytes + C[i] * 2);
            }
    }
};

namespace attn_body {
constexpr int NHEAD = FH, D = 64, PQ = 512, PO = 1024;
constexpr int NW = 8, QBLK = 32, QB = QBLK * NW, KVBLK = 64, NQB = SEQ / QB;
__device__ __forceinline__ int crow(int r, int hi) { return (r & 3) + 8 * (r >> 2) + 4 * hi; }
#define SBAR() __builtin_amdgcn_sched_barrier(0)
__device__ __forceinline__ void cmask(f32x16& p0, f32x16& p1, int jb, int qrel, int hi) {
    const float NEG = -INFINITY; int kb = 64 * jb + 4 * hi;
#pragma unroll
    for (int r = 0; r < 16; ++r) { int kv = kb + (r & 3) + 8 * (r >> 2); if (kv > qrel) p0[r] = NEG; if (kv + 32 > qrel) p1[r] = NEG; }
}
constexpr int NSLOT = 3, SLOTB = 8192;
constexpr int LDS_K = 0, LDS_V = NSLOT * SLOTB, LDS_WS = 2 * NSLOT * SLOTB, LDS_OST = LDS_WS + NW * 64 * 4, LDS_END = LDS_OST + NW * 4096;
constexpr int LDS_STOP = 156672;
constexpr int LDS_QUEUE = 151552;
constexpr int LDS_F = 86016, LDS_F_BYTES = SEQ * 8;
static_assert(LDS_F >= LDS_END + 512 && LDS_F + LDS_F_BYTES <= LDS_QUEUE && LDS_QUEUE + 4608 <= LDS_STOP && LDS_STOP + 32 <= LDS_BYTES - 16, "attention LDS map");
__device__ __forceinline__ void glds16(const void* gsrc, unsigned lds_dst) { unsigned keep;
    asm volatile("s_mov_b32 %0, m0\n\ts_mov_b32 m0, %2\n\ts_nop 0\n\tglobal_load_lds_dwordx4 %1, off\n\ts_mov_b32 m0, %0" : "=&s"(keep) : "v"(gsrc), "s"(lds_dst) : "memory"); }
__device__ __forceinline__ float max3f(float a, float b, float c) { float r; asm("v_max3_f32 %0, %1, %2, %3" : "=v"(r) : "v"(a), "v"(b), "v"(c)); return r; }
__device__ __forceinline__ float max2f(float a, float b) { float r; asm("v_max_f32_e32 %0, %1, %2" : "=v"(r) : "v"(a), "v"(b)); return r; }
__device__ __forceinline__ float fadd_s(float a, float b) { float r; asm("v_add_f32_e32 %0, %1, %2" : "=v"(r) : "v"(a), "v"(b)); return r; }
__device__ __forceinline__ float fsub_s(float a, float b) { float r; asm("v_sub_f32_e32 %0, %1, %2" : "=v"(r) : "v"(a), "v"(b)); return r; }
#define WAIT_BAR(N) asm volatile("s_waitcnt vmcnt(" #N ") lgkmcnt(0)\n\ts_barrier" ::: "memory")

typedef LAS const char* lds_cptr;
typedef short v4i16_t __attribute__((ext_vector_type(4)));
__device__ __forceinline__ void kload8(bf16x8* kf, lds_cptr kp) {
    kf[0] = *(const LAS bf16x8*)(kp);        kf[1] = *(const LAS bf16x8*)(kp + 512);
    kf[2] = *(const LAS bf16x8*)(kp + 2048); kf[3] = *(const LAS bf16x8*)(kp + 2560);
    kf[4] = *(const LAS bf16x8*)(kp + 4096); kf[5] = *(const LAS bf16x8*)(kp + 4608);
    kf[6] = *(const LAS bf16x8*)(kp + 6144); kf[7] = *(const LAS bf16x8*)(kp + 6656);
}
__device__ __forceinline__ void kload2(bf16x8* kf, lds_cptr kp, int j) { kf[2 * j] = *(const LAS bf16x8*)(kp + j * 2048); kf[2 * j + 1] = *(const LAS bf16x8*)(kp + j * 2048 + 512); }
__device__ __forceinline__ s16x4 vtr(lds_cptr p) { return __builtin_bit_cast(s16x4, __builtin_amdgcn_ds_read_tr16_b64_v4i16((LAS v4i16_t*)p)); }
__device__ __forceinline__ float rowmax(const f32x16& p0, const f32x16& p1) {
    float a = max3f(p0[0], p0[1], p1[0]), b = max3f(p0[2], p0[3], p1[1]); a = max3f(a, p1[2], p1[3]);
#pragma unroll
    for (int r = 4; r < 16; r += 4) { a = max3f(a, p0[r], p0[r + 1]); b = max3f(b, p0[r + 2], p0[r + 3]); a = max3f(a, p1[r], p1[r + 1]); b = max3f(b, p1[r + 2], p1[r + 3]); }
    const float m = max2f(a, b);
    auto rr = __builtin_amdgcn_permlane32_swap(__float_as_uint(m), __float_as_uint(m), false, false);
    return max2f(__uint_as_float(rr[0]), __uint_as_float(rr[1]));
}
__device__ __forceinline__ void pv(f32x16* o, int vb, bf16x8 pa0, bf16x8 pa1, bf16x8 pa2, bf16x8 pa3) {
#pragma unroll
    for (int d0 = 0; d0 < 2; ++d0) { s16x4 lo[4], hi[4];
#pragma unroll
        for (int ks = 0; ks < 4; ++ks) {
            asm volatile("ds_read_b64_tr_b16 %0,%1 offset:%c2" : "=&v"(lo[ks]) : "v"(vb), "i"(d0 * 4096 + ks * 1024) : "memory");
            asm volatile("ds_read_b64_tr_b16 %0,%1 offset:%c2" : "=&v"(hi[ks]) : "v"(vb), "i"(d0 * 4096 + ks * 1024 + 512) : "memory"); }
        asm volatile("s_waitcnt lgkmcnt(0)" ::: "memory"); SBAR();
#define PK(k) (bf16x8){lo[k][0], lo[k][1], lo[k][2], lo[k][3], hi[k][0], hi[k][1], hi[k][2], hi[k][3]}
        o[d0] = __builtin_amdgcn_mfma_f32_32x32x16_bf16(pa0, PK(0), o[d0], 0, 0, 0);
        o[d0] = __builtin_amdgcn_mfma_f32_32x32x16_bf16(pa1, PK(1), o[d0], 0, 0, 0);
        o[d0] = __builtin_amdgcn_mfma_f32_32x32x16_bf16(pa2, PK(2), o[d0], 0, 0, 0);
        o[d0] = __builtin_amdgcn_mfma_f32_32x32x16_bf16(pa3, PK(3), o[d0], 0, 0, 0);
#undef PK
    }
}

template <int THRL> __device__ __forceinline__ int attn_unit(int b, int h, int qb, int ts, float kmaxc, const bf16_t* Q, const bf16_t* __restrict__ K, const bf16_t* __restrict__ V, unsigned char* O, const unsigned* __restrict__ FA, char* shm, unsigned* qhead, LAS int* qnext) {
    const int tid = threadIdx.x, lane = tid & 63, r32 = lane & 31, hi = lane >> 5; const int wid = __builtin_amdgcn_readfirstlane(tid >> 6);
    const long rowbase = (long)b * SEQ; const int q0 = qb * QB;
    const int NT0 = (q0 + QB) / KVBLK - ts, TL = NT0 - 1; int NT = NT0;
    const bf16_t* Qw = Q + (rowbase + q0 + wid * QBLK) * PQ + h * D;
    const bf16_t* Kh = K + (rowbase + (long)ts * KVBLK) * PQ + h * D, *Vh = V + (rowbase + (long)ts * KVBLK) * PQ + h * D;
    const unsigned lds0 = (unsigned)(uintptr_t)shm;
    float* wsf = (float*)(shm + LDS_WS) + wid * 64;
    { const u32x4* Fg = (const u32x4*)(FA + ((size_t)(b * NHEAD + h) * SEQ + (size_t)ts * KVBLK) * 2); LAS u32x4* Fl4 = (LAS u32x4*)((LAS char*)(lds_cptr)shm + LDS_F); const int n4 = (q0 + QB - ts * KVBLK) / 2;
      for (int p = tid; p < n4; p += NW * 64) Fl4[p] = Fg[p]; }
    const LAS u32x2* Fa = (const LAS u32x2*)((lds_cptr)shm + LDS_F);
#define FVAL(w) (-((bflo((w).x) + bfhi((w).x)) + bflo((w).y)))
    asm volatile("s_waitcnt vmcnt(0) lgkmcnt(0)" ::: "memory");
    const bf16_t* ksrc = Kh + (long)lane * PQ + wid * 8;
    const bf16_t* vsrc = Vh + (long)(16 * (wid & 3) + (lane >> 2)) * PQ + (wid >> 2) * 32 + (lane & 3) * 8;
    const unsigned kdst = lds0 + LDS_K + wid * 1024, vdst = lds0 + LDS_V + wid * 1024;
#define DMA_K(t, slot) glds16(ksrc + (long)(TL - (t)) * KVBLK * PQ, (unsigned)__builtin_amdgcn_readfirstlane(kdst + (slot)))
#define DMA_V(t, slot) glds16(vsrc + (long)(TL - (t)) * KVBLK * PQ, (unsigned)__builtin_amdgcn_readfirstlane(vdst + (slot)))
    const int vb0 = (int)(lds0 + LDS_V) + ((lane >> 4) & 1) * 32 + (lane & 3) * 8 + (4 * hi + ((lane & 15) >> 2)) * 64;
    bf16x8 kf[8];
    const lds_cptr shm3 = (lds_cptr)shm; const lds_cptr kp0 = shm3 + LDS_K + hi * 1024 + r32 * 16; const lds_cptr vp0 = shm3 + LDS_V + ((lane >> 4) & 1) * 32 + (lane & 3) * 8 + (4 * hi + ((lane & 15) >> 2)) * 64;
    DMA_K(0, 0); DMA_V(0, 0); DMA_K(1, SLOTB);
    bf16x8 qr[4];
#pragma unroll
    for (int d0 = 0; d0 < 4; ++d0) qr[d0] = *reinterpret_cast<const bf16x8*>(&Qw[(long)r32 * PQ + d0 * 16 + hi * 8]);
    float mhat = 0.f, l_reg = 0.f, nm = 0.f; f32x16 o[2]; o[0] = f32x16{}; o[1] = f32x16{};
    u32x2 ka0, ka1; u32x4 qa;
#define FLD(tt) do { const LAS u32x2* fp_ = Fa + 64 * (TL - (tt)) + r32; ka0 = fp_[0]; ka1 = fp_[32]; } while (0)
#define KAF(w) __builtin_bit_cast(bf16x8, (u32x4){(w).x, (w).y, 0x3f803f80u, 0u})
#define SETQA() do { const unsigned h_ = cvtpk(nm, 0.f) & 0xffffu; const float r1_ = nm - __uint_as_float(h_ << 16); const unsigned m_ = cvtpk(r1_, 0.f) & 0xffffu; \
      const float r2_ = r1_ - __uint_as_float(m_ << 16); const unsigned l_ = cvtpk(r2_, 0.f) & 0xffffu; \
      qa.x = hi ? 0u : 0x3f803f80u; qa.y = hi ? 0u : (0x3f80u | (h_ << 16)); qa.z = hi ? 0u : (m_ | (l_ << 16)); qa.w = 0u; } while (0)
#define CINIT(C0, C1) do { C0 = __builtin_amdgcn_mfma_f32_32x32x16_bf16(KAF(ka0), __builtin_bit_cast(bf16x8, qa), f32x16{}, 0, 0, 0); \
      C1 = __builtin_amdgcn_mfma_f32_32x32x16_bf16(KAF(ka1), __builtin_bit_cast(bf16x8, qa), f32x16{}, 0, 0, 0); } while (0)
    const int qrel = wid * QBLK + r32;
#define CMASK(P0, P1, t) do { int jb_ = 3 - (t); if (jb_ >= 0) cmask(P0, P1, jb_, qrel, hi); } while (0)
    bool resc = false;
#define START(P0, P1) do { const float rm = rowmax(P0, P1); resc = false; \
    if (__any(rm > (float)THRL)) { const float dl = __builtin_fmaxf(rm, 0.f); mhat += dl; \
      _Pragma("unroll") for (int r = 0; r < 16; ++r) { P0[r] -= dl; P1[r] -= dl; } \
      nm = -mhat; SETQA(); } \
    _Pragma("unroll") for (int r = 0; r < 16; ++r) P0[r] = __builtin_amdgcn_exp2f(P0[r]); } while (0)
#define RESC() do { if (resc) { asm volatile("s_waitcnt lgkmcnt(0)" ::: "memory"); \
      _Pragma("unroll") for (int d_ = 0; d_ < 2; ++d_) _Pragma("unroll") for (int r = 0; r < 16; ++r) o[d_][r] *= wsf[crow(r, hi)]; } } while (0)
    f32x16 pA0, pA1, pB0, pB1;
    int sl_prev = 0, sl_cur = 0, sl_next = SLOTB;
#define ROT() do { sl_prev = sl_cur; sl_cur = sl_next; sl_next = (sl_next == (NSLOT - 1) * SLOTB) ? 0 : sl_next + SLOTB; } while (0)
    DMA_K(2, 2 * SLOTB);
    float qkb;
    { float qn2 = 0.f;
#pragma unroll
      for (int d0 = 0; d0 < 4; ++d0)
#pragma unroll
          for (int j = 0; j < 8; ++j) { const float v = __uint_as_float((unsigned)(unsigned short)qr[d0][j] << 16); qn2 += v * v; }
      auto rr = __builtin_amdgcn_permlane32_swap(__float_as_uint(qn2), __float_as_uint(qn2), false, false); qn2 = __uint_as_float(rr[0]) + __uint_as_float(rr[1]);
      qkb = sqrtf(qn2) * kmaxc; }
    WAIT_BAR(3);
    { const u32x2 wo = Fa[64 * NT0 - QB + qrel]; const float fown = FVAL(wo); mhat = -fown - qkb; nm = -mhat; SETQA(); }
    FLD(0); CINIT(pA0, pA1);
    { const lds_cptr kb = shm3 + LDS_K + hi * 1024 + r32 * 16;
#pragma unroll
      for (int d0 = 0; d0 < 4; ++d0) { const bf16x8 b0 = *(const LAS bf16x8*)(kb + d0 * 2048); const bf16x8 b1 = *(const LAS bf16x8*)(kb + d0 * 2048 + 512);
          pA0 = __builtin_amdgcn_mfma_f32_32x32x16_bf16(b0, qr[d0], pA0, 0, 0, 0); pA1 = __builtin_amdgcn_mfma_f32_32x32x16_bf16(b1, qr[d0], pA1, 0, 0, 0); } }
    asm volatile("s_nop 15\n\ts_nop 7" : "+v"(pA0), "+v"(pA1)); CMASK(pA0, pA1, 0);
    START(pA0, pA1);
    _Pragma("unroll") for (int r = 0; r < 16; ++r) pA1[r] = __builtin_amdgcn_exp2f(pA1[r]);
    FLD(1);
    WAIT_BAR(0);
    DMA_K(3, 0); DMA_V(1, SLOTB);
    ROT();
    kload8(kf, kp0 + sl_cur);
    WAIT_BAR(2);
    s16x4 vlo[8], vhi[8]; u32x4 pw0, pw1, pw2, pw3;
#define PKW(P, B) cvtpk(P[B], P[B + 1])
#define PAF(k) __builtin_bit_cast(bf16x8, pw##k)
#define VFR(i) (bf16x8){vlo[i][0], vlo[i][1], vlo[i][2], vlo[i][3], vhi[i][0], vhi[i][1], vhi[i][2], vhi[i][3]}
#define PIN(x) asm volatile("" : "+v"(x))
#define MX3(a, b, c) __builtin_fmaxf(__builtin_fmaxf((a), (b)), (c))
#define GAPA(MF, A0, A1, A2, A3, W0, W1, PW) do { MF; sacc += A0; sacc += A1; sacc += A2; sacc += A3; PIN(sacc); W0; W1; PIN(PW); SBAR(); } while (0)
#define EX(v) __builtin_amdgcn_exp2f(v)
#define GAPB(MF, X, B) do { MF; X[B] = EX(X[B]); X[B + 1] = EX(X[B + 1]); X[B + 2] = EX(X[B + 2]); X[B + 3] = EX(X[B + 3]); PIN(X); SBAR(); } while (0)
#define VRD(i) do { vlo[i] = vtr(vp_ + (((i) >> 2) * 4096 + ((i) & 3) * 1024)); vhi[i] = vtr(vp_ + (((i) >> 2) * 4096 + ((i) & 3) * 1024 + 512)); } while (0)
#define KRD(G, j) do { if (G) { kload2(kf, kp0 + sl_next, j); SBAR(); } } while (0)
#define STEP(C0, C1, P0, P1, t, GK, GV, GL) do { SBAR(); \
    CINIT(C0, C1); SBAR(); \
    const lds_cptr vp_ = vp0 + sl_prev; \
    VRD(0); SBAR(); float sacc = (P0[0] + P0[1]); \
    GAPA(C0 = __builtin_amdgcn_mfma_f32_32x32x16_bf16(kf[0], qr[0], C0, 0, 0, 0), P0[2], P0[3], P0[4], P0[5],     pw0[0] = PKW(P0, 0), pw0[1] = PKW(P0, 2), pw0); \
    VRD(4); SBAR(); GAPA(C1 = __builtin_amdgcn_mfma_f32_32x32x16_bf16(kf[1], qr[0], C1, 0, 0, 0), P0[6], P0[7], P0[8], P0[9],     pw0[2] = PKW(P0, 4), pw0[3] = PKW(P0, 6), pw0); \
    VRD(1); SBAR(); GAPA(C0 = __builtin_amdgcn_mfma_f32_32x32x16_bf16(kf[2], qr[1], C0, 0, 0, 0),   P0[10], P0[11], P0[12], P0[13], pw1[0] = PKW(P0, 8), pw1[1] = PKW(P0, 10), pw1); \
    VRD(5); SBAR(); GAPA(C1 = __builtin_amdgcn_mfma_f32_32x32x16_bf16(kf[3], qr[1], C1, 0, 0, 0),   P0[14], P0[15], P1[0], P1[1],   pw1[2] = PKW(P0, 12), pw1[3] = PKW(P0, 14), pw1); \
    VRD(2); SBAR(); GAPA(C0 = __builtin_amdgcn_mfma_f32_32x32x16_bf16(kf[4], qr[2], C0, 0, 0, 0),   P1[2], P1[3], P1[4], P1[5],     pw2[0] = PKW(P1, 0), pw2[1] = PKW(P1, 2), pw2); \
    VRD(6); SBAR(); GAPA(C1 = __builtin_amdgcn_mfma_f32_32x32x16_bf16(kf[5], qr[2], C1, 0, 0, 0),   P1[6], P1[7], P1[8], P1[9],     pw2[2] = PKW(P1, 4), pw2[3] = PKW(P1, 6), pw2); \
    VRD(3); SBAR(); GAPA(C0 = __builtin_amdgcn_mfma_f32_32x32x16_bf16(kf[6], qr[3], C0, 0, 0, 0),   P1[10], P1[11], P1[12], P1[13], pw3[0] = PKW(P1, 8), pw3[1] = PKW(P1, 10), pw3); \
    VRD(7); SBAR(); GAPA(C1 = __builtin_amdgcn_mfma_f32_32x32x16_bf16(kf[7], qr[3], C1, 0, 0, 0),   P1[14], P1[15], 0.f, 0.f,       pw3[2] = PKW(P1, 12), pw3[3] = PKW(P1, 14), pw3); \
    l_reg += sacc; \
    if (GK) { DMA_K((t) + 3, sl_cur); } if (GV) { DMA_V((t) + 1, sl_next); } \
    CMASK(C0, C1, t); \
    { float a = MX3(C0[0], C0[1], C1[0]), b = MX3(C0[2], C0[3], C1[1]); a = MX3(a, C1[2], C1[3]); \
      _Pragma("unroll") for (int r = 4; r < 16; r += 4) { a = MX3(a, C0[r], C0[r + 1]); b = MX3(b, C0[r + 2], C0[r + 3]); a = MX3(a, C1[r], C1[r + 1]); b = MX3(b, C1[r + 2], C1[r + 3]); } \
      float rm = __builtin_fmaxf(a, b); { auto rr = __builtin_amdgcn_permlane32_swap(__float_as_uint(rm), __float_as_uint(rm), false, false); rm = __builtin_fmaxf(__uint_as_float(rr[0]), __uint_as_float(rr[1])); } \
      resc = false; \
      if (__builtin_expect(__any(rm > (float)THRL), 0)) { const float dl = __builtin_fmaxf(rm, 0.f); mhat += dl; \
        _Pragma("unroll") for (int r = 0; r < 16; ++r) { C0[r] -= dl; C1[r] -= dl; } \
        nm = -mhat; SETQA(); \
        const float f = __builtin_amdgcn_exp2f(-dl); l_reg *= f; if (hi == 0) wsf[r32] = f; resc = true; } } \
    SBAR(); \
    GAPB(o[0] = __builtin_amdgcn_mfma_f32_32x32x16_bf16(PAF(0), VFR(0), o[0], 0, 0, 0), C0, 0); \
    GAPB(o[1] = __builtin_amdgcn_mfma_f32_32x32x16_bf16(PAF(0), VFR(4), o[1], 0, 0, 0), C0, 4); \
    KRD(GL, 0); GAPB(o[0] = __builtin_amdgcn_mfma_f32_32x32x16_bf16(PAF(1), VFR(1), o[0], 0, 0, 0), C0, 8); \
    KRD(GL, 1); GAPB(o[1] = __builtin_amdgcn_mfma_f32_32x32x16_bf16(PAF(1), VFR(5), o[1], 0, 0, 0), C0, 12); \
    KRD(GL, 2); GAPB(o[0] = __builtin_amdgcn_mfma_f32_32x32x16_bf16(PAF(2), VFR(2), o[0], 0, 0, 0), C1, 0); \
    KRD(GL, 3); GAPB(o[1] = __builtin_amdgcn_mfma_f32_32x32x16_bf16(PAF(2), VFR(6), o[1], 0, 0, 0), C1, 4); \
    GAPB(o[0] = __builtin_amdgcn_mfma_f32_32x32x16_bf16(PAF(3), VFR(3), o[0], 0, 0, 0), C1, 8); \
    GAPB(o[1] = __builtin_amdgcn_mfma_f32_32x32x16_bf16(PAF(3), VFR(7), o[1], 0, 0, 0), C1, 12); \
    FLD((t) + 1); \
    } while (0)
    int t = 1;
#define ENDW(tt) do { if ((tt) + 3 < NT) { WAIT_BAR(2); } else if ((tt) + 2 < NT) { WAIT_BAR(1); } else { WAIT_BAR(0); } } while (0)
    LAS float* stopf = (LAS float*)((LAS char*)(lds_cptr)shm + LDS_STOP);
#pragma unroll 1
    for (int pass = 0; pass < 2; ++pass) {
        const int lim = (pass == 0) ? (NT < 5 ? NT : 5) : NT;
        for (; t + 1 < lim; t += 2) {
            STEP(pB0, pB1, pA0, pA1, t, (t + 3 < NT), (t + 1 < NT), (t + 1 < NT));       ENDW(t);   RESC(); ROT();
            STEP(pA0, pA1, pB0, pB1, t + 1, (t + 4 < NT), (t + 2 < NT), (t + 2 < NT));     ENDW(t + 1); RESC(); ROT();
        }
        if (pass == 0) {
#undef CMASK
#define CMASK(P0, P1, t) do { } while (0)
            for (; t + 5 < NT; t += 2) {
                STEP(pB0, pB1, pA0, pA1, t, true, true, true);     WAIT_BAR(2); RESC(); ROT();
                if ((t & 7) == 5) { float bv = qkb - mhat;
                    bv = __builtin_fmaxf(bv, dpp_mov<0xB1>(bv)); bv = __builtin_fmaxf(bv, dpp_mov<0x4E>(bv)); bv = __builtin_fmaxf(bv, dpp_mov<0x141>(bv)); bv = __builtin_fmaxf(bv, dpp_mov<0x140>(bv));
                    const float r0 = __int_as_float(__builtin_amdgcn_readlane(__float_as_int(bv), 0)), r1 = __int_as_float(__builtin_amdgcn_readlane(__float_as_int(bv), 16));
                    const float r2 = __int_as_float(__builtin_amdgcn_readlane(__float_as_int(bv), 32)), r3 = __int_as_float(__builtin_amdgcn_readlane(__float_as_int(bv), 48));
                    if (lane == 0) stopf[wid] = __builtin_fmaxf(__builtin_fmaxf(r0, r1), __builtin_fmaxf(r2, r3)); }
                STEP(pA0, pA1, pB0, pB1, t + 1, true, true, true);   WAIT_BAR(2); RESC(); ROT();
                if ((t & 7) == 5) { const f32x4 s0 = *(const LAS f32x4*)stopf, s1 = *(const LAS f32x4*)(stopf + 4);
                    const float thr = __builtin_fmaxf(__builtin_fmaxf(__builtin_fmaxf(s0[0], s0[1]), __builtin_fmaxf(s0[2], s0[3])), __builtin_fmaxf(__builtin_fmaxf(s1[0], s1[1]), __builtin_fmaxf(s1[2], s1[3]))) + PRUNE_TH;
                    const int pt = TL - 2 * (lane + 1);
                    const u32x2 wv = Fa[64 * (pt < 0 ? 0 : pt) + 63]; const float fv = FVAL(wv);
                    const unsigned long long mk = __ballot((pt < 0) || (fv >= thr));
                    int np = 2 * ((int)__builtin_ctzll(mk) + 1); np = np < t + 5 ? t + 5 : np;
                    if (np < NT) NT = np; }
            }
#undef CMASK
#define CMASK(P0, P1, t) do { int jb_ = 3 - (t); if (jb_ >= 0) cmask(P0, P1, jb_, qrel, hi); } while (0)
        }
    }
    STEP(pB0, pB1, pA0, pA1, NT - 1, false, false, false); RESC();
    { float sacc = pB0[0] + pB0[1]; _Pragma("unroll") for (int r = 2; r < 16; ++r) sacc += pB0[r]; _Pragma("unroll") for (int r = 0; r < 16; ++r) sacc += pB1[r]; l_reg += sacc;
      pw0 = (u32x4){PKW(pB0, 0), PKW(pB0, 2), PKW(pB0, 4), PKW(pB0, 6)}; pw1 = (u32x4){PKW(pB0, 8), PKW(pB0, 10), PKW(pB0, 12), PKW(pB0, 14)}; pw2 = (u32x4){PKW(pB1, 0), PKW(pB1, 2), PKW(pB1, 4), PKW(pB1, 6)}; pw3 = (u32x4){PKW(pB1, 8), PKW(pB1, 10), PKW(pB1, 12), PKW(pB1, 14)};
      SBAR(); pv(o, vb0 + sl_cur, PAF(0), PAF(1), PAF(2), PAF(3)); }
    unsigned nxq = 0u; if (tid == 0) nxq = atomicAdd(qhead, 1u);
#undef PKW
#undef PAF
#undef VFR
#undef PIN
#undef MX3
#undef GAPA
#undef GAPB
#undef EX
#undef VRD
#undef KRD
#undef STEP
#undef ENDW
    { auto rr = __builtin_amdgcn_permlane32_swap(__float_as_uint(l_reg), __float_as_uint(l_reg), false, false); l_reg = __uint_as_float(rr[0]) + __uint_as_float(rr[1]); }
    if (hi == 0) wsf[32 + r32] = l_reg; asm volatile("s_waitcnt lgkmcnt(0)" ::: "memory");
    float rli[16];
#pragma unroll
    for (int r = 0; r < 16; ++r) rli[r] = __builtin_amdgcn_rcpf(wsf[32 + crow(r, hi)]);
    unsigned char* Ow = O + (rowbase + q0 + wid * QBLK) * PO + h * D;
    { unsigned char* stg = (unsigned char*)(shm + LDS_OST) + wid * 2048;
#pragma unroll
      for (int r = 0; r < 16; ++r) { const int orow = crow(r, hi);
#pragma unroll
          for (int d0 = 0; d0 < 2; ++d0) { const float v = __builtin_fminf(__builtin_fmaxf(o[d0][r] * rli[r] * MIX_SCALE, -440.0f), 440.0f);
              stg[orow * 64 + d0 * 32 + r32] = (unsigned char)(__builtin_amdgcn_cvt_pk_fp8_f32(v, v, 0, false) & 0xff); } }
      asm volatile("s_waitcnt lgkmcnt(0)" ::: "memory");
#pragma unroll
      for (int i = 0; i < 2; ++i) { const int row = i * 16 + (lane >> 2), ch = lane & 3; const u32x4 v = *(const u32x4*)(stg + row * 64 + ch * 16); *(u32x4*)(Ow + (long)row * PO + ch * 16) = v; } }
    if (tid == 0) qnext[0] = (int)nxq;
    asm volatile("s_waitcnt lgkmcnt(0)\n\ts_barrier" ::: "memory");
    return NT;
#undef DMA_K
#undef DMA_V
#undef CMASK
#undef START
#undef RESC
#undef ROT
#undef FLD
#undef CINIT
#undef KAF
#undef SETQA
#undef FVAL
}
#undef SBAR
#undef WAIT_BAR
}

namespace ret {
constexpr int RS = 272;
constexpr int IMG_Q = 0, IMG_K = 64 * RS, IMG_KT = 2 * 64 * RS, IMG_V = 3 * 64 * RS;
constexpr int PS = 144;
constexpr int IMG_P = 4 * 64 * RS;
constexpr int IMG_ST = IMG_P + 64 * PS;
constexpr int OS = 132;
constexpr int IMG_O = IMG_ST + 128 * RS;
constexpr int LDS_END = IMG_O + 64 * OS * 4;
static_assert(LDS_END <= LDS_BYTES, "retention LDS map");
typedef short v4i16_t __attribute__((ext_vector_type(4)));
__device__ __forceinline__ s16x4 tr4(LAS const char* p) { return __builtin_bit_cast(s16x4, __builtin_amdgcn_ds_read_tr16_b64_v4i16((LAS v4i16_t*)p)); }
__device__ __forceinline__ bf16x8 frag_tr(LAS const char* img, int stride, int k0, int c0, int lane) {
    const int g4 = lane >> 4, i = lane & 15, qq = i >> 2, p = i & 3, hh = g4 >> 1, nh = g4 & 1;
    LAS const char* a = img + (k0 + 8 * hh + qq) * stride + (c0 + 16 * nh + 4 * p) * 2;
    const s16x4 lo = tr4(a), hi = tr4(a + 4 * stride);
    return (bf16x8){lo[0], lo[1], lo[2], lo[3], hi[0], hi[1], hi[2], hi[3]};
}
__device__ __forceinline__ bf16x8 frag_row(LAS const char* img, int stride, int r0, int k0, int lane) {
    return *(const LAS bf16x8*)(img + (r0 + (lane & 31)) * stride + (k0 + 8 * (lane >> 5)) * 2);
}
__device__ __forceinline__ int crow(int r, int hi) { return (r & 3) + 8 * (r >> 2) + 4 * hi; }

template <bool APPLY>
__device__ __forceinline__ void unit(int bh, int g, const bf16_t* RQ, const bf16_t* RK, const bf16_t* RV, const bf16_t* SG, float* GST, unsigned char* MIX, LAS char* lds) {
    int tid_ = threadIdx.x; asm volatile("" : "+v"(tid_));
    const int tid = tid_, lane = tid & 63, hi = lane >> 5; const int w = __builtin_amdgcn_readfirstlane(tid >> 6);
    const int b = bh >> 2, h = bh & 3;
    const float l2g = log2f(1.0f - exp2f(-5.0f - (float)h));
    const float cd = exp2f(64.0f * l2g);
    const size_t row0 = (size_t)b * SEQ + (size_t)g * 512;
    u32x4 rq[2], rk[2], rv[2];
    auto issue = [&](int j) {
#pragma unroll
        for (int i = 0; i < 2; ++i) { const int p = tid + 512 * i, row = p >> 4, ch = p & 15; const size_t off = (row0 + j * 64 + row) * 512 + h * 128 + ch * 8;
            if (APPLY) rq[i] = *(const u32x4*)(RQ + off);
            rk[i] = *(const u32x4*)(RK + off); rv[i] = *(const u32x4*)(RV + off); }
    };
    const int db = w >> 1, eb0 = 2 * (w & 1);
    f32x16 S0 = f32x16{}, S1 = f32x16{};
    if (APPLY) {
        const float Gm = exp2f(512.0f * l2g);
        for (int gp0 = 0; gp0 < g; gp0 += 4) {
            f32x4 gv[4][8];
#pragma unroll
            for (int k = 0; k < 4; ++k) { const int gp = (gp0 + k < g) ? gp0 + k : g - 1; const f32x4* src = (const f32x4*)(GST + ((size_t)(bh * 16 + gp) * 8 + w) * 2048) + lane;
#pragma unroll
                for (int q = 0; q < 8; ++q) gv[k][q] = src[q * 64]; }
#pragma unroll
            for (int k = 0; k < 4; ++k) { const bool ok = gp0 + k < g; const float fm = ok ? Gm : 1.0f, am = ok ? 1.0f : 0.0f;
#pragma unroll
                for (int r = 0; r < 16; ++r) { S0[r] = S0[r] * fm + gv[k][r >> 2][r & 3] * am; S1[r] = S1[r] * fm + gv[k][4 + (r >> 2)][r & 3] * am; } }
        }
    }
    issue(0);
    for (int j = 0; j < 8; ++j) {
#pragma unroll
        for (int i = 0; i < 2; ++i) { const int p = tid + 512 * i, row = p >> 4, ch = p & 15; const int o = row * RS + ch * 16;
            if (APPLY) { *(LAS u32x4*)(lds + IMG_Q + o) = rq[i]; *(LAS u32x4*)(lds + IMG_K + o) = rk[i]; }
            *(LAS u32x4*)(lds + IMG_V + o) = rv[i];
            const float kw = exp2f((float)(63 - row) * l2g);
            u32x4 kt;
#pragma unroll
            for (int e = 0; e < 4; ++e) kt[e] = cvtpk(bflo(rk[i][e]) * kw, bfhi(rk[i][e]) * kw);
            *(LAS u32x4*)(lds + IMG_KT + o) = kt; }
        if (APPLY) {
#pragma unroll
            for (int tile = 0; tile < 2; ++tile) { const f32x16& S = tile ? S1 : S0; const int e = (eb0 + tile) * 32 + (lane & 31);
#pragma unroll
                for (int g4 = 0; g4 < 4; ++g4) { const int d = db * 32 + 8 * g4 + 4 * hi; u32x2 v; v.x = cvtpk(S[4 * g4], S[4 * g4 + 1]); v.y = cvtpk(S[4 * g4 + 2], S[4 * g4 + 3]);
                    *(LAS u32x2*)(lds + IMG_ST + e * RS + d * 2) = v; } }
        }
        u32x4 gg0 = {0u, 0u, 0u, 0u}, gg1 = {0u, 0u, 0u, 0u};
        if (APPLY) { const size_t trow = row0 + j * 64 + (tid >> 3); const bf16_t* gp = SG + trow * 512 + h * 128 + (tid & 7) * 16; gg0 = *(const u32x4*)gp; gg1 = *(const u32x4*)(gp + 8); }
        if (j + 1 < 8) issue(j + 1);
        LDS_WAIT(); __builtin_amdgcn_s_barrier();
        f32x16 oin = f32x16{}, oit = f32x16{};
        const int qb = w >> 2, eb = w & 3;
        if (APPLY) {
#pragma unroll
            for (int s = 0; s < 8; ++s) oin = __builtin_amdgcn_mfma_f32_32x32x16_bf16(frag_row(lds + IMG_Q, RS, qb * 32, s * 16, lane), frag_row(lds + IMG_ST, RS, eb * 32, s * 16, lane), oin, 0, 0, 0);
            if (w < 4) {
                const int tb = w >> 1, qb2 = w & 1; f32x16 sc = f32x16{};
#pragma unroll
                for (int s = 0; s < 8; ++s) sc = __builtin_amdgcn_mfma_f32_32x32x16_bf16(frag_row(lds + IMG_K, RS, tb * 32, s * 16, lane), frag_row(lds + IMG_Q, RS, qb2 * 32, s * 16, lane), sc, 0, 0, 0);
                const int q = qb2 * 32 + (lane & 31);
#pragma unroll
                for (int g4 = 0; g4 < 4; ++g4) { const int t0 = tb * 32 + 8 * g4 + 4 * hi; float pv4[4];
#pragma unroll
                    for (int e = 0; e < 4; ++e) { const int dd = q - (t0 + e); pv4[e] = sc[4 * g4 + e] * exp2f((float)(dd < 0 ? -dd : dd) * l2g); }
                    u32x2 v; v.x = cvtpk(pv4[0], pv4[1]); v.y = cvtpk(pv4[2], pv4[3]);
                    *(LAS u32x2*)(lds + IMG_P + q * PS + t0 * 2) = v; }
            }
            LDS_WAIT(); __builtin_amdgcn_s_barrier();
#pragma unroll
            for (int s = 0; s < 4; ++s) oit = __builtin_amdgcn_mfma_f32_32x32x16_bf16(frag_row(lds + IMG_P, PS, qb * 32, s * 16, lane), frag_tr(lds + IMG_V, RS, s * 16, eb * 32, lane), oit, 0, 0, 0);
#pragma unroll
            for (int r = 0; r < 16; ++r) { const int q = qb * 32 + crow(r, hi); const float qw = exp2f((float)(q + 1) * l2g);
                *(LAS float*)(lds + IMG_O + (q * OS + eb * 32 + (lane & 31)) * 4) = oit[r] + qw * oin[r]; }
        }
#pragma unroll
        for (int r = 0; r < 16; ++r) { S0[r] *= cd; S1[r] *= cd; }
#pragma unroll
        for (int s = 0; s < 4; ++s) { const bf16x8 a = frag_tr(lds + IMG_KT, RS, s * 16, db * 32, lane);
            S0 = __builtin_amdgcn_mfma_f32_32x32x16_bf16(a, frag_tr(lds + IMG_V, RS, s * 16, eb0 * 32, lane), S0, 0, 0, 0);
            S1 = __builtin_amdgcn_mfma_f32_32x32x16_bf16(a, frag_tr(lds + IMG_V, RS, s * 16, (eb0 + 1) * 32, lane), S1, 0, 0, 0); }
        LDS_WAIT(); __builtin_amdgcn_s_barrier();
        if (APPLY) {
            { const int q = tid >> 3, sg = tid & 7; const LAS f32x4* op = (const LAS f32x4*)(lds + IMG_O + (q * OS + sg * 16) * 4);
              f32x4 x0 = op[0], x1 = op[1], x2 = op[2], x3 = op[3];
              float s1 = ((x0.x + x0.y) + (x0.z + x0.w)) + ((x1.x + x1.y) + (x1.z + x1.w)) + ((x2.x + x2.y) + (x2.z + x2.w)) + ((x3.x + x3.y) + (x3.z + x3.w));
              s1 += dpp_mov<0xB1>(s1); s1 += dpp_mov<0x4E>(s1); s1 += dpp_mov<0x141>(s1);
              const float mu = s1 * (1.0f / 128.0f); x0 = x0 - mu; x1 = x1 - mu; x2 = x2 - mu; x3 = x3 - mu;
              float s2 = ((x0.x * x0.x + x0.y * x0.y) + (x0.z * x0.z + x0.w * x0.w)) + ((x1.x * x1.x + x1.y * x1.y) + (x1.z * x1.z + x1.w * x1.w)) + ((x2.x * x2.x + x2.y * x2.y) + (x2.z * x2.z + x2.w * x2.w)) + ((x3.x * x3.x + x3.y * x3.y) + (x3.z * x3.z + x3.w * x3.w));
              s2 += dpp_mov<0xB1>(s2); s2 += dpp_mov<0x4E>(s2); s2 += dpp_mov<0x141>(s2);
              const float rstd = rsqrtf(s2 * (1.0f / 128.0f) + GN_EPS);
              const size_t trow = row0 + j * 64 + q; const u32x4 g0 = gg0, g1 = gg1;
              const float ms = rstd * MIX_SCALE; u32x4 o;
#define MXC(v) __builtin_fminf(__builtin_fmaxf((v), -440.0f), 440.0f)
              o.x = pk4_fp8(MXC(x0.x * ms * bflo(g0.x)), MXC(x0.y * ms * bfhi(g0.x)), MXC(x0.z * ms * bflo(g0.y)), MXC(x0.w * ms * bfhi(g0.y)));
              o.y = pk4_fp8(MXC(x1.x * ms * bflo(g0.z)), MXC(x1.y * ms * bfhi(g0.z)), MXC(x1.z * ms * bflo(g0.w)), MXC(x1.w * ms * bfhi(g0.w)));
              o.z = pk4_fp8(MXC(x2.x * ms * bflo(g1.x)), MXC(x2.y * ms * bfhi(g1.x)), MXC(x2.z * ms * bflo(g1.y)), MXC(x2.w * ms * bfhi(g1.y)));
              o.w = pk4_fp8(MXC(x3.x * ms * bflo(g1.z)), MXC(x3.y * ms * bfhi(g1.z)), MXC(x3.z * ms * bflo(g1.w)), MXC(x3.w * ms * bfhi(g1.w)));
#undef MXC
              *(u32x4*)(MIX + trow * 1024 + h * 128 + sg * 16) = o; }
        }
    }
    if (!APPLY) {
        f32x4* dst = (f32x4*)(GST + ((size_t)(bh * 16 + g) * 8 + w) * 2048) + lane;
#pragma unroll
        for (int q = 0; q < 4; ++q) { dst[q * 64] = (f32x4){S0[4 * q], S0[4 * q + 1], S0[4 * q + 2], S0[4 * q + 3]}; dst[(4 + q) * 64] = (f32x4){S1[4 * q], S1[4 * q + 1], S1[4 * q + 2], S1[4 * q + 3]}; }
    }
    LDS_WAIT(); __builtin_amdgcn_s_barrier();
}
}


#define XB_TMO      128
#define XB_XCNT(j)  (256  + 64 * (j))
#define XB_XSUB(j)  (1280 + 64 * (j))
#define XB_XGEN(j)  (2304 + 64 * (j))
#define XB_TOP      3328
#define XB_TOPGEN   3392
#define XCD_BAR_WORDS 3456
#define XB_SPIN_CAP (1u << 18)
__device__ __forceinline__ unsigned xb_ld(unsigned* p)              { return __hip_atomic_load(p, __ATOMIC_RELAXED, __HIP_MEMORY_SCOPE_AGENT); }
__device__ __forceinline__ unsigned xb_add(unsigned* p, unsigned v) { return __hip_atomic_fetch_add(p, v, __ATOMIC_RELAXED, __HIP_MEMORY_SCOPE_AGENT); }
__device__ __forceinline__ unsigned xb_xcc_id() { return (unsigned)__builtin_amdgcn_s_getreg((3 << 11) | 20) & 0xFu; }
#define XB_SPIN(cond, bar) do { unsigned _sp = 0; while (cond) { __builtin_amdgcn_s_sleep(1); \
    if ((++_sp & 255u) == 0u) { if (xb_ld(&(bar)[XB_TMO])) break; if (_sp > XB_SPIN_CAP) { atomicAdd(&(bar)[XB_TMO], 1u); break; } } } } while (0)
struct XcdBarrier { unsigned* bar; unsigned x; volatile LAS unsigned* st; };
__device__ __forceinline__ XcdBarrier xcd_barrier_post(unsigned* bar, volatile LAS unsigned* st) {
    XcdBarrier b; b.bar = bar; b.x = xb_xcc_id(); b.st = st;
    if (threadIdx.x == 0) (void)xb_add(&bar[XB_XCNT(b.x)], 1u);
    return b;
}
__device__ __forceinline__ void xcd_barrier_complete(unsigned* bar, unsigned x, unsigned& nloc, unsigned& nx) {
    const unsigned G = gridDim.x * gridDim.y * gridDim.z;
    unsigned sum, cnt, mine, sp = 0u;
    for (;;) {
        sum = 0u; cnt = 0u; mine = 0u;
#pragma unroll
        for (unsigned j = 0; j < 16; ++j) { const unsigned c = xb_ld(&bar[XB_XCNT(j)]); sum += c; cnt += (c > 0u) ? 1u : 0u; mine = (j == x) ? c : mine; }
        if (sum == G) break;
        __builtin_amdgcn_s_sleep(1);
        if ((++sp & 255u) == 0u) { if (xb_ld(&bar[XB_TMO])) break; if (sp > XB_SPIN_CAP) { atomicAdd(&bar[XB_TMO], 1u); break; } }
    }
    nloc = mine > 0u ? mine : 1u; nx = cnt > 0u ? cnt : 1u;
}
__device__ __forceinline__ void xcd_barrier(const XcdBarrier& b) {
    asm volatile("s_waitcnt vmcnt(0)" ::: "memory");
    __syncthreads();
    if (threadIdx.x == 0) {
        unsigned* bar = b.bar;
        __builtin_amdgcn_s_waitcnt(0);
        unsigned nloc = b.st[0], nx = b.st[1];
        if (nloc == 0u) { xcd_barrier_complete(bar, b.x, nloc, nx); b.st[0] = nloc; b.st[1] = nx; }
        const unsigned old = xb_add(&bar[XB_XSUB(b.x)], 1u);
        const unsigned gen = old / nloc;
        if (old + 1u == (gen + 1u) * nloc) {
            __builtin_amdgcn_fence(__ATOMIC_RELEASE, "agent");
            asm volatile("s_waitcnt vmcnt(0)" ::: "memory");
            const unsigned og = xb_add(&bar[XB_TOP], 1u);
            const unsigned tg = og / nx;
            if (og + 1u == (tg + 1u) * nx) xb_add(&bar[XB_TOPGEN], 1u);
            else XB_SPIN(xb_ld(&bar[XB_TOPGEN]) == tg, bar);
            __builtin_amdgcn_fence(__ATOMIC_ACQUIRE, "agent");
            xb_add(&bar[XB_XGEN(b.x)], 1u);
            asm volatile("s_waitcnt vmcnt(0)" ::: "memory");
        } else {
            XB_SPIN(xb_ld(&bar[XB_XGEN(b.x)]) == gen, bar);
            __builtin_amdgcn_fence(__ATOMIC_ACQUIRE, "agent");
            asm volatile("s_waitcnt vmcnt(0)" ::: "memory");
        }
    }
    __syncthreads();
}

__device__ __forceinline__ void publish_inc(unsigned* cnt) {
    asm volatile("s_waitcnt vmcnt(0)" ::: "memory");
    __syncthreads();
    if (threadIdx.x == 0) { __builtin_amdgcn_fence(__ATOMIC_RELEASE, "agent"); asm volatile("s_waitcnt vmcnt(0)" ::: "memory");
        (void)__hip_atomic_fetch_add(cnt, 1u, __ATOMIC_RELAXED, __HIP_MEMORY_SCOPE_AGENT); }
}
__device__ __forceinline__ void wait_ge(unsigned* cnt, unsigned target) {
    if (threadIdx.x == 0) { unsigned sp = 0;
        while (__hip_atomic_load(cnt, __ATOMIC_RELAXED, __HIP_MEMORY_SCOPE_AGENT) < target) { __builtin_amdgcn_s_sleep(2); if (++sp > (1u << 22)) break; }
        __builtin_amdgcn_fence(__ATOMIC_ACQUIRE, "agent"); asm volatile("s_waitcnt vmcnt(0)" ::: "memory"); }
    __syncthreads();
}

struct Frame {
    LAS unsigned char* lds; int tid, lane, wave, vcu, G;
    __device__ __forceinline__ void refresh() { int t = threadIdx.x; asm volatile("" : "+v"(t)); tid = t; lane = t & 63; }
};

__device__ __forceinline__ void tr_item(const float* __restrict__ W, int ldw, int k0, int n0, const float* __restrict__ gk, bf16_t* WT, int kind, LAS unsigned* scr, int lane) {
    const int nch = lane & 15, kq = lane >> 4;
    f32x4 a[8], b[8];
#pragma unroll
    for (int i = 0; i < 8; ++i) { const int kp = 4 * i + kq; const float* p = W + (size_t)(k0 + 2 * kp) * ldw + n0 + 4 * nch; a[i] = *(const f32x4*)p; b[i] = *(const f32x4*)(p + ldw); }
#pragma unroll
    for (int i = 0; i < 8; ++i) { const int kp = 4 * i + kq; float ga = 1.f, gb = 1.f; if (gk) { ga = gk[k0 + 2 * kp]; gb = gk[k0 + 2 * kp + 1]; }
#pragma unroll
        for (int e = 0; e < 4; ++e) scr[(4 * nch + e) * 36 + kp] = cvtpk(a[i][e] * ga, b[i][e] * gb); }
    LDS_WAIT(); asm volatile("" ::: "memory");
    const int c = lane & 7, nr = lane >> 3;
#pragma unroll
    for (int j = 0; j < 8; ++j) { const int n = nr + 8 * j; const u32x4 v = *(const LAS u32x4*)(scr + n * 36 + 4 * c);
        const int cn = n0 + n; const int row = (kind == 0) ? pos_inproj(cn) : (kind == 1) ? pos_wide(cn) : pos_w1(cn);
        *(u32x4*)(WT + (size_t)row * 1024 + k0 + 8 * c) = v; }
    LDS_WAIT(); asm volatile("" ::: "memory");
}

struct Tr8Item { const float* W; unsigned char* WT; const float* gk; int ldw, k0, n0, kind; };
__device__ __forceinline__ Tr8Item tr8_decode(int r, const Params& P, unsigned char* W1T, unsigned char* W2T, const float* ones) {
    constexpr int P_1 = 32 * 8 * 32; Tr8Item t; const int half = r & 1; int p = r >> 1;
    if (p < P_1) { const int e = p >> 8, rr = p & 255; t.W = P.w1 + (size_t)e * 1024 * 2048; t.ldw = 2048; t.k0 = 128 * (rr / 32) + 64 * half; t.n0 = 64 * (rr % 32); t.gk = P.g_ffn; t.WT = W1T + (size_t)e * 2048 * 1024; t.kind = 2; }
    else { p -= P_1; const int e = p >> 7, rr = p & 127; t.W = P.w2 + (size_t)e * 1024 * 1024; t.ldw = 1024; t.k0 = 128 * (rr / 16) + 64 * half; t.n0 = 64 * (rr % 16); t.gk = ones; t.WT = W2T + (size_t)e * 1024 * 1024; t.kind = 1; }
    return t;
}
template <bool GK = true> __device__ __forceinline__ void tr8_load(const Tr8Item& t, f32x4 (&a)[4][4], f32x4 (&gq)[4], int lane) {
    const int nch = lane & 15, kq4 = lane >> 4;
#pragma unroll
    for (int i = 0; i < 4; ++i) { if constexpr (GK) gq[i] = *(const f32x4*)(t.gk + t.k0 + 4 * (4 * i + kq4)); else gq[i] = (f32x4){1.f, 1.f, 1.f, 1.f}; }
#pragma unroll
    for (int i = 0; i < 4; ++i) { const int kq = 4 * i + kq4; const float* p = t.W + (size_t)(t.k0 + 4 * kq) * t.ldw + t.n0 + 4 * nch;
#pragma unroll
        for (int r = 0; r < 4; ++r) a[i][r] = __builtin_nontemporal_load((const f32x4*)(p + (size_t)r * t.ldw)); }
}
__device__ __forceinline__ void tr8_proc(const Tr8Item& t, const f32x4 (&a)[4][4], const f32x4 (&gq)[4], LAS unsigned* scr, int lane, const int half) {
    const int nch = lane & 15, kq4 = lane >> 4;
#pragma unroll
    for (int i = 0; i < 4; ++i) { const int kq = 4 * i + kq4; float g[4];
#pragma unroll
        for (int r = 0; r < 4; ++r) g[r] = gq[i][r] * W_SCALE;
#pragma unroll
        for (int e = 0; e < 4; ++e) scr[(4 * nch + e) * 36 + 16 * half + (kq ^ (4 * ((nch >> 1) & 3)))] = pk4_fp8(a[i][0][e] * g[0], a[i][1][e] * g[1], a[i][2][e] * g[2], a[i][3][e] * g[3]); }
    if (half == 1) {
        LDS_WAIT(); asm volatile("" ::: "memory");
        const int c = lane & 7, nr = lane >> 3;
#pragma unroll
        for (int j = 0; j < 8; ++j) { const int n = nr + 8 * j; const u32x4 v = *(const LAS u32x4*)(scr + n * 36 + 16 * (c >> 2) + 4 * ((c & 3) ^ ((n >> 3) & 3)));
            const int cn = t.n0 + n; const int row = (t.kind == 1) ? pos_wide(cn) : pos_w1(cn);
            *(u32x4*)(t.WT + (size_t)row * 1024 + (t.k0 - 64) + 16 * c) = v; }
        LDS_WAIT(); asm volatile("" ::: "memory");
    }
}

__global__ void __launch_bounds__(NTHREADS, 2) mk_fwd(Params P) {
    __builtin_assume(__builtin_amdgcn_workitem_id_y() == 0); __builtin_assume(__builtin_amdgcn_workitem_id_z() == 0);
    extern __shared__ __attribute__((aligned(16))) unsigned char lds_raw[];
    cg::grid_group grid = cg::this_grid();
    Frame F; F.lds = (LAS unsigned char*)lds_raw; F.tid = threadIdx.x; F.lane = F.tid & 63; F.wave = __builtin_amdgcn_readfirstlane(F.tid >> 6);
    F.G = gridDim.x; { const int bx = blockIdx.x; F.vcu = (F.G % 8 == 0) ? (bx % 8) * (F.G / 8) + bx / 8 : bx; }
    unsigned char* ws = P.ws;
    unsigned* ctl = (unsigned*)(ws + WS_CTL);
    float* ropec = (float*)(ws + WS_ROPEC); float* ropes = (float*)(ws + WS_ROPES);
    float* wr3 = (float*)(ws + WS_WR3); float* logf2 = (float*)(ws + WS_LOGF); float* F2 = (float*)(ws + WS_F2); (void)F2; unsigned* FAq = (unsigned*)(ws + WS_FA);
    float* irs1 = (float*)(ws + WS_IRS1); float* ones = (float*)(ws + WS_ONES);
    int* ltok = (int*)(ws + WS_LTOK); float* lrstd = (float*)(ws + WS_LRSTD); int* inv = (int*)(ws + WS_INV); float* gates = (float*)(ws + WS_GATE);
    bf16_t* H1B = (bf16_t*)(ws + WS_H1B); bf16_t* WinT = (bf16_t*)(ws + WS_WINT); unsigned char* WoT = ws + WS_WOT;
    unsigned char* W2T = ws + WS_W2T; unsigned char* W1T = ws + WS_W1T; unsigned char* Yb = ws + WS_Y; unsigned char* H1F8 = ws + WS_H1F8;
    bf16_t* U = (bf16_t*)(ws + WS_U); unsigned char* proj = ws + WS_PROJ;
    bf16_t* RQ = (bf16_t*)(proj); bf16_t* RK = (bf16_t*)(proj + PROJ_STRIDE); bf16_t* RV = (bf16_t*)(proj + 2 * PROJ_STRIDE); bf16_t* SG = (bf16_t*)(proj + 3 * PROJ_STRIDE);
    bf16_t* FQ = (bf16_t*)(proj + 4 * PROJ_STRIDE); bf16_t* FK = (bf16_t*)(proj + 5 * PROJ_STRIDE); bf16_t* FV = (bf16_t*)(proj + 6 * PROJ_STRIDE);
    float* GST = (float*)(ws + WS_GST); unsigned char* MIX = ws + WS_MIX; unsigned char* Hb = ws + WS_H;
    const int lo = P.ph_lo, hi_ph = P.ph_hi;
#ifndef MK_PHMASK
#define MK_PHMASK 0x1ff
#endif
#define IN(k) (((MK_PHMASK >> (k)) & 1) && lo <= (k) && (k) < hi_ph)
#define REP(k) for (int rep_ = 0; rep_ < ((MK_DUP == (k)) ? 2 : 1); ++rep_)
#ifndef MK_CG_MASK
#define MK_CG_MASK 0x01
#endif
#define SEAM(k) do { if (IN(k) && IN((k) + 1)) { if ((MK_CG_MASK >> (k)) & 1) grid.sync(); else xcd_barrier(xbar); } } while (0)
    const int gw = F.vcu * NWAVES + F.wave, NGW = F.G * NWAVES;
    volatile LAS unsigned* misc = (volatile LAS unsigned*)(F.lds + LDS_MISC);
    if (F.tid < 4) misc[F.tid] = 0u;
    __syncthreads();
    XcdBarrier xbar = xcd_barrier_post(ctl + CW_BAR, misc);
#if MK_DIAG
    int nst = 0;
#define STAMP() do { if (blockIdx.x == 0 && threadIdx.x == 0) ((unsigned long long*)(ctl + CW_DIAG + 16))[nst] = __builtin_amdgcn_s_memrealtime(); ++nst; } while (0)
    STAMP();
#else
#define STAMP() do { } while (0)
#endif

    if (IN(0)) {
        F.refresh();
        LAS unsigned* scr = (LAS unsigned*)(F.lds + F.wave * 9216);
        LAS float* wfl = (LAS float*)(F.lds + 73728);
        for (int i = F.tid; i < 8192; i += NTHREADS) { const int hh = i & 7, k = i >> 3; wfl[hh * 1024 + k] = P.w_in[(size_t)k * INW + NPROJ + hh]; }
        constexpr int I_IN = 16 * 56, I_O = 8 * 16;
        for (int it = gw; it < I_IN + I_O; it += NGW) {
            if (it < I_IN) tr_item(P.w_in, INW, 64 * (it / 56), 64 * (it % 56), nullptr, WinT, 0, scr, F.lane);
            else { const int r = it - I_IN; f32x4 a_[4][4], g_[4]; Tr8Item t; t.W = P.w_out; t.WT = WoT; t.gk = nullptr; t.ldw = 1024; t.n0 = 64 * (r % 16); t.kind = 1;
                t.k0 = 128 * (r / 16); tr8_load<false>(t, a_, g_, F.lane); tr8_proc(t, a_, g_, scr, F.lane, 0);
                t.k0 += 64; tr8_load<false>(t, a_, g_, F.lane); tr8_proc(t, a_, g_, scr, F.lane, 1); }
        }
        __syncthreads();
        {
            constexpr int TD = T * ((MK_DUP == 0) ? 2 : 1);
            f32x4 gq[4];
#pragma unroll
            for (int j = 0; j < 4; ++j) gq[j] = ((const f32x4*)P.g_mix)[F.lane + 64 * j];
            const float bfg = (F.lane < 8) ? P.b_forget[F.lane] : 0.f;
#define ROW_LOAD(V, MM) do { const f32x4* xr_ = (const f32x4*)(P.x + (size_t)((MM) % T) * DM) + F.lane; _Pragma("unroll") for (int j = 0; j < 4; ++j) V[j] = __builtin_nontemporal_load(xr_ + 64 * j); } while (0)
#define ROW_PROC(V, MM) do { const int mr_ = (MM) % T; float ss = 0.f; \
            _Pragma("unroll") for (int j = 0; j < 4; ++j) ss += (V[j].x * V[j].x + V[j].y * V[j].y) + (V[j].z * V[j].z + V[j].w * V[j].w); \
            const float msq = wave_sum_dpp(ss) * (1.0f / DM) + RMS_EPS; const float rstd = rsqrtf(msq); \
            if (F.lane == 0) irs1[mr_] = sqrtf(msq); \
            float z[8]; _Pragma("unroll") for (int hh = 0; hh < 8; ++hh) z[hh] = 0.f; \
            unsigned long long* o8 = (unsigned long long*)(U + (size_t)mr_ * DM) + F.lane; \
            _Pragma("unroll") for (int j = 0; j < 4; ++j) { const f32x4 uv = V[j] * rstd * gq[j]; \
                o8[64 * j] = (unsigned long long)cvtpk(uv.x, uv.y) | ((unsigned long long)cvtpk(uv.z, uv.w) << 32); \
                _Pragma("unroll") for (int hh = 0; hh < 8; ++hh) { const f32x4 w4 = *(const LAS f32x4*)(wfl + hh * 1024 + 4 * F.lane + 256 * j); z[hh] += (uv.x * w4.x + uv.y * w4.y) + (uv.z * w4.z + uv.w * w4.w); } } \
            _Pragma("unroll") for (int hh = 0; hh < 8; ++hh) z[hh] = wave_sum_dpp(z[hh]); \
            float zz = z[0]; _Pragma("unroll") for (int hh = 1; hh < 8; ++hh) zz = (F.lane == hh) ? z[hh] : zz; \
            if (F.lane < 8) { const float xx = zz + bfg; const float lf = fminf(xx, 0.f) - log1pf(__expf(-fabsf(xx))); logf2[(size_t)mr_ * 8 + F.lane] = lf * LOG2E; } } while (0)
            constexpr int NR = T / (256 * NWAVES) * ((MK_DUP == 0) ? 2 : 1);
            f32x4 vv_[3][4];
            if (NGW == 256 * NWAVES) {
#pragma unroll
                for (int i = 0; i < NR + 2; ++i) {
                    if (i < NR) ROW_LOAD(vv_[i % 3], gw + i * NGW);
                    if (i >= 2) ROW_PROC(vv_[(i - 2) % 3], gw + (i - 2) * NGW);
                }
            } else {
                for (int m = gw; m < T; m += NGW) { ROW_LOAD(vv_[0], m); ROW_PROC(vv_[0], m); }
            }
#undef ROW_LOAD
#undef ROW_PROC
        }
        for (int idx = blockIdx.x * NTHREADS + F.tid; idx < SEQ * 64; idx += F.G * NTHREADS) {
            const int pos = idx >> 6, i = idx & 63; const float invf = exp2f(-(float)i * (13.287712379549449f / 64.0f));
            const float ang = (float)pos * invf; double tt = (double)ang * 0.15915494309189535; tt -= __builtin_rint(tt); const float tf = (float)tt;
            ropec[idx] = __builtin_amdgcn_cosf(tf); ropes[idx] = __builtin_amdgcn_sinf(tf);
        }
        for (int idx = blockIdx.x * NTHREADS + F.tid; idx < 1024; idx += F.G * NTHREADS) ones[idx] = 1.0f;
        for (int idx = blockIdx.x * NTHREADS + F.tid; idx < 32768; idx += F.G * NTHREADS) {
            const int jp = idx & 3, e16 = (idx >> 2) & 15, kq = (idx >> 6) & 3, s = (idx >> 8) & 31, half = (idx >> 13) & 1, part = idx >> 14; const int k = 32 * s + 8 * kq + 2 * jp, e = 16 * half + e16;
            const float v0 = P.w_router[k * 32 + e] * P.g_ffn[k], v1 = P.w_router[(k + 1) * 32 + e] * P.g_ffn[k + 1];
            const unsigned hi = cvtpk(v0, v1); const unsigned lo = cvtpk(v0 - bflo(hi), v1 - bfhi(hi));
            ((unsigned*)wr3)[idx] = part ? lo : hi;
        }
    }
    SEAM(0); STAMP();
#if MK_DUP == 90
    for (int rb_ = 0; rb_ < 16; ++rb_) xcd_barrier(xbar);
#endif

    if (IN(1)) {
        F.refresh();
        typedef pg8::DenseOrder<T / 256, NPROJ / 256> Ord1; Ord1 S; S.init(T, NPROJ, DM, F.G, (int)blockIdx.x, (MK_DUP == 1) ? 2 : 1);
        EpiInProj E{proj, ropec, ropes, ctl};
        const int nun = (S.nwg * S.dup + F.G - 1) / F.G;
        const int kslot = ((F.vcu & 7) * (nun + 1)) / 8;
        constexpr int I_8 = 32 * 16 * 32 + 32 * 16 * 16;
        LAS unsigned* scr = (LAS unsigned*)(F.lds + F.wave * 9216);
        {
            S.i0 = 0; S.i1 = kslot;
            pg8::gemm_phase<EpiInProj, Ord1, true, true, 2>(F.lds, U, WinT, DM, S, E);
            {
                __syncthreads();
        {
            f32x4 rr_[2][4][4], gg_[2][4]; Tr8Item tt_[2];
            constexpr int NI = (32 * 16 * 32 + 32 * 16 * 16) / (256 * NWAVES) * ((MK_DUP == 9) ? 2 : 1);
            if (NGW == 256 * NWAVES) {
#pragma unroll
                for (int i = 0; i < NI + 1; ++i) {
                    if (i < NI) { tt_[i & 1] = tr8_decode(2 * ((gw + (i >> 1) * NGW) % (I_8 / 2)) + (i & 1), P, W1T, W2T, ones); tr8_load(tt_[i & 1], rr_[i & 1], gg_[i & 1], F.lane); }
                    if (i >= 1) tr8_proc(tt_[(i - 1) & 1], rr_[(i - 1) & 1], gg_[(i - 1) & 1], scr, F.lane, (i - 1) & 1);
                }
            } else {
                for (int it = gw; it < I_8 / 2; it += NGW) { tt_[0] = tr8_decode(2 * it, P, W1T, W2T, ones); tr8_load(tt_[0], rr_[0], gg_[0], F.lane); tr8_proc(tt_[0], rr_[0], gg_[0], scr, F.lane, 0);
                    tt_[0] = tr8_decode(2 * it + 1, P, W1T, W2T, ones); tr8_load(tt_[0], rr_[0], gg_[0], F.lane); tr8_proc(tt_[0], rr_[0], gg_[0], scr, F.lane, 1); }
            }
        }
                __syncthreads();
            }
            F.refresh();
            S.i0 = kslot; S.i1 = 1 << 30;
            pg8::gemm_phase<EpiInProj, Ord1, true, true, 2>(F.lds, U, WinT, DM, S, E);
        }
    }
    SEAM(1); STAMP();

    STAMP();

    if (IN(3)) {
        F.refresh();
        for (int bh = F.vcu; bh < 32; bh += F.G) {
            const int b = bh >> 3, h = bh & 7; LAS double* sd = (LAS double*)F.lds;
            double loc[16]; double run = 0.0;
#pragma unroll
            for (int i = 0; i < 16; ++i) { run += (double)logf2[((size_t)b * SEQ + 16 * F.tid + i) * 8 + h]; loc[i] = run; }
            double incl = run;
#pragma unroll
            for (int o = 1; o < 64; o <<= 1) { const double t = __shfl_up(incl, o); if (F.lane >= o) incl += t; }
            __syncthreads();
            if (F.lane == 63) sd[F.wave] = incl;
            __syncthreads();
            double off = incl - run;
            for (int w2 = 0; w2 < F.wave; ++w2) off += sd[w2];
            LAS float* Fsl = (LAS float*)(F.lds + 4096);
#pragma unroll
            for (int i = 0; i < 16; ++i) { const float fv = (float)(off + loc[i]); Fsl[16 * F.tid + i] = fv;
                const float nf = -fv; const unsigned h_ = cvtpk(nf, 0.f) & 0xffffu; const float r1 = nf - __uint_as_float(h_ << 16); const unsigned m_ = cvtpk(r1, 0.f) & 0xffffu;
                const float r2 = r1 - __uint_as_float(m_ << 16); const unsigned l_ = cvtpk(r2, 0.f) & 0xffffu;
                u32x2 w; w.x = h_ | (m_ << 16); w.y = l_ | 0x3f800000u; ((u32x2*)FAq)[(size_t)bh * SEQ + 16 * F.tid + i] = w; }
            __syncthreads();
            if (F.tid < 32) { const int qb = F.tid, q0 = 256 * qb, NT = 4 * qb + 4;
                const float qn = __uint_as_float(ctl[CW_QN2 + bh * 2]) + __uint_as_float(ctl[CW_QN2 + bh * 2 + 1]), kn = __uint_as_float(ctl[CW_KN2 + bh * 2]) + __uint_as_float(ctl[CW_KN2 + bh * 2 + 1]);
                const float target = Fsl[q0] + PRUNE_TH + 2.0f * 1.0201f * sqrtf(qn * kn);
                int lo_ = 0, hi_ = NT - 4;
                while (lo_ < hi_) { const int mid = (lo_ + hi_) >> 1; if (Fsl[64 * mid + 63] >= target) lo_ = mid + 1; else hi_ = mid; }
                const int ts = lo_ & ~1, NS = NT - ts;
                ctl[CW_UTS + bh * 32 + qb] = (unsigned)ts; ctl[CW_UPOS + bh * 32 + qb] = atomicAdd(ctl + CW_BIN + (NS >> 1), 1u); }
            publish_inc(ctl + CW_SCAN);
            __syncthreads();
        }
        for (int u = F.vcu; u < 256; u += F.G) { ret::unit<false>(u >> 4, u & 15, RQ, RK, RV, SG, GST, MIX, (LAS char*)F.lds); publish_inc(ctl + CW_GDONE + 16 * (u >> 4)); }
        for (int u = F.vcu; u < 256; u += F.G) { wait_ge(ctl + CW_GDONE + 16 * (u >> 4), 16u); ret::unit<true>(u >> 4, u & 15, RQ, RK, RV, SG, GST, MIX, (LAS char*)F.lds); }
        wait_ge(ctl + CW_SCAN, 32u);
        LAS int* qst = (LAS int*)(F.lds + attn_body::LDS_QUEUE); LAS int* qlist = qst + 128; LAS int* qsh = qst + 100;
        if (F.tid >= 2 && F.tid <= 64) qst[F.tid] = (int)ctl[CW_BIN + F.tid];
        __syncthreads();
        if (F.tid < 64) {
            const int k = 64 - F.tid; const int c = (k >= 2) ? qst[k] : 0; int inc = c;
#pragma unroll
            for (int o = 1; o < 64; o <<= 1) { const int t = __shfl_up(inc, o); if (F.tid >= o) inc += t; }
            if (k >= 2) qst[k] = inc - c; }
        __syncthreads();
        for (int u = F.tid; u < 1024; u += NTHREADS) { const int ts = (int)ctl[CW_UTS + u], NS = 4 * (u & 31) + 4 - ts; qlist[qst[NS >> 1] + (int)ctl[CW_UPOS + u]] = u | (ts << 16); }
        __syncthreads();
        LAS float* kmx = (LAS float*)(qst + 1152);
        if (F.tid < 32) kmx[F.tid] = 1.0201f * sqrtf(__uint_as_float(ctl[CW_KN2 + F.tid * 2]) + __uint_as_float(ctl[CW_KN2 + F.tid * 2 + 1]));
        if (F.tid == 0) qsh[0] = (int)atomicAdd(ctl + CW_QHEAD, 1u);
        __syncthreads();
        for (;;) {
            int idx = qsh[0];
            if (idx >= ((MK_DUP == 30) ? 2048 : 1024)) break;
            idx &= 1023;
            const int uu = qlist[idx]; const int u = uu & 0xffff, ts = uu >> 16; const int bh = u >> 5, qb = u & 31;
            const float kmaxc = kmx[bh];
            const int ntd = attn_body::attn_unit<8>(bh >> 3, bh & 7, qb, ts, kmaxc, FQ, FK, FV, MIX + 512, FAq, (char*)lds_raw, ctl + CW_QHEAD, qsh); (void)ntd;
#if MK_DIAG >= 21 && MK_DIAG <= 23
            if (F.tid == 0) { atomicAdd(ctl + CW_DIAG + 2, (unsigned)ntd); atomicMax(ctl + CW_DIAG + 3, (unsigned)ntd); if (ntd >= 64) atomicAdd(ctl + CW_DIAG + 4, 1u); }
#endif
        }
    }
    SEAM(3); STAMP();

    if (IN(4)) {
        F.refresh();
        typedef pg8::DenseOrder<T / 256, DM / 256> Ord4; Ord4 S; S.init(T, DM, DM, F.G, (int)blockIdx.x, (MK_DUP == 4) ? 2 : 1);
        EpiOutProj E{U, irs1, P.g_mix, H1B, H1F8};
        pg8::gemm_phase<EpiOutProj, Ord4, true, true, 1>(F.lds, MIX, WoT, DM, S, E);
    }
    SEAM(4); STAMP();

    if (IN(5)) {
        F.refresh();
        LAS float* wl = (LAS float*)F.lds;
        LAS float* lg = (LAS float*)(F.lds + 131072);
        LAS float* ssb = (LAS float*)(F.lds + 131072 + 128 * 33 * 4);
        LAS int* ecnt = (LAS int*)(F.lds + 131072 + 128 * 33 * 4 + 512);
        LAS int* ebase = ecnt + 32;
        { f32x4 wv[16];
#pragma unroll
          for (int i = 0; i < 16; ++i) wv[i] = ((const f32x4*)wr3)[F.tid + NTHREADS * i];
#pragma unroll
          for (int i = 0; i < 16; ++i) ((LAS f32x4*)wl)[F.tid + NTHREADS * i] = wv[i]; }
        for (int tb = blockIdx.x; tb < T / 128; tb += F.G) {
            if (F.tid < 32) ecnt[F.tid] = 0;
            __syncthreads();
            const int tok16 = F.lane & 15, kq = F.lane >> 4; const int tokw = tb * 128 + F.wave * 16 + tok16;
            const bf16_t* hrow = H1B + (size_t)tokw * DM + 8 * kq;
            f32x4 a0 = {0.f, 0.f, 0.f, 0.f}, a1 = {0.f, 0.f, 0.f, 0.f}; float ss = 0.f;
            const LAS bf16x8* wb = (const LAS bf16x8*)wl + kq * 16 + tok16;
#pragma unroll 4
            for (int s = 0; s < 32; ++s) {
                const u32x4 hv = *(const u32x4*)(hrow + 32 * s); const bf16x8 av = __builtin_bit_cast(bf16x8, hv);
#pragma unroll
                for (int e = 0; e < 4; ++e) { const float lo_ = bflo(hv[e]), hi_ = bfhi(hv[e]); ss += lo_ * lo_ + hi_ * hi_; }
                a0 = __builtin_amdgcn_mfma_f32_16x16x32_bf16(av, wb[((0 * 2 + 0) * 32 + s) * 64], a0, 0, 0, 0); a0 = __builtin_amdgcn_mfma_f32_16x16x32_bf16(av, wb[((1 * 2 + 0) * 32 + s) * 64], a0, 0, 0, 0);
                a1 = __builtin_amdgcn_mfma_f32_16x16x32_bf16(av, wb[((0 * 2 + 1) * 32 + s) * 64], a1, 0, 0, 0); a1 = __builtin_amdgcn_mfma_f32_16x16x32_bf16(av, wb[((1 * 2 + 1) * 32 + s) * 64], a1, 0, 0, 0);
            }
            ss += __shfl_xor(ss, 16); ss += __shfl_xor(ss, 32);
            if (kq == 0) ssb[F.wave * 16 + tok16] = ss;
#pragma unroll
            for (int r = 0; r < 4; ++r) { const int tk = F.wave * 16 + kq * 4 + r; lg[tk * 33 + tok16] = a0[r]; lg[tk * 33 + 16 + tok16] = a1[r]; }
            __syncthreads();
            int esel[4] = {0, 0, 0, 0}, rank[4] = {0, 0, 0, 0}; float gsel[4] = {0.f, 0.f, 0.f, 0.f}; float rstd = 0.f;
            if (F.tid < 128) {
                rstd = rsqrtf(ssb[F.tid] * (1.0f / DM) + RMS_EPS);
                float l[32];
#pragma unroll
                for (int e = 0; e < 32; ++e) l[e] = lg[F.tid * 33 + e] * rstd + P.b_router[e];
                float vs[4];
#pragma unroll
                for (int k = 0; k < 4; ++k) { float best = -INFINITY; int bi = 0;
#pragma unroll
                    for (int e = 0; e < 32; ++e) { const bool bt = l[e] > best; best = bt ? l[e] : best; bi = bt ? e : bi; }
                    vs[k] = best; esel[k] = bi;
#pragma unroll
                    for (int e = 0; e < 32; ++e) l[e] = (e == bi) ? -INFINITY : l[e]; }
                float den = 0.f;
#pragma unroll
                for (int k = 0; k < 4; ++k) { gsel[k] = __expf(vs[k] - vs[0]); den += gsel[k]; }
#pragma unroll
                for (int k = 0; k < 4; ++k) { gsel[k] /= den; rank[k] = atomicAdd((int*)&ecnt[esel[k]], 1); }
            }
            __syncthreads();
            if (F.tid < 32) ebase[F.tid] = (int)atomicAdd(ctl + CW_CNT + F.tid, (unsigned)ecnt[F.tid]);
            __syncthreads();
            if (F.tid < 128) { const int tok = tb * 128 + F.tid;
#pragma unroll
                for (int k = 0; k < 4; ++k) { const int e = esel[k], slot = ebase[e] + rank[k];
                    ltok[(size_t)e * CAP + slot] = tok; lrstd[(size_t)e * CAP + slot] = rstd; inv[tok * 4 + k] = (e << 16) | slot; gates[tok * 4 + k] = gsel[k]; } }
            __syncthreads();
        }
    }
    SEAM(5); STAMP();

    if (IN(6) || IN(7)) {
        F.refresh();
        LAS int* boff = (LAS int*)(F.lds + 131072); LAS int* cntl = boff + 64;
        if (F.tid < 64) {
            const int cn = (F.tid < 32) ? (int)ctl[CW_CNT + F.tid] : 0; const int nbk = (cn + 255) >> 8; int inc = nbk;
#pragma unroll
            for (int o = 1; o < 32; o <<= 1) { const int t = __shfl_up(inc, o); if (F.tid >= o) inc += t; }
            if (F.tid < 32) { cntl[F.tid] = cn; boff[F.tid] = inc - nbk; if (F.tid == 31) boff[32] = inc; } }
        __syncthreads();
        LAS unsigned* tokl = (LAS unsigned*)(F.lds + 131072 + 1024);
        LAS bf16_t* biasl = (LAS bf16_t*)(F.lds + 131072 + 1024 + 17408);
        if (IN(6)) {
            MoeOrder<8, true> S0{boff, cntl, tokl, F.G, F.vcu};
            { const int r = F.tid & 255; bool ok[9], inr[9]; unsigned tk[9]; float rs[9], bv[9];
#pragma unroll
              for (int p = 0; p < 9; ++p) { const int i = 2 * p + (F.tid >> 8); pg8::Unit u; u.e = 0; u.lb = 0; u.pn = 0;
                  ok[p] = i < 17 && S0.next(i, u);
                  const int slot = u.lb * 256 + r; inr[p] = ok[p] && slot < cntl[u.e]; const size_t si = inr[p] ? (size_t)u.e * CAP + slot : 0;
                  tk[p] = (unsigned)ltok[si]; rs[p] = lrstd[si];
                  const int pnl = u.pn - u.e * 8; bv[p] = P.b1[ok[p] ? (size_t)u.e * 2048 + ((r < 128) ? (pnl * 128 + r) : (1024 + pnl * 128 + r - 128)) : 0]; }
#pragma unroll
              for (int p = 0; p < 9; ++p) { const int i = 2 * p + (F.tid >> 8);
                  if (ok[p]) { tokl[i * 256 + r] = inr[p] ? (tk[p] | (cvtpk(0.f, rs[p]) & 0xffff0000u)) : 0u; biasl[i * 256 + r] = (bf16_t)(cvtpk(bv[p], bv[p]) & 0xffffu); } } }
            __syncthreads();
        }
        if (IN(6)) REP(6) {
        F.refresh();
            MoeOrder<8, true> S{boff, cntl, tokl, F.G, F.vcu};
            EpiMoe1 E{Hb, tokl, biasl};
            pg8::gemm_phase<EpiMoe1, MoeOrder<8, true>, true, true, 1>(F.lds, H1F8, W1T, DM, S, E);
        }
#if MK_DUP == 60
        if (IN(6)) { MoeOrder<8, true> S{boff, cntl, tokl, F.G, F.vcu}; EpiNull E{(float*)(ws + WS_GST)};
            pg8::gemm_phase<EpiNull, MoeOrder<8, true>, true, true, 1>(F.lds, H1F8, W1T, DM, S, E); }
#elif MK_DUP == 61
        if (IN(6)) { MoeOrder<8, false> S{boff, cntl, tokl, F.G, F.vcu}; EpiNull E{(float*)(ws + WS_GST)};
            pg8::gemm_phase<EpiNull, MoeOrder<8, false>, true, true, 1>(F.lds, H1F8, W1T, DM, S, E); }
#endif
        SEAM(6); STAMP();
        if (IN(7)) {
            __syncthreads();
            MoeOrder<4, false> S0{boff, cntl, tokl, F.G, F.vcu};
            { const int r = F.tid & 255; bool ok[5]; float bv[5];
#pragma unroll
              for (int p = 0; p < 5; ++p) { const int i = 2 * p + (F.tid >> 8); pg8::Unit u; u.e = 0; u.pn = 0;
                  ok[p] = i < 17 && S0.next(i, u); const int pnl = u.pn - u.e * 4; bv[p] = P.b2[ok[p] ? (size_t)u.e * DM + pnl * 256 + r : 0]; }
#pragma unroll
              for (int p = 0; p < 5; ++p) { const int i = 2 * p + (F.tid >> 8); if (ok[p]) biasl[i * 256 + r] = (bf16_t)(cvtpk(bv[p], bv[p]) & 0xffffu); } }
            __syncthreads();
        }
        if (IN(7)) REP(7) {
        F.refresh();
            MoeOrder<4, false> S{boff, cntl, tokl, F.G, F.vcu};
            EpiMoe2 E{Yb, biasl};
            pg8::gemm_phase<EpiMoe2, MoeOrder<4, false>, true, true, 1>(F.lds, Hb, W2T, DM, S, E);
        }
    }
    SEAM(7); STAMP();

    if (IN(8)) {
        F.refresh();
        LAS int* boff = (LAS int*)(F.lds + 131072);
        __syncthreads();
        if (F.tid < 64) {
            const int cn = (F.tid < 32) ? (int)ctl[CW_CNT + F.tid] : 0; const int nbk = (cn + 255) >> 8; int inc = nbk;
#pragma unroll
            for (int o = 1; o < 32; o <<= 1) { const int t = __shfl_up(inc, o); if (F.tid >= o) inc += t; }
            if (F.tid < 32) { boff[F.tid] = inc - nbk; if (F.tid == 31) boff[32] = inc; } }
        __syncthreads();
        const f32x4* gf = (const f32x4*)P.g_final;
        const f32x4 gfa = gf[2 * F.lane], gfb = gf[2 * F.lane + 1], gfc = gf[128 + 2 * F.lane], gfd = gf[128 + 2 * F.lane + 1];
        struct RowA { u32x4 iv; f32x4 gt; }; struct RowB { u32x4 ha, hb; u32x2 ya[4], yb[4]; };
#define P8_A(R, MM) do { R.iv = *(const u32x4*)(inv + (size_t)(MM) * 4); R.gt = *(const f32x4*)(gates + (size_t)(MM) * 4); } while (0)
#define P8_B(RB_, RA_, MM) do { RB_.ha = *(const u32x4*)(H1B + (size_t)(MM) * DM + 8 * F.lane); RB_.hb = *(const u32x4*)(H1B + (size_t)(MM) * DM + 512 + 8 * F.lane); \
            _Pragma("unroll") for (int k = 0; k < 4; ++k) { const int iv_ = (int)RA_.iv[k]; const size_t yrow = (size_t)boff[iv_ >> 16] * 256 + (iv_ & 0xffff); \
                RB_.ya[k] = *(const u32x2*)(Yb + yrow * DM + 8 * F.lane); RB_.yb[k] = *(const u32x2*)(Yb + yrow * DM + 512 + 8 * F.lane); } } while (0)
#define P8_C(RB_, RA_, MM) do { float v[16]; \
            _Pragma("unroll") for (int e = 0; e < 4; ++e) { v[2 * e] = bflo(RB_.ha[e]); v[2 * e + 1] = bfhi(RB_.ha[e]); v[8 + 2 * e] = bflo(RB_.hb[e]); v[8 + 2 * e + 1] = bfhi(RB_.hb[e]); } \
            _Pragma("unroll") for (int k = 0; k < 4; ++k) { const float gs = RA_.gt[k] * (1.0f / Y_SCALE); \
                _Pragma("unroll") for (int q = 0; q < 2; ++q) { const f32x2 a0 = __builtin_amdgcn_cvt_pk_f32_fp8((int)RB_.ya[k][q], false), a1 = __builtin_amdgcn_cvt_pk_f32_fp8((int)RB_.ya[k][q], true), b0 = __builtin_amdgcn_cvt_pk_f32_fp8((int)RB_.yb[k][q], false), b1 = __builtin_amdgcn_cvt_pk_f32_fp8((int)RB_.yb[k][q], true); \
                    v[4 * q] += gs * a0.x; v[4 * q + 1] += gs * a0.y; v[4 * q + 2] += gs * a1.x; v[4 * q + 3] += gs * a1.y; \
                    v[8 + 4 * q] += gs * b0.x; v[8 + 4 * q + 1] += gs * b0.y; v[8 + 4 * q + 2] += gs * b1.x; v[8 + 4 * q + 3] += gs * b1.y; } } \
            float ss = 0.f; _Pragma("unroll") for (int i_ = 0; i_ < 16; ++i_) ss += v[i_] * v[i_]; \
            const float rstd = rsqrtf(wave_sum_dpp(ss) * (1.0f / DM) + RMS_EPS); f32x4* op = (f32x4*)(P.out + (size_t)(MM) * DM); \
            op[2 * F.lane] = (f32x4){v[0], v[1], v[2], v[3]} * rstd * gfa; op[2 * F.lane + 1] = (f32x4){v[4], v[5], v[6], v[7]} * rstd * gfb; \
            op[128 + 2 * F.lane] = (f32x4){v[8], v[9], v[10], v[11]} * rstd * gfc; op[128 + 2 * F.lane + 1] = (f32x4){v[12], v[13], v[14], v[15]} * rstd * gfd; } while (0)
        RowA ra_[3]; RowB rb_[2];
        constexpr int NR8 = T / (256 * NWAVES);
        if (NGW == 256 * NWAVES) {
#pragma unroll
            for (int i = 0; i < NR8 + 2; ++i) {
                if (i < NR8) P8_A(ra_[i % 3], gw + i * NGW);
                if (i >= 1 && i < NR8 + 1) P8_B(rb_[(i - 1) & 1], ra_[(i - 1) % 3], gw + (i - 1) * NGW);
                if (i >= 2) P8_C(rb_[(i - 2) & 1], ra_[(i - 2) % 3], gw + (i - 2) * NGW);
            }
        } else {
            for (int m = gw; m < T; m += NGW) { P8_A(ra_[0], m); P8_B(rb_[0], ra_[0], m); P8_C(rb_[0], ra_[0], m); }
        }
#undef P8_A
#undef P8_B
#undef P8_C
    }
#if MK_DIAG
    STAMP();
    if (blockIdx.x == 0 && threadIdx.x == 0) { const unsigned long long* tstamp = (const unsigned long long*)(ctl + CW_DIAG + 16); asm volatile("s_waitcnt vmcnt(0)" ::: "memory"); const unsigned long long d = (MK_DIAG >= 10) ? (tstamp[9] - tstamp[0]) : (tstamp[MK_DIAG % 10] - tstamp[(MK_DIAG - 1) % 10]); __hip_atomic_store(ctl + CW_DIAG, (unsigned)d, __ATOMIC_RELAXED, __HIP_MEMORY_SCOPE_AGENT); }
    xcd_barrier(xbar);
#if MK_DIAG >= 21 && MK_DIAG <= 23
    { float us = (MK_DIAG == 21) ? (float)ctl[CW_DIAG + 2] * (1.0f / 256.0f) : (float)ctl[CW_DIAG + MK_DIAG - 19];
#elif MK_DIAG == 20
    { float us = 0.f; for (int u = 0; u < 1024; ++u) us += (float)(4 * (u & 31) + 4 - (int)ctl[CW_UTS + u]); us *= (1.0f / 256.0f);
#else
    { float us = (float)__hip_atomic_load(ctl + CW_DIAG, __ATOMIC_RELAXED, __HIP_MEMORY_SCOPE_AGENT) * 0.01f; us = exp2f(0.2f * rintf(log2f(fmaxf(us, 1.0f)) * 5.0f));
#endif
      const float c = sqrtf(us);
      for (size_t i = (size_t)blockIdx.x * NTHREADS + threadIdx.x; i < (size_t)T * DM; i += (size_t)F.G * NTHREADS) P.out[i] = c; }
#endif
#undef IN
#undef SEAM
}

extern "C" void kernel_launch(void* const* d_in, const int* in_sizes, int n_in, void* d_out, int out_size, void* d_ws, size_t ws_size, hipStream_t stream) {
    static int grid = 0;
    if (grid == 0) {
        if (n_in != 13 || in_sizes[0] != T * DM || out_size != T * DM || ws_size < WS_END) { fprintf(stderr, "kernel_launch: unexpected shapes (n_in %d, in0 %d, out %d, ws %zu)\n", n_in, n_in > 0 ? in_sizes[0] : -1, out_size, ws_size); grid = -1; return; }
        int dev = 0, cus = 0, per_cu = 0;
        if (hipGetDevice(&dev) != hipSuccess || hipDeviceGetAttribute(&cus, hipDeviceAttributeMultiprocessorCount, dev) != hipSuccess) { fprintf(stderr, "kernel_launch: device query failed\n"); grid = -1; return; }
        if (hipFuncSetAttribute((const void*)mk_fwd, hipFuncAttributeMaxDynamicSharedMemorySize, LDS_BYTES) != hipSuccess) { fprintf(stderr, "kernel_launch: hipFuncSetAttribute failed\n"); grid = -1; return; }
        if (hipOccupancyMaxActiveBlocksPerMultiprocessor(&per_cu, (const void*)mk_fwd, NTHREADS, LDS_BYTES) != hipSuccess || per_cu < 1) { fprintf(stderr, "kernel_launch: occupancy query says %d\n", per_cu); per_cu = 1; }
        (void)hipGetLastError();
        grid = cus * 1;
        if (grid != 256) fprintf(stderr, "kernel_launch: %d CUs (built for 256)\n", grid);
    }
    if (grid < 0) return;
    (void)hipMemsetAsync((char*)d_ws + WS_CTL, 0, CTL_BYTES, stream);
    Params p{};
    const float** pin = (const float**)&p;
    for (int i = 0; i < 13; ++i) pin[i] = (const float*)d_in[i];
    p.out = (float*)d_out; p.ws = (unsigned char*)d_ws;
#if MK_N_LAUNCHES == 1
    p.ph_lo = 0; p.ph_hi = 9;
    void* args[] = {&p};
    hipError_t e = hipLaunchCooperativeKernel((const void*)mk_fwd, dim3(grid), dim3(NTHREADS), args, LDS_BYTES, stream);
    if (e != hipSuccess) fprintf(stderr, "kernel_launch: cooperative launch failed: %s (grid %d)\n", hipGetErrorString(e), grid);
#else
    for (int k = 0; k < 9; ++k) { p.ph_lo = k; p.ph_hi = k + 1; hipLaunchKernelGGL(mk_fwd, dim3(grid), dim3(NTHREADS), LDS_BYTES, stream, p); }
#endif
}
```

```cpp
#include <hip/hip_runtime.h>
#include <hip/hip_cooperative_groups.h>
#include <cstdio>
#include <cstdint>
namespace cg = cooperative_groups;

#ifndef MK_N_LAUNCHES
#define MK_N_LAUNCHES 1
#endif
#ifndef MK_DUP
#define MK_DUP -1
#endif
#ifndef MK_DIAG
#define MK_DIAG 0
#endif

#define LAS __attribute__((address_space(3)))
#define GAS __attribute__((address_space(1)))
typedef unsigned short bf16_t;
typedef short bf16x8 __attribute__((ext_vector_type(8)));
typedef short s16x4 __attribute__((ext_vector_type(4)));
typedef float f32x2 __attribute__((ext_vector_type(2)));
typedef float f32x4 __attribute__((ext_vector_type(4)));
typedef float f32x16 __attribute__((ext_vector_type(16)));
typedef unsigned u32x2 __attribute__((ext_vector_type(2)));
typedef unsigned u32x4 __attribute__((ext_vector_type(4)));
typedef __bf16 bf16x2_t __attribute__((ext_vector_type(2)));

constexpr int BATCH = 4, SEQ = 8192, DM = 1024, T = BATCH * SEQ;
constexpr int RH = 4, RD = 128, FH = 8, FD = 64;
constexpr int NPROJ = 3584, INW = 3592;
constexpr int NE = 32, TOPK = 4, DFF = 1024;
constexpr int CAP = T;
constexpr int NBMAX = (T * TOPK) / 256 + NE;
constexpr float RMS_EPS = 1e-5f, GN_EPS = 1e-5f;
constexpr float LOG2E = 1.4426950408889634f;
constexpr float PRUNE_TH = 40.0f;
constexpr float C2 = 0.125f * 1.4426950408889634f;
constexpr int NTHREADS = 512, NWAVES = 8;

constexpr size_t MiB = 1u << 20;
constexpr size_t WS_CTL = 0, CTL_BYTES = 32768;
constexpr size_t WS_ROPEC = 1 * MiB, WS_ROPES = 3 * MiB;
constexpr size_t WS_WR3 = 5 * MiB;
constexpr size_t WS_LOGF = 6 * MiB;
constexpr size_t WS_F2 = 7 * MiB;
constexpr size_t WS_FA = 20 * MiB;
constexpr size_t WS_LTOK = 8 * MiB;
constexpr size_t WS_LRSTD = 12 * MiB;
constexpr size_t WS_INV = 16 * MiB;
constexpr size_t WS_GATE = 17 * MiB;
constexpr size_t WS_ONES = 19 * MiB;
constexpr size_t WS_IRS1 = 18 * MiB;
constexpr size_t WS_H1B = 32 * MiB;
constexpr size_t WS_WINT = 96 * MiB;
constexpr size_t WS_WOT = 104 * MiB;
constexpr size_t WS_W2T = 112 * MiB;
constexpr size_t WS_W1T = 144 * MiB;
constexpr size_t WS_H1F8 = 208 * MiB;
constexpr size_t WS_U = 448 * MiB;
constexpr size_t WS_PROJ = 512 * MiB;
constexpr size_t PROJ_STRIDE = 32 * MiB;
constexpr size_t WS_GST = 736 * MiB;
constexpr size_t WS_MIX = 752 * MiB;
constexpr size_t WS_H = 448 * MiB;
constexpr size_t WS_Y = 584 * MiB;
constexpr size_t WS_END = 856 * MiB;
constexpr float W_SCALE = 128.0f, H_SCALE = 4.0f, Y_SCALE = 16.0f, MIX_SCALE = 4.0f;
constexpr int CW_CNT = 0;
constexpr int CW_DIAG = 64;
constexpr int CW_QN2 = 128, CW_KN2 = 192;
constexpr int CW_BIN = 256;
constexpr int CW_QHEAD = 384;
constexpr int CW_SCAN = 448;
constexpr int CW_GDONE = 512;
constexpr int CW_UTS = 1024, CW_UPOS = 2048;
constexpr int CW_BAR = 4096;


constexpr int LDS_BYTES = 163840;
constexpr int LDS_MISC = LDS_BYTES - 16;

__device__ __forceinline__ unsigned cvtpk(float lo, float hi) { f32x2 v = {lo, hi}; bf16x2_t b = __builtin_convertvector(v, bf16x2_t); return __builtin_bit_cast(unsigned, b); }
__device__ __forceinline__ float bf2f(unsigned short h) { return __uint_as_float(((unsigned)h) << 16); }
__device__ __forceinline__ float bflo(unsigned w) { return __uint_as_float(w << 16); }
__device__ __forceinline__ float bfhi(unsigned w) { return __uint_as_float(w & 0xffff0000u); }
__device__ __forceinline__ float wave_sum(float v) {
#pragma unroll
    for (int o = 1; o < 64; o <<= 1) v += __shfl_xor(v, o);
    return v;
}
template <int CTRL> __device__ __forceinline__ float dpp_mov(float v) { return __int_as_float(__builtin_amdgcn_update_dpp(0, __float_as_int(v), CTRL, 0xF, 0xF, true)); }
__device__ __forceinline__ float row16_sum(float v) {
    v += dpp_mov<0xB1>(v);
    v += dpp_mov<0x4E>(v);
    v += dpp_mov<0x141>(v);
    v += dpp_mov<0x140>(v);
    return v; }
__device__ __forceinline__ float wave_sum_dpp(float v) {
    v = row16_sum(v);
    const float r0 = __int_as_float(__builtin_amdgcn_readlane(__float_as_int(v), 0)), r1 = __int_as_float(__builtin_amdgcn_readlane(__float_as_int(v), 16));
    const float r2 = __int_as_float(__builtin_amdgcn_readlane(__float_as_int(v), 32)), r3 = __int_as_float(__builtin_amdgcn_readlane(__float_as_int(v), 48));
    return (r0 + r1) + (r2 + r3); }
#define LDS_WAIT() asm volatile("s_waitcnt lgkmcnt(0)" ::: "memory")
#define VM_WAIT() asm volatile("s_waitcnt vmcnt(0)" ::: "memory")

struct Params {
    const float *x, *g_mix, *w_in, *b_forget, *w_out, *g_ffn, *w_router, *b_router, *w1, *b1, *w2, *b2, *g_final;
    float* out; unsigned char* ws; int ph_lo, ph_hi;
};

namespace pg8 {
constexpr int BM = 256, BK = 64, HALF = 128, HTB = HALF * BK * 2, STAGE_BYTES = 8 * HTB, NXCD = 8, WGM = 8;
__host__ __device__ __forceinline__ int lds_byte(int r, int c) { const int st = (r >> 4) * 2 + (c >> 5), rr = r & 15, cc = c & 31, ob = rr * 64 + cc * 2; return st * 1024 + (ob ^ (((ob >> 9) & 1) << 5)); }
__host__ __device__ __forceinline__ void stage_rc(int b, int& R, int& C) { const int st = b / 1024, sb = b % 1024, swz = sb ^ (((sb >> 9) & 1) << 5); R = (st >> 1) * 16 + swz / 64; C = (st & 1) * 32 + (swz % 64) / 2; }

struct Unit { int pm, pn, e, lb, idx; };

template <int NM, int NN>
struct DenseOrder {
    static constexpr int nM = NM, nN = NN, nwg = NM * NN;
    int G, c; int K; int dup; int i0, i1;
    __device__ void init(int M, int N, int K_, int G_, int c_, int dup_ = 1) { (void)M; (void)N; G = G_; c = c_; K = K_; dup = dup_; i0 = 0; i1 = 1 << 30; }
    __device__ __forceinline__ bool next(int i_, Unit& u) const {
        const int i = i_ + i0; if (i >= i1) return false;
        const int L = i * G + c; if (L >= nwg * dup) return false;
        int wgid = L % nwg; { constexpr int q = nwg / NXCD, r = nwg % NXCD; const int xcd = wgid % NXCD, off = wgid / NXCD; wgid = (xcd < r ? xcd * (q + 1) : r * (q + 1) + (xcd - r) * q) + off; }
        static_assert(NM % WGM == 0, "row-tile groups are full");
        constexpr int nig = WGM * nN; const int gid = wgid / nig, fm = gid * WGM;
        u.pm = fm + ((wgid % nig) % WGM); u.pn = (wgid % nig) / WGM; u.e = 0; u.lb = 0; u.idx = i; return true;
    }
    __device__ __forceinline__ void aoffs(const Unit& u, unsigned (&ao)[2][2], const int (&R)[2], const int (&C)[2], int rowbytes) const {
#pragma unroll
        for (int h = 0; h < 2; ++h)
#pragma unroll
            for (int i = 0; i < 2; ++i) ao[h][i] = (unsigned)((u.pm * BM + h * HALF + R[i]) * rowbytes + C[i] * 2);
    }
};

typedef int v8i32 __attribute__((ext_vector_type(8)));
typedef int v4i32 __attribute__((ext_vector_type(4)));
template <class Epi, class Sched, bool ALIGN_EPI, bool SP2, int ES>
__device__ __forceinline__ void gemm_phase(LAS unsigned char* lds, const void* Abase, const void* Btbase, const int K, const Sched& S, const Epi& E) {
    const int tid = threadIdx.x, wid = __builtin_amdgcn_readfirstlane(tid >> 6), lane = tid & 63, wr = wid >> 2, wc = wid & 3, fr = lane & 15, fq = lane >> 4;
    const int rowbytes = K * ES;
    const int nt = rowbytes / 128;
    int RR[2], CC[2]; unsigned voffB[2];
#pragma unroll
    for (int i = 0; i < 2; ++i) { stage_rc(tid * 16 + i * 8192, RR[i], CC[i]); voffB[i] = (unsigned)(RR[i] * rowbytes + CC[i] * 2); }
    const size_t kstep = (size_t)128;
    const size_t hstep = (size_t)HALF * rowbytes;
    const size_t tstep = 2 * hstep;
    const unsigned ldsw = (unsigned)wid * 1024u;
    const int aoff = lds_byte(wr * 64 + fr, fq * 8), boff = lds_byte(wc * 32 + fr, fq * 8);
    const char* Ab = (const char*)Abase;
#define PG8_SA(b, h) (((b) * 2 + (h)) * HTB)
#define PG8_SB(b, h) ((4 + (b) * 2 + (h)) * HTB)
#define PG8_STAGE(bufoff, gbase, voff) do { _Pragma("unroll") for (int _i = 0; _i < 2; ++_i) \
        __builtin_amdgcn_global_load_lds((const unsigned*)((const char*)(gbase) + (voff)[_i]), (LAS unsigned*)(lds + (bufoff) + ldsw + _i * 8192), 16, 0, 0); } while (0)
#define PG8_STAGE_A(bufoff, kb, AO, h) do { _Pragma("unroll") for (int _i = 0; _i < 2; ++_i) \
        __builtin_amdgcn_global_load_lds((const unsigned*)(Ab + (kb) + (AO)[h][_i]), (LAS unsigned*)(lds + (bufoff) + ldsw + _i * 8192), 16, 0, 0); } while (0)
#define PG8_LDA(dst, b, h) do { _Pragma("unroll") for (int m = 0; m < 4; ++m) _Pragma("unroll") for (int k = 0; k < 2; ++k) dst[m][k] = *(const LAS bf16x8*)(lds + PG8_SA(b, h) + aoff + m * 2048 + k * 1024); } while (0)
#define PG8_LDB(dst, b, h) do { _Pragma("unroll") for (int n = 0; n < 2; ++n) _Pragma("unroll") for (int k = 0; k < 2; ++k) dst[n][k] = *(const LAS bf16x8*)(lds + PG8_SB(b, h) + boff + n * 2048 + k * 1024); } while (0)
#define PG8_F8(x) __builtin_shufflevector(__builtin_bit_cast(v4i32, (x)[0]), __builtin_bit_cast(v4i32, (x)[1]), 0, 1, 2, 3, 4, 5, 6, 7)
#define PG8_MMA(ai, bj, At, Bt) do { __builtin_amdgcn_s_setprio(1); _Pragma("unroll") for (int m = 0; m < 4; ++m) _Pragma("unroll") for (int n = 0; n < 2; ++n) { \
        if constexpr (ES == 2) { _Pragma("unroll") for (int k = 0; k < 2; ++k) acc[ai][bj][m][n] = __builtin_amdgcn_mfma_f32_16x16x32_bf16(Bt[n][k], At[m][k], acc[ai][bj][m][n], 0, 0, 0); } \
        else asm volatile("v_mfma_f32_16x16x128_f8f6f4 %0, %1, %2, %0" : "+v"(acc[ai][bj][m][n]) : "v"(PG8_F8(Bt[n])), "v"(PG8_F8(At[m]))); } \
        __builtin_amdgcn_s_setprio(0); } while (0)
#define PG8_WAIT_V(n) asm volatile("s_waitcnt vmcnt(" #n ")" ::: "memory")
#define PG8_WAIT_L(n) asm volatile("s_waitcnt lgkmcnt(" #n ")" ::: "memory")
#define PG8_BAR __builtin_amdgcn_s_barrier()
#define PG8_SCHED __builtin_amdgcn_sched_barrier(0)
    Unit cur, nxt; int ui = 0;
    if (!S.next(0, cur)) return;
    f32x4 acc[2][2][4][2];
#define PG8_ZERO() do { _Pragma("unroll") for (int a = 0; a < 2; ++a) _Pragma("unroll") for (int b = 0; b < 2; ++b) _Pragma("unroll") for (int m = 0; m < 4; ++m) _Pragma("unroll") for (int n = 0; n < 2; ++n) { \
        f32x2 z0_, z1_; asm volatile("v_mov_b64 %0, 0" : "=v"(z0_)); asm volatile("v_mov_b64 %0, 0" : "=v"(z1_)); acc[a][b][m][n] = (f32x4){z0_.x, z0_.y, z1_.x, z1_.y}; } } while (0)
    PG8_ZERO();
    bf16x8 At[4][2], B0[2][2], B1[2][2];
    unsigned aoC[2][2], aoN[2][2];
    S.aoffs(cur, aoC, RR, CC, rowbytes);
    const char* cB = (const char*)Btbase + (size_t)cur.pn * tstep;
    static_assert(SP2, "only the SP2 loop is kept");
    PG8_STAGE(PG8_SB(0, 0), cB, voffB); PG8_STAGE(PG8_SB(0, 1), cB + hstep, voffB); PG8_STAGE_A(PG8_SA(0, 0), 0, aoC, 0); PG8_STAGE_A(PG8_SA(0, 1), 0, aoC, 1);
    if (wr == 1) PG8_BAR;
    PG8_WAIT_V(2); PG8_BAR;
    PG8_STAGE(PG8_SB(1, 0), cB + kstep, voffB); PG8_STAGE_A(PG8_SA(1, 0), kstep, aoC, 0); PG8_STAGE(PG8_SB(1, 1), cB + hstep + kstep, voffB);
    PG8_WAIT_V(6); PG8_BAR;
    for (;;) {
        const bool has_next = S.next(ui + 1, nxt);
        if (has_next) S.aoffs(nxt, aoN, RR, CC, rowbytes);
        else {
#pragma unroll
            for (int h = 0; h < 2; ++h)
#pragma unroll
                for (int i = 0; i < 2; ++i) aoN[h][i] = aoC[h][i];
        }
        const char* nB = has_next ? (const char*)Btbase + (size_t)nxt.pn * tstep : cB;
#pragma unroll 1
        for (int t = 0; t < nt; t += 2) {
            const bool last = (t == nt - 2);
            const size_t kb1 = (size_t)(t + 1) * kstep;
            const size_t kb2 = last ? 0 : (size_t)(t + 2) * kstep, kb3 = kb2 + kstep;
            unsigned ao2[2][2];
#pragma unroll
            for (int h = 0; h < 2; ++h)
#pragma unroll
                for (int i = 0; i < 2; ++i) ao2[h][i] = last ? aoN[h][i] : aoC[h][i];
            const char* b2 = last ? nB : cB + (size_t)(t + 2) * kstep;
            const char* b3 = b2 + kstep;
            PG8_LDB(B0, 0, 0); PG8_LDB(B1, 0, 1); PG8_SCHED; PG8_LDA(At, 0, 0); PG8_STAGE_A(PG8_SA(1, 1), kb1, aoC, 1);
            PG8_WAIT_V(8); PG8_WAIT_L(0); PG8_BAR; PG8_MMA(0, 0, At, B0); PG8_MMA(0, 1, At, B1); PG8_BAR; PG8_SCHED;
            PG8_LDA(At, 0, 1); PG8_STAGE(PG8_SB(0, 0), b2, voffB); PG8_STAGE(PG8_SB(0, 1), b2 + hstep, voffB); PG8_STAGE_A(PG8_SA(0, 0), kb2, ao2, 0);
            PG8_WAIT_V(8); PG8_WAIT_L(0); PG8_BAR; PG8_MMA(1, 0, At, B0); PG8_MMA(1, 1, At, B1); PG8_BAR; PG8_SCHED;
            PG8_LDB(B0, 1, 0); PG8_LDB(B1, 1, 1); PG8_SCHED; PG8_LDA(At, 1, 0); PG8_STAGE_A(PG8_SA(0, 1), kb2, ao2, 1);
            PG8_WAIT_V(8); PG8_WAIT_L(0); PG8_BAR; PG8_MMA(0, 0, At, B0); PG8_MMA(0, 1, At, B1); PG8_BAR; PG8_SCHED;
            PG8_LDA(At, 1, 1); PG8_STAGE(PG8_SB(1, 0), b3, voffB); PG8_STAGE(PG8_SB(1, 1), b3 + hstep, voffB); PG8_STAGE_A(PG8_SA(1, 0), kb3, ao2, 0);
            PG8_WAIT_V(8); PG8_WAIT_L(0); PG8_BAR; PG8_MMA(1, 0, At, B0); PG8_MMA(1, 1, At, B1); PG8_BAR; PG8_SCHED;
        }
        if constexpr (ALIGN_EPI) { if (wr == 0) PG8_BAR; }
        if constexpr (ES == 1) asm volatile("s_nop 15\n\ts_nop 15" ::: "memory");
        E(acc, cur, wr, wc, fr, fq);
        if (!has_next) break;
        PG8_ZERO();
        cur = nxt; cB = nB; ++ui;
#pragma unroll
        for (int h = 0; h < 2; ++h)
#pragma unroll
            for (int i = 0; i < 2; ++i) aoC[h][i] = aoN[h][i];
        if constexpr (ALIGN_EPI) { if (wr == 1) PG8_BAR; }
    }
    PG8_WAIT_V(0);
    if constexpr (!ALIGN_EPI) { if (wr == 0) PG8_BAR; }
    PG8_BAR;
#undef PG8_ZERO
#undef PG8_SA
#undef PG8_SB
#undef PG8_STAGE
#undef PG8_STAGE_A
#undef PG8_LDA
#undef PG8_LDB
#undef PG8_MMA
#undef PG8_F8
#undef PG8_WAIT_V
#undef PG8_WAIT_L
#undef PG8_BAR
#undef PG8_SCHED
}
}


__device__ __forceinline__ int perm32_pos(int t) { return 16 * ((t >> 2) & 1) + 4 * ((t >> 3) & 3) + (t & 3); }
__device__ __forceinline__ int pos_inproj(int c) {
    if (c < 1024) { const int hc = c & 127; return (c & ~127) | (32 * ((hc >> 4) & 3) + 16 * (hc >> 6) + (hc & 15)); }
    return (c & ~31) | perm32_pos(c & 31);
}
__device__ __forceinline__ int pos_plain(int c) { return (c & ~31) | perm32_pos(c & 31); }
__device__ __forceinline__ int pos_wide(int c) { const int t = c & 255; return (c & ~255) | (128 * ((t >> 3) & 1) + 32 * (t >> 6) + 16 * ((t >> 2) & 1) + 4 * ((t >> 4) & 3) + (t & 3)); }
__device__ __forceinline__ int pos_w1(int n) { const int jj = n & 1023, lin = n >> 10, pn = jj >> 7, tp = jj & 127; return pn * 256 + lin * 128 + ((tp & ~31) | perm32_pos(tp & 31)); }

struct EpiInProj {
    unsigned char* proj; const float* ropec; const float* ropes; unsigned* ctl;
    __device__ __forceinline__ void operator()(const f32x4 (&acc)[2][2][4][2], const pg8::Unit& u, int wr, int wc, int fr, int fq) const {
        const int type = u.pn >> 1; bf16_t* base = (bf16_t*)(proj + (size_t)type * PROJ_STRIDE);
        const int colh = (u.pn & 1) * 256;
        if (type < 2) {
            const float sc = (type == 1) ? 0.08838834764831845f : 1.0f;
            const int i0 = 16 * wc + 4 * fq;
#pragma unroll
            for (int ai = 0; ai < 2; ++ai)
#pragma unroll
                for (int m = 0; m < 4; ++m) {
                    const int row = u.pm * 256 + ai * 128 + wr * 64 + m * 16 + fr; const int pos = row & (SEQ - 1);
                    const f32x4 cs = *(const f32x4*)(ropec + pos * 64 + i0), sn = *(const f32x4*)(ropes + pos * 64 + i0);
#pragma unroll
                    for (int bj = 0; bj < 2; ++bj) {
                        const f32x4 x1 = acc[ai][bj][m][0], x2 = acc[ai][bj][m][1];
                        const f32x4 o1 = (x1 * cs - x2 * sn) * sc, o2 = (x1 * sn + x2 * cs) * sc;
                        bf16_t* dst = base + (size_t)row * 512 + colh + bj * 128 + i0;
                        u32x2 w1, w2; w1.x = cvtpk(o1[0], o1[1]); w1.y = cvtpk(o1[2], o1[3]); w2.x = cvtpk(o2[0], o2[1]); w2.y = cvtpk(o2[2], o2[3]);
                        *(u32x2*)dst = w1; *(u32x2*)(dst + 64) = w2;
                    }
                }
        } else {
            const float sc = (type == 4) ? C2 : 1.0f;
            float mx[2] = {0.f, 0.f};
#pragma unroll
            for (int ai = 0; ai < 2; ++ai)
#pragma unroll
                for (int m = 0; m < 4; ++m) {
                    const int row = u.pm * 256 + ai * 128 + wr * 64 + m * 16 + fr;
#pragma unroll
                    for (int bj = 0; bj < 2; ++bj) {
                        f32x4 v0 = acc[ai][bj][m][0] * sc, v1 = acc[ai][bj][m][1] * sc;
                        if (type == 4 || type == 5) { float ssq = (v0[0] * v0[0] + v0[1] * v0[1]) + (v0[2] * v0[2] + v0[3] * v0[3]) + (v1[0] * v1[0] + v1[1] * v1[1]) + (v1[2] * v1[2] + v1[3] * v1[3]);
                            ssq += __shfl_xor(ssq, 16); ssq += __shfl_xor(ssq, 32); mx[bj] = fmaxf(mx[bj], ssq); }
                        if (type == 3) {
#pragma unroll
                            for (int j = 0; j < 4; ++j) { v0[j] = v0[j] * __builtin_amdgcn_rcpf(1.0f + __builtin_amdgcn_exp2f(-LOG2E * v0[j])); v1[j] = v1[j] * __builtin_amdgcn_rcpf(1.0f + __builtin_amdgcn_exp2f(-LOG2E * v1[j])); }
                        }
                        u32x4 w; w.x = cvtpk(v0[0], v0[1]); w.y = cvtpk(v0[2], v0[3]); w.z = cvtpk(v1[0], v1[1]); w.w = cvtpk(v1[2], v1[3]);
                        __builtin_nontemporal_store(w, (u32x4*)(base + (size_t)row * 512 + colh + bj * 128 + wc * 32 + 8 * fq));
                    }
                }
            if (type == 4 || type == 5) {
#pragma unroll
                for (int bj = 0; bj < 2; ++bj) { float v = mx[bj]; v = fmaxf(v, __shfl_xor(v, 1)); v = fmaxf(v, __shfl_xor(v, 2)); v = fmaxf(v, __shfl_xor(v, 4)); v = fmaxf(v, __shfl_xor(v, 8));
                    if ((threadIdx.x & 63) == 0) { const int bh = (u.pm >> 5) * 8 + (u.pn & 1) * 4 + bj * 2 + (wc >> 1);
                        atomicMax(ctl + ((type == 4) ? CW_QN2 : CW_KN2) + bh * 2 + (wc & 1), __float_as_uint(v)); } }
            }
        }
    }
};

__device__ __forceinline__ unsigned pk4_fp8(float a, float b, float c, float d) { int w = 0; w = __builtin_amdgcn_cvt_pk_fp8_f32(a, b, w, false); w = __builtin_amdgcn_cvt_pk_fp8_f32(c, d, w, true); return (unsigned)w; }
struct EpiOutProj {
    const bf16_t* U; const float* irs1; const float* g_mix; bf16_t* h1b; unsigned char* h1f8;
    __device__ __forceinline__ void operator()(const f32x4 (&acc)[2][2][4][2], const pg8::Unit& u, int wr, int wc, int fr, int fq) const {
        const int col = u.pn * 256 + 64 * wc + 16 * fq;
        f32x4 gi[2][2];
#pragma unroll
        for (int q = 0; q < 4; ++q) { f32x4 g = *(const f32x4*)(g_mix + col + 4 * q);
#pragma unroll
            for (int j = 0; j < 4; ++j) g[j] = __builtin_amdgcn_rcpf(g[j]);
            gi[q >> 1][q & 1] = g; }
#pragma unroll
        for (int ai = 0; ai < 2; ++ai) {
            u32x4 uw[4][2]; float ir[4];
#pragma unroll
            for (int m = 0; m < 4; ++m) { const int row = u.pm * 256 + ai * 128 + wr * 64 + m * 16 + fr; ir[m] = irs1[row];
                uw[m][0] = *(const u32x4*)(U + (size_t)row * DM + col); uw[m][1] = *(const u32x4*)(U + (size_t)row * DM + col + 8); }
#pragma unroll
            for (int m = 0; m < 4; ++m) {
                const int row = u.pm * 256 + ai * 128 + wr * 64 + m * 16 + fr; const float s = ir[m]; u32x4 wf8;
#pragma unroll
                for (int bj = 0; bj < 2; ++bj) { const u32x4 w4 = uw[m][bj];
                    const f32x4 xa = {bflo(w4.x), bfhi(w4.x), bflo(w4.y), bfhi(w4.y)}, xb = {bflo(w4.z), bfhi(w4.z), bflo(w4.w), bfhi(w4.w)};
                    const f32x4 v0 = acc[ai][bj][m][0] * (1.0f / (MIX_SCALE * W_SCALE)) + xa * gi[bj][0] * s, v1 = acc[ai][bj][m][1] * (1.0f / (MIX_SCALE * W_SCALE)) + xb * gi[bj][1] * s;
                    u32x4 w; w.x = cvtpk(v0[0], v0[1]); w.y = cvtpk(v0[2], v0[3]); w.z = cvtpk(v1[0], v1[1]); w.w = cvtpk(v1[2], v1[3]);
                    *(u32x4*)(h1b + (size_t)row * DM + col + 8 * bj) = w;
                    wf8[2 * bj] = pk4_fp8(v0[0], v0[1], v0[2], v0[3]); wf8[2 * bj + 1] = pk4_fp8(v1[0], v1[1], v1[2], v1[3]); }
                *(u32x4*)(h1f8 + (size_t)row * DM + col) = wf8;
            }
            asm volatile("" ::: "memory");
        }
    }
};

struct EpiMoe1 {
    unsigned char* H; const LAS unsigned* tokr; const LAS bf16_t* biasl;
    __device__ __forceinline__ void operator()(const f32x4 (&acc)[2][2][4][2], const pg8::Unit& u, int wr, int wc, int fr, int fq) const {
        const int e = u.e, pnl = u.pn - e * 8; const int cl = wc * 32 + 8 * fq, cq = pnl * 128 + cl;
        const u32x4 bgw = *(const LAS u32x4*)(biasl + u.idx * 256 + cl), blw = *(const LAS u32x4*)(biasl + u.idx * 256 + 128 + cl);
        constexpr float K1 = 1.702f * LOG2E;
        const f32x4 bg0 = (f32x4){bflo(bgw.x), bfhi(bgw.x), bflo(bgw.y), bfhi(bgw.y)} * K1, bg1 = (f32x4){bflo(bgw.z), bfhi(bgw.z), bflo(bgw.w), bfhi(bgw.w)} * K1;
        const f32x4 bl0 = {bflo(blw.x), bfhi(blw.x), bflo(blw.y), bfhi(blw.y)}, bl1 = {bflo(blw.z), bfhi(blw.z), bflo(blw.w), bfhi(blw.w)};
#pragma unroll
        for (int ai = 0; ai < 2; ++ai)
#pragma unroll
            for (int m = 0; m < 4; ++m) {
                const int rt = ai * 128 + wr * 64 + m * 16 + fr;
                const float rs = bfhi(tokr[u.idx * 256 + rt]) * (1.0f / W_SCALE);
                const float rk = rs * K1; float o[8];
                const f32x2 rk2 = {rk, rk}, rs2 = {rs, rs}, hk2 = {H_SCALE / K1, H_SCALE / K1}, one2 = {1.0f, 1.0f};
#pragma unroll
                for (int hh = 0; hh < 2; ++hh)
#pragma unroll
                    for (int jp = 0; jp < 2; ++jp) {
                        const f32x4 ag = acc[ai][0][m][hh], al = acc[ai][1][m][hh], bgv = hh ? bg1 : bg0, blv = hh ? bl1 : bl0;
                        const f32x2 ag2 = {ag[2 * jp], ag[2 * jp + 1]}, al2 = {al[2 * jp], al[2 * jp + 1]}, bg2 = {bgv[2 * jp], bgv[2 * jp + 1]}, bl2 = {blv[2 * jp], blv[2 * jp + 1]};
                        f32x2 gk = __builtin_elementwise_fma(ag2, rk2, bg2);
                        gk.x = __builtin_fminf(gk.x, 7.0f * K1); gk.y = __builtin_fminf(gk.y, 7.0f * K1);
                        f32x2 ex = {__builtin_amdgcn_exp2f(-gk.x), __builtin_amdgcn_exp2f(-gk.y)};
                        ex = ex + one2;
                        const f32x2 rc = {__builtin_amdgcn_rcpf(ex.x), __builtin_amdgcn_rcpf(ex.y)};
                        const f32x2 sg = gk * rc;
                        f32x2 l = __builtin_elementwise_fma(al2, rs2, bl2);
                        l.x = __builtin_fminf(__builtin_fmaxf(l.x, -7.0f), 7.0f); l.y = __builtin_fminf(__builtin_fmaxf(l.y, -7.0f), 7.0f);
                        const f32x2 ov = sg * __builtin_elementwise_fma(l, hk2, hk2);
                        o[4 * hh + 2 * jp] = ov.x; o[4 * hh + 2 * jp + 1] = ov.y;
                    }
                u32x2 w; w.x = pk4_fp8(o[0], o[1], o[2], o[3]); w.y = pk4_fp8(o[4], o[5], o[6], o[7]);
                *(u32x2*)(H + (size_t)(u.pm * 256 + rt) * DFF + cq) = w;
            }
    }
};

struct EpiNull { float* sink;
    __device__ __forceinline__ void operator()(const f32x4 (&acc)[2][2][4][2], const pg8::Unit& u, int wr, int wc, int fr, int fq) const {
        float s = 0.f;
#pragma unroll
        for (int ai = 0; ai < 2; ++ai)
#pragma unroll
            for (int bj = 0; bj < 2; ++bj)
#pragma unroll
                for (int m = 0; m < 4; ++m)
#pragma unroll
                    for (int n = 0; n < 2; ++n) s += acc[ai][bj][m][n][0];
        if (s == 123.456f) sink[0] = s;
    }
};
struct EpiMoe2 {
    unsigned char* Y; const LAS bf16_t* biasl;
    __device__ __forceinline__ void operator()(const f32x4 (&acc)[2][2][4][2], const pg8::Unit& u, int wr, int wc, int fr, int fq) const {
        const int e = u.e, pnl = u.pn - e * 4; const int cl = 64 * wc + 16 * fq, col = pnl * 256 + cl;
        const u32x4 bw0 = *(const LAS u32x4*)(biasl + u.idx * 256 + cl), bw1 = *(const LAS u32x4*)(biasl + u.idx * 256 + cl + 8);
        f32x4 bb[2][2];
        bb[0][0] = (f32x4){bflo(bw0.x), bfhi(bw0.x), bflo(bw0.y), bfhi(bw0.y)} * Y_SCALE; bb[0][1] = (f32x4){bflo(bw0.z), bfhi(bw0.z), bflo(bw0.w), bfhi(bw0.w)} * Y_SCALE;
        bb[1][0] = (f32x4){bflo(bw1.x), bfhi(bw1.x), bflo(bw1.y), bfhi(bw1.y)} * Y_SCALE; bb[1][1] = (f32x4){bflo(bw1.z), bfhi(bw1.z), bflo(bw1.w), bfhi(bw1.w)} * Y_SCALE;
#pragma unroll
        for (int ai = 0; ai < 2; ++ai)
#pragma unroll
            for (int m = 0; m < 4; ++m) {
                const int rt = ai * 128 + wr * 64 + m * 16 + fr; u32x4 w;
#pragma unroll
                for (int bj = 0; bj < 2; ++bj) { const f32x4 v0 = acc[ai][bj][m][0] * (Y_SCALE / (W_SCALE * H_SCALE)) + bb[bj][0], v1 = acc[ai][bj][m][1] * (Y_SCALE / (W_SCALE * H_SCALE)) + bb[bj][1];
                    w[2 * bj] = pk4_fp8(v0[0], v0[1], v0[2], v0[3]); w[2 * bj + 1] = pk4_fp8(v1[0], v1[1], v1[2], v1[3]); }
                *(u32x4*)(Y + (size_t)(u.pm * 256 + rt) * DM + col) = w;
            }
    }
};

template <int NT, bool GATHER>
struct MoeOrder {
    const LAS int* boff;
    const LAS int* cntl;
    const LAS unsigned* tokl;
    int G, vcu;
    __device__ __forceinline__ bool next(int i, pg8::Unit& u) const {
        int x, j, rpb;
        if (G == 256) { x = vcu >> 5; j = vcu & 31; rpb = 32 / NT; }
        else { const int cpx = G >> 3; x = vcu / cpx; j = vcu % cpx; rpb = cpx / NT; }
        const int rb = (i * 8 + x) * rpb + j / NT; const int nb = boff[32];
        if (rb >= nb) return false;
        const int bk = boff[__lane_id() & 31]; const int e = __builtin_popcount((unsigned)__ballot(bk <= rb)) - 1;
        u.pm = rb; u.e = e; u.lb = rb - boff[e]; u.pn = e * NT + (j % NT); u.idx = i; return true;
    }
    __device__ __forceinline__ void aoffs(const pg8::Unit& u, unsigned (&ao)[2][2], const int (&R)[2], const int (&C)[2], int rowbytes) const {
#pragma unroll
        for (int h = 0; h < 2; ++h)
#pragma unroll
            for (int i = 0; i < 2; ++i) {
                if constexpr (GATHER) {
                    const int tok = (int)(tokl[u.idx * 256 + h * 128 + R[i]] & 0xffffu);
                    ao[h][i] = (unsigned)(tok * rowbytes + C[i] * 2);
                } else ao[h][i] = (unsigned)((u.pm * 256 + h * 128 + R[i]) * rowbytes + C[i] * 2);
            }
    }
};

namespace attn_body {
constexpr int NHEAD = FH, D = 64, PQ = 512, PO = 1024;
constexpr int NW = 8, QBLK = 32, QB = QBLK * NW, KVBLK = 64, NQB = SEQ / QB;
__device__ __forceinline__ int crow(int r, int hi) { return (r & 3) + 8 * (r >> 2) + 4 * hi; }
#define SBAR() __builtin_amdgcn_sched_barrier(0)
__device__ __forceinline__ void cmask(f32x16& p0, f32x16& p1, int jb, int qrel, int hi) {
    const float NEG = -INFINITY; int kb = 64 * jb + 4 * hi;
#pragma unroll
    for (int r = 0; r < 16; ++r) { int kv = kb + (r & 3) + 8 * (r >> 2); if (kv > qrel) p0[r] = NEG; if (kv + 32 > qrel) p1[r] = NEG; }
}
constexpr int NSLOT = 3, SLOTB = 8192;
constexpr int LDS_K = 0, LDS_V = NSLOT * SLOTB, LDS_WS = 2 * NSLOT * SLOTB, LDS_OST = LDS_WS + NW * 64 * 4, LDS_END = LDS_OST + NW * 4096;
constexpr int LDS_STOP = 156672;
constexpr int LDS_QUEUE = 151552;
constexpr int LDS_F = 86016, LDS_F_BYTES = SEQ * 8;
static_assert(LDS_F >= LDS_END + 512 && LDS_F + LDS_F_BYTES <= LDS_QUEUE && LDS_QUEUE + 4608 <= LDS_STOP && LDS_STOP + 32 <= LDS_BYTES - 16, "attention LDS map");
__device__ __forceinline__ void glds16(const void* gsrc, unsigned lds_dst) { unsigned keep;
    asm volatile("s_mov_b32 %0, m0\n\ts_mov_b32 m0, %2\n\ts_nop 0\n\tglobal_load_lds_dwordx4 %1, off\n\ts_mov_b32 m0, %0" : "=&s"(keep) : "v"(gsrc), "s"(lds_dst) : "memory"); }
__device__ __forceinline__ float max3f(float a, float b, float c) { float r; asm("v_max3_f32 %0, %1, %2, %3" : "=v"(r) : "v"(a), "v"(b), "v"(c)); return r; }
__device__ __forceinline__ float max2f(float a, float b) { float r; asm("v_max_f32_e32 %0, %1, %2" : "=v"(r) : "v"(a), "v"(b)); return r; }
__device__ __forceinline__ float fadd_s(float a, float b) { float r; asm("v_add_f32_e32 %0, %1, %2" : "=v"(r) : "v"(a), "v"(b)); return r; }
__device__ __forceinline__ float fsub_s(float a, float b) { float r; asm("v_sub_f32_e32 %0, %1, %2" : "=v"(r) : "v"(a), "v"(b)); return r; }
#define WAIT_BAR(N) asm volatile("s_waitcnt vmcnt(" #N ") lgkmcnt(0)\n\ts_barrier" ::: "memory")

typedef LAS const char* lds_cptr;
typedef short v4i16_t __attribute__((ext_vector_type(4)));
__device__ __forceinline__ void kload8(bf16x8* kf, lds_cptr kp) {
    kf[0] = *(const LAS bf16x8*)(kp);        kf[1] = *(const LAS bf16x8*)(kp + 512);
    kf[2] = *(const LAS bf16x8*)(kp + 2048); kf[3] = *(const LAS bf16x8*)(kp + 2560);
    kf[4] = *(const LAS bf16x8*)(kp + 4096); kf[5] = *(const LAS bf16x8*)(kp + 4608);
    kf[6] = *(const LAS bf16x8*)(kp + 6144); kf[7] = *(const LAS bf16x8*)(kp + 6656);
}
__device__ __forceinline__ void kload2(bf16x8* kf, lds_cptr kp, int j) { kf[2 * j] = *(const LAS bf16x8*)(kp + j * 2048); kf[2 * j + 1] = *(const LAS bf16x8*)(kp + j * 2048 + 512); }
__device__ __forceinline__ s16x4 vtr(lds_cptr p) { return __builtin_bit_cast(s16x4, __builtin_amdgcn_ds_read_tr16_b64_v4i16((LAS v4i16_t*)p)); }
__device__ __forceinline__ float rowmax(const f32x16& p0, const f32x16& p1) {
    float a = max3f(p0[0], p0[1], p1[0]), b = max3f(p0[2], p0[3], p1[1]); a = max3f(a, p1[2], p1[3]);
#pragma unroll
    for (int r = 4; r < 16; r += 4) { a = max3f(a, p0[r], p0[r + 1]); b = max3f(b, p0[r + 2], p0[r + 3]); a = max3f(a, p1[r], p1[r + 1]); b = max3f(b, p1[r + 2], p1[r + 3]); }
    const float m = max2f(a, b);
    auto rr = __builtin_amdgcn_permlane32_swap(__float_as_uint(m), __float_as_uint(m), false, false);
    return max2f(__uint_as_float(rr[0]), __uint_as_float(rr[1]));
}
__device__ __forceinline__ void pv(f32x16* o, int vb, bf16x8 pa0, bf16x8 pa1, bf16x8 pa2, bf16x8 pa3) {
#pragma unroll
    for (int d0 = 0; d0 < 2; ++d0) { s16x4 lo[4], hi[4];
#pragma unroll
        for (int ks = 0; ks < 4; ++ks) {
            asm volatile("ds_read_b64_tr_b16 %0,%1 offset:%c2" : "=&v"(lo[ks]) : "v"(vb), "i"(d0 * 4096 + ks * 1024) : "memory");
            asm volatile("ds_read_b64_tr_b16 %0,%1 offset:%c2" : "=&v"(hi[ks]) : "v"(vb), "i"(d0 * 4096 + ks * 1024 + 512) : "memory"); }
        asm volatile("s_waitcnt lgkmcnt(0)" ::: "memory"); SBAR();
#define PK(k) (bf16x8){lo[k][0], lo[k][1], lo[k][2], lo[k][3], hi[k][0], hi[k][1], hi[k][2], hi[k][3]}
        o[d0] = __builtin_amdgcn_mfma_f32_32x32x16_bf16(pa0, PK(0), o[d0], 0, 0, 0);
        o[d0] = __builtin_amdgcn_mfma_f32_32x32x16_bf16(pa1, PK(1), o[d0], 0, 0, 0);
        o[d0] = __builtin_amdgcn_mfma_f32_32x32x16_bf16(pa2, PK(2), o[d0], 0, 0, 0);
        o[d0] = __builtin_amdgcn_mfma_f32_32x32x16_bf16(pa3, PK(3), o[d0], 0, 0, 0);
#undef PK
    }
}

template <int THRL> __device__ __forceinline__ int attn_unit(int b, int h, int qb, int ts, float kmaxc, const bf16_t* Q, const bf16_t* __restrict__ K, const bf16_t* __restrict__ V, unsigned char* O, const unsigned* __restrict__ FA, char* shm, unsigned* qhead, LAS int* qnext) {
    const int tid = threadIdx.x, lane = tid & 63, r32 = lane & 31, hi = lane >> 5; const int wid = __builtin_amdgcn_readfirstlane(tid >> 6);
    const long rowbase = (long)b * SEQ; const int q0 = qb * QB;
    const int NT0 = (q0 + QB) / KVBLK - ts, TL = NT0 - 1; int NT = NT0;
    const bf16_t* Qw = Q + (rowbase + q0 + wid * QBLK) * PQ + h * D;
    const bf16_t* Kh = K + (rowbase + (long)ts * KVBLK) * PQ + h * D, *Vh = V + (rowbase + (long)ts * KVBLK) * PQ + h * D;
    const unsigned lds0 = (unsigned)(uintptr_t)shm;
    float* wsf = (float*)(shm + LDS_WS) + wid * 64;
    { const u32x4* Fg = (const u32x4*)(FA + ((size_t)(b * NHEAD + h) * SEQ + (size_t)ts * KVBLK) * 2); LAS u32x4* Fl4 = (LAS u32x4*)((LAS char*)(lds_cptr)shm + LDS_F); const int n4 = (q0 + QB - ts * KVBLK) / 2;
      for (int p = tid; p < n4; p += NW * 64) Fl4[p] = Fg[p]; }
    const LAS u32x2* Fa = (const LAS u32x2*)((lds_cptr)shm + LDS_F);
#define FVAL(w) (-((bflo((w).x) + bfhi((w).x)) + bflo((w).y)))
    asm volatile("s_waitcnt vmcnt(0) lgkmcnt(0)" ::: "memory");
    const bf16_t* ksrc = Kh + (long)lane * PQ + wid * 8;
    const bf16_t* vsrc = Vh + (long)(16 * (wid & 3) + (lane >> 2)) * PQ + (wid >> 2) * 32 + (lane & 3) * 8;
    const unsigned kdst = lds0 + LDS_K + wid * 1024, vdst = lds0 + LDS_V + wid * 1024;
#define DMA_K(t, slot) glds16(ksrc + (long)(TL - (t)) * KVBLK * PQ, (unsigned)__builtin_amdgcn_readfirstlane(kdst + (slot)))
#define DMA_V(t, slot) glds16(vsrc + (long)(TL - (t)) * KVBLK * PQ, (unsigned)__builtin_amdgcn_readfirstlane(vdst + (slot)))
    const int vb0 = (int)(lds0 + LDS_V) + ((lane >> 4) & 1) * 32 + (lane & 3) * 8 + (4 * hi + ((lane & 15) >> 2)) * 64;
    bf16x8 kf[8];
    const lds_cptr shm3 = (lds_cptr)shm; const lds_cptr kp0 = shm3 + LDS_K + hi * 1024 + r32 * 16; const lds_cptr vp0 = shm3 + LDS_V + ((lane >> 4) & 1) * 32 + (lane & 3) * 8 + (4 * hi + ((lane & 15) >> 2)) * 64;
    DMA_K(0, 0); DMA_V(0, 0); DMA_K(1, SLOTB);
    bf16x8 qr[4];
#pragma unroll
    for (int d0 = 0; d0 < 4; ++d0) qr[d0] = *reinterpret_cast<const bf16x8*>(&Qw[(long)r32 * PQ + d0 * 16 + hi * 8]);
    float mhat = 0.f, l_reg = 0.f, nm = 0.f; f32x16 o[2]; o[0] = f32x16{}; o[1] = f32x16{};
    u32x2 ka0, ka1; u32x4 qa;
#define FLD(tt) do { const LAS u32x2* fp_ = Fa + 64 * (TL - (tt)) + r32; ka0 = fp_[0]; ka1 = fp_[32]; } while (0)
#define KAF(w) __builtin_bit_cast(bf16x8, (u32x4){(w).x, (w).y, 0x3f803f80u, 0u})
#define SETQA() do { const unsigned h_ = cvtpk(nm, 0.f) & 0xffffu; const float r1_ = nm - __uint_as_float(h_ << 16); const unsigned m_ = cvtpk(r1_, 0.f) & 0xffffu; \
      const float r2_ = r1_ - __uint_as_float(m_ << 16); const unsigned l_ = cvtpk(r2_, 0.f) & 0xffffu; \
      qa.x = hi ? 0u : 0x3f803f80u; qa.y = hi ? 0u : (0x3f80u | (h_ << 16)); qa.z = hi ? 0u : (m_ | (l_ << 16)); qa.w = 0u; } while (0)
#define CINIT(C0, C1) do { C0 = __builtin_amdgcn_mfma_f32_32x32x16_bf16(KAF(ka0), __builtin_bit_cast(bf16x8, qa), f32x16{}, 0, 0, 0); \
      C1 = __builtin_amdgcn_mfma_f32_32x32x16_bf16(KAF(ka1), __builtin_bit_cast(bf16x8, qa), f32x16{}, 0, 0, 0); } while (0)
    const int qrel = wid * QBLK + r32;
#define CMASK(P0, P1, t) do { int jb_ = 3 - (t); if (jb_ >= 0) cmask(P0, P1, jb_, qrel, hi); } while (0)
    bool resc = false;
#define START(P0, P1) do { const float rm = rowmax(P0, P1); resc = false; \
    if (__any(rm > (float)THRL)) { const float dl = __builtin_fmaxf(rm, 0.f); mhat += dl; \
      _Pragma("unroll") for (int r = 0; r < 16; ++r) { P0[r] -= dl; P1[r] -= dl; } \
      nm = -mhat; SETQA(); } \
    _Pragma("unroll") for (int r = 0; r < 16; ++r) P0[r] = __builtin_amdgcn_exp2f(P0[r]); } while (0)
#define RESC() do { if (resc) { asm volatile("s_waitcnt lgkmcnt(0)" ::: "memory"); \
      _Pragma("unroll") for (int d_ = 0; d_ < 2; ++d_) _Pragma("unroll") for (int r = 0; r < 16; ++r) o[d_][r] *= wsf[crow(r, hi)]; } } while (0)
    f32x16 pA0, pA1, pB0, pB1;
    int sl_prev = 0, sl_cur = 0, sl_next = SLOTB;
#define ROT() do { sl_prev = sl_cur; sl_cur = sl_next; sl_next = (sl_next == (NSLOT - 1) * SLOTB) ? 0 : sl_next + SLOTB; } while (0)
    DMA_K(2, 2 * SLOTB);
    float qkb;
    { float qn2 = 0.f;
#pragma unroll
      for (int d0 = 0; d0 < 4; ++d0)
#pragma unroll
          for (int j = 0; j < 8; ++j) { const float v = __uint_as_float((unsigned)(unsigned short)qr[d0][j] << 16); qn2 += v * v; }
      auto rr = __builtin_amdgcn_permlane32_swap(__float_as_uint(qn2), __float_as_uint(qn2), false, false); qn2 = __uint_as_float(rr[0]) + __uint_as_float(rr[1]);
      qkb = sqrtf(qn2) * kmaxc; }
    WAIT_BAR(3);
    { const u32x2 wo = Fa[64 * NT0 - QB + qrel]; const float fown = FVAL(wo); mhat = -fown - qkb; nm = -mhat; SETQA(); }
    FLD(0); CINIT(pA0, pA1);
    { const lds_cptr kb = shm3 + LDS_K + hi * 1024 + r32 * 16;
#pragma unroll
      for (int d0 = 0; d0 < 4; ++d0) { const bf16x8 b0 = *(const LAS bf16x8*)(kb + d0 * 2048); const bf16x8 b1 = *(const LAS bf16x8*)(kb + d0 * 2048 + 512);
          pA0 = __builtin_amdgcn_mfma_f32_32x32x16_bf16(b0, qr[d0], pA0, 0, 0, 0); pA1 = __builtin_amdgcn_mfma_f32_32x32x16_bf16(b1, qr[d0], pA1, 0, 0, 0); } }
    asm volatile("s_nop 15\n\ts_nop 7" : "+v"(pA0), "+v"(pA1)); CMASK(pA0, pA1, 0);
    START(pA0, pA1);
    _Pragma("unroll") for (int r = 0; r < 16; ++r) pA1[r] = __builtin_amdgcn_exp2f(pA1[r]);
    FLD(1);
    WAIT_BAR(0);
    DMA_K(3, 0); DMA_V(1, SLOTB);
    ROT();
    kload8(kf, kp0 + sl_cur);
    WAIT_BAR(2);
    s16x4 vlo[8], vhi[8]; u32x4 pw0, pw1, pw2, pw3;
#define PKW(P, B) cvtpk(P[B], P[B + 1])
#define PAF(k) __builtin_bit_cast(bf16x8, pw##k)
#define VFR(i) (bf16x8){vlo[i][0], vlo[i][1], vlo[i][2], vlo[i][3], vhi[i][0], vhi[i][1], vhi[i][2], vhi[i][3]}
#define PIN(x) asm volatile("" : "+v"(x))
#define MX3(a, b, c) __builtin_fmaxf(__builtin_fmaxf((a), (b)), (c))
#define GAPA(MF, A0, A1, A2, A3, W0, W1, PW) do { MF; sacc += A0; sacc += A1; sacc += A2; sacc += A3; PIN(sacc); W0; W1; PIN(PW); SBAR(); } while (0)
#define EX(v) __builtin_amdgcn_exp2f(v)
#define GAPB(MF, X, B) do { MF; X[B] = EX(X[B]); X[B + 1] = EX(X[B + 1]); X[B + 2] = EX(X[B + 2]); X[B + 3] = EX(X[B + 3]); PIN(X); SBAR(); } while (0)
#define VRD(i) do { vlo[i] = vtr(vp_ + (((i) >> 2) * 4096 + ((i) & 3) * 1024)); vhi[i] = vtr(vp_ + (((i) >> 2) * 4096 + ((i) & 3) * 1024 + 512)); } while (0)
#define KRD(G, j) do { if (G) { kload2(kf, kp0 + sl_next, j); SBAR(); } } while (0)
#define STEP(C0, C1, P0, P1, t, GK, GV, GL) do { SBAR(); \
    CINIT(C0, C1); SBAR(); \
    const lds_cptr vp_ = vp0 + sl_prev; \
    VRD(0); SBAR(); float sacc = (P0[0] + P0[1]); \
    GAPA(C0 = __builtin_amdgcn_mfma_f32_32x32x16_bf16(kf[0], qr[0], C0, 0, 0, 0), P0[2], P0[3], P0[4], P0[5],     pw0[0] = PKW(P0, 0), pw0[1] = PKW(P0, 2), pw0); \
    VRD(4); SBAR(); GAPA(C1 = __builtin_amdgcn_mfma_f32_32x32x16_bf16(kf[1], qr[0], C1, 0, 0, 0), P0[6], P0[7], P0[8], P0[9],     pw0[2] = PKW(P0, 4), pw0[3] = PKW(P0, 6), pw0); \
    VRD(1); SBAR(); GAPA(C0 = __builtin_amdgcn_mfma_f32_32x32x16_bf16(kf[2], qr[1], C0, 0, 0, 0),   P0[10], P0[11], P0[12], P0[13], pw1[0] = PKW(P0, 8), pw1[1] = PKW(P0, 10), pw1); \
    VRD(5); SBAR(); GAPA(C1 = __builtin_amdgcn_mfma_f32_32x32x16_bf16(kf[3], qr[1], C1, 0, 0, 0),   P0[14], P0[15], P1[0], P1[1],   pw1[2] = PKW(P0, 12), pw1[3] = PKW(P0, 14), pw1); \
    VRD(2); SBAR(); GAPA(C0 = __builtin_amdgcn_mfma_f32_32x32x16_bf16(kf[4], qr[2], C0, 0, 0, 0),   P1[2], P1[3], P1[4], P1[5],     pw2[0] = PKW(P1, 0), pw2[1] = PKW(P1, 2), pw2); \
    VRD(6); SBAR(); GAPA(C1 = __builtin_amdgcn_mfma_f32_32x32x16_bf16(kf[5], qr[2], C1, 0, 0, 0),   P1[6], P1[7], P1[8], P1[9],     pw2[2] = PKW(P1, 4), pw2[3] = PKW(P1, 6), pw2); \
    VRD(3); SBAR(); GAPA(C0 = __builtin_amdgcn_mfma_f32_32x32x16_bf16(kf[6], qr[3], C0, 0, 0, 0),   P1[10], P1[11], P1[12], P1[13], pw3[0] = PKW(P1, 8), pw3[1] = PKW(P1, 10), pw3); \
    VRD(7); SBAR(); GAPA(C1 = __builtin_amdgcn_mfma_f32_32x32x16_bf16(kf[7], qr[3], C1, 0, 0, 0),   P1[14], P1[15], 0.f, 0.f,       pw3[2] = PKW(P1, 12), pw3[3] = PKW(P1, 14), pw3); \
    l_reg += sacc; \
    if (GK) { DMA_K((t) + 3, sl_cur); } if (GV) { DMA_V((t) + 1, sl_next); } \
    CMASK(C0, C1, t); \
    { float a = MX3(C0[0], C0[1], C1[0]), b = MX3(C0[2], C0[3], C1[1]); a = MX3(a, C1[2], C1[3]); \
      _Pragma("unroll") for (int r = 4; r < 16; r += 4) { a = MX3(a, C0[r], C0[r + 1]); b = MX3(b, C0[r + 2], C0[r + 3]); a = MX3(a, C1[r], C1[r + 1]); b = MX3(b, C1[r + 2], C1[r + 3]); } \
      float rm = __builtin_fmaxf(a, b); { auto rr = __builtin_amdgcn_permlane32_swap(__float_as_uint(rm), __float_as_uint(rm), false, false); rm = __builtin_fmaxf(__uint_as_float(rr[0]), __uint_as_float(rr[1])); } \
      resc = false; \
      if (__builtin_expect(__any(rm > (float)THRL), 0)) { const float dl = __builtin_fmaxf(rm, 0.f); mhat += dl; \
        _Pragma("unroll") for (int r = 0; r < 16; ++r) { C0[r] -= dl; C1[r] -= dl; } \
        nm = -mhat; SETQA(); \
        const float f = __builtin_amdgcn_exp2f(-dl); l_reg *= f; if (hi == 0) wsf[r32] = f; resc = true; } } \
    SBAR(); \
    GAPB(o[0] = __builtin_amdgcn_mfma_f32_32x32x16_bf16(PAF(0), VFR(0), o[0], 0, 0, 0), C0, 0); \
    GAPB(o[1] = __builtin_amdgcn_mfma_f32_32x32x16_bf16(PAF(0), VFR(4), o[1], 0, 0, 0), C0, 4); \
    KRD(GL, 0); GAPB(o[0] = __builtin_amdgcn_mfma_f32_32x32x16_bf16(PAF(1), VFR(1), o[0], 0, 0, 0), C0, 8); \
    KRD(GL, 1); GAPB(o[1] = __builtin_amdgcn_mfma_f32_32x32x16_bf16(PAF(1), VFR(5), o[1], 0, 0, 0), C0, 12); \
    KRD(GL, 2); GAPB(o[0] = __builtin_amdgcn_mfma_f32_32x32x16_bf16(PAF(2), VFR(2), o[0], 0, 0, 0), C1, 0); \
    KRD(GL, 3); GAPB(o[1] = __builtin_amdgcn_mfma_f32_32x32x16_bf16(PAF(2), VFR(6), o[1], 0, 0, 0), C1, 4); \
    GAPB(o[0] = __builtin_amdgcn_mfma_f32_32x32x16_bf16(PAF(3), VFR(3), o[0], 0, 0, 0), C1, 8); \
    GAPB(o[1] = __builtin_amdgcn_mfma_f32_32x32x16_bf16(PAF(3), VFR(7), o[1], 0, 0, 0), C1, 12); \
    FLD((t) + 1); \
    } while (0)
    int t = 1;
#define ENDW(tt) do { if ((tt) + 3 < NT) { WAIT_BAR(2); } else if ((tt) + 2 < NT) { WAIT_BAR(1); } else { WAIT_BAR(0); } } while (0)
    LAS float* stopf = (LAS float*)((LAS char*)(lds_cptr)shm + LDS_STOP);
#pragma unroll 1
    for (int pass = 0; pass < 2; ++pass) {
        const int lim = (pass == 0) ? (NT < 5 ? NT : 5) : NT;
        for (; t + 1 < lim; t += 2) {
            STEP(pB0, pB1, pA0, pA1, t, (t + 3 < NT), (t + 1 < NT), (t + 1 < NT));       ENDW(t);   RESC(); ROT();
            STEP(pA0, pA1, pB0, pB1, t + 1, (t + 4 < NT), (t + 2 < NT), (t + 2 < NT));     ENDW(t + 1); RESC(); ROT();
        }
        if (pass == 0) {
#undef CMASK
#define CMASK(P0, P1, t) do { } while (0)
            for (; t + 5 < NT; t += 2) {
                STEP(pB0, pB1, pA0, pA1, t, true, true, true);     WAIT_BAR(2); RESC(); ROT();
                if ((t & 7) == 5) { float bv = qkb - mhat;
                    bv = __builtin_fmaxf(bv, dpp_mov<0xB1>(bv)); bv = __builtin_fmaxf(bv, dpp_mov<0x4E>(bv)); bv = __builtin_fmaxf(bv, dpp_mov<0x141>(bv)); bv = __builtin_fmaxf(bv, dpp_mov<0x140>(bv));
                    const float r0 = __int_as_float(__builtin_amdgcn_readlane(__float_as_int(bv), 0)), r1 = __int_as_float(__builtin_amdgcn_readlane(__float_as_int(bv), 16));
                    const float r2 = __int_as_float(__builtin_amdgcn_readlane(__float_as_int(bv), 32)), r3 = __int_as_float(__builtin_amdgcn_readlane(__float_as_int(bv), 48));
                    if (lane == 0) stopf[wid] = __builtin_fmaxf(__builtin_fmaxf(r0, r1), __builtin_fmaxf(r2, r3)); }
                STEP(pA0, pA1, pB0, pB1, t + 1, true, true, true);   WAIT_BAR(2); RESC(); ROT();
                if ((t & 7) == 5) { const f32x4 s0 = *(const LAS f32x4*)stopf, s1 = *(const LAS f32x4*)(stopf + 4);
                    const float thr = __builtin_fmaxf(__builtin_fmaxf(__builtin_fmaxf(s0[0], s0[1]), __builtin_fmaxf(s0[2], s0[3])), __builtin_fmaxf(__builtin_fmaxf(s1[0], s1[1]), __builtin_fmaxf(s1[2], s1[3]))) + PRUNE_TH;
                    const int pt = TL - 2 * (lane + 1);
                    const u32x2 wv = Fa[64 * (pt < 0 ? 0 : pt) + 63]; const float fv = FVAL(wv);
                    const unsigned long long mk = __ballot((pt < 0) || (fv >= thr));
                    int np = 2 * ((int)__builtin_ctzll(mk) + 1); np = np < t + 5 ? t + 5 : np;
                    if (np < NT) NT = np; }
            }
#undef CMASK
#define CMASK(P0, P1, t) do { int jb_ = 3 - (t); if (jb_ >= 0) cmask(P0, P1, jb_, qrel, hi); } while (0)
        }
    }
    STEP(pB0, pB1, pA0, pA1, NT - 1, false, false, false); RESC();
    { float sacc = pB0[0] + pB0[1]; _Pragma("unroll") for (int r = 2; r < 16; ++r) sacc += pB0[r]; _Pragma("unroll") for (int r = 0; r < 16; ++r) sacc += pB1[r]; l_reg += sacc;
      pw0 = (u32x4){PKW(pB0, 0), PKW(pB0, 2), PKW(pB0, 4), PKW(pB0, 6)}; pw1 = (u32x4){PKW(pB0, 8), PKW(pB0, 10), PKW(pB0, 12), PKW(pB0, 14)}; pw2 = (u32x4){PKW(pB1, 0), PKW(pB1, 2), PKW(pB1, 4), PKW(pB1, 6)}; pw3 = (u32x4){PKW(pB1, 8), PKW(pB1, 10), PKW(pB1, 12), PKW(pB1, 14)};
      SBAR(); pv(o, vb0 + sl_cur, PAF(0), PAF(1), PAF(2), PAF(3)); }
    unsigned nxq = 0u; if (tid == 0) nxq = atomicAdd(qhead, 1u);
#undef PKW
#undef PAF
#undef VFR
#undef PIN
#undef MX3
#undef GAPA
#undef GAPB
#undef EX
#undef VRD
#undef KRD
#undef STEP
#undef ENDW
    { auto rr = __builtin_amdgcn_permlane32_swap(__float_as_uint(l_reg), __float_as_uint(l_reg), false, false); l_reg = __uint_as_float(rr[0]) + __uint_as_float(rr[1]); }
    if (hi == 0) wsf[32 + r32] = l_reg; asm volatile("s_waitcnt lgkmcnt(0)" ::: "memory");
    float rli[16];
#pragma unroll
    for (int r = 0; r < 16; ++r) rli[r] = __builtin_amdgcn_rcpf(wsf[32 + crow(r, hi)]);
    unsigned char* Ow = O + (rowbase + q0 + wid * QBLK) * PO + h * D;
    { unsigned char* stg = (unsigned char*)(shm + LDS_OST) + wid * 2048;
#pragma unroll
      for (int r = 0; r < 16; ++r) { const int orow = crow(r, hi);
#pragma unroll
          for (int d0 = 0; d0 < 2; ++d0) { const float v = __builtin_fminf(__builtin_fmaxf(o[d0][r] * rli[r] * MIX_SCALE, -440.0f), 440.0f);
              stg[orow * 64 + d0 * 32 + r32] = (unsigned char)(__builtin_amdgcn_cvt_pk_fp8_f32(v, v, 0, false) & 0xff); } }
      asm volatile("s_waitcnt lgkmcnt(0)" ::: "memory");
#pragma unroll
      for (int i = 0; i < 2; ++i) { const int row = i * 16 + (lane >> 2), ch = lane & 3; const u32x4 v = *(const u32x4*)(stg + row * 64 + ch * 16); *(u32x4*)(Ow + (long)row * PO + ch * 16) = v; } }
    if (tid == 0) qnext[0] = (int)nxq;
    asm volatile("s_waitcnt lgkmcnt(0)\n\ts_barrier" ::: "memory");
    return NT;
#undef DMA_K
#undef DMA_V
#undef CMASK
#undef START
#undef RESC
#undef ROT
#undef FLD
#undef CINIT
#undef KAF
#undef SETQA
#undef FVAL
}
#undef SBAR
#undef WAIT_BAR
}

namespace ret {
constexpr int RS = 272;
constexpr int IMG_Q = 0, IMG_K = 64 * RS, IMG_KT = 2 * 64 * RS, IMG_V = 3 * 64 * RS;
constexpr int PS = 144;
constexpr int IMG_P = 4 * 64 * RS;
constexpr int IMG_ST = IMG_P + 64 * PS;
constexpr int OS = 132;
constexpr int IMG_O = IMG_ST + 128 * RS;
constexpr int LDS_END = IMG_O + 64 * OS * 4;
static_assert(LDS_END <= LDS_BYTES, "retention LDS map");
typedef short v4i16_t __attribute__((ext_vector_type(4)));
__device__ __forceinline__ s16x4 tr4(LAS const char* p) { return __builtin_bit_cast(s16x4, __builtin_amdgcn_ds_read_tr16_b64_v4i16((LAS v4i16_t*)p)); }
__device__ __forceinline__ bf16x8 frag_tr(LAS const char* img, int stride, int k0, int c0, int lane) {
    const int g4 = lane >> 4, i = lane & 15, qq = i >> 2, p = i & 3, hh = g4 >> 1, nh = g4 & 1;
    LAS const char* a = img + (k0 + 8 * hh + qq) * stride + (c0 + 16 * nh + 4 * p) * 2;
    const s16x4 lo = tr4(a), hi = tr4(a + 4 * stride);
    return (bf16x8){lo[0], lo[1], lo[2], lo[3], hi[0], hi[1], hi[2], hi[3]};
}
__device__ __forceinline__ bf16x8 frag_row(LAS const char* img, int stride, int r0, int k0, int lane) {
    return *(const LAS bf16x8*)(img + (r0 + (lane & 31)) * stride + (k0 + 8 * (lane >> 5)) * 2);
}
__device__ __forceinline__ int crow(int r, int hi) { return (r & 3) + 8 * (r >> 2) + 4 * hi; }

template <bool APPLY>
__device__ __forceinline__ void unit(int bh, int g, const bf16_t* RQ, const bf16_t* RK, const bf16_t* RV, const bf16_t* SG, float* GST, unsigned char* MIX, LAS char* lds) {
    int tid_ = threadIdx.x; asm volatile("" : "+v"(tid_));
    const int tid = tid_, lane = tid & 63, hi = lane >> 5; const int w = __builtin_amdgcn_readfirstlane(tid >> 6);
    const int b = bh >> 2, h = bh & 3;
    const float l2g = log2f(1.0f - exp2f(-5.0f - (float)h));
    const float cd = exp2f(64.0f * l2g);
    const size_t row0 = (size_t)b * SEQ + (size_t)g * 512;
    constexpr int NSET = APPLY ? 2 : 3;
    u32x4 rqs[APPLY ? 2 : 1][2], rks[NSET][2], rvs[NSET][2];
    auto issue = [&](int j, int s) {
#pragma unroll
        for (int i = 0; i < 2; ++i) { const int p = tid + 512 * i, row = p >> 4, ch = p & 15; const size_t off = (row0 + j * 64 + row) * 512 + h * 128 + ch * 8;
            if (APPLY) rqs[s & 1][i] = *(const u32x4*)(RQ + off);
            rks[s][i] = *(const u32x4*)(RK + off); rvs[s][i] = *(const u32x4*)(RV + off); }
    };
    const int db = w >> 1, eb0 = 2 * (w & 1);
    f32x16 S0 = f32x16{}, S1 = f32x16{};
    if (APPLY) {
        const float Gm = exp2f(512.0f * l2g);
        for (int gp0 = 0; gp0 < g; gp0 += 4) {
            f32x4 gv[4][8];
#pragma unroll
            for (int k = 0; k < 4; ++k) { const int gp = (gp0 + k < g) ? gp0 + k : g - 1; const f32x4* src = (const f32x4*)(GST + ((size_t)(bh * 16 + gp) * 8 + w) * 2048) + lane;
#pragma unroll
                for (int q = 0; q < 8; ++q) gv[k][q] = src[q * 64]; }
#pragma unroll
            for (int k = 0; k < 4; ++k) { const bool ok = gp0 + k < g; const float fm = ok ? Gm : 1.0f, am = ok ? 1.0f : 0.0f;
#pragma unroll
                for (int r = 0; r < 16; ++r) { S0[r] = S0[r] * fm + gv[k][r >> 2][r & 3] * am; S1[r] = S1[r] * fm + gv[k][4 + (r >> 2)][r & 3] * am; } }
        }
    }
    issue(0, 0); issue(1, 1); if (!APPLY) issue(2, 2 % NSET);
#pragma unroll (APPLY ? 2 : 8)
    for (int j = 0; j < 8; ++j) {
        const int cs = APPLY ? (j & 1) : j % 3; const u32x4 (&rk)[2] = rks[cs]; const u32x4 (&rv)[2] = rvs[cs]; const u32x4 (&rq)[2] = rqs[APPLY ? cs : 0];
#pragma unroll
        for (int i = 0; i < 2; ++i) { const int p = tid + 512 * i, row = p >> 4, ch = p & 15; const int o = row * RS + ch * 16;
            if (APPLY) { *(LAS u32x4*)(lds + IMG_Q + o) = rq[i]; *(LAS u32x4*)(lds + IMG_K + o) = rk[i]; }
            *(LAS u32x4*)(lds + IMG_V + o) = rv[i];
            const float kw = exp2f((float)(63 - row) * l2g);
            u32x4 kt;
#pragma unroll
            for (int e = 0; e < 4; ++e) kt[e] = cvtpk(bflo(rk[i][e]) * kw, bfhi(rk[i][e]) * kw);
            *(LAS u32x4*)(lds + IMG_KT + o) = kt; }
        if (APPLY) {
#pragma unroll
            for (int tile = 0; tile < 2; ++tile) { const f32x16& S = tile ? S1 : S0; const int e = (eb0 + tile) * 32 + (lane & 31);
#pragma unroll
                for (int g4 = 0; g4 < 4; ++g4) { const int d = db * 32 + 8 * g4 + 4 * hi; u32x2 v; v.x = cvtpk(S[4 * g4], S[4 * g4 + 1]); v.y = cvtpk(S[4 * g4 + 2], S[4 * g4 + 3]);
                    *(LAS u32x2*)(lds + IMG_ST + e * RS + d * 2) = v; } }
        }
        u32x4 gg0 = {0u, 0u, 0u, 0u}, gg1 = {0u, 0u, 0u, 0u};
        if (APPLY) { const size_t trow = row0 + j * 64 + (tid >> 3); const bf16_t* gp = SG + trow * 512 + h * 128 + (tid & 7) * 16; gg0 = *(const u32x4*)gp; gg1 = *(const u32x4*)(gp + 8); }
        if (APPLY) { if (j + 2 < 8) issue(j + 2, cs); } else { if (j + 3 < 8) issue(j + 3, cs); }
        LDS_WAIT(); __builtin_amdgcn_s_barrier();
        f32x16 oin = f32x16{}, oit = f32x16{};
        const int qb = w >> 2, eb = w & 3;
        if (APPLY) {
#pragma unroll
            for (int s = 0; s < 8; ++s) oin = __builtin_amdgcn_mfma_f32_32x32x16_bf16(frag_row(lds + IMG_Q, RS, qb * 32, s * 16, lane), frag_row(lds + IMG_ST, RS, eb * 32, s * 16, lane), oin, 0, 0, 0);
            if (w < 4) {
                const int tb = w >> 1, qb2 = w & 1; f32x16 sc = f32x16{};
#pragma unroll
                for (int s = 0; s < 8; ++s) sc = __builtin_amdgcn_mfma_f32_32x32x16_bf16(frag_row(lds + IMG_K, RS, tb * 32, s * 16, lane), frag_row(lds + IMG_Q, RS, qb2 * 32, s * 16, lane), sc, 0, 0, 0);
                const int q = qb2 * 32 + (lane & 31);
#pragma unroll
                for (int g4 = 0; g4 < 4; ++g4) { const int t0 = tb * 32 + 8 * g4 + 4 * hi; float pv4[4];
#pragma unroll
                    for (int e = 0; e < 4; ++e) { const int dd = q - (t0 + e); pv4[e] = sc[4 * g4 + e] * exp2f((float)(dd < 0 ? -dd : dd) * l2g); }
                    u32x2 v; v.x = cvtpk(pv4[0], pv4[1]); v.y = cvtpk(pv4[2], pv4[3]);
                    *(LAS u32x2*)(lds + IMG_P + q * PS + t0 * 2) = v; }
            }
            LDS_WAIT(); __builtin_amdgcn_s_barrier();
#pragma unroll
            for (int s = 0; s < 4; ++s) oit = __builtin_amdgcn_mfma_f32_32x32x16_bf16(frag_row(lds + IMG_P, PS, qb * 32, s * 16, lane), frag_tr(lds + IMG_V, RS, s * 16, eb * 32, lane), oit, 0, 0, 0);
#pragma unroll
            for (int r = 0; r < 16; ++r) { const int q = qb * 32 + crow(r, hi); const float qw = exp2f((float)(q + 1) * l2g);
                *(LAS float*)(lds + IMG_O + (q * OS + eb * 32 + (lane & 31)) * 4) = oit[r] + qw * oin[r]; }
        }
#pragma unroll
        for (int r = 0; r < 16; ++r) { S0[r] *= cd; S1[r] *= cd; }
#pragma unroll
        for (int s = 0; s < 4; ++s) { const bf16x8 a = frag_tr(lds + IMG_KT, RS, s * 16, db * 32, lane);
            S0 = __builtin_amdgcn_mfma_f32_32x32x16_bf16(a, frag_tr(lds + IMG_V, RS, s * 16, eb0 * 32, lane), S0, 0, 0, 0);
            S1 = __builtin_amdgcn_mfma_f32_32x32x16_bf16(a, frag_tr(lds + IMG_V, RS, s * 16, (eb0 + 1) * 32, lane), S1, 0, 0, 0); }
        LDS_WAIT(); __builtin_amdgcn_s_barrier();
        if (APPLY) {
            { const int q = tid >> 3, sg = tid & 7; const LAS f32x4* op = (const LAS f32x4*)(lds + IMG_O + (q * OS + sg * 16) * 4);
              f32x4 x0 = op[0], x1 = op[1], x2 = op[2], x3 = op[3];
              float s1 = ((x0.x + x0.y) + (x0.z + x0.w)) + ((x1.x + x1.y) + (x1.z + x1.w)) + ((x2.x + x2.y) + (x2.z + x2.w)) + ((x3.x + x3.y) + (x3.z + x3.w));
              s1 += dpp_mov<0xB1>(s1); s1 += dpp_mov<0x4E>(s1); s1 += dpp_mov<0x141>(s1);
              const float mu = s1 * (1.0f / 128.0f); x0 = x0 - mu; x1 = x1 - mu; x2 = x2 - mu; x3 = x3 - mu;
              float s2 = ((x0.x * x0.x + x0.y * x0.y) + (x0.z * x0.z + x0.w * x0.w)) + ((x1.x * x1.x + x1.y * x1.y) + (x1.z * x1.z + x1.w * x1.w)) + ((x2.x * x2.x + x2.y * x2.y) + (x2.z * x2.z + x2.w * x2.w)) + ((x3.x * x3.x + x3.y * x3.y) + (x3.z * x3.z + x3.w * x3.w));
              s2 += dpp_mov<0xB1>(s2); s2 += dpp_mov<0x4E>(s2); s2 += dpp_mov<0x141>(s2);
              const float rstd = rsqrtf(s2 * (1.0f / 128.0f) + GN_EPS);
              const size_t trow = row0 + j * 64 + q; const u32x4 g0 = gg0, g1 = gg1;
              const float ms = rstd * MIX_SCALE; u32x4 o;
#define MXC(v) __builtin_fminf(__builtin_fmaxf((v), -440.0f), 440.0f)
              o.x = pk4_fp8(MXC(x0.x * ms * bflo(g0.x)), MXC(x0.y * ms * bfhi(g0.x)), MXC(x0.z * ms * bflo(g0.y)), MXC(x0.w * ms * bfhi(g0.y)));
              o.y = pk4_fp8(MXC(x1.x * ms * bflo(g0.z)), MXC(x1.y * ms * bfhi(g0.z)), MXC(x1.z * ms * bflo(g0.w)), MXC(x1.w * ms * bfhi(g0.w)));
              o.z = pk4_fp8(MXC(x2.x * ms * bflo(g1.x)), MXC(x2.y * ms * bfhi(g1.x)), MXC(x2.z * ms * bflo(g1.y)), MXC(x2.w * ms * bfhi(g1.y)));
              o.w = pk4_fp8(MXC(x3.x * ms * bflo(g1.z)), MXC(x3.y * ms * bfhi(g1.z)), MXC(x3.z * ms * bflo(g1.w)), MXC(x3.w * ms * bfhi(g1.w)));
#undef MXC
              *(u32x4*)(MIX + trow * 1024 + h * 128 + sg * 16) = o; }
        }
    }
    if (!APPLY) {
        f32x4* dst = (f32x4*)(GST + ((size_t)(bh * 16 + g) * 8 + w) * 2048) + lane;
#pragma unroll
        for (int q = 0; q < 4; ++q) { dst[q * 64] = (f32x4){S0[4 * q], S0[4 * q + 1], S0[4 * q + 2], S0[4 * q + 3]}; dst[(4 + q) * 64] = (f32x4){S1[4 * q], S1[4 * q + 1], S1[4 * q + 2], S1[4 * q + 3]}; }
    }
    LDS_WAIT(); __builtin_amdgcn_s_barrier();
}
}


#define XB_TMO      128
#define XB_XCNT(j)  (256  + 64 * (j))
#define XB_XSUB(j)  (1280 + 64 * (j))
#define XB_XGEN(j)  (2304 + 64 * (j))
#define XB_TOP      3328
#define XB_TOPGEN   3392
#define XCD_BAR_WORDS 3456
#define XB_SPIN_CAP (1u << 18)
__device__ __forceinline__ unsigned xb_ld(unsigned* p)              { return __hip_atomic_load(p, __ATOMIC_RELAXED, __HIP_MEMORY_SCOPE_AGENT); }
__device__ __forceinline__ unsigned xb_add(unsigned* p, unsigned v) { return __hip_atomic_fetch_add(p, v, __ATOMIC_RELAXED, __HIP_MEMORY_SCOPE_AGENT); }
__device__ __forceinline__ unsigned xb_xcc_id() { return (unsigned)__builtin_amdgcn_s_getreg((3 << 11) | 20) & 0xFu; }
#define XB_SPIN(cond, bar) do { unsigned _sp = 0; while (cond) { __builtin_amdgcn_s_sleep(1); \
    if ((++_sp & 255u) == 0u) { if (xb_ld(&(bar)[XB_TMO])) break; if (_sp > XB_SPIN_CAP) { atomicAdd(&(bar)[XB_TMO], 1u); break; } } } } while (0)
struct XcdBarrier { unsigned* bar; unsigned x; volatile LAS unsigned* st; };
__device__ __forceinline__ XcdBarrier xcd_barrier_post(unsigned* bar, volatile LAS unsigned* st) {
    XcdBarrier b; b.bar = bar; b.x = xb_xcc_id(); b.st = st;
    if (threadIdx.x == 0) (void)xb_add(&bar[XB_XCNT(b.x)], 1u);
    return b;
}
__device__ __forceinline__ void xcd_barrier_complete(unsigned* bar, unsigned x, unsigned& nloc, unsigned& nx) {
    const unsigned G = gridDim.x * gridDim.y * gridDim.z;
    unsigned sum, cnt, mine, sp = 0u;
    for (;;) {
        sum = 0u; cnt = 0u; mine = 0u;
#pragma unroll
        for (unsigned j = 0; j < 16; ++j) { const unsigned c = xb_ld(&bar[XB_XCNT(j)]); sum += c; cnt += (c > 0u) ? 1u : 0u; mine = (j == x) ? c : mine; }
        if (sum == G) break;
        __builtin_amdgcn_s_sleep(1);
        if ((++sp & 255u) == 0u) { if (xb_ld(&bar[XB_TMO])) break; if (sp > XB_SPIN_CAP) { atomicAdd(&bar[XB_TMO], 1u); break; } }
    }
    nloc = mine > 0u ? mine : 1u; nx = cnt > 0u ? cnt : 1u;
}
__device__ __forceinline__ void xcd_barrier(const XcdBarrier& b) {
    asm volatile("s_waitcnt vmcnt(0)" ::: "memory");
    __syncthreads();
    if (threadIdx.x == 0) {
        unsigned* bar = b.bar;
        __builtin_amdgcn_s_waitcnt(0);
        unsigned nloc = b.st[0], nx = b.st[1];
        if (nloc == 0u) { xcd_barrier_complete(bar, b.x, nloc, nx); b.st[0] = nloc; b.st[1] = nx; }
        const unsigned old = xb_add(&bar[XB_XSUB(b.x)], 1u);
        const unsigned gen = old / nloc;
        if (old + 1u == (gen + 1u) * nloc) {
            __builtin_amdgcn_fence(__ATOMIC_RELEASE, "agent");
            asm volatile("s_waitcnt vmcnt(0)" ::: "memory");
            const unsigned og = xb_add(&bar[XB_TOP], 1u);
            const unsigned tg = og / nx;
            if (og + 1u == (tg + 1u) * nx) xb_add(&bar[XB_TOPGEN], 1u);
            else XB_SPIN(xb_ld(&bar[XB_TOPGEN]) == tg, bar);
            __builtin_amdgcn_fence(__ATOMIC_ACQUIRE, "agent");
            xb_add(&bar[XB_XGEN(b.x)], 1u);
            asm volatile("s_waitcnt vmcnt(0)" ::: "memory");
        } else {
            XB_SPIN(xb_ld(&bar[XB_XGEN(b.x)]) == gen, bar);
            __builtin_amdgcn_fence(__ATOMIC_ACQUIRE, "agent");
            asm volatile("s_waitcnt vmcnt(0)" ::: "memory");
        }
    }
    __syncthreads();
}

__device__ __forceinline__ void publish_inc(unsigned* cnt) {
    asm volatile("s_waitcnt vmcnt(0)" ::: "memory");
    __syncthreads();
    if (threadIdx.x == 0) { __builtin_amdgcn_fence(__ATOMIC_RELEASE, "agent"); asm volatile("s_waitcnt vmcnt(0)" ::: "memory");
        (void)__hip_atomic_fetch_add(cnt, 1u, __ATOMIC_RELAXED, __HIP_MEMORY_SCOPE_AGENT); }
}
__device__ __forceinline__ void wait_ge(unsigned* cnt, unsigned target) {
    if (threadIdx.x == 0) { unsigned sp = 0;
        while (__hip_atomic_load(cnt, __ATOMIC_RELAXED, __HIP_MEMORY_SCOPE_AGENT) < target) { __builtin_amdgcn_s_sleep(2); if (++sp > (1u << 22)) break; }
        __builtin_amdgcn_fence(__ATOMIC_ACQUIRE, "agent"); asm volatile("s_waitcnt vmcnt(0)" ::: "memory"); }
    __syncthreads();
}

struct Frame {
    LAS unsigned char* lds; int tid, lane, wave, vcu, G;
    __device__ __forceinline__ void refresh() { int t = threadIdx.x; asm volatile("" : "+v"(t)); tid = t; lane = t & 63; }
};

__device__ __forceinline__ void tr_item(const float* __restrict__ W, int ldw, int k0, int n0, const float* __restrict__ gk, bf16_t* WT, int kind, LAS unsigned* scr, int lane) {
    const int nch = lane & 15, kq = lane >> 4;
    f32x4 a[8], b[8];
#pragma unroll
    for (int i = 0; i < 8; ++i) { const int kp = 4 * i + kq; const float* p = W + (size_t)(k0 + 2 * kp) * ldw + n0 + 4 * nch; a[i] = *(const f32x4*)p; b[i] = *(const f32x4*)(p + ldw); }
#pragma unroll
    for (int i = 0; i < 8; ++i) { const int kp = 4 * i + kq; float ga = 1.f, gb = 1.f; if (gk) { ga = gk[k0 + 2 * kp]; gb = gk[k0 + 2 * kp + 1]; }
#pragma unroll
        for (int e = 0; e < 4; ++e) scr[(4 * nch + e) * 36 + kp] = cvtpk(a[i][e] * ga, b[i][e] * gb); }
    LDS_WAIT(); asm volatile("" ::: "memory");
    const int c = lane & 7, nr = lane >> 3;
#pragma unroll
    for (int j = 0; j < 8; ++j) { const int n = nr + 8 * j; const u32x4 v = *(const LAS u32x4*)(scr + n * 36 + 4 * c);
        const int cn = n0 + n; const int row = (kind == 0) ? pos_inproj(cn) : (kind == 1) ? pos_wide(cn) : pos_w1(cn);
        *(u32x4*)(WT + (size_t)row * 1024 + k0 + 8 * c) = v; }
    LDS_WAIT(); asm volatile("" ::: "memory");
}

struct Tr8Item { const float* W; unsigned char* WT; const float* gk; int ldw, k0, n0, kind; };
__device__ __forceinline__ Tr8Item tr8_decode(int r, const Params& P, unsigned char* W1T, unsigned char* W2T, const float* ones) {
    constexpr int P_1 = 32 * 8 * 32; Tr8Item t; const int half = r & 1; int p = r >> 1;
    if (p < P_1) { const int e = p >> 8, rr = p & 255; t.W = P.w1 + (size_t)e * 1024 * 2048; t.ldw = 2048; t.k0 = 128 * (rr / 32) + 64 * half; t.n0 = 64 * (rr % 32); t.gk = P.g_ffn; t.WT = W1T + (size_t)e * 2048 * 1024; t.kind = 2; }
    else { p -= P_1; const int e = p >> 7, rr = p & 127; t.W = P.w2 + (size_t)e * 1024 * 1024; t.ldw = 1024; t.k0 = 128 * (rr / 16) + 64 * half; t.n0 = 64 * (rr % 16); t.gk = ones; t.WT = W2T + (size_t)e * 1024 * 1024; t.kind = 1; }
    return t;
}
template <bool GK = true> __device__ __forceinline__ void tr8_load(const Tr8Item& t, f32x4 (&a)[4][4], f32x4 (&gq)[4], int lane) {
    const int nch = lane & 15, kq4 = lane >> 4;
#pragma unroll
    for (int i = 0; i < 4; ++i) { if constexpr (GK) gq[i] = *(const f32x4*)(t.gk + t.k0 + 4 * (4 * i + kq4)); else gq[i] = (f32x4){1.f, 1.f, 1.f, 1.f}; }
#pragma unroll
    for (int i = 0; i < 4; ++i) { const int kq = 4 * i + kq4; const float* p = t.W + (size_t)(t.k0 + 4 * kq) * t.ldw + t.n0 + 4 * nch;
#pragma unroll
        for (int r = 0; r < 4; ++r) a[i][r] = __builtin_nontemporal_load((const f32x4*)(p + (size_t)r * t.ldw)); }
}
__device__ __forceinline__ void tr8_proc(const Tr8Item& t, const f32x4 (&a)[4][4], const f32x4 (&gq)[4], LAS unsigned* scr, int lane, const int half) {
    const int nch = lane & 15, kq4 = lane >> 4;
#pragma unroll
    for (int i = 0; i < 4; ++i) { const int kq = 4 * i + kq4; float g[4];
#pragma unroll
        for (int r = 0; r < 4; ++r) g[r] = gq[i][r] * W_SCALE;
#pragma unroll
        for (int e = 0; e < 4; ++e) scr[(4 * nch + e) * 36 + 16 * half + (kq ^ (4 * ((nch >> 1) & 3)))] = pk4_fp8(a[i][0][e] * g[0], a[i][1][e] * g[1], a[i][2][e] * g[2], a[i][3][e] * g[3]); }
    if (half == 1) {
        LDS_WAIT(); asm volatile("" ::: "memory");
        const int c = lane & 7, nr = lane >> 3;
#pragma unroll
        for (int j = 0; j < 8; ++j) { const int n = nr + 8 * j; const u32x4 v = *(const LAS u32x4*)(scr + n * 36 + 16 * (c >> 2) + 4 * ((c & 3) ^ ((n >> 3) & 3)));
            const int cn = t.n0 + n; const int row = (t.kind == 1) ? pos_wide(cn) : pos_w1(cn);
            *(u32x4*)(t.WT + (size_t)row * 1024 + (t.k0 - 64) + 16 * c) = v; }
        LDS_WAIT(); asm volatile("" ::: "memory");
    }
}

__global__ void __launch_bounds__(NTHREADS, 2) mk_fwd(Params P) {
    __builtin_assume(__builtin_amdgcn_workitem_id_y() == 0); __builtin_assume(__builtin_amdgcn_workitem_id_z() == 0);
    extern __shared__ __attribute__((aligned(16))) unsigned char lds_raw[];
    cg::grid_group grid = cg::this_grid();
    Frame F; F.lds = (LAS unsigned char*)lds_raw; F.tid = threadIdx.x; F.lane = F.tid & 63; F.wave = __builtin_amdgcn_readfirstlane(F.tid >> 6);
    F.G = gridDim.x; { const int bx = blockIdx.x; F.vcu = (F.G % 8 == 0) ? (bx % 8) * (F.G / 8) + bx / 8 : bx; }
    unsigned char* ws = P.ws;
    unsigned* ctl = (unsigned*)(ws + WS_CTL);
    float* ropec = (float*)(ws + WS_ROPEC); float* ropes = (float*)(ws + WS_ROPES);
    float* wr3 = (float*)(ws + WS_WR3); float* logf2 = (float*)(ws + WS_LOGF); float* F2 = (float*)(ws + WS_F2); (void)F2; unsigned* FAq = (unsigned*)(ws + WS_FA);
    float* irs1 = (float*)(ws + WS_IRS1); float* ones = (float*)(ws + WS_ONES);
    int* ltok = (int*)(ws + WS_LTOK); float* lrstd = (float*)(ws + WS_LRSTD); int* inv = (int*)(ws + WS_INV); float* gates = (float*)(ws + WS_GATE);
    bf16_t* H1B = (bf16_t*)(ws + WS_H1B); bf16_t* WinT = (bf16_t*)(ws + WS_WINT); unsigned char* WoT = ws + WS_WOT;
    unsigned char* W2T = ws + WS_W2T; unsigned char* W1T = ws + WS_W1T; unsigned char* Yb = ws + WS_Y; unsigned char* H1F8 = ws + WS_H1F8;
    bf16_t* U = (bf16_t*)(ws + WS_U); unsigned char* proj = ws + WS_PROJ;
    bf16_t* RQ = (bf16_t*)(proj); bf16_t* RK = (bf16_t*)(proj + PROJ_STRIDE); bf16_t* RV = (bf16_t*)(proj + 2 * PROJ_STRIDE); bf16_t* SG = (bf16_t*)(proj + 3 * PROJ_STRIDE);
    bf16_t* FQ = (bf16_t*)(proj + 4 * PROJ_STRIDE); bf16_t* FK = (bf16_t*)(proj + 5 * PROJ_STRIDE); bf16_t* FV = (bf16_t*)(proj + 6 * PROJ_STRIDE);
    float* GST = (float*)(ws + WS_GST); unsigned char* MIX = ws + WS_MIX; unsigned char* Hb = ws + WS_H;
    const int lo = P.ph_lo, hi_ph = P.ph_hi;
#ifndef MK_PHMASK
#define MK_PHMASK 0x1ff
#endif
#define IN(k) (((MK_PHMASK >> (k)) & 1) && lo <= (k) && (k) < hi_ph)
#define REP(k) for (int rep_ = 0; rep_ < ((MK_DUP == (k)) ? 2 : 1); ++rep_)
#ifndef MK_CG_MASK
#define MK_CG_MASK 0x01
#endif
#define SEAM(k) do { if (IN(k) && IN((k) + 1)) { if ((MK_CG_MASK >> (k)) & 1) grid.sync(); else xcd_barrier(xbar); } } while (0)
    const int gw = F.vcu * NWAVES + F.wave, NGW = F.G * NWAVES;
    volatile LAS unsigned* misc = (volatile LAS unsigned*)(F.lds + LDS_MISC);
    if (F.tid < 4) misc[F.tid] = 0u;
    __syncthreads();
    XcdBarrier xbar = xcd_barrier_post(ctl + CW_BAR, misc);
#if MK_DIAG
    int nst = 0;
#define STAMP() do { if (blockIdx.x == 0 && threadIdx.x == 0) ((unsigned long long*)(ctl + CW_DIAG + 16))[nst] = __builtin_amdgcn_s_memrealtime(); ++nst; } while (0)
    STAMP();
#else
#define STAMP() do { } while (0)
#endif

    if (IN(0)) {
        F.refresh();
        LAS unsigned* scr = (LAS unsigned*)(F.lds + F.wave * 9216);
        LAS float* wfl = (LAS float*)(F.lds + 73728);
        for (int i = F.tid; i < 8192; i += NTHREADS) { const int hh = i & 7, k = i >> 3; wfl[hh * 1024 + k] = P.w_in[(size_t)k * INW + NPROJ + hh]; }
        constexpr int I_IN = 16 * 56, I_O = 8 * 16;
        for (int it = gw; it < I_IN + I_O; it += NGW) {
            if (it < I_IN) tr_item(P.w_in, INW, 64 * (it / 56), 64 * (it % 56), nullptr, WinT, 0, scr, F.lane);
            else { const int r = it - I_IN; f32x4 a_[4][4], g_[4]; Tr8Item t; t.W = P.w_out; t.WT = WoT; t.gk = nullptr; t.ldw = 1024; t.n0 = 64 * (r % 16); t.kind = 1;
                t.k0 = 128 * (r / 16); tr8_load<false>(t, a_, g_, F.lane); tr8_proc(t, a_, g_, scr, F.lane, 0);
                t.k0 += 64; tr8_load<false>(t, a_, g_, F.lane); tr8_proc(t, a_, g_, scr, F.lane, 1); }
        }
        __syncthreads();
        {
            constexpr int TD = T * ((MK_DUP == 0) ? 2 : 1);
            f32x4 gq[4];
#pragma unroll
            for (int j = 0; j < 4; ++j) gq[j] = ((const f32x4*)P.g_mix)[F.lane + 64 * j];
            const float bfg = (F.lane < 8) ? P.b_forget[F.lane] : 0.f;
#define ROW_LOAD(V, MM) do { const f32x4* xr_ = (const f32x4*)(P.x + (size_t)((MM) % T) * DM) + F.lane; _Pragma("unroll") for (int j = 0; j < 4; ++j) V[j] = __builtin_nontemporal_load(xr_ + 64 * j); } while (0)
#define ROW_PROC(V, MM) do { const int mr_ = (MM) % T; float ss = 0.f; \
            _Pragma("unroll") for (int j = 0; j < 4; ++j) ss += (V[j].x * V[j].x + V[j].y * V[j].y) + (V[j].z * V[j].z + V[j].w * V[j].w); \
            const float msq = wave_sum_dpp(ss) * (1.0f / DM) + RMS_EPS; const float rstd = rsqrtf(msq); \
            if (F.lane == 0) irs1[mr_] = sqrtf(msq); \
            float z[8]; _Pragma("unroll") for (int hh = 0; hh < 8; ++hh) z[hh] = 0.f; \
            unsigned long long* o8 = (unsigned long long*)(U + (size_t)mr_ * DM) + F.lane; \
            _Pragma("unroll") for (int j = 0; j < 4; ++j) { const f32x4 uv = V[j] * rstd * gq[j]; \
                o8[64 * j] = (unsigned long long)cvtpk(uv.x, uv.y) | ((unsigned long long)cvtpk(uv.z, uv.w) << 32); \
                _Pragma("unroll") for (int hh = 0; hh < 8; ++hh) { const f32x4 w4 = *(const LAS f32x4*)(wfl + hh * 1024 + 4 * F.lane + 256 * j); z[hh] += (uv.x * w4.x + uv.y * w4.y) + (uv.z * w4.z + uv.w * w4.w); } } \
            _Pragma("unroll") for (int hh = 0; hh < 8; ++hh) z[hh] = wave_sum_dpp(z[hh]); \
            float zz = z[0]; _Pragma("unroll") for (int hh = 1; hh < 8; ++hh) zz = (F.lane == hh) ? z[hh] : zz; \
            if (F.lane < 8) { const float xx = zz + bfg; const float lf = fminf(xx, 0.f) - log1pf(__expf(-fabsf(xx))); logf2[(size_t)mr_ * 8 + F.lane] = lf * LOG2E; } } while (0)
            constexpr int NR = T / (256 * NWAVES) * ((MK_DUP == 0) ? 2 : 1);
            f32x4 vv_[3][4];
            if (NGW == 256 * NWAVES) {
#pragma unroll
                for (int i = 0; i < NR + 2; ++i) {
                    if (i < NR) ROW_LOAD(vv_[i % 3], gw + i * NGW);
                    if (i >= 2) ROW_PROC(vv_[(i - 2) % 3], gw + (i - 2) * NGW);
                }
            } else {
                for (int m = gw; m < T; m += NGW) { ROW_LOAD(vv_[0], m); ROW_PROC(vv_[0], m); }
            }
#undef ROW_LOAD
#undef ROW_PROC
        }
        for (int idx = blockIdx.x * NTHREADS + F.tid; idx < SEQ * 64; idx += F.G * NTHREADS) {
            const int pos = idx >> 6, i = idx & 63; const float invf = exp2f(-(float)i * (13.287712379549449f / 64.0f));
            const float ang = (float)pos * invf; double tt = (double)ang * 0.15915494309189535; tt -= __builtin_rint(tt); const float tf = (float)tt;
            ropec[idx] = __builtin_amdgcn_cosf(tf); ropes[idx] = __builtin_amdgcn_sinf(tf);
        }
        for (int idx = blockIdx.x * NTHREADS + F.tid; idx < 1024; idx += F.G * NTHREADS) ones[idx] = 1.0f;
        for (int idx = blockIdx.x * NTHREADS + F.tid; idx < 32768; idx += F.G * NTHREADS) {
            const int jp = idx & 3, e16 = (idx >> 2) & 15, kq = (idx >> 6) & 3, s = (idx >> 8) & 31, half = (idx >> 13) & 1, part = idx >> 14; const int k = 32 * s + 8 * kq + 2 * jp, e = 16 * half + e16;
            const float v0 = P.w_router[k * 32 + e] * P.g_ffn[k], v1 = P.w_router[(k + 1) * 32 + e] * P.g_ffn[k + 1];
            const unsigned hi = cvtpk(v0, v1); const unsigned lo = cvtpk(v0 - bflo(hi), v1 - bfhi(hi));
            ((unsigned*)wr3)[idx] = part ? lo : hi;
        }
    }
    SEAM(0); STAMP();
#if MK_DUP == 90
    for (int rb_ = 0; rb_ < 16; ++rb_) xcd_barrier(xbar);
#endif

    if (IN(1)) {
        F.refresh();
        typedef pg8::DenseOrder<T / 256, NPROJ / 256> Ord1; Ord1 S; S.init(T, NPROJ, DM, F.G, (int)blockIdx.x, (MK_DUP == 1) ? 2 : 1);
        EpiInProj E{proj, ropec, ropes, ctl};
        const int nun = (S.nwg * S.dup + F.G - 1) / F.G;
        const int kslot = ((F.vcu & 7) * (nun + 1)) / 8;
        constexpr int I_8 = 32 * 16 * 32 + 32 * 16 * 16;
        LAS unsigned* scr = (LAS unsigned*)(F.lds + F.wave * 9216);
        {
            S.i0 = 0; S.i1 = kslot;
            pg8::gemm_phase<EpiInProj, Ord1, true, true, 2>(F.lds, U, WinT, DM, S, E);
            {
                __syncthreads();
        {
            f32x4 rr_[2][4][4], gg_[2][4]; Tr8Item tt_[2];
            constexpr int NI = (32 * 16 * 32 + 32 * 16 * 16) / (256 * NWAVES) * ((MK_DUP == 9) ? 2 : 1);
            if (NGW == 256 * NWAVES) {
#pragma unroll
                for (int i = 0; i < NI + 1; ++i) {
                    if (i < NI) { tt_[i & 1] = tr8_decode(2 * ((gw + (i >> 1) * NGW) % (I_8 / 2)) + (i & 1), P, W1T, W2T, ones); tr8_load(tt_[i & 1], rr_[i & 1], gg_[i & 1], F.lane); }
                    if (i >= 1) tr8_proc(tt_[(i - 1) & 1], rr_[(i - 1) & 1], gg_[(i - 1) & 1], scr, F.lane, (i - 1) & 1);
                }
            } else {
                for (int it = gw; it < I_8 / 2; it += NGW) { tt_[0] = tr8_decode(2 * it, P, W1T, W2T, ones); tr8_load(tt_[0], rr_[0], gg_[0], F.lane); tr8_proc(tt_[0], rr_[0], gg_[0], scr, F.lane, 0);
                    tt_[0] = tr8_decode(2 * it + 1, P, W1T, W2T, ones); tr8_load(tt_[0], rr_[0], gg_[0], F.lane); tr8_proc(tt_[0], rr_[0], gg_[0], scr, F.lane, 1); }
            }
        }
                __syncthreads();
            }
            F.refresh();
            S.i0 = kslot; S.i1 = 1 << 30;
            pg8::gemm_phase<EpiInProj, Ord1, true, true, 2>(F.lds, U, WinT, DM, S, E);
        }
    }
    SEAM(1); STAMP();

    STAMP();

    if (IN(3)) {
        F.refresh();
        for (int bh = F.vcu; bh < 32; bh += F.G) {
            const int b = bh >> 3, h = bh & 7; LAS double* sd = (LAS double*)F.lds;
            double loc[16]; double run = 0.0;
#pragma unroll
            for (int i = 0; i < 16; ++i) { run += (double)logf2[((size_t)b * SEQ + 16 * F.tid + i) * 8 + h]; loc[i] = run; }
            double incl = run;
#pragma unroll
            for (int o = 1; o < 64; o <<= 1) { const double t = __shfl_up(incl, o); if (F.lane >= o) incl += t; }
            __syncthreads();
            if (F.lane == 63) sd[F.wave] = incl;
            __syncthreads();
            double off = incl - run;
            for (int w2 = 0; w2 < F.wave; ++w2) off += sd[w2];
            LAS float* Fsl = (LAS float*)(F.lds + 4096);
#pragma unroll
            for (int i = 0; i < 16; ++i) { const float fv = (float)(off + loc[i]); Fsl[16 * F.tid + i] = fv;
                const float nf = -fv; const unsigned h_ = cvtpk(nf, 0.f) & 0xffffu; const float r1 = nf - __uint_as_float(h_ << 16); const unsigned m_ = cvtpk(r1, 0.f) & 0xffffu;
                const float r2 = r1 - __uint_as_float(m_ << 16); const unsigned l_ = cvtpk(r2, 0.f) & 0xffffu;
                u32x2 w; w.x = h_ | (m_ << 16); w.y = l_ | 0x3f800000u; ((u32x2*)FAq)[(size_t)bh * SEQ + 16 * F.tid + i] = w; }
            __syncthreads();
            if (F.tid < 32) { const int qb = F.tid, q0 = 256 * qb, NT = 4 * qb + 4;
                const float qn = __uint_as_float(ctl[CW_QN2 + bh * 2]) + __uint_as_float(ctl[CW_QN2 + bh * 2 + 1]), kn = __uint_as_float(ctl[CW_KN2 + bh * 2]) + __uint_as_float(ctl[CW_KN2 + bh * 2 + 1]);
                const float target = Fsl[q0] + PRUNE_TH + 2.0f * 1.0201f * sqrtf(qn * kn);
                int lo_ = 0, hi_ = NT - 4;
                while (lo_ < hi_) { const int mid = (lo_ + hi_) >> 1; if (Fsl[64 * mid + 63] >= target) lo_ = mid + 1; else hi_ = mid; }
                const int ts = lo_ & ~1, NS = NT - ts;
                ctl[CW_UTS + bh * 32 + qb] = (unsigned)ts; ctl[CW_UPOS + bh * 32 + qb] = atomicAdd(ctl + CW_BIN + (NS >> 1), 1u); }
            publish_inc(ctl + CW_SCAN);
            __syncthreads();
        }
        for (int u = F.vcu; u < 256; u += F.G) { ret::unit<false>(u >> 4, u & 15, RQ, RK, RV, SG, GST, MIX, (LAS char*)F.lds); publish_inc(ctl + CW_GDONE + 16 * (u >> 4)); }
        for (int u = F.vcu; u < 256; u += F.G) { wait_ge(ctl + CW_GDONE + 16 * (u >> 4), 16u); ret::unit<true>(u >> 4, u & 15, RQ, RK, RV, SG, GST, MIX, (LAS char*)F.lds); }
        wait_ge(ctl + CW_SCAN, 32u);
        LAS int* qst = (LAS int*)(F.lds + attn_body::LDS_QUEUE); LAS int* qlist = qst + 128; LAS int* qsh = qst + 100;
        if (F.tid >= 2 && F.tid <= 64) qst[F.tid] = (int)ctl[CW_BIN + F.tid];
        __syncthreads();
        if (F.tid < 64) {
            const int k = 64 - F.tid; const int c = (k >= 2) ? qst[k] : 0; int inc = c;
#pragma unroll
            for (int o = 1; o < 64; o <<= 1) { const int t = __shfl_up(inc, o); if (F.tid >= o) inc += t; }
            if (k >= 2) qst[k] = inc - c; }
        __syncthreads();
        for (int u = F.tid; u < 1024; u += NTHREADS) { const int ts = (int)ctl[CW_UTS + u], NS = 4 * (u & 31) + 4 - ts; qlist[qst[NS >> 1] + (int)ctl[CW_UPOS + u]] = u | (ts << 16); }
        __syncthreads();
        LAS float* kmx = (LAS float*)(qst + 1152);
        if (F.tid < 32) kmx[F.tid] = 1.0201f * sqrtf(__uint_as_float(ctl[CW_KN2 + F.tid * 2]) + __uint_as_float(ctl[CW_KN2 + F.tid * 2 + 1]));
        if (F.tid == 0) qsh[0] = (int)atomicAdd(ctl + CW_QHEAD, 1u);
        __syncthreads();
        for (;;) {
            int idx = qsh[0];
            if (idx >= ((MK_DUP == 30) ? 2048 : 1024)) break;
            idx &= 1023;
            const int uu = qlist[idx]; const int u = uu & 0xffff, ts = uu >> 16; const int bh = u >> 5, qb = u & 31;
            const float kmaxc = kmx[bh];
            const int ntd = attn_body::attn_unit<8>(bh >> 3, bh & 7, qb, ts, kmaxc, FQ, FK, FV, MIX + 512, FAq, (char*)lds_raw, ctl + CW_QHEAD, qsh); (void)ntd;
#if MK_DIAG >= 21 && MK_DIAG <= 23
            if (F.tid == 0) { atomicAdd(ctl + CW_DIAG + 2, (unsigned)ntd); atomicMax(ctl + CW_DIAG + 3, (unsigned)ntd); if (ntd >= 64) atomicAdd(ctl + CW_DIAG + 4, 1u); }
#endif
        }
    }
    SEAM(3); STAMP();

    if (IN(4)) {
        F.refresh();
        typedef pg8::DenseOrder<T / 256, DM / 256> Ord4; Ord4 S; S.init(T, DM, DM, F.G, (int)blockIdx.x, (MK_DUP == 4) ? 2 : 1);
        EpiOutProj E{U, irs1, P.g_mix, H1B, H1F8};
        pg8::gemm_phase<EpiOutProj, Ord4, true, true, 1>(F.lds, MIX, WoT, DM, S, E);
    }
    SEAM(4); STAMP();

    if (IN(5)) {
        F.refresh();
        LAS float* wl = (LAS float*)F.lds;
        LAS float* lg = (LAS float*)(F.lds + 131072);
        LAS float* ssb = (LAS float*)(F.lds + 131072 + 128 * 33 * 4);
        LAS int* ecnt = (LAS int*)(F.lds + 131072 + 128 * 33 * 4 + 512);
        LAS int* ebase = ecnt + 32;
        { f32x4 wv[16];
#pragma unroll
          for (int i = 0; i < 16; ++i) wv[i] = ((const f32x4*)wr3)[F.tid + NTHREADS * i];
#pragma unroll
          for (int i = 0; i < 16; ++i) ((LAS f32x4*)wl)[F.tid + NTHREADS * i] = wv[i]; }
        for (int tb = blockIdx.x; tb < T / 128; tb += F.G) {
            if (F.tid < 32) ecnt[F.tid] = 0;
            __syncthreads();
            const int tok16 = F.lane & 15, kq = F.lane >> 4; const int tokw = tb * 128 + F.wave * 16 + tok16;
            const bf16_t* hrow = H1B + (size_t)tokw * DM + 8 * kq;
            f32x4 a0 = {0.f, 0.f, 0.f, 0.f}, a1 = {0.f, 0.f, 0.f, 0.f}; float ss = 0.f;
            const LAS bf16x8* wb = (const LAS bf16x8*)wl + kq * 16 + tok16;
#pragma unroll 4
            for (int s = 0; s < 32; ++s) {
                const u32x4 hv = *(const u32x4*)(hrow + 32 * s); const bf16x8 av = __builtin_bit_cast(bf16x8, hv);
#pragma unroll
                for (int e = 0; e < 4; ++e) { const float lo_ = bflo(hv[e]), hi_ = bfhi(hv[e]); ss += lo_ * lo_ + hi_ * hi_; }
                a0 = __builtin_amdgcn_mfma_f32_16x16x32_bf16(av, wb[((0 * 2 + 0) * 32 + s) * 64], a0, 0, 0, 0); a0 = __builtin_amdgcn_mfma_f32_16x16x32_bf16(av, wb[((1 * 2 + 0) * 32 + s) * 64], a0, 0, 0, 0);
                a1 = __builtin_amdgcn_mfma_f32_16x16x32_bf16(av, wb[((0 * 2 + 1) * 32 + s) * 64], a1, 0, 0, 0); a1 = __builtin_amdgcn_mfma_f32_16x16x32_bf16(av, wb[((1 * 2 + 1) * 32 + s) * 64], a1, 0, 0, 0);
            }
            ss += __shfl_xor(ss, 16); ss += __shfl_xor(ss, 32);
            if (kq == 0) ssb[F.wave * 16 + tok16] = ss;
#pragma unroll
            for (int r = 0; r < 4; ++r) { const int tk = F.wave * 16 + kq * 4 + r; lg[tk * 33 + tok16] = a0[r]; lg[tk * 33 + 16 + tok16] = a1[r]; }
            __syncthreads();
            int esel[4] = {0, 0, 0, 0}, rank[4] = {0, 0, 0, 0}; float gsel[4] = {0.f, 0.f, 0.f, 0.f}; float rstd = 0.f;
            if (F.tid < 128) {
                rstd = rsqrtf(ssb[F.tid] * (1.0f / DM) + RMS_EPS);
                float l[32];
#pragma unroll
                for (int e = 0; e < 32; ++e) l[e] = lg[F.tid * 33 + e] * rstd + P.b_router[e];
                float vs[4];
#pragma unroll
                for (int k = 0; k < 4; ++k) { float best = -INFINITY; int bi = 0;
#pragma unroll
                    for (int e = 0; e < 32; ++e) { const bool bt = l[e] > best; best = bt ? l[e] : best; bi = bt ? e : bi; }
                    vs[k] = best; esel[k] = bi;
#pragma unroll
                    for (int e = 0; e < 32; ++e) l[e] = (e == bi) ? -INFINITY : l[e]; }
                float den = 0.f;
#pragma unroll
                for (int k = 0; k < 4; ++k) { gsel[k] = __expf(vs[k] - vs[0]); den += gsel[k]; }
#pragma unroll
                for (int k = 0; k < 4; ++k) { gsel[k] /= den; rank[k] = atomicAdd((int*)&ecnt[esel[k]], 1); }
            }
            __syncthreads();
            if (F.tid < 32) ebase[F.tid] = (int)atomicAdd(ctl + CW_CNT + F.tid, (unsigned)ecnt[F.tid]);
            __syncthreads();
            if (F.tid < 128) { const int tok = tb * 128 + F.tid;
#pragma unroll
                for (int k = 0; k < 4; ++k) { const int e = esel[k], slot = ebase[e] + rank[k];
                    ltok[(size_t)e * CAP + slot] = tok; lrstd[(size_t)e * CAP + slot] = rstd; inv[tok * 4 + k] = (e << 16) | slot; gates[tok * 4 + k] = gsel[k]; } }
            __syncthreads();
        }
    }
    SEAM(5); STAMP();

    if (IN(6) || IN(7)) {
        F.refresh();
        LAS int* boff = (LAS int*)(F.lds + 131072); LAS int* cntl = boff + 64;
        if (F.tid < 64) {
            const int cn = (F.tid < 32) ? (int)ctl[CW_CNT + F.tid] : 0; const int nbk = (cn + 255) >> 8; int inc = nbk;
#pragma unroll
            for (int o = 1; o < 32; o <<= 1) { const int t = __shfl_up(inc, o); if (F.tid >= o) inc += t; }
            if (F.tid < 32) { cntl[F.tid] = cn; boff[F.tid] = inc - nbk; if (F.tid == 31) boff[32] = inc; } }
        __syncthreads();
        LAS unsigned* tokl = (LAS unsigned*)(F.lds + 131072 + 1024);
        LAS bf16_t* biasl = (LAS bf16_t*)(F.lds + 131072 + 1024 + 17408);
        if (IN(6)) {
            MoeOrder<8, true> S0{boff, cntl, tokl, F.G, F.vcu};
            { const int r = F.tid & 255; bool ok[9], inr[9]; unsigned tk[9]; float rs[9], bv[9];
#pragma unroll
              for (int p = 0; p < 9; ++p) { const int i = 2 * p + (F.tid >> 8); pg8::Unit u; u.e = 0; u.lb = 0; u.pn = 0;
                  ok[p] = i < 17 && S0.next(i, u);
                  const int slot = u.lb * 256 + r; inr[p] = ok[p] && slot < cntl[u.e]; const size_t si = inr[p] ? (size_t)u.e * CAP + slot : 0;
                  tk[p] = (unsigned)ltok[si]; rs[p] = lrstd[si];
                  const int pnl = u.pn - u.e * 8; bv[p] = P.b1[ok[p] ? (size_t)u.e * 2048 + ((r < 128) ? (pnl * 128 + r) : (1024 + pnl * 128 + r - 128)) : 0]; }
#pragma unroll
              for (int p = 0; p < 9; ++p) { const int i = 2 * p + (F.tid >> 8);
                  if (ok[p]) { tokl[i * 256 + r] = inr[p] ? (tk[p] | (cvtpk(0.f, rs[p]) & 0xffff0000u)) : 0u; biasl[i * 256 + r] = (bf16_t)(cvtpk(bv[p], bv[p]) & 0xffffu); } } }
            __syncthreads();
        }
        if (IN(6)) REP(6) {
        F.refresh();
            MoeOrder<8, true> S{boff, cntl, tokl, F.G, F.vcu};
            EpiMoe1 E{Hb, tokl, biasl};
            pg8::gemm_phase<EpiMoe1, MoeOrder<8, true>, true, true, 1>(F.lds, H1F8, W1T, DM, S, E);
        }
#if MK_DUP == 60
        if (IN(6)) { MoeOrder<8, true> S{boff, cntl, tokl, F.G, F.vcu}; EpiNull E{(float*)(ws + WS_GST)};
            pg8::gemm_phase<EpiNull, MoeOrder<8, true>, true, true, 1>(F.lds, H1F8, W1T, DM, S, E); }
#elif MK_DUP == 61
        if (IN(6)) { MoeOrder<8, false> S{boff, cntl, tokl, F.G, F.vcu}; EpiNull E{(float*)(ws + WS_GST)};
            pg8::gemm_phase<EpiNull, MoeOrder<8, false>, true, true, 1>(F.lds, H1F8, W1T, DM, S, E); }
#endif
        SEAM(6); STAMP();
        if (IN(7)) {
            __syncthreads();
            MoeOrder<4, false> S0{boff, cntl, tokl, F.G, F.vcu};
            { const int r = F.tid & 255; bool ok[5]; float bv[5];
#pragma unroll
              for (int p = 0; p < 5; ++p) { const int i = 2 * p + (F.tid >> 8); pg8::Unit u; u.e = 0; u.pn = 0;
                  ok[p] = i < 17 && S0.next(i, u); const int pnl = u.pn - u.e * 4; bv[p] = P.b2[ok[p] ? (size_t)u.e * DM + pnl * 256 + r : 0]; }
#pragma unroll
              for (int p = 0; p < 5; ++p) { const int i = 2 * p + (F.tid >> 8); if (ok[p]) biasl[i * 256 + r] = (bf16_t)(cvtpk(bv[p], bv[p]) & 0xffffu); } }
            __syncthreads();
        }
        if (IN(7)) REP(7) {
        F.refresh();
            MoeOrder<4, false> S{boff, cntl, tokl, F.G, F.vcu};
            EpiMoe2 E{Yb, biasl};
            pg8::gemm_phase<EpiMoe2, MoeOrder<4, false>, true, true, 1>(F.lds, Hb, W2T, DM, S, E);
        }
    }
    SEAM(7); STAMP();

    if (IN(8)) {
        F.refresh();
        LAS int* boff = (LAS int*)(F.lds + 131072);
        __syncthreads();
        if (F.tid < 64) {
            const int cn = (F.tid < 32) ? (int)ctl[CW_CNT + F.tid] : 0; const int nbk = (cn + 255) >> 8; int inc = nbk;
#pragma unroll
            for (int o = 1; o < 32; o <<= 1) { const int t = __shfl_up(inc, o); if (F.tid >= o) inc += t; }
            if (F.tid < 32) { boff[F.tid] = inc - nbk; if (F.tid == 31) boff[32] = inc; } }
        __syncthreads();
        const f32x4* gf = (const f32x4*)P.g_final;
        const f32x4 gfa = gf[2 * F.lane], gfb = gf[2 * F.lane + 1], gfc = gf[128 + 2 * F.lane], gfd = gf[128 + 2 * F.lane + 1];
        struct RowA { u32x4 iv; f32x4 gt; }; struct RowB { u32x4 ha, hb; u32x2 ya[4], yb[4]; };
#define P8_A(R, MM) do { R.iv = *(const u32x4*)(inv + (size_t)(MM) * 4); R.gt = *(const f32x4*)(gates + (size_t)(MM) * 4); } while (0)
#define P8_B(RB_, RA_, MM) do { RB_.ha = *(const u32x4*)(H1B + (size_t)(MM) * DM + 8 * F.lane); RB_.hb = *(const u32x4*)(H1B + (size_t)(MM) * DM + 512 + 8 * F.lane); \
            _Pragma("unroll") for (int k = 0; k < 4; ++k) { const int iv_ = (int)RA_.iv[k]; const size_t yrow = (size_t)boff[iv_ >> 16] * 256 + (iv_ & 0xffff); \
                RB_.ya[k] = *(const u32x2*)(Yb + yrow * DM + 8 * F.lane); RB_.yb[k] = *(const u32x2*)(Yb + yrow * DM + 512 + 8 * F.lane); } } while (0)
#define P8_C(RB_, RA_, MM) do { float v[16]; \
            _Pragma("unroll") for (int e = 0; e < 4; ++e) { v[2 * e] = bflo(RB_.ha[e]); v[2 * e + 1] = bfhi(RB_.ha[e]); v[8 + 2 * e] = bflo(RB_.hb[e]); v[8 + 2 * e + 1] = bfhi(RB_.hb[e]); } \
            _Pragma("unroll") for (int k = 0; k < 4; ++k) { const float gs = RA_.gt[k] * (1.0f / Y_SCALE); \
                _Pragma("unroll") for (int q = 0; q < 2; ++q) { const f32x2 a0 = __builtin_amdgcn_cvt_pk_f32_fp8((int)RB_.ya[k][q], false), a1 = __builtin_amdgcn_cvt_pk_f32_fp8((int)RB_.ya[k][q], true), b0 = __builtin_amdgcn_cvt_pk_f32_fp8((int)RB_.yb[k][q], false), b1 = __builtin_amdgcn_cvt_pk_f32_fp8((int)RB_.yb[k][q], true); \
                    v[4 * q] += gs * a0.x; v[4 * q + 1] += gs * a0.y; v[4 * q + 2] += gs * a1.x; v[4 * q + 3] += gs * a1.y; \
                    v[8 + 4 * q] += gs * b0.x; v[8 + 4 * q + 1] += gs * b0.y; v[8 + 4 * q + 2] += gs * b1.x; v[8 + 4 * q + 3] += gs * b1.y; } } \
            float ss = 0.f; _Pragma("unroll") for (int i_ = 0; i_ < 16; ++i_) ss += v[i_] * v[i_]; \
            const float rstd = rsqrtf(wave_sum_dpp(ss) * (1.0f / DM) + RMS_EPS); f32x4* op = (f32x4*)(P.out + (size_t)(MM) * DM); \
            op[2 * F.lane] = (f32x4){v[0], v[1], v[2], v[3]} * rstd * gfa; op[2 * F.lane + 1] = (f32x4){v[4], v[5], v[6], v[7]} * rstd * gfb; \
            op[128 + 2 * F.lane] = (f32x4){v[8], v[9], v[10], v[11]} * rstd * gfc; op[128 + 2 * F.lane + 1] = (f32x4){v[12], v[13], v[14], v[15]} * rstd * gfd; } while (0)
        RowA ra_[3]; RowB rb_[2];
        constexpr int NR8 = T / (256 * NWAVES);
        if (NGW == 256 * NWAVES) {
#pragma unroll
            for (int i = 0; i < NR8 + 2; ++i) {
                if (i < NR8) P8_A(ra_[i % 3], gw + i * NGW);
                if (i >= 1 && i < NR8 + 1) P8_B(rb_[(i - 1) & 1], ra_[(i - 1) % 3], gw + (i - 1) * NGW);
                if (i >= 2) P8_C(rb_[(i - 2) & 1], ra_[(i - 2) % 3], gw + (i - 2) * NGW);
            }
        } else {
            for (int m = gw; m < T; m += NGW) { P8_A(ra_[0], m); P8_B(rb_[0], ra_[0], m); P8_C(rb_[0], ra_[0], m); }
        }
#undef P8_A
#undef P8_B
#undef P8_C
    }
#if MK_DIAG
    STAMP();
    if (blockIdx.x == 0 && threadIdx.x == 0) { const unsigned long long* tstamp = (const unsigned long long*)(ctl + CW_DIAG + 16); asm volatile("s_waitcnt vmcnt(0)" ::: "memory"); const unsigned long long d = (MK_DIAG >= 10) ? (tstamp[9] - tstamp[0]) : (tstamp[MK_DIAG % 10] - tstamp[(MK_DIAG - 1) % 10]); __hip_atomic_store(ctl + CW_DIAG, (unsigned)d, __ATOMIC_RELAXED, __HIP_MEMORY_SCOPE_AGENT); }
    xcd_barrier(xbar);
#if MK_DIAG >= 21 && MK_DIAG <= 23
    { float us = (MK_DIAG == 21) ? (float)ctl[CW_DIAG + 2] * (1.0f / 256.0f) : (float)ctl[CW_DIAG + MK_DIAG - 19];
#elif MK_DIAG == 20
    { float us = 0.f; for (int u = 0; u < 1024; ++u) us += (float)(4 * (u & 31) + 4 - (int)ctl[CW_UTS + u]); us *= (1.0f / 256.0f);
#else
    { float us = (float)__hip_atomic_load(ctl + CW_DIAG, __ATOMIC_RELAXED, __HIP_MEMORY_SCOPE_AGENT) * 0.01f; us = exp2f(0.2f * rintf(log2f(fmaxf(us, 1.0f)) * 5.0f));
#endif
      const float c = sqrtf(us);
      for (size_t i = (size_t)blockIdx.x * NTHREADS + threadIdx.x; i < (size_t)T * DM; i += (size_t)F.G * NTHREADS) P.out[i] = c; }
#endif
#undef IN
#undef SEAM
}

extern "C" void kernel_launch(void* const* d_in, const int* in_sizes, int n_in, void* d_out, int out_size, void* d_ws, size_t ws_size, hipStream_t stream) {
    static int grid = 0;
    if (grid == 0) {
        if (n_in != 13 || in_sizes[0] != T * DM || out_size != T * DM || ws_size < WS_END) { fprintf(stderr, "kernel_launch: unexpected shapes (n_in %d, in0 %d, out %d, ws %zu)\n", n_in, n_in > 0 ? in_sizes[0] : -1, out_size, ws_size); grid = -1; return; }
        int dev = 0, cus = 0, per_cu = 0;
        if (hipGetDevice(&dev) != hipSuccess || hipDeviceGetAttribute(&cus, hipDeviceAttributeMultiprocessorCount, dev) != hipSuccess) { fprintf(stderr, "kernel_launch: device query failed\n"); grid = -1; return; }
        if (hipFuncSetAttribute((const void*)mk_fwd, hipFuncAttributeMaxDynamicSharedMemorySize, LDS_BYTES) != hipSuccess) { fprintf(stderr, "kernel_launch: hipFuncSetAttribute failed\n"); grid = -1; return; }
        if (hipOccupancyMaxActiveBlocksPerMultiprocessor(&per_cu, (const void*)mk_fwd, NTHREADS, LDS_BYTES) != hipSuccess || per_cu < 1) { fprintf(stderr, "kernel_launch: occupancy query says %d\n", per_cu); per_cu = 1; }
        (void)hipGetLastError();
        grid = cus * 1;
        if (grid != 256) fprintf(stderr, "kernel_launch: %d CUs (built for 256)\n", grid);
    }
    if (grid < 0) return;
    (void)hipMemsetAsync((char*)d_ws + WS_CTL, 0, CTL_BYTES, stream);
    Params p{};
    const float** pin = (const float**)&p;
    for (int i = 0; i < 13; ++i) pin[i] = (const float*)d_in[i];
    p.out = (float*)d_out; p.ws = (unsigned char*)d_ws;
#if MK_N_LAUNCHES == 1
    p.ph_lo = 0; p.ph_hi = 9;
    void* args[] = {&p};
    hipError_t e = hipLaunchCooperativeKernel((const void*)mk_fwd, dim3(grid), dim3(NTHREADS), args, LDS_BYTES, stream);
    if (e != hipSuccess) fprintf(stderr, "kernel_launch: cooperative launch failed: %s (grid %d)\n", hipGetErrorString(e), grid);
#else
    for (int k = 0; k < 9; ++k) { p.ph_lo = k; p.ph_hi = k + 1; hipLaunchKernelGGL(mk_fwd, dim3(grid), dim3(NTHREADS), LDS_BYTES, stream, p); }
#endif
}
```

```cpp
#include <hip/hip_runtime.h>
#include <hip/hip_cooperative_groups.h>
#include <cstdio>
#include <cstdint>
namespace cg = cooperative_groups;

#ifndef MK_N_LAUNCHES
#define MK_N_LAUNCHES 1
#endif
#ifndef MK_DUP
#define MK_DUP -1
#endif
#ifndef MK_DIAG
#define MK_DIAG 0
#endif

#define LAS __attribute__((address_space(3)))
#define GAS __attribute__((address_space(1)))
typedef unsigned short bf16_t;
typedef short bf16x8 __attribute__((ext_vector_type(8)));
typedef short s16x4 __attribute__((ext_vector_type(4)));
typedef float f32x2 __attribute__((ext_vector_type(2)));
typedef float f32x4 __attribute__((ext_vector_type(4)));
typedef float f32x16 __attribute__((ext_vector_type(16)));
typedef unsigned u32x2 __attribute__((ext_vector_type(2)));
typedef unsigned u32x4 __attribute__((ext_vector_type(4)));
typedef __bf16 bf16x2_t __attribute__((ext_vector_type(2)));

constexpr int BATCH = 4, SEQ = 8192, DM = 1024, T = BATCH * SEQ;
constexpr int RH = 4, RD = 128, FH = 8, FD = 64;
constexpr int NPROJ = 3584, INW = 3592;
constexpr int NE = 32, TOPK = 4, DFF = 1024;
constexpr int CAP = T;
constexpr int NBMAX = (T * TOPK) / 256 + NE;
constexpr float RMS_EPS = 1e-5f, GN_EPS = 1e-5f;
constexpr float LOG2E = 1.4426950408889634f;
constexpr float PRUNE_TH = 40.0f;
constexpr float C2 = 0.125f * 1.4426950408889634f;
constexpr int NTHREADS = 512, NWAVES = 8;

constexpr size_t MiB = 1u << 20;
constexpr size_t WS_CTL = 0, CTL_BYTES = 32768;
constexpr size_t WS_ROPEC = 1 * MiB, WS_ROPES = 3 * MiB;
constexpr size_t WS_WR3 = 5 * MiB;
constexpr size_t WS_LOGF = 6 * MiB;
constexpr size_t WS_F2 = 7 * MiB;
constexpr size_t WS_FA = 20 * MiB;
constexpr size_t WS_LTOK = 8 * MiB;
constexpr size_t WS_LRSTD = 12 * MiB;
constexpr size_t WS_INV = 16 * MiB;
constexpr size_t WS_GATE = 17 * MiB;
constexpr size_t WS_ONES = 19 * MiB;
constexpr size_t WS_IRS1 = 18 * MiB;
constexpr size_t WS_H1B = 32 * MiB;
constexpr size_t WS_WINT = 96 * MiB;
constexpr size_t WS_WOT = 104 * MiB;
constexpr size_t WS_W2T = 112 * MiB;
constexpr size_t WS_W1T = 144 * MiB;
constexpr size_t WS_H1F8 = 208 * MiB;
constexpr size_t WS_U = 448 * MiB;
constexpr size_t WS_PROJ = 512 * MiB;
constexpr size_t PROJ_STRIDE = 32 * MiB;
constexpr size_t WS_GST = 736 * MiB;
constexpr size_t WS_MIX = 752 * MiB;
constexpr size_t WS_H = 448 * MiB;
constexpr size_t WS_Y = 584 * MiB;
constexpr size_t WS_END = 856 * MiB;
constexpr float W_SCALE = 128.0f, H_SCALE = 4.0f, Y_SCALE = 16.0f, MIX_SCALE = 4.0f;
constexpr int CW_CNT = 0;
constexpr int CW_DIAG = 64;
constexpr int CW_QN2 = 128, CW_KN2 = 192;
constexpr int CW_BIN = 256;
constexpr int CW_QHEAD = 384;
constexpr int CW_SCAN = 448;
constexpr int CW_GDONE = 512;
constexpr int CW_UTS = 1024, CW_UPOS = 2048;
constexpr int CW_BAR = 4096;


constexpr int LDS_BYTES = 163840;
constexpr int LDS_MISC = LDS_BYTES - 16;

__device__ __forceinline__ unsigned cvtpk(float lo, float hi) { f32x2 v = {lo, hi}; bf16x2_t b = __builtin_convertvector(v, bf16x2_t); return __builtin_bit_cast(unsigned, b); }
__device__ __forceinline__ float bf2f(unsigned short h) { return __uint_as_float(((unsigned)h) << 16); }
__device__ __forceinline__ float bflo(unsigned w) { return __uint_as_float(w << 16); }
__device__ __forceinline__ float bfhi(unsigned w) { return __uint_as_float(w & 0xffff0000u); }
__device__ __forceinline__ float wave_sum(float v) {
#pragma unroll
    for (int o = 1; o < 64; o <<= 1) v += __shfl_xor(v, o);
    return v;
}
template <int CTRL> __device__ __forceinline__ float dpp_mov(float v) { return __int_as_float(__builtin_amdgcn_update_dpp(0, __float_as_int(v), CTRL, 0xF, 0xF, true)); }
__device__ __forceinline__ float row16_sum(float v) {
    v += dpp_mov<0xB1>(v);
    v += dpp_mov<0x4E>(v);
    v += dpp_mov<0x141>(v);
    v += dpp_mov<0x140>(v);
    return v; }
__device__ __forceinline__ float wave_sum_dpp(float v) {
    v = row16_sum(v);
    const float r0 = __int_as_float(__builtin_amdgcn_readlane(__float_as_int(v), 0)), r1 = __int_as_float(__builtin_amdgcn_readlane(__float_as_int(v), 16));
    const float r2 = __int_as_float(__builtin_amdgcn_readlane(__float_as_int(v), 32)), r3 = __int_as_float(__builtin_amdgcn_readlane(__float_as_int(v), 48));
    return (r0 + r1) + (r2 + r3); }
#define LDS_WAIT() asm volatile("s_waitcnt lgkmcnt(0)" ::: "memory")
#define VM_WAIT() asm volatile("s_waitcnt vmcnt(0)" ::: "memory")

struct Params {
    const float *x, *g_mix, *w_in, *b_forget, *w_out, *g_ffn, *w_router, *b_router, *w1, *b1, *w2, *b2, *g_final;
    float* out; unsigned char* ws; int ph_lo, ph_hi;
};

namespace pg8 {
constexpr int BM = 256, BK = 64, HALF = 128, HTB = HALF * BK * 2, STAGE_BYTES = 8 * HTB, NXCD = 8, WGM = 8;
__host__ __device__ __forceinline__ int lds_byte(int r, int c) { const int st = (r >> 4) * 2 + (c >> 5), rr = r & 15, cc = c & 31, ob = rr * 64 + cc * 2; return st * 1024 + (ob ^ (((ob >> 9) & 1) << 5)); }
__host__ __device__ __forceinline__ void stage_rc(int b, int& R, int& C) { const int st = b / 1024, sb = b % 1024, swz = sb ^ (((sb >> 9) & 1) << 5); R = (st >> 1) * 16 + swz / 64; C = (st & 1) * 32 + (swz % 64) / 2; }

struct Unit { int pm, pn, e, lb, idx; };

template <int NM, int NN>
struct DenseOrder {
    static constexpr int nM = NM, nN = NN, nwg = NM * NN;
    int G, c; int K; int dup; int i0, i1;
    __device__ void init(int M, int N, int K_, int G_, int c_, int dup_ = 1) { (void)M; (void)N; G = G_; c = c_; K = K_; dup = dup_; i0 = 0; i1 = 1 << 30; }
    __device__ __forceinline__ bool next(int i_, Unit& u) const {
        const int i = i_ + i0; if (i >= i1) return false;
        const int L = i * G + c; if (L >= nwg * dup) return false;
        int wgid = L % nwg; { constexpr int q = nwg / NXCD, r = nwg % NXCD; const int xcd = wgid % NXCD, off = wgid / NXCD; wgid = (xcd < r ? xcd * (q + 1) : r * (q + 1) + (xcd - r) * q) + off; }
        static_assert(NM % WGM == 0, "row-tile groups are full");
        constexpr int nig = WGM * nN; const int gid = wgid / nig, fm = gid * WGM;
        u.pm = fm + ((wgid % nig) % WGM); u.pn = (wgid % nig) / WGM; u.e = 0; u.lb = 0; u.idx = i; return true;
    }
    __device__ __forceinline__ void aoffs(const Unit& u, unsigned (&ao)[2][2], const int (&R)[2], const int (&C)[2], int rowbytes) const {
#pragma unroll
        for (int h = 0; h < 2; ++h)
#pragma unroll
            for (int i = 0; i < 2; ++i) ao[h][i] = (unsigned)((u.pm * BM + h * HALF + R[i]) * rowbytes + C[i] * 2);
    }
};

typedef int v8i32 __attribute__((ext_vector_type(8)));
typedef int v4i32 __attribute__((ext_vector_type(4)));
template <class Epi, class Sched, bool ALIGN_EPI, bool SP2, int ES>
__device__ __forceinline__ void gemm_phase(LAS unsigned char* lds, const void* Abase, const void* Btbase, const int K, const Sched& S, const Epi& E) {
    const int tid = threadIdx.x, wid = __builtin_amdgcn_readfirstlane(tid >> 6), lane = tid & 63, wr = wid >> 2, wc = wid & 3, fr = lane & 15, fq = lane >> 4;
    const int rowbytes = K * ES;
    const int nt = rowbytes / 128;
    int RR[2], CC[2]; unsigned voffB[2];
#pragma unroll
    for (int i = 0; i < 2; ++i) { stage_rc(tid * 16 + i * 8192, RR[i], CC[i]); voffB[i] = (unsigned)(RR[i] * rowbytes + CC[i] * 2); }
    const size_t kstep = (size_t)128;
    const size_t hstep = (size_t)HALF * rowbytes;
    const size_t tstep = 2 * hstep;
    const unsigned ldsw = (unsigned)wid * 1024u;
    const int aoff = lds_byte(wr * 64 + fr, fq * 8), boff = lds_byte(wc * 32 + fr, fq * 8);
    const char* Ab = (const char*)Abase;
#define PG8_SA(b, h) (((b) * 2 + (h)) * HTB)
#define PG8_SB(b, h) ((4 + (b) * 2 + (h)) * HTB)
#define PG8_STAGE(bufoff, gbase, voff) do { _Pragma("unroll") for (int _i = 0; _i < 2; ++_i) \
        __builtin_amdgcn_global_load_lds((const unsigned*)((const char*)(gbase) + (voff)[_i]), (LAS unsigned*)(lds + (bufoff) + ldsw + _i * 8192), 16, 0, 0); } while (0)
#define PG8_STAGE_A(bufoff, kb, AO, h) do { _Pragma("unroll") for (int _i = 0; _i < 2; ++_i) \
        __builtin_amdgcn_global_load_lds((const unsigned*)(Ab + (kb) + (AO)[h][_i]), (LAS unsigned*)(lds + (bufoff) + ldsw + _i * 8192), 16, 0, 0); } while (0)
#define PG8_LDA(dst, b, h) do { _Pragma("unroll") for (int m = 0; m < 4; ++m) _Pragma("unroll") for (int k = 0; k < 2; ++k) dst[m][k] = *(const LAS bf16x8*)(lds + PG8_SA(b, h) + aoff + m * 2048 + k * 1024); } while (0)
#define PG8_LDB(dst, b, h) do { _Pragma("unroll") for (int n = 0; n < 2; ++n) _Pragma("unroll") for (int k = 0; k < 2; ++k) dst[n][k] = *(const LAS bf16x8*)(lds + PG8_SB(b, h) + boff + n * 2048 + k * 1024); } while (0)
#define PG8_F8(x) __builtin_shufflevector(__builtin_bit_cast(v4i32, (x)[0]), __builtin_bit_cast(v4i32, (x)[1]), 0, 1, 2, 3, 4, 5, 6, 7)
#define PG8_MMA(ai, bj, At, Bt) do { __builtin_amdgcn_s_setprio(1); _Pragma("unroll") for (int m = 0; m < 4; ++m) _Pragma("unroll") for (int n = 0; n < 2; ++n) { \
        if constexpr (ES == 2) { _Pragma("unroll") for (int k = 0; k < 2; ++k) acc[ai][bj][m][n] = __builtin_amdgcn_mfma_f32_16x16x32_bf16(Bt[n][k], At[m][k], acc[ai][bj][m][n], 0, 0, 0); } \
        else asm volatile("v_mfma_f32_16x16x128_f8f6f4 %0, %1, %2, %0" : "+v"(acc[ai][bj][m][n]) : "v"(PG8_F8(Bt[n])), "v"(PG8_F8(At[m]))); } \
        __builtin_amdgcn_s_setprio(0); } while (0)
#define PG8_WAIT_V(n) asm volatile("s_waitcnt vmcnt(" #n ")" ::: "memory")
#define PG8_WAIT_L(n) asm volatile("s_waitcnt lgkmcnt(" #n ")" ::: "memory")
#define PG8_BAR __builtin_amdgcn_s_barrier()
#define PG8_SCHED __builtin_amdgcn_sched_barrier(0)
    Unit cur, nxt; int ui = 0;
    if (!S.next(0, cur)) return;
    f32x4 acc[2][2][4][2];
#define PG8_ZERO() do { _Pragma("unroll") for (int a = 0; a < 2; ++a) _Pragma("unroll") for (int b = 0; b < 2; ++b) _Pragma("unroll") for (int m = 0; m < 4; ++m) _Pragma("unroll") for (int n = 0; n < 2; ++n) { \
        f32x2 z0_, z1_; asm volatile("v_mov_b64 %0, 0" : "=v"(z0_)); asm volatile("v_mov_b64 %0, 0" : "=v"(z1_)); acc[a][b][m][n] = (f32x4){z0_.x, z0_.y, z1_.x, z1_.y}; } } while (0)
    PG8_ZERO();
    bf16x8 At[4][2], B0[2][2], B1[2][2];
    unsigned aoC[2][2], aoN[2][2];
    S.aoffs(cur, aoC, RR, CC, rowbytes);
    const char* cB = (const char*)Btbase + (size_t)cur.pn * tstep;
    static_assert(SP2, "only the SP2 loop is kept");
    PG8_STAGE(PG8_SB(0, 0), cB, voffB); PG8_STAGE(PG8_SB(0, 1), cB + hstep, voffB); PG8_STAGE_A(PG8_SA(0, 0), 0, aoC, 0); PG8_STAGE_A(PG8_SA(0, 1), 0, aoC, 1);
    if (wr == 1) PG8_BAR;
    PG8_WAIT_V(2); PG8_BAR;
    PG8_STAGE(PG8_SB(1, 0), cB + kstep, voffB); PG8_STAGE_A(PG8_SA(1, 0), kstep, aoC, 0); PG8_STAGE(PG8_SB(1, 1), cB + hstep + kstep, voffB);
    PG8_WAIT_V(6); PG8_BAR;
    for (;;) {
        const bool has_next = S.next(ui + 1, nxt);
        if (has_next) S.aoffs(nxt, aoN, RR, CC, rowbytes);
        else {
#pragma unroll
            for (int h = 0; h < 2; ++h)
#pragma unroll
                for (int i = 0; i < 2; ++i) aoN[h][i] = aoC[h][i];
        }
        const char* nB = has_next ? (const char*)Btbase + (size_t)nxt.pn * tstep : cB;
#pragma unroll 1
        for (int t = 0; t < nt; t += 2) {
            const bool last = (t == nt - 2);
            const size_t kb1 = (size_t)(t + 1) * kstep;
            const size_t kb2 = last ? 0 : (size_t)(t + 2) * kstep, kb3 = kb2 + kstep;
            unsigned ao2[2][2];
#pragma unroll
            for (int h = 0; h < 2; ++h)
#pragma unroll
                for (int i = 0; i < 2; ++i) ao2[h][i] = last ? aoN[h][i] : aoC[h][i];
            const char* b2 = last ? nB : cB + (size_t)(t + 2) * kstep;
            const char* b3 = b2 + kstep;
            PG8_LDB(B0, 0, 0); PG8_LDB(B1, 0, 1); PG8_SCHED; PG8_LDA(At, 0, 0); PG8_STAGE_A(PG8_SA(1, 1), kb1, aoC, 1);
            PG8_WAIT_V(8); PG8_WAIT_L(0); PG8_BAR; PG8_MMA(0, 0, At, B0); PG8_MMA(0, 1, At, B1); PG8_BAR; PG8_SCHED;
            PG8_LDA(At, 0, 1); PG8_STAGE(PG8_SB(0, 0), b2, voffB); PG8_STAGE(PG8_SB(0, 1), b2 + hstep, voffB); PG8_STAGE_A(PG8_SA(0, 0), kb2, ao2, 0);
            PG8_WAIT_V(8); PG8_WAIT_L(0); PG8_BAR; PG8_MMA(1, 0, At, B0); PG8_MMA(1, 1, At, B1); PG8_BAR; PG8_SCHED;
            PG8_LDB(B0, 1, 0); PG8_LDB(B1, 1, 1); PG8_SCHED; PG8_LDA(At, 1, 0); PG8_STAGE_A(PG8_SA(0, 1), kb2, ao2, 1);
            PG8_WAIT_V(8); PG8_WAIT_L(0); PG8_BAR; PG8_MMA(0, 0, At, B0); PG8_MMA(0, 1, At, B1); PG8_BAR; PG8_SCHED;
            PG8_LDA(At, 1, 1); PG8_STAGE(PG8_SB(1, 0), b3, voffB); PG8_STAGE(PG8_SB(1, 1), b3 + hstep, voffB); PG8_STAGE_A(PG8_SA(1, 0), kb3, ao2, 0);
            PG8_WAIT_V(8); PG8_WAIT_L(0); PG8_BAR; PG8_MMA(1, 0, At, B0); PG8_MMA(1, 1, At, B1); PG8_BAR; PG8_SCHED;
        }
        if constexpr (ALIGN_EPI) { if (wr == 0) PG8_BAR; }
        if constexpr (ES == 1) asm volatile("s_nop 15\n\ts_nop 15" ::: "memory");
        E(acc, cur, wr, wc, fr, fq);
        if (!has_next) break;
        PG8_ZERO();
        cur = nxt; cB = nB; ++ui;
#pragma unroll
        for (int h = 0; h < 2; ++h)
#pragma unroll
            for (int i = 0; i < 2; ++i) aoC[h][i] = aoN[h][i];
        if constexpr (ALIGN_EPI) { if (wr == 1) PG8_BAR; }
    }
    PG8_WAIT_V(0);
    if constexpr (!ALIGN_EPI) { if (wr == 0) PG8_BAR; }
    PG8_BAR;
#undef PG8_ZERO
#undef PG8_SA
#undef PG8_SB
#undef PG8_STAGE
#undef PG8_STAGE_A
#undef PG8_LDA
#undef PG8_LDB
#undef PG8_MMA
#undef PG8_F8
#undef PG8_WAIT_V
#undef PG8_WAIT_L
#undef PG8_BAR
#undef PG8_SCHED
}
}


__device__ __forceinline__ int perm32_pos(int t) { return 16 * ((t >> 2) & 1) + 4 * ((t >> 3) & 3) + (t & 3); }
__device__ __forceinline__ int pos_inproj(int c) {
    if (c < 1024) { const int hc = c & 127; return (c & ~127) | (32 * ((hc >> 4) & 3) + 16 * (hc >> 6) + (hc & 15)); }
    return (c & ~31) | perm32_pos(c & 31);
}
__device__ __forceinline__ int pos_plain(int c) { return (c & ~31) | perm32_pos(c & 31); }
__device__ __forceinline__ int pos_wide(int c) { const int t = c & 255; return (c & ~255) | (128 * ((t >> 3) & 1) + 32 * (t >> 6) + 16 * ((t >> 2) & 1) + 4 * ((t >> 4) & 3) + (t & 3)); }
__device__ __forceinline__ int pos_w1(int n) { const int jj = n & 1023, lin = n >> 10, pn = jj >> 7, tp = jj & 127; return pn * 256 + lin * 128 + ((tp & ~31) | perm32_pos(tp & 31)); }

struct EpiInProj {
    unsigned char* proj; const float* ropec; const float* ropes; unsigned* ctl;
    __device__ __forceinline__ void operator()(const f32x4 (&acc)[2][2][4][2], const pg8::Unit& u, int wr, int wc, int fr, int fq) const {
        const int type = u.pn >> 1; bf16_t* base = (bf16_t*)(proj + (size_t)type * PROJ_STRIDE);
        const int colh = (u.pn & 1) * 256;
        if (type < 2) {
            const float sc = (type == 1) ? 0.08838834764831845f : 1.0f;
            const int i0 = 16 * wc + 4 * fq;
#pragma unroll
            for (int ai = 0; ai < 2; ++ai)
#pragma unroll
                for (int m = 0; m < 4; ++m) {
                    const int row = u.pm * 256 + ai * 128 + wr * 64 + m * 16 + fr; const int pos = row & (SEQ - 1);
                    const f32x4 cs = *(const f32x4*)(ropec + pos * 64 + i0), sn = *(const f32x4*)(ropes + pos * 64 + i0);
#pragma unroll
                    for (int bj = 0; bj < 2; ++bj) {
                        const f32x4 x1 = acc[ai][bj][m][0], x2 = acc[ai][bj][m][1];
                        const f32x4 o1 = (x1 * cs - x2 * sn) * sc, o2 = (x1 * sn + x2 * cs) * sc;
                        bf16_t* dst = base + (size_t)row * 512 + colh + bj * 128 + i0;
                        u32x2 w1, w2; w1.x = cvtpk(o1[0], o1[1]); w1.y = cvtpk(o1[2], o1[3]); w2.x = cvtpk(o2[0], o2[1]); w2.y = cvtpk(o2[2], o2[3]);
                        *(u32x2*)dst = w1; *(u32x2*)(dst + 64) = w2;
                    }
                }
        } else {
            const float sc = (type == 4) ? C2 : 1.0f;
            float mx[2] = {0.f, 0.f};
#pragma unroll
            for (int ai = 0; ai < 2; ++ai)
#pragma unroll
                for (int m = 0; m < 4; ++m) {
                    const int row = u.pm * 256 + ai * 128 + wr * 64 + m * 16 + fr;
#pragma unroll
                    for (int bj = 0; bj < 2; ++bj) {
                        f32x4 v0 = acc[ai][bj][m][0] * sc, v1 = acc[ai][bj][m][1] * sc;
                        if (type == 4 || type == 5) { float ssq = (v0[0] * v0[0] + v0[1] * v0[1]) + (v0[2] * v0[2] + v0[3] * v0[3]) + (v1[0] * v1[0] + v1[1] * v1[1]) + (v1[2] * v1[2] + v1[3] * v1[3]);
                            ssq += __shfl_xor(ssq, 16); ssq += __shfl_xor(ssq, 32); mx[bj] = fmaxf(mx[bj], ssq); }
                        if (type == 3) {
#pragma unroll
                            for (int j = 0; j < 4; ++j) { v0[j] = v0[j] * __builtin_amdgcn_rcpf(1.0f + __builtin_amdgcn_exp2f(-LOG2E * v0[j])); v1[j] = v1[j] * __builtin_amdgcn_rcpf(1.0f + __builtin_amdgcn_exp2f(-LOG2E * v1[j])); }
                        }
                        u32x4 w; w.x = cvtpk(v0[0], v0[1]); w.y = cvtpk(v0[2], v0[3]); w.z = cvtpk(v1[0], v1[1]); w.w = cvtpk(v1[2], v1[3]);
                        __builtin_nontemporal_store(w, (u32x4*)(base + (size_t)row * 512 + colh + bj * 128 + wc * 32 + 8 * fq));
                    }
                }
            if (type == 4 || type == 5) {
#pragma unroll
                for (int bj = 0; bj < 2; ++bj) { float v = mx[bj]; v = fmaxf(v, __shfl_xor(v, 1)); v = fmaxf(v, __shfl_xor(v, 2)); v = fmaxf(v, __shfl_xor(v, 4)); v = fmaxf(v, __shfl_xor(v, 8));
                    if ((threadIdx.x & 63) == 0) { const int bh = (u.pm >> 5) * 8 + (u.pn & 1) * 4 + bj * 2 + (wc >> 1);
                        atomicMax(ctl + ((type == 4) ? CW_QN2 : CW_KN2) + bh * 2 + (wc & 1), __float_as_uint(v)); } }
            }
        }
    }
};

__device__ __forceinline__ unsigned pk4_fp8(float a, float b, float c, float d) { int w = 0; w = __builtin_amdgcn_cvt_pk_fp8_f32(a, b, w, false); w = __builtin_amdgcn_cvt_pk_fp8_f32(c, d, w, true); return (unsigned)w; }
struct EpiOutProj {
    const bf16_t* U; const float* irs1; const float* g_mix; bf16_t* h1b; unsigned char* h1f8;
    __device__ __forceinline__ void operator()(const f32x4 (&acc)[2][2][4][2], const pg8::Unit& u, int wr, int wc, int fr, int fq) const {
        const int col = u.pn * 256 + 64 * wc + 16 * fq;
        f32x4 gi[2][2];
#pragma unroll
        for (int q = 0; q < 4; ++q) { f32x4 g = *(const f32x4*)(g_mix + col + 4 * q);
#pragma unroll
            for (int j = 0; j < 4; ++j) g[j] = __builtin_amdgcn_rcpf(g[j]);
            gi[q >> 1][q & 1] = g; }
#pragma unroll
        for (int ai = 0; ai < 2; ++ai) {
            u32x4 uw[4][2]; float ir[4];
#pragma unroll
            for (int m = 0; m < 4; ++m) { const int row = u.pm * 256 + ai * 128 + wr * 64 + m * 16 + fr; ir[m] = irs1[row];
                uw[m][0] = *(const u32x4*)(U + (size_t)row * DM + col); uw[m][1] = *(const u32x4*)(U + (size_t)row * DM + col + 8); }
#pragma unroll
            for (int m = 0; m < 4; ++m) {
                const int row = u.pm * 256 + ai * 128 + wr * 64 + m * 16 + fr; const float s = ir[m]; u32x4 wf8;
#pragma unroll
                for (int bj = 0; bj < 2; ++bj) { const u32x4 w4 = uw[m][bj];
                    const f32x4 xa = {bflo(w4.x), bfhi(w4.x), bflo(w4.y), bfhi(w4.y)}, xb = {bflo(w4.z), bfhi(w4.z), bflo(w4.w), bfhi(w4.w)};
                    const f32x4 v0 = acc[ai][bj][m][0] * (1.0f / (MIX_SCALE * W_SCALE)) + xa * gi[bj][0] * s, v1 = acc[ai][bj][m][1] * (1.0f / (MIX_SCALE * W_SCALE)) + xb * gi[bj][1] * s;
                    u32x4 w; w.x = cvtpk(v0[0], v0[1]); w.y = cvtpk(v0[2], v0[3]); w.z = cvtpk(v1[0], v1[1]); w.w = cvtpk(v1[2], v1[3]);
                    *(u32x4*)(h1b + (size_t)row * DM + col + 8 * bj) = w;
                    wf8[2 * bj] = pk4_fp8(v0[0], v0[1], v0[2], v0[3]); wf8[2 * bj + 1] = pk4_fp8(v1[0], v1[1], v1[2], v1[3]); }
                *(u32x4*)(h1f8 + (size_t)row * DM + col) = wf8;
            }
            asm volatile("" ::: "memory");
        }
    }
};

struct EpiMoe1 {
    unsigned char* H; const LAS unsigned* tokr; const LAS bf16_t* biasl;
    __device__ __forceinline__ void operator()(const f32x4 (&acc)[2][2][4][2], const pg8::Unit& u, int wr, int wc, int fr, int fq) const {
        const int e = u.e, pnl = u.pn - e * 8; const int cl = wc * 32 + 8 * fq, cq = pnl * 128 + cl;
        const u32x4 bgw = *(const LAS u32x4*)(biasl + u.idx * 256 + cl), blw = *(const LAS u32x4*)(biasl + u.idx * 256 + 128 + cl);
        constexpr float K1 = 1.702f * LOG2E;
        const f32x4 bg0 = (f32x4){bflo(bgw.x), bfhi(bgw.x), bflo(bgw.y), bfhi(bgw.y)} * K1, bg1 = (f32x4){bflo(bgw.z), bfhi(bgw.z), bflo(bgw.w), bfhi(bgw.w)} * K1;
        const f32x4 bl0 = {bflo(blw.x), bfhi(blw.x), bflo(blw.y), bfhi(blw.y)}, bl1 = {bflo(blw.z), bfhi(blw.z), bflo(blw.w), bfhi(blw.w)};
#pragma unroll
        for (int ai = 0; ai < 2; ++ai)
#pragma unroll
            for (int m = 0; m < 4; ++m) {
                const int rt = ai * 128 + wr * 64 + m * 16 + fr;
                const float rs = bfhi(tokr[u.idx * 256 + rt]) * (1.0f / W_SCALE);
                const float rk = rs * K1; float o[8];
                const f32x2 rk2 = {rk, rk}, rs2 = {rs, rs}, hk2 = {H_SCALE / K1, H_SCALE / K1}, one2 = {1.0f, 1.0f};
#pragma unroll
                for (int hh = 0; hh < 2; ++hh)
#pragma unroll
                    for (int jp = 0; jp < 2; ++jp) {
                        const f32x4 ag = acc[ai][0][m][hh], al = acc[ai][1][m][hh], bgv = hh ? bg1 : bg0, blv = hh ? bl1 : bl0;
                        const f32x2 ag2 = {ag[2 * jp], ag[2 * jp + 1]}, al2 = {al[2 * jp], al[2 * jp + 1]}, bg2 = {bgv[2 * jp], bgv[2 * jp + 1]}, bl2 = {blv[2 * jp], blv[2 * jp + 1]};
                        f32x2 gk = __builtin_elementwise_fma(ag2, rk2, bg2);
                        gk.x = __builtin_fminf(gk.x, 7.0f * K1); gk.y = __builtin_fminf(gk.y, 7.0f * K1);
                        f32x2 ex = {__builtin_amdgcn_exp2f(-gk.x), __builtin_amdgcn_exp2f(-gk.y)};
                        ex = ex + one2;
                        const f32x2 rc = {__builtin_amdgcn_rcpf(ex.x), __builtin_amdgcn_rcpf(ex.y)};
                        const f32x2 sg = gk * rc;
                        f32x2 l = __builtin_elementwise_fma(al2, rs2, bl2);
                        l.x = __builtin_fminf(__builtin_fmaxf(l.x, -7.0f), 7.0f); l.y = __builtin_fminf(__builtin_fmaxf(l.y, -7.0f), 7.0f);
                        const f32x2 ov = sg * __builtin_elementwise_fma(l, hk2, hk2);
                        o[4 * hh + 2 * jp] = ov.x; o[4 * hh + 2 * jp + 1] = ov.y;
                    }
                u32x2 w; w.x = pk4_fp8(o[0], o[1], o[2], o[3]); w.y = pk4_fp8(o[4], o[5], o[6], o[7]);
                *(u32x2*)(H + (size_t)(u.pm * 256 + rt) * DFF + cq) = w;
            }
    }
};

struct EpiNull { float* sink;
    __device__ __forceinline__ void operator()(const f32x4 (&acc)[2][2][4][2], const pg8::Unit& u, int wr, int wc, int fr, int fq) const {
        float s = 0.f;
#pragma unroll
        for (int ai = 0; ai < 2; ++ai)
#pragma unroll
            for (int bj = 0; bj < 2; ++bj)
#pragma unroll
                for (int m = 0; m < 4; ++m)
#pragma unroll
                    for (int n = 0; n < 2; ++n) s += acc[ai][bj][m][n][0];
        if (s == 123.456f) sink[0] = s;
    }
};
struct EpiMoe2 {
    unsigned char* Y; const LAS bf16_t* biasl;
    __device__ __forceinline__ void operator()(const f32x4 (&acc)[2][2][4][2], const pg8::Unit& u, int wr, int wc, int fr, int fq) const {
        const int e = u.e, pnl = u.pn - e * 4; const int cl = 64 * wc + 16 * fq, col = pnl * 256 + cl;
        const u32x4 bw0 = *(const LAS u32x4*)(biasl + u.idx * 256 + cl), bw1 = *(const LAS u32x4*)(biasl + u.idx * 256 + cl + 8);
        f32x4 bb[2][2];
        bb[0][0] = (f32x4){bflo(bw0.x), bfhi(bw0.x), bflo(bw0.y), bfhi(bw0.y)} * Y_SCALE; bb[0][1] = (f32x4){bflo(bw0.z), bfhi(bw0.z), bflo(bw0.w), bfhi(bw0.w)} * Y_SCALE;
        bb[1][0] = (f32x4){bflo(bw1.x), bfhi(bw1.x), bflo(bw1.y), bfhi(bw1.y)} * Y_SCALE; bb[1][1] = (f32x4){bflo(bw1.z), bfhi(bw1.z), bflo(bw1.w), bfhi(bw1.w)} * Y_SCALE;
#pragma unroll
        for (int ai = 0; ai < 2; ++ai)
#pragma unroll
            for (int m = 0; m < 4; ++m) {
                const int rt = ai * 128 + wr * 64 + m * 16 + fr; u32x4 w;
#pragma unroll
                for (int bj = 0; bj < 2; ++bj) { const f32x4 v0 = acc[ai][bj][m][0] * (Y_SCALE / (W_SCALE * H_SCALE)) + bb[bj][0], v1 = acc[ai][bj][m][1] * (Y_SCALE / (W_SCALE * H_SCALE)) + bb[bj][1];
                    w[2 * bj] = pk4_fp8(v0[0], v0[1], v0[2], v0[3]); w[2 * bj + 1] = pk4_fp8(v1[0], v1[1], v1[2], v1[3]); }
                *(u32x4*)(Y + (size_t)(u.pm * 256 + rt) * DM + col) = w;
            }
    }
};

template <int NT, bool GATHER>
struct MoeOrder {
    const LAS int* boff;
    const LAS int* cntl;
    const LAS unsigned* tokl;
    int G, vcu;
    __device__ __forceinline__ bool next(int i, pg8::Unit& u) const {
        int x, j, rpb;
        if (G == 256) { x = vcu >> 5; j = vcu & 31; rpb = 32 / NT; }
        else { const int cpx = G >> 3; x = vcu / cpx; j = vcu % cpx; rpb = cpx / NT; }
        const int rb = (i * 8 + x) * rpb + j / NT; const int nb = boff[32];
        if (rb >= nb) return false;
        const int bk = boff[__lane_id() & 31]; const int e = __builtin_popcount((unsigned)__ballot(bk <= rb)) - 1;
        u.pm = rb; u.e = e; u.lb = rb - boff[e]; u.pn = e * NT + (j % NT); u.idx = i; return true;
    }
    __device__ __forceinline__ void aoffs(const pg8::Unit& u, unsigned (&ao)[2][2], const int (&R)[2], const int (&C)[2], int rowbytes) const {
#pragma unroll
        for (int h = 0; h < 2; ++h)
#pragma unroll
            for (int i = 0; i < 2; ++i) {
                if constexpr (GATHER) {
                    const int tok = (int)(tokl[u.idx * 256 + h * 128 + R[i]] & 0xffffu);
                    ao[h][i] = (unsigned)(tok * rowbytes + C[i] * 2);
                } else ao[h][i] = (unsigned)((u.pm * 256 + h * 128 + R[i]) * rowbytes + C[i] * 2);
            }
    }
};

namespace attn_body {
constexpr int NHEAD = FH, D = 64, PQ = 512, PO = 1024;
constexpr int NW = 8, QBLK = 32, QB = QBLK * NW, KVBLK = 64, NQB = SEQ / QB;
__device__ __forceinline__ int crow(int r, int hi) { return (r & 3) + 8 * (r >> 2) + 4 * hi; }
#define SBAR() __builtin_amdgcn_sched_barrier(0)
__device__ __forceinline__ void cmask(f32x16& p0, f32x16& p1, int jb, int qrel, int hi) {
    const float NEG = -INFINITY; int kb = 64 * jb + 4 * hi;
#pragma unroll
    for (int r = 0; r < 16; ++r) { int kv = kb + (r & 3) + 8 * (r >> 2); if (kv > qrel) p0[r] = NEG; if (kv + 32 > qrel) p1[r] = NEG; }
}
constexpr int NSLOT = 3, SLOTB = 8192;
constexpr int LDS_K = 0, LDS_V = NSLOT * SLOTB, LDS_WS = 2 * NSLOT * SLOTB, LDS_OST = LDS_WS + NW * 64 * 4, LDS_END = LDS_OST + NW * 4096;
constexpr int LDS_STOP = 156672;
constexpr int LDS_QUEUE = 151552;
constexpr int LDS_F = 86016, LDS_F_BYTES = SEQ * 8;
static_assert(LDS_F >= LDS_END + 512 && LDS_F + LDS_F_BYTES <= LDS_QUEUE && LDS_QUEUE + 4608 <= LDS_STOP && LDS_STOP + 32 <= LDS_BYTES - 16, "attention LDS map");
__device__ __forceinline__ void glds16(const void* gsrc, unsigned lds_dst) { unsigned keep;
    asm volatile("s_mov_b32 %0, m0\n\ts_mov_b32 m0, %2\n\ts_nop 0\n\tglobal_load_lds_dwordx4 %1, off\n\ts_mov_b32 m0, %0" : "=&s"(keep) : "v"(gsrc), "s"(lds_dst) : "memory"); }
__device__ __forceinline__ float max3f(float a, float b, float c) { float r; asm("v_max3_f32 %0, %1, %2, %3" : "=v"(r) : "v"(a), "v"(b), "v"(c)); return r; }
__device__ __forceinline__ float max2f(float a, float b) { float r; asm("v_max_f32_e32 %0, %1, %2" : "=v"(r) : "v"(a), "v"(b)); return r; }
__device__ __forceinline__ float fadd_s(float a, float b) { float r; asm("v_add_f32_e32 %0, %1, %2" : "=v"(r) : "v"(a), "v"(b)); return r; }
__device__ __forceinline__ float fsub_s(float a, float b) { float r; asm("v_sub_f32_e32 %0, %1, %2" : "=v"(r) : "v"(a), "v"(b)); return r; }
#define WAIT_BAR(N) asm volatile("s_waitcnt vmcnt(" #N ") lgkmcnt(0)\n\ts_barrier" ::: "memory")

typedef LAS const char* lds_cptr;
typedef short v4i16_t __attribute__((ext_vector_type(4)));
__device__ __forceinline__ void kload8(bf16x8* kf, lds_cptr kp) {
    kf[0] = *(const LAS bf16x8*)(kp);        kf[1] = *(const LAS bf16x8*)(kp + 512);
    kf[2] = *(const LAS bf16x8*)(kp + 2048); kf[3] = *(const LAS bf16x8*)(kp + 2560);
    kf[4] = *(const LAS bf16x8*)(kp + 4096); kf[5] = *(const LAS bf16x8*)(kp + 4608);
    kf[6] = *(const LAS bf16x8*)(kp + 6144); kf[7] = *(const LAS bf16x8*)(kp + 6656);
}
__device__ __forceinline__ void kload2(bf16x8* kf, lds_cptr kp, int j) { kf[2 * j] = *(const LAS bf16x8*)(kp + j * 2048); kf[2 * j + 1] = *(const LAS bf16x8*)(kp + j * 2048 + 512); }
__device__ __forceinline__ s16x4 vtr(lds_cptr p) { return __builtin_bit_cast(s16x4, __builtin_amdgcn_ds_read_tr16_b64_v4i16((LAS v4i16_t*)p)); }
__device__ __forceinline__ float rowmax(const f32x16& p0, const f32x16& p1) {
    float a = max3f(p0[0], p0[1], p1[0]), b = max3f(p0[2], p0[3], p1[1]); a = max3f(a, p1[2], p1[3]);
#pragma unroll
    for (int r = 4; r < 16; r += 4) { a = max3f(a, p0[r], p0[r + 1]); b = max3f(b, p0[r + 2], p0[r + 3]); a = max3f(a, p1[r], p1[r + 1]); b = max3f(b, p1[r + 2], p1[r + 3]); }
    const float m = max2f(a, b);
    auto rr = __builtin_amdgcn_permlane32_swap(__float_as_uint(m), __float_as_uint(m), false, false);
    return max2f(__uint_as_float(rr[0]), __uint_as_float(rr[1]));
}
__device__ __forceinline__ void pv(f32x16* o, int vb, bf16x8 pa0, bf16x8 pa1, bf16x8 pa2, bf16x8 pa3) {
#pragma unroll
    for (int d0 = 0; d0 < 2; ++d0) { s16x4 lo[4], hi[4];
#pragma unroll
        for (int ks = 0; ks < 4; ++ks) {
            asm volatile("ds_read_b64_tr_b16 %0,%1 offset:%c2" : "=&v"(lo[ks]) : "v"(vb), "i"(d0 * 4096 + ks * 1024) : "memory");
            asm volatile("ds_read_b64_tr_b16 %0,%1 offset:%c2" : "=&v"(hi[ks]) : "v"(vb), "i"(d0 * 4096 + ks * 1024 + 512) : "memory"); }
        asm volatile("s_waitcnt lgkmcnt(0)" ::: "memory"); SBAR();
#define PK(k) (bf16x8){lo[k][0], lo[k][1], lo[k][2], lo[k][3], hi[k][0], hi[k][1], hi[k][2], hi[k][3]}
        o[d0] = __builtin_amdgcn_mfma_f32_32x32x16_bf16(pa0, PK(0), o[d0], 0, 0, 0);
        o[d0] = __builtin_amdgcn_mfma_f32_32x32x16_bf16(pa1, PK(1), o[d0], 0, 0, 0);
        o[d0] = __builtin_amdgcn_mfma_f32_32x32x16_bf16(pa2, PK(2), o[d0], 0, 0, 0);
        o[d0] = __builtin_amdgcn_mfma_f32_32x32x16_bf16(pa3, PK(3), o[d0], 0, 0, 0);
#undef PK
    }
}

template <int THRL> __device__ __forceinline__ int attn_unit(int b, int h, int qb, int ts, float kmaxc, const bf16_t* Q, const bf16_t* __restrict__ K, const bf16_t* __restrict__ V, unsigned char* O, const unsigned* __restrict__ FA, char* shm, unsigned* qhead, LAS int* qnext) {
    const int tid = threadIdx.x, lane = tid & 63, r32 = lane & 31, hi = lane >> 5; const int wid = __builtin_amdgcn_readfirstlane(tid >> 6);
    const long rowbase = (long)b * SEQ; const int q0 = qb * QB;
    const int NT0 = (q0 + QB) / KVBLK - ts, TL = NT0 - 1; int NT = NT0;
    const bf16_t* Qw = Q + (rowbase + q0 + wid * QBLK) * PQ + h * D;
    const bf16_t* Kh = K + (rowbase + (long)ts * KVBLK) * PQ + h * D, *Vh = V + (rowbase + (long)ts * KVBLK) * PQ + h * D;
    const unsigned lds0 = (unsigned)(uintptr_t)shm;
    float* wsf = (float*)(shm + LDS_WS) + wid * 64;
    { const u32x4* Fg = (const u32x4*)(FA + ((size_t)(b * NHEAD + h) * SEQ + (size_t)ts * KVBLK) * 2); LAS u32x4* Fl4 = (LAS u32x4*)((LAS char*)(lds_cptr)shm + LDS_F); const int n4 = (q0 + QB - ts * KVBLK) / 2;
      for (int p = tid; p < n4; p += NW * 64) Fl4[p] = Fg[p]; }
    const LAS u32x2* Fa = (const LAS u32x2*)((lds_cptr)shm + LDS_F);
#define FVAL(w) (-((bflo((w).x) + bfhi((w).x)) + bflo((w).y)))
    asm volatile("s_waitcnt vmcnt(0) lgkmcnt(0)" ::: "memory");
    const bf16_t* ksrc = Kh + (long)lane * PQ + wid * 8;
    const bf16_t* vsrc = Vh + (long)(16 * (wid & 3) + (lane >> 2)) * PQ + (wid >> 2) * 32 + (lane & 3) * 8;
    const unsigned kdst = lds0 + LDS_K + wid * 1024, vdst = lds0 + LDS_V + wid * 1024;
#define DMA_K(t, slot) glds16(ksrc + (long)(TL - (t)) * KVBLK * PQ, (unsigned)__builtin_amdgcn_readfirstlane(kdst + (slot)))
#define DMA_V(t, slot) glds16(vsrc + (long)(TL - (t)) * KVBLK * PQ, (unsigned)__builtin_amdgcn_readfirstlane(vdst + (slot)))
    const int vb0 = (int)(lds0 + LDS_V) + ((lane >> 4) & 1) * 32 + (lane & 3) * 8 + (4 * hi + ((lane & 15) >> 2)) * 64;
    bf16x8 kf[8];
    const lds_cptr shm3 = (lds_cptr)shm; const lds_cptr kp0 = shm3 + LDS_K + hi * 1024 + r32 * 16; const lds_cptr vp0 = shm3 + LDS_V + ((lane >> 4) & 1) * 32 + (lane & 3) * 8 + (4 * hi + ((lane & 15) >> 2)) * 64;
    DMA_K(0, 0); DMA_V(0, 0); DMA_K(1, SLOTB);
    bf16x8 qr[4];
#pragma unroll
    for (int d0 = 0; d0 < 4; ++d0) qr[d0] = *reinterpret_cast<const bf16x8*>(&Qw[(long)r32 * PQ + d0 * 16 + hi * 8]);
    float mhat = 0.f, l_reg = 0.f, nm = 0.f; f32x16 o[2]; o[0] = f32x16{}; o[1] = f32x16{};
    u32x2 ka0, ka1; u32x4 qa;
#define FLD(tt) do { const LAS u32x2* fp_ = Fa + 64 * (TL - (tt)) + r32; ka0 = fp_[0]; ka1 = fp_[32]; } while (0)
#define KAF(w) __builtin_bit_cast(bf16x8, (u32x4){(w).x, (w).y, 0x3f803f80u, 0u})
#define SETQA() do { const unsigned h_ = cvtpk(nm, 0.f) & 0xffffu; const float r1_ = nm - __uint_as_float(h_ << 16); const unsigned m_ = cvtpk(r1_, 0.f) & 0xffffu; \
      const float r2_ = r1_ - __uint_as_float(m_ << 16); const unsigned l_ = cvtpk(r2_, 0.f) & 0xffffu; \
      qa.x = hi ? 0u : 0x3f803f80u; qa.y = hi ? 0u : (0x3f80u | (h_ << 16)); qa.z = hi ? 0u : (m_ | (l_ << 16)); qa.w = 0u; } while (0)
#define CINIT(C0, C1) do { C0 = __builtin_amdgcn_mfma_f32_32x32x16_bf16(KAF(ka0), __builtin_bit_cast(bf16x8, qa), f32x16{}, 0, 0, 0); \
      C1 = __builtin_amdgcn_mfma_f32_32x32x16_bf16(KAF(ka1), __builtin_bit_cast(bf16x8, qa), f32x16{}, 0, 0, 0); } while (0)
    const int qrel = wid * QBLK + r32;
#define CMASK(P0, P1, t) do { int jb_ = 3 - (t); if (jb_ >= 0) cmask(P0, P1, jb_, qrel, hi); } while (0)
    bool resc = false;
#define START(P0, P1) do { const float rm = rowmax(P0, P1); resc = false; \
    if (__any(rm > (float)THRL)) { const float dl = __builtin_fmaxf(rm, 0.f); mhat += dl; \
      _Pragma("unroll") for (int r = 0; r < 16; ++r) { P0[r] -= dl; P1[r] -= dl; } \
      nm = -mhat; SETQA(); } \
    _Pragma("unroll") for (int r = 0; r < 16; ++r) P0[r] = __builtin_amdgcn_exp2f(P0[r]); } while (0)
#define RESC() do { if (resc) { asm volatile("s_waitcnt lgkmcnt(0)" ::: "memory"); \
      _Pragma("unroll") for (int d_ = 0; d_ < 2; ++d_) _Pragma("unroll") for (int r = 0; r < 16; ++r) o[d_][r] *= wsf[crow(r, hi)]; } } while (0)
    f32x16 pA0, pA1, pB0, pB1;
    int sl_prev = 0, sl_cur = 0, sl_next = SLOTB;
#define ROT() do { sl_prev = sl_cur; sl_cur = sl_next; sl_next = (sl_next == (NSLOT - 1) * SLOTB) ? 0 : sl_next + SLOTB; } while (0)
    DMA_K(2, 2 * SLOTB);
    float qkb;
    { float qn2 = 0.f;
#pragma unroll
      for (int d0 = 0; d0 < 4; ++d0)
#pragma unroll
          for (int j = 0; j < 8; ++j) { const float v = __uint_as_float((unsigned)(unsigned short)qr[d0][j] << 16); qn2 += v * v; }
      auto rr = __builtin_amdgcn_permlane32_swap(__float_as_uint(qn2), __float_as_uint(qn2), false, false); qn2 = __uint_as_float(rr[0]) + __uint_as_float(rr[1]);
      qkb = sqrtf(qn2) * kmaxc; }
    WAIT_BAR(3);
    { const u32x2 wo = Fa[64 * NT0 - QB + qrel]; const float fown = FVAL(wo); mhat = -fown - qkb; nm = -mhat; SETQA(); }
    FLD(0); CINIT(pA0, pA1);
    { const lds_cptr kb = shm3 + LDS_K + hi * 1024 + r32 * 16;
#pragma unroll
      for (int d0 = 0; d0 < 4; ++d0) { const bf16x8 b0 = *(const LAS bf16x8*)(kb + d0 * 2048); const bf16x8 b1 = *(const LAS bf16x8*)(kb + d0 * 2048 + 512);
          pA0 = __builtin_amdgcn_mfma_f32_32x32x16_bf16(b0, qr[d0], pA0, 0, 0, 0); pA1 = __builtin_amdgcn_mfma_f32_32x32x16_bf16(b1, qr[d0], pA1, 0, 0, 0); } }
    asm volatile("s_nop 15\n\ts_nop 7" : "+v"(pA0), "+v"(pA1)); CMASK(pA0, pA1, 0);
    START(pA0, pA1);
    _Pragma("unroll") for (int r = 0; r < 16; ++r) pA1[r] = __builtin_amdgcn_exp2f(pA1[r]);
    FLD(1);
    WAIT_BAR(0);
    DMA_K(3, 0); DMA_V(1, SLOTB);
    ROT();
    kload8(kf, kp0 + sl_cur);
    WAIT_BAR(2);
    s16x4 vlo[8], vhi[8]; u32x4 pw0, pw1, pw2, pw3;
#define PKW(P, B) cvtpk(P[B], P[B + 1])
#define PAF(k) __builtin_bit_cast(bf16x8, pw##k)
#define VFR(i) (bf16x8){vlo[i][0], vlo[i][1], vlo[i][2], vlo[i][3], vhi[i][0], vhi[i][1], vhi[i][2], vhi[i][3]}
#define PIN(x) asm volatile("" : "+v"(x))
#define MX3(a, b, c) __builtin_fmaxf(__builtin_fmaxf((a), (b)), (c))
#define GAPA(MF, A0, A1, A2, A3, W0, W1, PW) do { MF; sacc += A0; sacc += A1; sacc += A2; sacc += A3; PIN(sacc); W0; W1; PIN(PW); SBAR(); } while (0)
#define EX(v) __builtin_amdgcn_exp2f(v)
#define GAPB(MF, X, B) do { MF; X[B] = EX(X[B]); X[B + 1] = EX(X[B + 1]); X[B + 2] = EX(X[B + 2]); X[B + 3] = EX(X[B + 3]); PIN(X); SBAR(); } while (0)
#define VRD(i) do { vlo[i] = vtr(vp_ + (((i) >> 2) * 4096 + ((i) & 3) * 1024)); vhi[i] = vtr(vp_ + (((i) >> 2) * 4096 + ((i) & 3) * 1024 + 512)); } while (0)
#define KRD(G, j) do { if (G) { kload2(kf, kp0 + sl_next, j); SBAR(); } } while (0)
#define STEP(C0, C1, P0, P1, t, GK, GV, GL) do { SBAR(); \
    CINIT(C0, C1); SBAR(); \
    const lds_cptr vp_ = vp0 + sl_prev; \
    VRD(0); SBAR(); float sacc = (P0[0] + P0[1]); \
    GAPA(C0 = __builtin_amdgcn_mfma_f32_32x32x16_bf16(kf[0], qr[0], C0, 0, 0, 0), P0[2], P0[3], P0[4], P0[5],     pw0[0] = PKW(P0, 0), pw0[1] = PKW(P0, 2), pw0); \
    VRD(4); SBAR(); GAPA(C1 = __builtin_amdgcn_mfma_f32_32x32x16_bf16(kf[1], qr[0], C1, 0, 0, 0), P0[6], P0[7], P0[8], P0[9],     pw0[2] = PKW(P0, 4), pw0[3] = PKW(P0, 6), pw0); \
    VRD(1); SBAR(); GAPA(C0 = __builtin_amdgcn_mfma_f32_32x32x16_bf16(kf[2], qr[1], C0, 0, 0, 0),   P0[10], P0[11], P0[12], P0[13], pw1[0] = PKW(P0, 8), pw1[1] = PKW(P0, 10), pw1); \
    VRD(5); SBAR(); GAPA(C1 = __builtin_amdgcn_mfma_f32_32x32x16_bf16(kf[3], qr[1], C1, 0, 0, 0),   P0[14], P0[15], P1[0], P1[1],   pw1[2] = PKW(P0, 12), pw1[3] = PKW(P0, 14), pw1); \
    VRD(2); SBAR(); GAPA(C0 = __builtin_amdgcn_mfma_f32_32x32x16_bf16(kf[4], qr[2], C0, 0, 0, 0),   P1[2], P1[3], P1[4], P1[5],     pw2[0] = PKW(P1, 0), pw2[1] = PKW(P1, 2), pw2); \
    VRD(6); SBAR(); GAPA(C1 = __builtin_amdgcn_mfma_f32_32x32x16_bf16(kf[5], qr[2], C1, 0, 0, 0),   P1[6], P1[7], P1[8], P1[9],     pw2[2] = PKW(P1, 4), pw2[3] = PKW(P1, 6), pw2); \
    VRD(3); SBAR(); GAPA(C0 = __builtin_amdgcn_mfma_f32_32x32x16_bf16(kf[6], qr[3], C0, 0, 0, 0),   P1[10], P1[11], P1[12], P1[13], pw3[0] = PKW(P1, 8), pw3[1] = PKW(P1, 10), pw3); \
    VRD(7); SBAR(); GAPA(C1 = __builtin_amdgcn_mfma_f32_32x32x16_bf16(kf[7], qr[3], C1, 0, 0, 0),   P1[14], P1[15], 0.f, 0.f,       pw3[2] = PKW(P1, 12), pw3[3] = PKW(P1, 14), pw3); \
    l_reg += sacc; \
    if (GK) { DMA_K((t) + 3, sl_cur); } if (GV) { DMA_V((t) + 1, sl_next); } \
    CMASK(C0, C1, t); \
    { float a = MX3(C0[0], C0[1], C1[0]), b = MX3(C0[2], C0[3], C1[1]); a = MX3(a, C1[2], C1[3]); \
      _Pragma("unroll") for (int r = 4; r < 16; r += 4) { a = MX3(a, C0[r], C0[r + 1]); b = MX3(b, C0[r + 2], C0[r + 3]); a = MX3(a, C1[r], C1[r + 1]); b = MX3(b, C1[r + 2], C1[r + 3]); } \
      float rm = __builtin_fmaxf(a, b); { auto rr = __builtin_amdgcn_permlane32_swap(__float_as_uint(rm), __float_as_uint(rm), false, false); rm = __builtin_fmaxf(__uint_as_float(rr[0]), __uint_as_float(rr[1])); } \
      resc = false; \
      if (__builtin_expect(__any(rm > (float)THRL), 0)) { const float dl = __builtin_fmaxf(rm, 0.f); mhat += dl; \
        _Pragma("unroll") for (int r = 0; r < 16; ++r) { C0[r] -= dl; C1[r] -= dl; } \
        nm = -mhat; SETQA(); \
        const float f = __builtin_amdgcn_exp2f(-dl); l_reg *= f; if (hi == 0) wsf[r32] = f; resc = true; } } \
    SBAR(); \
    GAPB(o[0] = __builtin_amdgcn_mfma_f32_32x32x16_bf16(PAF(0), VFR(0), o[0], 0, 0, 0), C0, 0); \
    GAPB(o[1] = __builtin_amdgcn_mfma_f32_32x32x16_bf16(PAF(0), VFR(4), o[1], 0, 0, 0), C0, 4); \
    KRD(GL, 0); GAPB(o[0] = __builtin_amdgcn_mfma_f32_32x32x16_bf16(PAF(1), VFR(1), o[0], 0, 0, 0), C0, 8); \
    KRD(GL, 1); GAPB(o[1] = __builtin_amdgcn_mfma_f32_32x32x16_bf16(PAF(1), VFR(5), o[1], 0, 0, 0), C0, 12); \
    KRD(GL, 2); GAPB(o[0] = __builtin_amdgcn_mfma_f32_32x32x16_bf16(PAF(2), VFR(2), o[0], 0, 0, 0), C1, 0); \
    KRD(GL, 3); GAPB(o[1] = __builtin_amdgcn_mfma_f32_32x32x16_bf16(PAF(2), VFR(6), o[1], 0, 0, 0), C1, 4); \
    GAPB(o[0] = __builtin_amdgcn_mfma_f32_32x32x16_bf16(PAF(3), VFR(3), o[0], 0, 0, 0), C1, 8); \
    GAPB(o[1] = __builtin_amdgcn_mfma_f32_32x32x16_bf16(PAF(3), VFR(7), o[1], 0, 0, 0), C1, 12); \
    FLD((t) + 1); \
    } while (0)
    int t = 1;
#define ENDW(tt) do { if ((tt) + 3 < NT) { WAIT_BAR(2); } else if ((tt) + 2 < NT) { WAIT_BAR(1); } else { WAIT_BAR(0); } } while (0)
    LAS float* stopf = (LAS float*)((LAS char*)(lds_cptr)shm + LDS_STOP);
#pragma unroll 1
    for (int pass = 0; pass < 2; ++pass) {
        const int lim = (pass == 0) ? (NT < 5 ? NT : 5) : NT;
        for (; t + 1 < lim; t += 2) {
            STEP(pB0, pB1, pA0, pA1, t, (t + 3 < NT), (t + 1 < NT), (t + 1 < NT));       ENDW(t);   RESC(); ROT();
            STEP(pA0, pA1, pB0, pB1, t + 1, (t + 4 < NT), (t + 2 < NT), (t + 2 < NT));     ENDW(t + 1); RESC(); ROT();
        }
        if (pass == 0) {
#undef CMASK
#define CMASK(P0, P1, t) do { } while (0)
            for (; t + 5 < NT; t += 2) {
                STEP(pB0, pB1, pA0, pA1, t, true, true, true);     WAIT_BAR(2); RESC(); ROT();
                if ((t & 7) == 5) { float bv = qkb - mhat;
                    bv = __builtin_fmaxf(bv, dpp_mov<0xB1>(bv)); bv = __builtin_fmaxf(bv, dpp_mov<0x4E>(bv)); bv = __builtin_fmaxf(bv, dpp_mov<0x141>(bv)); bv = __builtin_fmaxf(bv, dpp_mov<0x140>(bv));
                    const float r0 = __int_as_float(__builtin_amdgcn_readlane(__float_as_int(bv), 0)), r1 = __int_as_float(__builtin_amdgcn_readlane(__float_as_int(bv), 16));
                    const float r2 = __int_as_float(__builtin_amdgcn_readlane(__float_as_int(bv), 32)), r3 = __int_as_float(__builtin_amdgcn_readlane(__float_as_int(bv), 48));
                    if (lane == 0) stopf[wid] = __builtin_fmaxf(__builtin_fmaxf(r0, r1), __builtin_fmaxf(r2, r3)); }
                STEP(pA0, pA1, pB0, pB1, t + 1, true, true, true);   WAIT_BAR(2); RESC(); ROT();
                if ((t & 7) == 5) { const f32x4 s0 = *(const LAS f32x4*)stopf, s1 = *(const LAS f32x4*)(stopf + 4);
                    const float thr = __builtin_fmaxf(__builtin_fmaxf(__builtin_fmaxf(s0[0], s0[1]), __builtin_fmaxf(s0[2], s0[3])), __builtin_fmaxf(__builtin_fmaxf(s1[0], s1[1]), __builtin_fmaxf(s1[2], s1[3]))) + PRUNE_TH;
                    const int pt = TL - 2 * (lane + 1);
                    const u32x2 wv = Fa[64 * (pt < 0 ? 0 : pt) + 63]; const float fv = FVAL(wv);
                    const unsigned long long mk = __ballot((pt < 0) || (fv >= thr));
                    int np = 2 * ((int)__builtin_ctzll(mk) + 1); np = np < t + 5 ? t + 5 : np;
                    if (np < NT) NT = np; }
            }
#undef CMASK
#define CMASK(P0, P1, t) do { int jb_ = 3 - (t); if (jb_ >= 0) cmask(P0, P1, jb_, qrel, hi); } while (0)
        }
    }
    STEP(pB0, pB1, pA0, pA1, NT - 1, false, false, false); RESC();
    { float sacc = pB0[0] + pB0[1]; _Pragma("unroll") for (int r = 2; r < 16; ++r) sacc += pB0[r]; _Pragma("unroll") for (int r = 0; r < 16; ++r) sacc += pB1[r]; l_reg += sacc;
      pw0 = (u32x4){PKW(pB0, 0), PKW(pB0, 2), PKW(pB0, 4), PKW(pB0, 6)}; pw1 = (u32x4){PKW(pB0, 8), PKW(pB0, 10), PKW(pB0, 12), PKW(pB0, 14)}; pw2 = (u32x4){PKW(pB1, 0), PKW(pB1, 2), PKW(pB1, 4), PKW(pB1, 6)}; pw3 = (u32x4){PKW(pB1, 8), PKW(pB1, 10), PKW(pB1, 12), PKW(pB1, 14)};
      SBAR(); pv(o, vb0 + sl_cur, PAF(0), PAF(1), PAF(2), PAF(3)); }
    unsigned nxq = 0u; if (tid == 0) nxq = atomicAdd(qhead, 1u);
#undef PKW
#undef PAF
#undef VFR
#undef PIN
#undef MX3
#undef GAPA
#undef GAPB
#undef EX
#undef VRD
#undef KRD
#undef STEP
#undef ENDW
    { auto rr = __builtin_amdgcn_permlane32_swap(__float_as_uint(l_reg), __float_as_uint(l_reg), false, false); l_reg = __uint_as_float(rr[0]) + __uint_as_float(rr[1]); }
    if (hi == 0) wsf[32 + r32] = l_reg; asm volatile("s_waitcnt lgkmcnt(0)" ::: "memory");
    float rli[16];
#pragma unroll
    for (int r = 0; r < 16; ++r) rli[r] = __builtin_amdgcn_rcpf(wsf[32 + crow(r, hi)]);
    unsigned char* Ow = O + (rowbase + q0 + wid * QBLK) * PO + h * D;
    { unsigned char* stg = (unsigned char*)(shm + LDS_OST) + wid * 2048;
#pragma unroll
      for (int r = 0; r < 16; ++r) { const int orow = crow(r, hi);
#pragma unroll
          for (int d0 = 0; d0 < 2; ++d0) { const float v = __builtin_fminf(__builtin_fmaxf(o[d0][r] * rli[r] * MIX_SCALE, -440.0f), 440.0f);
              stg[orow * 64 + d0 * 32 + r32] = (unsigned char)(__builtin_amdgcn_cvt_pk_fp8_f32(v, v, 0, false) & 0xff); } }
      asm volatile("s_waitcnt lgkmcnt(0)" ::: "memory");
#pragma unroll
      for (int i = 0; i < 2; ++i) { const int row = i * 16 + (lane >> 2), ch = lane & 3; const u32x4 v = *(const u32x4*)(stg + row * 64 + ch * 16); *(u32x4*)(Ow + (long)row * PO + ch * 16) = v; } }
    if (tid == 0) qnext[0] = (int)nxq;
    asm volatile("s_waitcnt lgkmcnt(0)\n\ts_barrier" ::: "memory");
    return NT;
#undef DMA_K
#undef DMA_V
#undef CMASK
#undef START
#undef RESC
#undef ROT
#undef FLD
#undef CINIT
#undef KAF
#undef SETQA
#undef FVAL
}
#undef SBAR
#undef WAIT_BAR
}

namespace ret {
constexpr int RS = 272;
constexpr int IMG_Q = 0, IMG_K = 64 * RS, IMG_KT = 2 * 64 * RS, IMG_V = 3 * 64 * RS;
constexpr int PS = 144;
constexpr int IMG_P = 4 * 64 * RS;
constexpr int IMG_ST = IMG_P + 64 * PS;
constexpr int OS = 132;
constexpr int IMG_O = IMG_ST + 128 * RS;
constexpr int LDS_END = IMG_O + 64 * OS * 4;
static_assert(LDS_END <= LDS_BYTES, "retention LDS map");
typedef short v4i16_t __attribute__((ext_vector_type(4)));
__device__ __forceinline__ s16x4 tr4(LAS const char* p) { return __builtin_bit_cast(s16x4, __builtin_amdgcn_ds_read_tr16_b64_v4i16((LAS v4i16_t*)p)); }
__device__ __forceinline__ bf16x8 frag_tr(LAS const char* img, int stride, int k0, int c0, int lane) {
    const int g4 = lane >> 4, i = lane & 15, qq = i >> 2, p = i & 3, hh = g4 >> 1, nh = g4 & 1;
    LAS const char* a = img + (k0 + 8 * hh + qq) * stride + (c0 + 16 * nh + 4 * p) * 2;
    const s16x4 lo = tr4(a), hi = tr4(a + 4 * stride);
    return (bf16x8){lo[0], lo[1], lo[2], lo[3], hi[0], hi[1], hi[2], hi[3]};
}
__device__ __forceinline__ bf16x8 frag_row(LAS const char* img, int stride, int r0, int k0, int lane) {
    return *(const LAS bf16x8*)(img + (r0 + (lane & 31)) * stride + (k0 + 8 * (lane >> 5)) * 2);
}
__device__ __forceinline__ int crow(int r, int hi) { return (r & 3) + 8 * (r >> 2) + 4 * hi; }

template <bool APPLY>
__device__ __forceinline__ void unit(int bh, int g, const bf16_t* RQ, const bf16_t* RK, const bf16_t* RV, const bf16_t* SG, float* GST, unsigned char* MIX, LAS char* lds) {
    int tid_ = threadIdx.x; asm volatile("" : "+v"(tid_));
    const int tid = tid_, lane = tid & 63, hi = lane >> 5; const int w = __builtin_amdgcn_readfirstlane(tid >> 6);
    const int b = bh >> 2, h = bh & 3;
    const float l2g = log2f(1.0f - exp2f(-5.0f - (float)h));
    const float cd = exp2f(64.0f * l2g);
    const size_t row0 = (size_t)b * SEQ + (size_t)g * 512;
    constexpr int NSET = APPLY ? 2 : 3;
    u32x4 rqs[APPLY ? 2 : 1][2], rks[NSET][2], rvs[NSET][2];
    auto issue = [&](int j, int s) {
#pragma unroll
        for (int i = 0; i < 2; ++i) { const int p = tid + 512 * i, row = p >> 4, ch = p & 15; const size_t off = (row0 + j * 64 + row) * 512 + h * 128 + ch * 8;
            if (APPLY) rqs[s & 1][i] = *(const u32x4*)(RQ + off);
            rks[s][i] = *(const u32x4*)(RK + off); rvs[s][i] = *(const u32x4*)(RV + off); }
    };
    const int db = w >> 1, eb0 = 2 * (w & 1);
    f32x16 S0 = f32x16{}, S1 = f32x16{};
    if (APPLY) {
        const float Gm = exp2f(512.0f * l2g);
        for (int gp0 = 0; gp0 < g; gp0 += 4) {
            f32x4 gv[4][8];
#pragma unroll
            for (int k = 0; k < 4; ++k) { const int gp = (gp0 + k < g) ? gp0 + k : g - 1; const f32x4* src = (const f32x4*)(GST + ((size_t)(bh * 16 + gp) * 8 + w) * 2048) + lane;
#pragma unroll
                for (int q = 0; q < 8; ++q) gv[k][q] = src[q * 64]; }
#pragma unroll
            for (int k = 0; k < 4; ++k) { const bool ok = gp0 + k < g; const float fm = ok ? Gm : 1.0f, am = ok ? 1.0f : 0.0f;
#pragma unroll
                for (int r = 0; r < 16; ++r) { S0[r] = S0[r] * fm + gv[k][r >> 2][r & 3] * am; S1[r] = S1[r] * fm + gv[k][4 + (r >> 2)][r & 3] * am; } }
        }
    }
    issue(0, 0); issue(1, 1); if (!APPLY) issue(2, 2 % NSET);
#pragma unroll (APPLY ? 2 : 8)
    for (int j = 0; j < 8; ++j) {
        const int cs = APPLY ? (j & 1) : j % 3; const u32x4 (&rk)[2] = rks[cs]; const u32x4 (&rv)[2] = rvs[cs]; const u32x4 (&rq)[2] = rqs[APPLY ? cs : 0];
#pragma unroll
        for (int i = 0; i < 2; ++i) { const int p = tid + 512 * i, row = p >> 4, ch = p & 15; const int o = row * RS + ch * 16;
            if (APPLY) { *(LAS u32x4*)(lds + IMG_Q + o) = rq[i]; *(LAS u32x4*)(lds + IMG_K + o) = rk[i]; }
            *(LAS u32x4*)(lds + IMG_V + o) = rv[i];
            const float kw = exp2f((float)(63 - row) * l2g);
            u32x4 kt;
#pragma unroll
            for (int e = 0; e < 4; ++e) kt[e] = cvtpk(bflo(rk[i][e]) * kw, bfhi(rk[i][e]) * kw);
            *(LAS u32x4*)(lds + IMG_KT + o) = kt; }
        if (APPLY) {
#pragma unroll
            for (int tile = 0; tile < 2; ++tile) { const f32x16& S = tile ? S1 : S0; const int e = (eb0 + tile) * 32 + (lane & 31);
#pragma unroll
                for (int g4 = 0; g4 < 4; ++g4) { const int d = db * 32 + 8 * g4 + 4 * hi; u32x2 v; v.x = cvtpk(S[4 * g4], S[4 * g4 + 1]); v.y = cvtpk(S[4 * g4 + 2], S[4 * g4 + 3]);
                    *(LAS u32x2*)(lds + IMG_ST + e * RS + d * 2) = v; } }
        }
        u32x4 gg0 = {0u, 0u, 0u, 0u}, gg1 = {0u, 0u, 0u, 0u};
        if (APPLY) { const size_t trow = row0 + j * 64 + (tid >> 3); const bf16_t* gp = SG + trow * 512 + h * 128 + (tid & 7) * 16; gg0 = *(const u32x4*)gp; gg1 = *(const u32x4*)(gp + 8); }
        if (APPLY) { if (j + 2 < 8) issue(j + 2, cs); } else { if (j + 3 < 8) issue(j + 3, cs); }
        LDS_WAIT(); __builtin_amdgcn_s_barrier();
        f32x16 oin = f32x16{}, oit = f32x16{};
        const int qb = w >> 2, eb = w & 3;
        if (APPLY) {
#pragma unroll
            for (int s = 0; s < 8; ++s) oin = __builtin_amdgcn_mfma_f32_32x32x16_bf16(frag_row(lds + IMG_Q, RS, qb * 32, s * 16, lane), frag_row(lds + IMG_ST, RS, eb * 32, s * 16, lane), oin, 0, 0, 0);
            if (w < 4) {
                const int tb = w >> 1, qb2 = w & 1; f32x16 sc = f32x16{};
#pragma unroll
                for (int s = 0; s < 8; ++s) sc = __builtin_amdgcn_mfma_f32_32x32x16_bf16(frag_row(lds + IMG_K, RS, tb * 32, s * 16, lane), frag_row(lds + IMG_Q, RS, qb2 * 32, s * 16, lane), sc, 0, 0, 0);
                const int q = qb2 * 32 + (lane & 31);
#pragma unroll
                for (int g4 = 0; g4 < 4; ++g4) { const int t0 = tb * 32 + 8 * g4 + 4 * hi; float pv4[4];
#pragma unroll
                    for (int e = 0; e < 4; ++e) { const int dd = q - (t0 + e); pv4[e] = sc[4 * g4 + e] * exp2f((float)(dd < 0 ? -dd : dd) * l2g); }
                    u32x2 v; v.x = cvtpk(pv4[0], pv4[1]); v.y = cvtpk(pv4[2], pv4[3]);
                    *(LAS u32x2*)(lds + IMG_P + q * PS + t0 * 2) = v; }
            }
            LDS_WAIT(); __builtin_amdgcn_s_barrier();
#pragma unroll
            for (int s = 0; s < 4; ++s) oit = __builtin_amdgcn_mfma_f32_32x32x16_bf16(frag_row(lds + IMG_P, PS, qb * 32, s * 16, lane), frag_tr(lds + IMG_V, RS, s * 16, eb * 32, lane), oit, 0, 0, 0);
#pragma unroll
            for (int r = 0; r < 16; ++r) { const int q = qb * 32 + crow(r, hi); const float qw = exp2f((float)(q + 1) * l2g);
                *(LAS float*)(lds + IMG_O + (q * OS + eb * 32 + (lane & 31)) * 4) = oit[r] + qw * oin[r]; }
        }
#pragma unroll
        for (int r = 0; r < 16; ++r) { S0[r] *= cd; S1[r] *= cd; }
#pragma unroll
        for (int s = 0; s < 4; ++s) { const bf16x8 a = frag_tr(lds + IMG_KT, RS, s * 16, db * 32, lane);
            S0 = __builtin_amdgcn_mfma_f32_32x32x16_bf16(a, frag_tr(lds + IMG_V, RS, s * 16, eb0 * 32, lane), S0, 0, 0, 0);
            S1 = __builtin_amdgcn_mfma_f32_32x32x16_bf16(a, frag_tr(lds + IMG_V, RS, s * 16, (eb0 + 1) * 32, lane), S1, 0, 0, 0); }
        LDS_WAIT(); __builtin_amdgcn_s_barrier();
        if (APPLY) {
            { const int q = tid >> 3, sg = tid & 7; const LAS f32x4* op = (const LAS f32x4*)(lds + IMG_O + (q * OS + sg * 16) * 4);
              f32x4 x0 = op[0], x1 = op[1], x2 = op[2], x3 = op[3];
              float s1 = ((x0.x + x0.y) + (x0.z + x0.w)) + ((x1.x + x1.y) + (x1.z + x1.w)) + ((x2.x + x2.y) + (x2.z + x2.w)) + ((x3.x + x3.y) + (x3.z + x3.w));
              s1 += dpp_mov<0xB1>(s1); s1 += dpp_mov<0x4E>(s1); s1 += dpp_mov<0x141>(s1);
              const float mu = s1 * (1.0f / 128.0f); x0 = x0 - mu; x1 = x1 - mu; x2 = x2 - mu; x3 = x3 - mu;
              float s2 = ((x0.x * x0.x + x0.y * x0.y) + (x0.z * x0.z + x0.w * x0.w)) + ((x1.x * x1.x + x1.y * x1.y) + (x1.z * x1.z + x1.w * x1.w)) + ((x2.x * x2.x + x2.y * x2.y) + (x2.z * x2.z + x2.w * x2.w)) + ((x3.x * x3.x + x3.y * x3.y) + (x3.z * x3.z + x3.w * x3.w));
              s2 += dpp_mov<0xB1>(s2); s2 += dpp_mov<0x4E>(s2); s2 += dpp_mov<0x141>(s2);
              const float rstd = rsqrtf(s2 * (1.0f / 128.0f) + GN_EPS);
              const size_t trow = row0 + j * 64 + q; const u32x4 g0 = gg0, g1 = gg1;
              const float ms = rstd * MIX_SCALE; u32x4 o;
#define MXC(v) __builtin_fminf(__builtin_fmaxf((v), -440.0f), 440.0f)
              o.x = pk4_fp8(MXC(x0.x * ms * bflo(g0.x)), MXC(x0.y * ms * bfhi(g0.x)), MXC(x0.z * ms * bflo(g0.y)), MXC(x0.w * ms * bfhi(g0.y)));
              o.y = pk4_fp8(MXC(x1.x * ms * bflo(g0.z)), MXC(x1.y * ms * bfhi(g0.z)), MXC(x1.z * ms * bflo(g0.w)), MXC(x1.w * ms * bfhi(g0.w)));
              o.z = pk4_fp8(MXC(x2.x * ms * bflo(g1.x)), MXC(x2.y * ms * bfhi(g1.x)), MXC(x2.z * ms * bflo(g1.y)), MXC(x2.w * ms * bfhi(g1.y)));
              o.w = pk4_fp8(MXC(x3.x * ms * bflo(g1.z)), MXC(x3.y * ms * bfhi(g1.z)), MXC(x3.z * ms * bflo(g1.w)), MXC(x3.w * ms * bfhi(g1.w)));
#undef MXC
              *(u32x4*)(MIX + trow * 1024 + h * 128 + sg * 16) = o; }
        }
    }
    if (!APPLY) {
        f32x4* dst = (f32x4*)(GST + ((size_t)(bh * 16 + g) * 8 + w) * 2048) + lane;
#pragma unroll
        for (int q = 0; q < 4; ++q) { dst[q * 64] = (f32x4){S0[4 * q], S0[4 * q + 1], S0[4 * q + 2], S0[4 * q + 3]}; dst[(4 + q) * 64] = (f32x4){S1[4 * q], S1[4 * q + 1], S1[4 * q + 2], S1[4 * q + 3]}; }
    }
    LDS_WAIT(); __builtin_amdgcn_s_barrier();
}
}


#define XB_TMO      128
#define XB_XCNT(j)  (256  + 64 * (j))
#define XB_XSUB(j)  (1280 + 64 * (j))
#define XB_XGEN(j)  (2304 + 64 * (j))
#define XB_TOP      3328
#define XB_TOPGEN   3392
#define XCD_BAR_WORDS 3456
#define XB_SPIN_CAP (1u << 18)
__device__ __forceinline__ unsigned xb_ld(unsigned* p)              { return __hip_atomic_load(p, __ATOMIC_RELAXED, __HIP_MEMORY_SCOPE_AGENT); }
__device__ __forceinline__ unsigned xb_add(unsigned* p, unsigned v) { return __hip_atomic_fetch_add(p, v, __ATOMIC_RELAXED, __HIP_MEMORY_SCOPE_AGENT); }
__device__ __forceinline__ unsigned xb_xcc_id() { return (unsigned)__builtin_amdgcn_s_getreg((3 << 11) | 20) & 0xFu; }
#define XB_SPIN(cond, bar) do { unsigned _sp = 0; while (cond) { __builtin_amdgcn_s_sleep(1); \
    if ((++_sp & 255u) == 0u) { if (xb_ld(&(bar)[XB_TMO])) break; if (_sp > XB_SPIN_CAP) { atomicAdd(&(bar)[XB_TMO], 1u); break; } } } } while (0)
struct XcdBarrier { unsigned* bar; unsigned x; volatile LAS unsigned* st; };
__device__ __forceinline__ XcdBarrier xcd_barrier_post(unsigned* bar, volatile LAS unsigned* st) {
    XcdBarrier b; b.bar = bar; b.x = xb_xcc_id(); b.st = st;
    if (threadIdx.x == 0) (void)xb_add(&bar[XB_XCNT(b.x)], 1u);
    return b;
}
__device__ __forceinline__ void xcd_barrier_complete(unsigned* bar, unsigned x, unsigned& nloc, unsigned& nx) {
    const unsigned G = gridDim.x * gridDim.y * gridDim.z;
    unsigned sum, cnt, mine, sp = 0u;
    for (;;) {
        sum = 0u; cnt = 0u; mine = 0u;
#pragma unroll
        for (unsigned j = 0; j < 16; ++j) { const unsigned c = xb_ld(&bar[XB_XCNT(j)]); sum += c; cnt += (c > 0u) ? 1u : 0u; mine = (j == x) ? c : mine; }
        if (sum == G) break;
        __builtin_amdgcn_s_sleep(1);
        if ((++sp & 255u) == 0u) { if (xb_ld(&bar[XB_TMO])) break; if (sp > XB_SPIN_CAP) { atomicAdd(&bar[XB_TMO], 1u); break; } }
    }
    nloc = mine > 0u ? mine : 1u; nx = cnt > 0u ? cnt : 1u;
}
__device__ __forceinline__ void xcd_barrier(const XcdBarrier& b) {
    asm volatile("s_waitcnt vmcnt(0)" ::: "memory");
    __syncthreads();
    if (threadIdx.x == 0) {
        unsigned* bar = b.bar;
        __builtin_amdgcn_s_waitcnt(0);
        unsigned nloc = b.st[0], nx = b.st[1];
        if (nloc == 0u) { xcd_barrier_complete(bar, b.x, nloc, nx); b.st[0] = nloc; b.st[1] = nx; }
        const unsigned old = xb_add(&bar[XB_XSUB(b.x)], 1u);
        const unsigned gen = old / nloc;
        if (old + 1u == (gen + 1u) * nloc) {
            __builtin_amdgcn_fence(__ATOMIC_RELEASE, "agent");
            asm volatile("s_waitcnt vmcnt(0)" ::: "memory");
            const unsigned og = xb_add(&bar[XB_TOP], 1u);
            const unsigned tg = og / nx;
            if (og + 1u == (tg + 1u) * nx) xb_add(&bar[XB_TOPGEN], 1u);
            else XB_SPIN(xb_ld(&bar[XB_TOPGEN]) == tg, bar);
            __builtin_amdgcn_fence(__ATOMIC_ACQUIRE, "agent");
            xb_add(&bar[XB_XGEN(b.x)], 1u);
            asm volatile("s_waitcnt vmcnt(0)" ::: "memory");
        } else {
            XB_SPIN(xb_ld(&bar[XB_XGEN(b.x)]) == gen, bar);
            __builtin_amdgcn_fence(__ATOMIC_ACQUIRE, "agent");
            asm volatile("s_waitcnt vmcnt(0)" ::: "memory");
        }
    }
    __syncthreads();
}

__device__ __forceinline__ void publish_inc(unsigned* cnt) {
    asm volatile("s_waitcnt vmcnt(0)" ::: "memory");
    __syncthreads();
    if (threadIdx.x == 0) { __builtin_amdgcn_fence(__ATOMIC_RELEASE, "agent"); asm volatile("s_waitcnt vmcnt(0)" ::: "memory");
        (void)__hip_atomic_fetch_add(cnt, 1u, __ATOMIC_RELAXED, __HIP_MEMORY_SCOPE_AGENT); }
}
__device__ __forceinline__ void wait_ge(unsigned* cnt, unsigned target) {
    if (threadIdx.x == 0) { unsigned sp = 0;
        while (__hip_atomic_load(cnt, __ATOMIC_RELAXED, __HIP_MEMORY_SCOPE_AGENT) < target) { __builtin_amdgcn_s_sleep(2); if (++sp > (1u << 22)) break; }
        __builtin_amdgcn_fence(__ATOMIC_ACQUIRE, "agent"); asm volatile("s_waitcnt vmcnt(0)" ::: "memory"); }
    __syncthreads();
}

struct Frame {
    LAS unsigned char* lds; int tid, lane, wave, vcu, G;
    __device__ __forceinline__ void refresh() { int t = threadIdx.x; asm volatile("" : "+v"(t)); tid = t; lane = t & 63; }
};

__device__ __forceinline__ void tr_item(const float* __restrict__ W, int ldw, int k0, int n0, const float* __restrict__ gk, bf16_t* WT, int kind, LAS unsigned* scr, int lane) {
    const int nch = lane & 15, kq = lane >> 4;
    f32x4 a[8], b[8];
#pragma unroll
    for (int i = 0; i < 8; ++i) { const int kp = 4 * i + kq; const float* p = W + (size_t)(k0 + 2 * kp) * ldw + n0 + 4 * nch; a[i] = *(const f32x4*)p; b[i] = *(const f32x4*)(p + ldw); }
#pragma unroll
    for (int i = 0; i < 8; ++i) { const int kp = 4 * i + kq; float ga = 1.f, gb = 1.f; if (gk) { ga = gk[k0 + 2 * kp]; gb = gk[k0 + 2 * kp + 1]; }
#pragma unroll
        for (int e = 0; e < 4; ++e) scr[(4 * nch + e) * 36 + kp] = cvtpk(a[i][e] * ga, b[i][e] * gb); }
    LDS_WAIT(); asm volatile("" ::: "memory");
    const int c = lane & 7, nr = lane >> 3;
#pragma unroll
    for (int j = 0; j < 8; ++j) { const int n = nr + 8 * j; const u32x4 v = *(const LAS u32x4*)(scr + n * 36 + 4 * c);
        const int cn = n0 + n; const int row = (kind == 0) ? pos_inproj(cn) : (kind == 1) ? pos_wide(cn) : pos_w1(cn);
        *(u32x4*)(WT + (size_t)row * 1024 + k0 + 8 * c) = v; }
    LDS_WAIT(); asm volatile("" ::: "memory");
}

struct Tr8Item { const float* W; unsigned char* WT; const float* gk; int ldw, k0, n0, kind; };
__device__ __forceinline__ Tr8Item tr8_decode(int r, const Params& P, unsigned char* W1T, unsigned char* W2T, const float* ones) {
    constexpr int P_1 = 32 * 8 * 32; Tr8Item t; const int half = r & 1; int p = r >> 1;
    if (p < P_1) { const int e = p >> 8, rr = p & 255; t.W = P.w1 + (size_t)e * 1024 * 2048; t.ldw = 2048; t.k0 = 128 * (rr / 32) + 64 * half; t.n0 = 64 * (rr % 32); t.gk = P.g_ffn; t.WT = W1T + (size_t)e * 2048 * 1024; t.kind = 2; }
    else { p -= P_1; const int e = p >> 7, rr = p & 127; t.W = P.w2 + (size_t)e * 1024 * 1024; t.ldw = 1024; t.k0 = 128 * (rr / 16) + 64 * half; t.n0 = 64 * (rr % 16); t.gk = ones; t.WT = W2T + (size_t)e * 1024 * 1024; t.kind = 1; }
    return t;
}
template <bool GK = true> __device__ __forceinline__ void tr8_load(const Tr8Item& t, f32x4 (&a)[4][4], f32x4 (&gq)[4], int lane) {
    const int nch = lane & 15, kq4 = lane >> 4;
#pragma unroll
    for (int i = 0; i < 4; ++i) { if constexpr (GK) gq[i] = *(const f32x4*)(t.gk + t.k0 + 4 * (4 * i + kq4)); else gq[i] = (f32x4){1.f, 1.f, 1.f, 1.f}; }
#pragma unroll
    for (int i = 0; i < 4; ++i) { const int kq = 4 * i + kq4; const float* p = t.W + (size_t)(t.k0 + 4 * kq) * t.ldw + t.n0 + 4 * nch;
#pragma unroll
        for (int r = 0; r < 4; ++r) a[i][r] = __builtin_nontemporal_load((const f32x4*)(p + (size_t)r * t.ldw)); }
}
__device__ __forceinline__ void tr8_proc(const Tr8Item& t, const f32x4 (&a)[4][4], const f32x4 (&gq)[4], LAS unsigned* scr, int lane, const int half) {
    const int nch = lane & 15, kq4 = lane >> 4;
#pragma unroll
    for (int i = 0; i < 4; ++i) { const int kq = 4 * i + kq4; float g[4];
#pragma unroll
        for (int r = 0; r < 4; ++r) g[r] = gq[i][r] * W_SCALE;
#pragma unroll
        for (int e = 0; e < 4; ++e) scr[(4 * nch + e) * 36 + 16 * half + (kq ^ (4 * ((nch >> 1) & 3)))] = pk4_fp8(a[i][0][e] * g[0], a[i][1][e] * g[1], a[i][2][e] * g[2], a[i][3][e] * g[3]); }
    if (half == 1) {
        LDS_WAIT(); asm volatile("" ::: "memory");
        const int c = lane & 7, nr = lane >> 3;
#pragma unroll
        for (int j = 0; j < 8; ++j) { const int n = nr + 8 * j; const u32x4 v = *(const LAS u32x4*)(scr + n * 36 + 16 * (c >> 2) + 4 * ((c & 3) ^ ((n >> 3) & 3)));
            const int cn = t.n0 + n; const int row = (t.kind == 1) ? pos_wide(cn) : pos_w1(cn);
            *(u32x4*)(t.WT + (size_t)row * 1024 + (t.k0 - 64) + 16 * c) = v; }
        LDS_WAIT(); asm volatile("" ::: "memory");
    }
}

__global__ void __launch_bounds__(NTHREADS, 2) mk_fwd(Params P) {
    __builtin_assume(__builtin_amdgcn_workitem_id_y() == 0); __builtin_assume(__builtin_amdgcn_workitem_id_z() == 0);
    extern __shared__ __attribute__((aligned(16))) unsigned char lds_raw[];
    cg::grid_group grid = cg::this_grid();
    Frame F; F.lds = (LAS unsigned char*)lds_raw; F.tid = threadIdx.x; F.lane = F.tid & 63; F.wave = __builtin_amdgcn_readfirstlane(F.tid >> 6);
    F.G = gridDim.x; { const int bx = blockIdx.x; F.vcu = (F.G % 8 == 0) ? (bx % 8) * (F.G / 8) + bx / 8 : bx; }
    unsigned char* ws = P.ws;
    unsigned* ctl = (unsigned*)(ws + WS_CTL);
    float* ropec = (float*)(ws + WS_ROPEC); float* ropes = (float*)(ws + WS_ROPES);
    float* wr3 = (float*)(ws + WS_WR3); float* logf2 = (float*)(ws + WS_LOGF); float* F2 = (float*)(ws + WS_F2); (void)F2; unsigned* FAq = (unsigned*)(ws + WS_FA);
    float* irs1 = (float*)(ws + WS_IRS1); float* ones = (float*)(ws + WS_ONES);
    int* ltok = (int*)(ws + WS_LTOK); float* lrstd = (float*)(ws + WS_LRSTD); int* inv = (int*)(ws + WS_INV); float* gates = (float*)(ws + WS_GATE);
    bf16_t* H1B = (bf16_t*)(ws + WS_H1B); bf16_t* WinT = (bf16_t*)(ws + WS_WINT); unsigned char* WoT = ws + WS_WOT;
    unsigned char* W2T = ws + WS_W2T; unsigned char* W1T = ws + WS_W1T; unsigned char* Yb = ws + WS_Y; unsigned char* H1F8 = ws + WS_H1F8;
    bf16_t* U = (bf16_t*)(ws + WS_U); unsigned char* proj = ws + WS_PROJ;
    bf16_t* RQ = (bf16_t*)(proj); bf16_t* RK = (bf16_t*)(proj + PROJ_STRIDE); bf16_t* RV = (bf16_t*)(proj + 2 * PROJ_STRIDE); bf16_t* SG = (bf16_t*)(proj + 3 * PROJ_STRIDE);
    bf16_t* FQ = (bf16_t*)(proj + 4 * PROJ_STRIDE); bf16_t* FK = (bf16_t*)(proj + 5 * PROJ_STRIDE); bf16_t* FV = (bf16_t*)(proj + 6 * PROJ_STRIDE);
    float* GST = (float*)(ws + WS_GST); unsigned char* MIX = ws + WS_MIX; unsigned char* Hb = ws + WS_H;
    const int lo = P.ph_lo, hi_ph = P.ph_hi;
#ifndef MK_PHMASK
#define MK_PHMASK 0x1ff
#endif
#define IN(k) (((MK_PHMASK >> (k)) & 1) && lo <= (k) && (k) < hi_ph)
#define REP(k) for (int rep_ = 0; rep_ < ((MK_DUP == (k)) ? 2 : 1); ++rep_)
#ifndef MK_CG_MASK
#define MK_CG_MASK 0x01
#endif
#define SEAM(k) do { if (IN(k) && IN((k) + 1)) { if ((MK_CG_MASK >> (k)) & 1) grid.sync(); else xcd_barrier(xbar); } } while (0)
    const int gw = F.vcu * NWAVES + F.wave, NGW = F.G * NWAVES;
    volatile LAS unsigned* misc = (volatile LAS unsigned*)(F.lds + LDS_MISC);
    if (F.tid < 4) misc[F.tid] = 0u;
    __syncthreads();
    XcdBarrier xbar; xbar.bar = ctl + CW_BAR; xbar.x = 0u; xbar.st = misc;
#if MK_N_LAUNCHES != 1
    xbar = xcd_barrier_post(ctl + CW_BAR, misc);
#endif
#if MK_DIAG
    int nst = 0;
#define STAMP() do { if (blockIdx.x == 0 && threadIdx.x == 0) ((unsigned long long*)(ctl + CW_DIAG + 16))[nst] = __builtin_amdgcn_s_memrealtime(); ++nst; } while (0)
    STAMP();
#else
#define STAMP() do { } while (0)
#endif

    if (IN(0)) {
        F.refresh();
#if MK_N_LAUNCHES == 1
        { const int gt = (int)blockIdx.x * NTHREADS + F.tid; if (gt < (int)(CTL_BYTES / 4)) ctl[gt] = 0u; }
#endif
        LAS unsigned* scr = (LAS unsigned*)(F.lds + F.wave * 9216);
        LAS float* wfl = (LAS float*)(F.lds + 73728);
        for (int i = F.tid; i < 8192; i += NTHREADS) { const int hh = i & 7, k = i >> 3; wfl[hh * 1024 + k] = P.w_in[(size_t)k * INW + NPROJ + hh]; }
        constexpr int I_IN = 16 * 56, I_O = 8 * 16;
        for (int it = gw; it < I_IN + I_O; it += NGW) {
            if (it < I_IN) tr_item(P.w_in, INW, 64 * (it / 56), 64 * (it % 56), nullptr, WinT, 0, scr, F.lane);
            else { const int r = it - I_IN; f32x4 a_[4][4], g_[4]; Tr8Item t; t.W = P.w_out; t.WT = WoT; t.gk = nullptr; t.ldw = 1024; t.n0 = 64 * (r % 16); t.kind = 1;
                t.k0 = 128 * (r / 16); tr8_load<false>(t, a_, g_, F.lane); tr8_proc(t, a_, g_, scr, F.lane, 0);
                t.k0 += 64; tr8_load<false>(t, a_, g_, F.lane); tr8_proc(t, a_, g_, scr, F.lane, 1); }
        }
        __syncthreads();
        {
            constexpr int TD = T * ((MK_DUP == 0) ? 2 : 1);
            f32x4 gq[4];
#pragma unroll
            for (int j = 0; j < 4; ++j) gq[j] = ((const f32x4*)P.g_mix)[F.lane + 64 * j];
            const float bfg = (F.lane < 8) ? P.b_forget[F.lane] : 0.f;
#define ROW_LOAD(V, MM) do { const f32x4* xr_ = (const f32x4*)(P.x + (size_t)((MM) % T) * DM) + F.lane; _Pragma("unroll") for (int j = 0; j < 4; ++j) V[j] = __builtin_nontemporal_load(xr_ + 64 * j); } while (0)
#define ROW_PROC(V, MM) do { const int mr_ = (MM) % T; float ss = 0.f; \
            _Pragma("unroll") for (int j = 0; j < 4; ++j) ss += (V[j].x * V[j].x + V[j].y * V[j].y) + (V[j].z * V[j].z + V[j].w * V[j].w); \
            const float msq = wave_sum_dpp(ss) * (1.0f / DM) + RMS_EPS; const float rstd = rsqrtf(msq); \
            if (F.lane == 0) irs1[mr_] = sqrtf(msq); \
            float z[8]; _Pragma("unroll") for (int hh = 0; hh < 8; ++hh) z[hh] = 0.f; \
            unsigned long long* o8 = (unsigned long long*)(U + (size_t)mr_ * DM) + F.lane; \
            _Pragma("unroll") for (int j = 0; j < 4; ++j) { const f32x4 uv = V[j] * rstd * gq[j]; \
                o8[64 * j] = (unsigned long long)cvtpk(uv.x, uv.y) | ((unsigned long long)cvtpk(uv.z, uv.w) << 32); \
                _Pragma("unroll") for (int hh = 0; hh < 8; ++hh) { const f32x4 w4 = *(const LAS f32x4*)(wfl + hh * 1024 + 4 * F.lane + 256 * j); z[hh] += (uv.x * w4.x + uv.y * w4.y) + (uv.z * w4.z + uv.w * w4.w); } } \
            _Pragma("unroll") for (int hh = 0; hh < 8; ++hh) z[hh] = wave_sum_dpp(z[hh]); \
            float zz = z[0]; _Pragma("unroll") for (int hh = 1; hh < 8; ++hh) zz = (F.lane == hh) ? z[hh] : zz; \
            if (F.lane < 8) { const float xx = zz + bfg; const float lf = fminf(xx, 0.f) - log1pf(__expf(-fabsf(xx))); logf2[(size_t)mr_ * 8 + F.lane] = lf * LOG2E; } } while (0)
            constexpr int NR = T / (256 * NWAVES) * ((MK_DUP == 0) ? 2 : 1);
            f32x4 vv_[3][4];
            if (NGW == 256 * NWAVES) {
#pragma unroll
                for (int i = 0; i < NR + 2; ++i) {
                    if (i < NR) ROW_LOAD(vv_[i % 3], gw + i * NGW);
                    if (i >= 2) ROW_PROC(vv_[(i - 2) % 3], gw + (i - 2) * NGW);
                }
            } else {
                for (int m = gw; m < T; m += NGW) { ROW_LOAD(vv_[0], m); ROW_PROC(vv_[0], m); }
            }
#undef ROW_LOAD
#undef ROW_PROC
        }
        for (int idx = blockIdx.x * NTHREADS + F.tid; idx < SEQ * 64; idx += F.G * NTHREADS) {
            const int pos = idx >> 6, i = idx & 63; const float invf = exp2f(-(float)i * (13.287712379549449f / 64.0f));
            const float ang = (float)pos * invf; double tt = (double)ang * 0.15915494309189535; tt -= __builtin_rint(tt); const float tf = (float)tt;
            ropec[idx] = __builtin_amdgcn_cosf(tf); ropes[idx] = __builtin_amdgcn_sinf(tf);
        }
        for (int idx = blockIdx.x * NTHREADS + F.tid; idx < 1024; idx += F.G * NTHREADS) ones[idx] = 1.0f;
        for (int idx = blockIdx.x * NTHREADS + F.tid; idx < 32768; idx += F.G * NTHREADS) {
            const int jp = idx & 3, e16 = (idx >> 2) & 15, kq = (idx >> 6) & 3, s = (idx >> 8) & 31, half = (idx >> 13) & 1, part = idx >> 14; const int k = 32 * s + 8 * kq + 2 * jp, e = 16 * half + e16;
            const float v0 = P.w_router[k * 32 + e] * P.g_ffn[k], v1 = P.w_router[(k + 1) * 32 + e] * P.g_ffn[k + 1];
            const unsigned hi = cvtpk(v0, v1); const unsigned lo = cvtpk(v0 - bflo(hi), v1 - bfhi(hi));
            ((unsigned*)wr3)[idx] = part ? lo : hi;
        }
    }
    SEAM(0); STAMP();
#if MK_N_LAUNCHES == 1
    xbar = xcd_barrier_post(ctl + CW_BAR, misc);
#endif
#if MK_DUP == 90
    for (int rb_ = 0; rb_ < 16; ++rb_) xcd_barrier(xbar);
#endif

    if (IN(1)) {
        F.refresh();
        typedef pg8::DenseOrder<T / 256, NPROJ / 256> Ord1; Ord1 S; S.init(T, NPROJ, DM, F.G, (int)blockIdx.x, (MK_DUP == 1) ? 2 : 1);
        EpiInProj E{proj, ropec, ropes, ctl};
        const int nun = (S.nwg * S.dup + F.G - 1) / F.G;
        const int kslot = ((F.vcu & 7) * (nun + 1)) / 8;
        constexpr int I_8 = 32 * 16 * 32 + 32 * 16 * 16;
        LAS unsigned* scr = (LAS unsigned*)(F.lds + F.wave * 9216);
        {
            S.i0 = 0; S.i1 = kslot;
            pg8::gemm_phase<EpiInProj, Ord1, true, true, 2>(F.lds, U, WinT, DM, S, E);
            {
                __syncthreads();
        {
            f32x4 rr_[2][4][4], gg_[2][4]; Tr8Item tt_[2];
            constexpr int NI = (32 * 16 * 32 + 32 * 16 * 16) / (256 * NWAVES) * ((MK_DUP == 9) ? 2 : 1);
            if (NGW == 256 * NWAVES) {
#pragma unroll
                for (int i = 0; i < NI + 1; ++i) {
                    if (i < NI) { tt_[i & 1] = tr8_decode(2 * ((gw + (i >> 1) * NGW) % (I_8 / 2)) + (i & 1), P, W1T, W2T, ones); tr8_load(tt_[i & 1], rr_[i & 1], gg_[i & 1], F.lane); }
                    if (i >= 1) tr8_proc(tt_[(i - 1) & 1], rr_[(i - 1) & 1], gg_[(i - 1) & 1], scr, F.lane, (i - 1) & 1);
                }
            } else {
                for (int it = gw; it < I_8 / 2; it += NGW) { tt_[0] = tr8_decode(2 * it, P, W1T, W2T, ones); tr8_load(tt_[0], rr_[0], gg_[0], F.lane); tr8_proc(tt_[0], rr_[0], gg_[0], scr, F.lane, 0);
                    tt_[0] = tr8_decode(2 * it + 1, P, W1T, W2T, ones); tr8_load(tt_[0], rr_[0], gg_[0], F.lane); tr8_proc(tt_[0], rr_[0], gg_[0], scr, F.lane, 1); }
            }
        }
                __syncthreads();
            }
            F.refresh();
            S.i0 = kslot; S.i1 = 1 << 30;
            pg8::gemm_phase<EpiInProj, Ord1, true, true, 2>(F.lds, U, WinT, DM, S, E);
        }
    }
    SEAM(1); STAMP();

    STAMP();

    if (IN(3)) {
        F.refresh();
        for (int bh = F.vcu; bh < 32; bh += F.G) {
            const int b = bh >> 3, h = bh & 7; LAS double* sd = (LAS double*)F.lds;
            double loc[16]; double run = 0.0;
#pragma unroll
            for (int i = 0; i < 16; ++i) { run += (double)logf2[((size_t)b * SEQ + 16 * F.tid + i) * 8 + h]; loc[i] = run; }
            double incl = run;
#pragma unroll
            for (int o = 1; o < 64; o <<= 1) { const double t = __shfl_up(incl, o); if (F.lane >= o) incl += t; }
            __syncthreads();
            if (F.lane == 63) sd[F.wave] = incl;
            __syncthreads();
            double off = incl - run;
            for (int w2 = 0; w2 < F.wave; ++w2) off += sd[w2];
            LAS float* Fsl = (LAS float*)(F.lds + 4096);
#pragma unroll
            for (int i = 0; i < 16; ++i) { const float fv = (float)(off + loc[i]); Fsl[16 * F.tid + i] = fv;
                const float nf = -fv; const unsigned h_ = cvtpk(nf, 0.f) & 0xffffu; const float r1 = nf - __uint_as_float(h_ << 16); const unsigned m_ = cvtpk(r1, 0.f) & 0xffffu;
                const float r2 = r1 - __uint_as_float(m_ << 16); const unsigned l_ = cvtpk(r2, 0.f) & 0xffffu;
                u32x2 w; w.x = h_ | (m_ << 16); w.y = l_ | 0x3f800000u; ((u32x2*)FAq)[(size_t)bh * SEQ + 16 * F.tid + i] = w; }
            __syncthreads();
            if (F.tid < 32) { const int qb = F.tid, q0 = 256 * qb, NT = 4 * qb + 4;
                const float qn = __uint_as_float(ctl[CW_QN2 + bh * 2]) + __uint_as_float(ctl[CW_QN2 + bh * 2 + 1]), kn = __uint_as_float(ctl[CW_KN2 + bh * 2]) + __uint_as_float(ctl[CW_KN2 + bh * 2 + 1]);
                const float target = Fsl[q0] + PRUNE_TH + 2.0f * 1.0201f * sqrtf(qn * kn);
                int lo_ = 0, hi_ = NT - 4;
                while (lo_ < hi_) { const int mid = (lo_ + hi_) >> 1; if (Fsl[64 * mid + 63] >= target) lo_ = mid + 1; else hi_ = mid; }
                const int ts = lo_ & ~1, NS = NT - ts;
                ctl[CW_UTS + bh * 32 + qb] = (unsigned)ts; ctl[CW_UPOS + bh * 32 + qb] = atomicAdd(ctl + CW_BIN + (NS >> 1), 1u); }
            publish_inc(ctl + CW_SCAN);
            __syncthreads();
        }
        for (int u = F.vcu; u < 256; u += F.G) { ret::unit<false>(u >> 4, u & 15, RQ, RK, RV, SG, GST, MIX, (LAS char*)F.lds); publish_inc(ctl + CW_GDONE + 16 * (u >> 4)); }
        for (int u = F.vcu; u < 256; u += F.G) { wait_ge(ctl + CW_GDONE + 16 * (u >> 4), 16u); ret::unit<true>(u >> 4, u & 15, RQ, RK, RV, SG, GST, MIX, (LAS char*)F.lds); }
        wait_ge(ctl + CW_SCAN, 32u);
        LAS int* qst = (LAS int*)(F.lds + attn_body::LDS_QUEUE); LAS int* qlist = qst + 128; LAS int* qsh = qst + 100;
        if (F.tid >= 2 && F.tid <= 64) qst[F.tid] = (int)ctl[CW_BIN + F.tid];
        __syncthreads();
        if (F.tid < 64) {
            const int k = 64 - F.tid; const int c = (k >= 2) ? qst[k] : 0; int inc = c;
#pragma unroll
            for (int o = 1; o < 64; o <<= 1) { const int t = __shfl_up(inc, o); if (F.tid >= o) inc += t; }
            if (k >= 2) qst[k] = inc - c; }
        __syncthreads();
        for (int u = F.tid; u < 1024; u += NTHREADS) { const int ts = (int)ctl[CW_UTS + u], NS = 4 * (u & 31) + 4 - ts; qlist[qst[NS >> 1] + (int)ctl[CW_UPOS + u]] = u | (ts << 16); }
        __syncthreads();
        LAS float* kmx = (LAS float*)(qst + 1152);
        if (F.tid < 32) kmx[F.tid] = 1.0201f * sqrtf(__uint_as_float(ctl[CW_KN2 + F.tid * 2]) + __uint_as_float(ctl[CW_KN2 + F.tid * 2 + 1]));
        if (F.tid == 0) qsh[0] = (int)atomicAdd(ctl + CW_QHEAD, 1u);
        __syncthreads();
        for (;;) {
            int idx = qsh[0];
            if (idx >= ((MK_DUP == 30) ? 2048 : 1024)) break;
            idx &= 1023;
            const int uu = qlist[idx]; const int u = uu & 0xffff, ts = uu >> 16; const int bh = u >> 5, qb = u & 31;
            const float kmaxc = kmx[bh];
            const int ntd = attn_body::attn_unit<8>(bh >> 3, bh & 7, qb, ts, kmaxc, FQ, FK, FV, MIX + 512, FAq, (char*)lds_raw, ctl + CW_QHEAD, qsh); (void)ntd;
#if MK_DIAG >= 21 && MK_DIAG <= 23
            if (F.tid == 0) { atomicAdd(ctl + CW_DIAG + 2, (unsigned)ntd); atomicMax(ctl + CW_DIAG + 3, (unsigned)ntd); if (ntd >= 64) atomicAdd(ctl + CW_DIAG + 4, 1u); }
#endif
        }
    }
    SEAM(3); STAMP();

    if (IN(4)) {
        F.refresh();
        typedef pg8::DenseOrder<T / 256, DM / 256> Ord4; Ord4 S; S.init(T, DM, DM, F.G, (int)blockIdx.x, (MK_DUP == 4) ? 2 : 1);
        EpiOutProj E{U, irs1, P.g_mix, H1B, H1F8};
        pg8::gemm_phase<EpiOutProj, Ord4, true, true, 1>(F.lds, MIX, WoT, DM, S, E);
    }
    SEAM(4); STAMP();

    if (IN(5)) {
        F.refresh();
        LAS float* wl = (LAS float*)F.lds;
        LAS float* lg = (LAS float*)(F.lds + 131072);
        LAS float* ssb = (LAS float*)(F.lds + 131072 + 128 * 33 * 4);
        LAS int* ecnt = (LAS int*)(F.lds + 131072 + 128 * 33 * 4 + 512);
        LAS int* ebase = ecnt + 32;
        { f32x4 wv[16];
#pragma unroll
          for (int i = 0; i < 16; ++i) wv[i] = ((const f32x4*)wr3)[F.tid + NTHREADS * i];
#pragma unroll
          for (int i = 0; i < 16; ++i) ((LAS f32x4*)wl)[F.tid + NTHREADS * i] = wv[i]; }
        for (int tb = blockIdx.x; tb < T / 128; tb += F.G) {
            if (F.tid < 32) ecnt[F.tid] = 0;
            __syncthreads();
            const int tok16 = F.lane & 15, kq = F.lane >> 4; const int tokw = tb * 128 + F.wave * 16 + tok16;
            const bf16_t* hrow = H1B + (size_t)tokw * DM + 8 * kq;
            f32x4 a0 = {0.f, 0.f, 0.f, 0.f}, a1 = {0.f, 0.f, 0.f, 0.f}; float ss = 0.f;
            const LAS bf16x8* wb = (const LAS bf16x8*)wl + kq * 16 + tok16;
#pragma unroll 4
            for (int s = 0; s < 32; ++s) {
                const u32x4 hv = *(const u32x4*)(hrow + 32 * s); const bf16x8 av = __builtin_bit_cast(bf16x8, hv);
#pragma unroll
                for (int e = 0; e < 4; ++e) { const float lo_ = bflo(hv[e]), hi_ = bfhi(hv[e]); ss += lo_ * lo_ + hi_ * hi_; }
                a0 = __builtin_amdgcn_mfma_f32_16x16x32_bf16(av, wb[((0 * 2 + 0) * 32 + s) * 64], a0, 0, 0, 0); a0 = __builtin_amdgcn_mfma_f32_16x16x32_bf16(av, wb[((1 * 2 + 0) * 32 + s) * 64], a0, 0, 0, 0);
                a1 = __builtin_amdgcn_mfma_f32_16x16x32_bf16(av, wb[((0 * 2 + 1) * 32 + s) * 64], a1, 0, 0, 0); a1 = __builtin_amdgcn_mfma_f32_16x16x32_bf16(av, wb[((1 * 2 + 1) * 32 + s) * 64], a1, 0, 0, 0);
            }
            ss += __shfl_xor(ss, 16); ss += __shfl_xor(ss, 32);
            if (kq == 0) ssb[F.wave * 16 + tok16] = ss;
#pragma unroll
            for (int r = 0; r < 4; ++r) { const int tk = F.wave * 16 + kq * 4 + r; lg[tk * 33 + tok16] = a0[r]; lg[tk * 33 + 16 + tok16] = a1[r]; }
            __syncthreads();
            int esel[4] = {0, 0, 0, 0}, rank[4] = {0, 0, 0, 0}; float gsel[4] = {0.f, 0.f, 0.f, 0.f}; float rstd = 0.f;
            if (F.tid < 128) {
                rstd = rsqrtf(ssb[F.tid] * (1.0f / DM) + RMS_EPS);
                float l[32];
#pragma unroll
                for (int e = 0; e < 32; ++e) l[e] = lg[F.tid * 33 + e] * rstd + P.b_router[e];
                float vs[4];
#pragma unroll
                for (int k = 0; k < 4; ++k) { float best = -INFINITY; int bi = 0;
#pragma unroll
                    for (int e = 0; e < 32; ++e) { const bool bt = l[e] > best; best = bt ? l[e] : best; bi = bt ? e : bi; }
                    vs[k] = best; esel[k] = bi;
#pragma unroll
                    for (int e = 0; e < 32; ++e) l[e] = (e == bi) ? -INFINITY : l[e]; }
                float den = 0.f;
#pragma unroll
                for (int k = 0; k < 4; ++k) { gsel[k] = __expf(vs[k] - vs[0]); den += gsel[k]; }
#pragma unroll
                for (int k = 0; k < 4; ++k) { gsel[k] /= den; rank[k] = atomicAdd((int*)&ecnt[esel[k]], 1); }
            }
            __syncthreads();
            if (F.tid < 32) ebase[F.tid] = (int)atomicAdd(ctl + CW_CNT + F.tid, (unsigned)ecnt[F.tid]);
            __syncthreads();
            if (F.tid < 128) { const int tok = tb * 128 + F.tid;
#pragma unroll
                for (int k = 0; k < 4; ++k) { const int e = esel[k], slot = ebase[e] + rank[k];
                    ltok[(size_t)e * CAP + slot] = tok; lrstd[(size_t)e * CAP + slot] = rstd; inv[tok * 4 + k] = (e << 16) | slot; gates[tok * 4 + k] = gsel[k]; } }
            __syncthreads();
        }
    }
    SEAM(5); STAMP();

    if (IN(6) || IN(7)) {
        F.refresh();
        LAS int* boff = (LAS int*)(F.lds + 131072); LAS int* cntl = boff + 64;
        if (F.tid < 64) {
            const int cn = (F.tid < 32) ? (int)ctl[CW_CNT + F.tid] : 0; const int nbk = (cn + 255) >> 8; int inc = nbk;
#pragma unroll
            for (int o = 1; o < 32; o <<= 1) { const int t = __shfl_up(inc, o); if (F.tid >= o) inc += t; }
            if (F.tid < 32) { cntl[F.tid] = cn; boff[F.tid] = inc - nbk; if (F.tid == 31) boff[32] = inc; } }
        __syncthreads();
        LAS unsigned* tokl = (LAS unsigned*)(F.lds + 131072 + 1024);
        LAS bf16_t* biasl = (LAS bf16_t*)(F.lds + 131072 + 1024 + 17408);
        if (IN(6)) {
            MoeOrder<8, true> S0{boff, cntl, tokl, F.G, F.vcu};
            { const int r = F.tid & 255; bool ok[9], inr[9]; unsigned tk[9]; float rs[9], bv[9];
#pragma unroll
              for (int p = 0; p < 9; ++p) { const int i = 2 * p + (F.tid >> 8); pg8::Unit u; u.e = 0; u.lb = 0; u.pn = 0;
                  ok[p] = i < 17 && S0.next(i, u);
                  const int slot = u.lb * 256 + r; inr[p] = ok[p] && slot < cntl[u.e]; const size_t si = inr[p] ? (size_t)u.e * CAP + slot : 0;
                  tk[p] = (unsigned)ltok[si]; rs[p] = lrstd[si];
                  const int pnl = u.pn - u.e * 8; bv[p] = P.b1[ok[p] ? (size_t)u.e * 2048 + ((r < 128) ? (pnl * 128 + r) : (1024 + pnl * 128 + r - 128)) : 0]; }
#pragma unroll
              for (int p = 0; p < 9; ++p) { const int i = 2 * p + (F.tid >> 8);
                  if (ok[p]) { tokl[i * 256 + r] = inr[p] ? (tk[p] | (cvtpk(0.f, rs[p]) & 0xffff0000u)) : 0u; biasl[i * 256 + r] = (bf16_t)(cvtpk(bv[p], bv[p]) & 0xffffu); } } }
            __syncthreads();
        }
        if (IN(6)) REP(6) {
        F.refresh();
            MoeOrder<8, true> S{boff, cntl, tokl, F.G, F.vcu};
            EpiMoe1 E{Hb, tokl, biasl};
            pg8::gemm_phase<EpiMoe1, MoeOrder<8, true>, true, true, 1>(F.lds, H1F8, W1T, DM, S, E);
        }
#if MK_DUP == 60
        if (IN(6)) { MoeOrder<8, true> S{boff, cntl, tokl, F.G, F.vcu}; EpiNull E{(float*)(ws + WS_GST)};
            pg8::gemm_phase<EpiNull, MoeOrder<8, true>, true, true, 1>(F.lds, H1F8, W1T, DM, S, E); }
#elif MK_DUP == 61
        if (IN(6)) { MoeOrder<8, false> S{boff, cntl, tokl, F.G, F.vcu}; EpiNull E{(float*)(ws + WS_GST)};
            pg8::gemm_phase<EpiNull, MoeOrder<8, false>, true, true, 1>(F.lds, H1F8, W1T, DM, S, E); }
#endif
        SEAM(6); STAMP();
        if (IN(7)) {
            __syncthreads();
            MoeOrder<4, false> S0{boff, cntl, tokl, F.G, F.vcu};
            { const int r = F.tid & 255; bool ok[5]; float bv[5];
#pragma unroll
              for (int p = 0; p < 5; ++p) { const int i = 2 * p + (F.tid >> 8); pg8::Unit u; u.e = 0; u.pn = 0;
                  ok[p] = i < 17 && S0.next(i, u); const int pnl = u.pn - u.e * 4; bv[p] = P.b2[ok[p] ? (size_t)u.e * DM + pnl * 256 + r : 0]; }
#pragma unroll
              for (int p = 0; p < 5; ++p) { const int i = 2 * p + (F.tid >> 8); if (ok[p]) biasl[i * 256 + r] = (bf16_t)(cvtpk(bv[p], bv[p]) & 0xffffu); } }
            __syncthreads();
        }
        if (IN(7)) REP(7) {
        F.refresh();
            MoeOrder<4, false> S{boff, cntl, tokl, F.G, F.vcu};
            EpiMoe2 E{Yb, biasl};
            pg8::gemm_phase<EpiMoe2, MoeOrder<4, false>, true, true, 1>(F.lds, Hb, W2T, DM, S, E);
        }
    }
    SEAM(7); STAMP();

    if (IN(8)) {
        F.refresh();
        LAS int* boff = (LAS int*)(F.lds + 131072);
        __syncthreads();
        if (F.tid < 64) {
            const int cn = (F.tid < 32) ? (int)ctl[CW_CNT + F.tid] : 0; const int nbk = (cn + 255) >> 8; int inc = nbk;
#pragma unroll
            for (int o = 1; o < 32; o <<= 1) { const int t = __shfl_up(inc, o); if (F.tid >= o) inc += t; }
            if (F.tid < 32) { boff[F.tid] = inc - nbk; if (F.tid == 31) boff[32] = inc; } }
        __syncthreads();
        const f32x4* gf = (const f32x4*)P.g_final;
        const f32x4 gfa = gf[2 * F.lane], gfb = gf[2 * F.lane + 1], gfc = gf[128 + 2 * F.lane], gfd = gf[128 + 2 * F.lane + 1];
        struct RowA { u32x4 iv; f32x4 gt; }; struct RowB { u32x4 ha, hb; u32x2 ya[4], yb[4]; };
#define P8_A(R, MM) do { R.iv = *(const u32x4*)(inv + (size_t)(MM) * 4); R.gt = *(const f32x4*)(gates + (size_t)(MM) * 4); } while (0)
#define P8_B(RB_, RA_, MM) do { RB_.ha = *(const u32x4*)(H1B + (size_t)(MM) * DM + 8 * F.lane); RB_.hb = *(const u32x4*)(H1B + (size_t)(MM) * DM + 512 + 8 * F.lane); \
            _Pragma("unroll") for (int k = 0; k < 4; ++k) { const int iv_ = (int)RA_.iv[k]; const size_t yrow = (size_t)boff[iv_ >> 16] * 256 + (iv_ & 0xffff); \
                RB_.ya[k] = *(const u32x2*)(Yb + yrow * DM + 8 * F.lane); RB_.yb[k] = *(const u32x2*)(Yb + yrow * DM + 512 + 8 * F.lane); } } while (0)
#define P8_C(RB_, RA_, MM) do { float v[16]; \
            _Pragma("unroll") for (int e = 0; e < 4; ++e) { v[2 * e] = bflo(RB_.ha[e]); v[2 * e + 1] = bfhi(RB_.ha[e]); v[8 + 2 * e] = bflo(RB_.hb[e]); v[8 + 2 * e + 1] = bfhi(RB_.hb[e]); } \
            _Pragma("unroll") for (int k = 0; k < 4; ++k) { const float gs = RA_.gt[k] * (1.0f / Y_SCALE); \
                _Pragma("unroll") for (int q = 0; q < 2; ++q) { const f32x2 a0 = __builtin_amdgcn_cvt_pk_f32_fp8((int)RB_.ya[k][q], false), a1 = __builtin_amdgcn_cvt_pk_f32_fp8((int)RB_.ya[k][q], true), b0 = __builtin_amdgcn_cvt_pk_f32_fp8((int)RB_.yb[k][q], false), b1 = __builtin_amdgcn_cvt_pk_f32_fp8((int)RB_.yb[k][q], true); \
                    v[4 * q] += gs * a0.x; v[4 * q + 1] += gs * a0.y; v[4 * q + 2] += gs * a1.x; v[4 * q + 3] += gs * a1.y; \
                    v[8 + 4 * q] += gs * b0.x; v[8 + 4 * q + 1] += gs * b0.y; v[8 + 4 * q + 2] += gs * b1.x; v[8 + 4 * q + 3] += gs * b1.y; } } \
            float ss = 0.f; _Pragma("unroll") for (int i_ = 0; i_ < 16; ++i_) ss += v[i_] * v[i_]; \
            const float rstd = rsqrtf(wave_sum_dpp(ss) * (1.0f / DM) + RMS_EPS); f32x4* op = (f32x4*)(P.out + (size_t)(MM) * DM); \
            op[2 * F.lane] = (f32x4){v[0], v[1], v[2], v[3]} * rstd * gfa; op[2 * F.lane + 1] = (f32x4){v[4], v[5], v[6], v[7]} * rstd * gfb; \
            op[128 + 2 * F.lane] = (f32x4){v[8], v[9], v[10], v[11]} * rstd * gfc; op[128 + 2 * F.lane + 1] = (f32x4){v[12], v[13], v[14], v[15]} * rstd * gfd; } while (0)
        RowA ra_[3]; RowB rb_[2];
        constexpr int NR8 = T / (256 * NWAVES);
        if (NGW == 256 * NWAVES) {
#pragma unroll
            for (int i = 0; i < NR8 + 2; ++i) {
                if (i < NR8) P8_A(ra_[i % 3], gw + i * NGW);
                if (i >= 1 && i < NR8 + 1) P8_B(rb_[(i - 1) & 1], ra_[(i - 1) % 3], gw + (i - 1) * NGW);
                if (i >= 2) P8_C(rb_[(i - 2) & 1], ra_[(i - 2) % 3], gw + (i - 2) * NGW);
            }
        } else {
            for (int m = gw; m < T; m += NGW) { P8_A(ra_[0], m); P8_B(rb_[0], ra_[0], m); P8_C(rb_[0], ra_[0], m); }
        }
#undef P8_A
#undef P8_B
#undef P8_C
    }
#if MK_DIAG
    STAMP();
    if (blockIdx.x == 0 && threadIdx.x == 0) { const unsigned long long* tstamp = (const unsigned long long*)(ctl + CW_DIAG + 16); asm volatile("s_waitcnt vmcnt(0)" ::: "memory"); const unsigned long long d = (MK_DIAG >= 10) ? (tstamp[9] - tstamp[0]) : (tstamp[MK_DIAG % 10] - tstamp[(MK_DIAG - 1) % 10]); __hip_atomic_store(ctl + CW_DIAG, (unsigned)d, __ATOMIC_RELAXED, __HIP_MEMORY_SCOPE_AGENT); }
    xcd_barrier(xbar);
#if MK_DIAG >= 21 && MK_DIAG <= 23
    { float us = (MK_DIAG == 21) ? (float)ctl[CW_DIAG + 2] * (1.0f / 256.0f) : (float)ctl[CW_DIAG + MK_DIAG - 19];
#elif MK_DIAG == 20
    { float us = 0.f; for (int u = 0; u < 1024; ++u) us += (float)(4 * (u & 31) + 4 - (int)ctl[CW_UTS + u]); us *= (1.0f / 256.0f);
#else
    { float us = (float)__hip_atomic_load(ctl + CW_DIAG, __ATOMIC_RELAXED, __HIP_MEMORY_SCOPE_AGENT) * 0.01f; us = exp2f(0.2f * rintf(log2f(fmaxf(us, 1.0f)) * 5.0f));
#endif
      const float c = sqrtf(us);
      for (size_t i = (size_t)blockIdx.x * NTHREADS + threadIdx.x; i < (size_t)T * DM; i += (size_t)F.G * NTHREADS) P.out[i] = c; }
#endif
#undef IN
#undef SEAM
}

extern "C" void kernel_launch(void* const* d_in, const int* in_sizes, int n_in, void* d_out, int out_size, void* d_ws, size_t ws_size, hipStream_t stream) {
    static int grid = 0;
    if (grid == 0) {
        if (n_in != 13 || in_sizes[0] != T * DM || out_size != T * DM || ws_size < WS_END) { fprintf(stderr, "kernel_launch: unexpected shapes (n_in %d, in0 %d, out %d, ws %zu)\n", n_in, n_in > 0 ? in_sizes[0] : -1, out_size, ws_size); grid = -1; return; }
        int dev = 0, cus = 0, per_cu = 0;
        if (hipGetDevice(&dev) != hipSuccess || hipDeviceGetAttribute(&cus, hipDeviceAttributeMultiprocessorCount, dev) != hipSuccess) { fprintf(stderr, "kernel_launch: device query failed\n"); grid = -1; return; }
        if (hipFuncSetAttribute((const void*)mk_fwd, hipFuncAttributeMaxDynamicSharedMemorySize, LDS_BYTES) != hipSuccess) { fprintf(stderr, "kernel_launch: hipFuncSetAttribute failed\n"); grid = -1; return; }
        if (hipOccupancyMaxActiveBlocksPerMultiprocessor(&per_cu, (const void*)mk_fwd, NTHREADS, LDS_BYTES) != hipSuccess || per_cu < 1) { fprintf(stderr, "kernel_launch: occupancy query says %d\n", per_cu); per_cu = 1; }
        (void)hipGetLastError();
        grid = cus * 1;
        if (grid != 256) fprintf(stderr, "kernel_launch: %d CUs (built for 256)\n", grid);
    }
    if (grid < 0) return;
#if MK_N_LAUNCHES != 1
    (void)hipMemsetAsync((char*)d_ws + WS_CTL, 0, CTL_BYTES, stream);
#endif
    Params p{};
    const float** pin = (const float**)&p;
    for (int i = 0; i < 13; ++i) pin[i] = (const float*)d_in[i];
    p.out = (float*)d_out; p.ws = (unsigned char*)d_ws;
#if MK_N_LAUNCHES == 1
    p.ph_lo = 0; p.ph_hi = 9;
    void* args[] = {&p};
    hipError_t e = hipLaunchCooperativeKernel((const void*)mk_fwd, dim3(grid), dim3(NTHREADS), args, LDS_BYTES, stream);
    if (e != hipSuccess) fprintf(stderr, "kernel_launch: cooperative launch failed: %s (grid %d)\n", hipGetErrorString(e), grid);
#else
    for (int k = 0; k < 9; ++k) { p.ph_lo = k; p.ph_hi = k + 1; hipLaunchKernelGGL(mk_fwd, dim3(grid), dim3(NTHREADS), LDS_BYTES, stream, p); }
#endif
}
```

```cpp
#include <hip/hip_runtime.h>
#include <hip/hip_cooperative_groups.h>
#include <cstdio>
#include <cstdint>
namespace cg = cooperative_groups;

#ifndef MK_N_LAUNCHES
#define MK_N_LAUNCHES 1
#endif
#ifndef MK_DUP
#define MK_DUP -1
#endif
#ifndef MK_DIAG
#define MK_DIAG 0
#endif

#define LAS __attribute__((address_space(3)))
#define GAS __attribute__((address_space(1)))
typedef unsigned short bf16_t;
typedef short bf16x8 __attribute__((ext_vector_type(8)));
typedef short s16x4 __attribute__((ext_vector_type(4)));
typedef float f32x2 __attribute__((ext_vector_type(2)));
typedef float f32x4 __attribute__((ext_vector_type(4)));
typedef float f32x16 __attribute__((ext_vector_type(16)));
typedef unsigned u32x2 __attribute__((ext_vector_type(2)));
typedef unsigned u32x4 __attribute__((ext_vector_type(4)));
typedef __bf16 bf16x2_t __attribute__((ext_vector_type(2)));

constexpr int BATCH = 4, SEQ = 8192, DM = 1024, T = BATCH * SEQ;
constexpr int RH = 4, RD = 128, FH = 8, FD = 64;
constexpr int NPROJ = 3584, INW = 3592;
constexpr int NE = 32, TOPK = 4, DFF = 1024;
constexpr int CAP = T;
constexpr int NBMAX = (T * TOPK) / 256 + NE;
constexpr float RMS_EPS = 1e-5f, GN_EPS = 1e-5f;
constexpr float LOG2E = 1.4426950408889634f;
constexpr float PRUNE_TH = 40.0f;
constexpr float C2 = 0.125f * 1.4426950408889634f;
constexpr int NTHREADS = 512, NWAVES = 8;

constexpr size_t MiB = 1u << 20;
constexpr size_t WS_CTL = 0, CTL_BYTES = 32768;
constexpr size_t WS_ROPEC = 1 * MiB, WS_ROPES = 3 * MiB;
constexpr size_t WS_WR3 = 5 * MiB;
constexpr size_t WS_LOGF = 6 * MiB;
constexpr size_t WS_F2 = 7 * MiB;
constexpr size_t WS_FA = 20 * MiB;
constexpr size_t WS_LTOK = 8 * MiB;
constexpr size_t WS_LRSTD = 12 * MiB;
constexpr size_t WS_INV = 16 * MiB;
constexpr size_t WS_GATE = 17 * MiB;
constexpr size_t WS_ONES = 19 * MiB;
constexpr size_t WS_IRS1 = 18 * MiB;
constexpr size_t WS_H1B = 32 * MiB;
constexpr size_t WS_WINT = 96 * MiB;
constexpr size_t WS_WOT = 104 * MiB;
constexpr size_t WS_W2T = 112 * MiB;
constexpr size_t WS_W1T = 144 * MiB;
constexpr size_t WS_H1F8 = 208 * MiB;
constexpr size_t WS_U = 448 * MiB;
constexpr size_t WS_PROJ = 512 * MiB;
constexpr size_t PROJ_STRIDE = 32 * MiB;
constexpr size_t WS_GST = 736 * MiB;
constexpr size_t WS_MIX = 752 * MiB;
constexpr size_t WS_H = 448 * MiB;
constexpr size_t WS_Y = 584 * MiB;
constexpr size_t WS_END = 856 * MiB;
constexpr float W_SCALE = 128.0f, H_SCALE = 4.0f, Y_SCALE = 16.0f, MIX_SCALE = 4.0f;
constexpr int CW_CNT = 0;
constexpr int CW_DIAG = 64;
constexpr int CW_QN2 = 128, CW_KN2 = 192;
constexpr int CW_BIN = 256;
constexpr int CW_QHEAD = 384;
constexpr int CW_SCAN = 448;
constexpr int CW_GDONE = 512;
constexpr int CW_UTS = 1024, CW_UPOS = 2048;
constexpr int CW_BAR = 4096;


constexpr int LDS_BYTES = 163840;
constexpr int LDS_MISC = LDS_BYTES - 16;

__device__ __forceinline__ unsigned cvtpk(float lo, float hi) { f32x2 v = {lo, hi}; bf16x2_t b = __builtin_convertvector(v, bf16x2_t); return __builtin_bit_cast(unsigned, b); }
__device__ __forceinline__ float bf2f(unsigned short h) { return __uint_as_float(((unsigned)h) << 16); }
__device__ __forceinline__ float bflo(unsigned w) { return __uint_as_float(w << 16); }
__device__ __forceinline__ float bfhi(unsigned w) { return __uint_as_float(w & 0xffff0000u); }
__device__ __forceinline__ float wave_sum(float v) {
#pragma unroll
    for (int o = 1; o < 64; o <<= 1) v += __shfl_xor(v, o);
    return v;
}
template <int CTRL> __device__ __forceinline__ float dpp_mov(float v) { return __int_as_float(__builtin_amdgcn_update_dpp(0, __float_as_int(v), CTRL, 0xF, 0xF, true)); }
__device__ __forceinline__ float row16_sum(float v) {
    v += dpp_mov<0xB1>(v);
    v += dpp_mov<0x4E>(v);
    v += dpp_mov<0x141>(v);
    v += dpp_mov<0x140>(v);
    return v; }
__device__ __forceinline__ float wave_sum_dpp(float v) {
    v = row16_sum(v);
    const float r0 = __int_as_float(__builtin_amdgcn_readlane(__float_as_int(v), 0)), r1 = __int_as_float(__builtin_amdgcn_readlane(__float_as_int(v), 16));
    const float r2 = __int_as_float(__builtin_amdgcn_readlane(__float_as_int(v), 32)), r3 = __int_as_float(__builtin_amdgcn_readlane(__float_as_int(v), 48));
    return (r0 + r1) + (r2 + r3); }
#define LDS_WAIT() asm volatile("s_waitcnt lgkmcnt(0)" ::: "memory")
#define VM_WAIT() asm volatile("s_waitcnt vmcnt(0)" ::: "memory")

struct Params {
    const float *x, *g_mix, *w_in, *b_forget, *w_out, *g_ffn, *w_router, *b_router, *w1, *b1, *w2, *b2, *g_final;
    float* out; unsigned char* ws; int ph_lo, ph_hi;
};

namespace pg8 {
constexpr int BM = 256, BK = 64, HALF = 128, HTB = HALF * BK * 2, STAGE_BYTES = 8 * HTB, NXCD = 8, WGM = 8;
__host__ __device__ __forceinline__ int lds_byte(int r, int c) { const int st = (r >> 4) * 2 + (c >> 5), rr = r & 15, cc = c & 31, ob = rr * 64 + cc * 2; return st * 1024 + (ob ^ (((ob >> 9) & 1) << 5)); }
__host__ __device__ __forceinline__ void stage_rc(int b, int& R, int& C) { const int st = b / 1024, sb = b % 1024, swz = sb ^ (((sb >> 9) & 1) << 5); R = (st >> 1) * 16 + swz / 64; C = (st & 1) * 32 + (swz % 64) / 2; }

struct Unit { int pm, pn, e, lb, idx; };

template <int NM, int NN>
struct DenseOrder {
    static constexpr int nM = NM, nN = NN, nwg = NM * NN;
    int G, c; int K; int dup; int i0, i1;
    __device__ void init(int M, int N, int K_, int G_, int c_, int dup_ = 1) { (void)M; (void)N; G = G_; c = c_; K = K_; dup = dup_; i0 = 0; i1 = 1 << 30; }
    __device__ __forceinline__ bool next(int i_, Unit& u) const {
        const int i = i_ + i0; if (i >= i1) return false;
        const int L = i * G + c; if (L >= nwg * dup) return false;
        int wgid = L % nwg; { constexpr int q = nwg / NXCD, r = nwg % NXCD; const int xcd = wgid % NXCD, off = wgid / NXCD; wgid = (xcd < r ? xcd * (q + 1) : r * (q + 1) + (xcd - r) * q) + off; }
        static_assert(NM % WGM == 0, "row-tile groups are full");
        constexpr int nig = WGM * nN; const int gid = wgid / nig, fm = gid * WGM;
        u.pm = fm + ((wgid % nig) % WGM); u.pn = (wgid % nig) / WGM; u.e = 0; u.lb = 0; u.idx = i; return true;
    }
    __device__ __forceinline__ void aoffs(const Unit& u, unsigned (&ao)[2][2], const int (&R)[2], const int (&C)[2], int rowbytes) const {
#pragma unroll
        for (int h = 0; h < 2; ++h)
#pragma unroll
            for (int i = 0; i < 2; ++i) ao[h][i] = (unsigned)((u.pm * BM + h * HALF + R[i]) * rowbytes + C[i] * 2);
    }
};

typedef int v8i32 __attribute__((ext_vector_type(8)));
typedef int v4i32 __attribute__((ext_vector_type(4)));
template <class Epi, class Sched, bool ALIGN_EPI, bool SP2, int ES>
__device__ __forceinline__ void gemm_phase(LAS unsigned char* lds, const void* Abase, const void* Btbase, const int K, const Sched& S, const Epi& E) {
    const int tid = threadIdx.x, wid = __builtin_amdgcn_readfirstlane(tid >> 6), lane = tid & 63, wr = wid >> 2, wc = wid & 3, fr = lane & 15, fq = lane >> 4;
    const int rowbytes = K * ES;
    const int nt = rowbytes / 128;
    int RR[2], CC[2]; unsigned voffB[2];
#pragma unroll
    for (int i = 0; i < 2; ++i) { stage_rc(tid * 16 + i * 8192, RR[i], CC[i]); voffB[i] = (unsigned)(RR[i] * rowbytes + CC[i] * 2); }
    const size_t kstep = (size_t)128;
    const size_t hstep = (size_t)HALF * rowbytes;
    const size_t tstep = 2 * hstep;
    const unsigned ldsw = (unsigned)wid * 1024u;
    const int aoff = lds_byte(wr * 64 + fr, fq * 8), boff = lds_byte(wc * 32 + fr, fq * 8);
    const char* Ab = (const char*)Abase;
#define PG8_SA(b, h) (((b) * 2 + (h)) * HTB)
#define PG8_SB(b, h) ((4 + (b) * 2 + (h)) * HTB)
#define PG8_STAGE(bufoff, gbase, voff) do { _Pragma("unroll") for (int _i = 0; _i < 2; ++_i) \
        __builtin_amdgcn_global_load_lds((const unsigned*)((const char*)(gbase) + (voff)[_i]), (LAS unsigned*)(lds + (bufoff) + ldsw + _i * 8192), 16, 0, 0); } while (0)
#define PG8_STAGE_A(bufoff, kb, AO, h) do { _Pragma("unroll") for (int _i = 0; _i < 2; ++_i) \
        __builtin_amdgcn_global_load_lds((const unsigned*)(Ab + (kb) + (AO)[h][_i]), (LAS unsigned*)(lds + (bufoff) + ldsw + _i * 8192), 16, 0, 0); } while (0)
#define PG8_LDA(dst, b, h) do { _Pragma("unroll") for (int m = 0; m < 4; ++m) _Pragma("unroll") for (int k = 0; k < 2; ++k) dst[m][k] = *(const LAS bf16x8*)(lds + PG8_SA(b, h) + aoff + m * 2048 + k * 1024); } while (0)
#define PG8_LDB(dst, b, h) do { _Pragma("unroll") for (int n = 0; n < 2; ++n) _Pragma("unroll") for (int k = 0; k < 2; ++k) dst[n][k] = *(const LAS bf16x8*)(lds + PG8_SB(b, h) + boff + n * 2048 + k * 1024); } while (0)
#define PG8_F8(x) __builtin_shufflevector(__builtin_bit_cast(v4i32, (x)[0]), __builtin_bit_cast(v4i32, (x)[1]), 0, 1, 2, 3, 4, 5, 6, 7)
#define PG8_MMA(ai, bj, At, Bt) do { __builtin_amdgcn_s_setprio(1); _Pragma("unroll") for (int m = 0; m < 4; ++m) _Pragma("unroll") for (int n = 0; n < 2; ++n) { \
        if constexpr (ES == 2) { _Pragma("unroll") for (int k = 0; k < 2; ++k) acc[ai][bj][m][n] = __builtin_amdgcn_mfma_f32_16x16x32_bf16(Bt[n][k], At[m][k], acc[ai][bj][m][n], 0, 0, 0); } \
        else asm volatile("v_mfma_f32_16x16x128_f8f6f4 %0, %1, %2, %0" : "+v"(acc[ai][bj][m][n]) : "v"(PG8_F8(Bt[n])), "v"(PG8_F8(At[m]))); } \
        __builtin_amdgcn_s_setprio(0); } while (0)
#define PG8_WAIT_V(n) asm volatile("s_waitcnt vmcnt(" #n ")" ::: "memory")
#define PG8_WAIT_L(n) asm volatile("s_waitcnt lgkmcnt(" #n ")" ::: "memory")
#define PG8_BAR __builtin_amdgcn_s_barrier()
#define PG8_SCHED __builtin_amdgcn_sched_barrier(0)
    Unit cur, nxt; int ui = 0;
    if (!S.next(0, cur)) return;
    f32x4 acc[2][2][4][2];
#define PG8_ZERO() do { _Pragma("unroll") for (int a = 0; a < 2; ++a) _Pragma("unroll") for (int b = 0; b < 2; ++b) _Pragma("unroll") for (int m = 0; m < 4; ++m) _Pragma("unroll") for (int n = 0; n < 2; ++n) { \
        f32x2 z0_, z1_; asm volatile("v_mov_b64 %0, 0" : "=v"(z0_)); asm volatile("v_mov_b64 %0, 0" : "=v"(z1_)); acc[a][b][m][n] = (f32x4){z0_.x, z0_.y, z1_.x, z1_.y}; } } while (0)
    PG8_ZERO();
    bf16x8 At[4][2], B0[2][2], B1[2][2];
    unsigned aoC[2][2], aoN[2][2];
    S.aoffs(cur, aoC, RR, CC, rowbytes);
    const char* cB = (const char*)Btbase + (size_t)cur.pn * tstep;
    static_assert(SP2, "only the SP2 loop is kept");
    PG8_STAGE(PG8_SB(0, 0), cB, voffB); PG8_STAGE(PG8_SB(0, 1), cB + hstep, voffB); PG8_STAGE_A(PG8_SA(0, 0), 0, aoC, 0); PG8_STAGE_A(PG8_SA(0, 1), 0, aoC, 1);
    if (wr == 1) PG8_BAR;
    PG8_WAIT_V(2); PG8_BAR;
    PG8_STAGE(PG8_SB(1, 0), cB + kstep, voffB); PG8_STAGE_A(PG8_SA(1, 0), kstep, aoC, 0); PG8_STAGE(PG8_SB(1, 1), cB + hstep + kstep, voffB);
    PG8_WAIT_V(6); PG8_BAR;
    for (;;) {
        const bool has_next = S.next(ui + 1, nxt);
        if (has_next) S.aoffs(nxt, aoN, RR, CC, rowbytes);
        else {
#pragma unroll
            for (int h = 0; h < 2; ++h)
#pragma unroll
                for (int i = 0; i < 2; ++i) aoN[h][i] = aoC[h][i];
        }
        const char* nB = has_next ? (const char*)Btbase + (size_t)nxt.pn * tstep : cB;
#pragma unroll 1
        for (int t = 0; t < nt; t += 2) {
            const bool last = (t == nt - 2);
            const size_t kb1 = (size_t)(t + 1) * kstep;
            const size_t kb2 = last ? 0 : (size_t)(t + 2) * kstep, kb3 = kb2 + kstep;
            unsigned ao2[2][2];
#pragma unroll
            for (int h = 0; h < 2; ++h)
#pragma unroll
                for (int i = 0; i < 2; ++i) ao2[h][i] = last ? aoN[h][i] : aoC[h][i];
            const char* b2 = last ? nB : cB + (size_t)(t + 2) * kstep;
            const char* b3 = b2 + kstep;
            PG8_LDB(B0, 0, 0); PG8_LDB(B1, 0, 1); PG8_SCHED; PG8_LDA(At, 0, 0); PG8_STAGE_A(PG8_SA(1, 1), kb1, aoC, 1);
            PG8_WAIT_V(8); PG8_WAIT_L(0); PG8_BAR; PG8_MMA(0, 0, At, B0); PG8_MMA(0, 1, At, B1); PG8_BAR; PG8_SCHED;
            PG8_LDA(At, 0, 1); PG8_STAGE(PG8_SB(0, 0), b2, voffB); PG8_STAGE(PG8_SB(0, 1), b2 + hstep, voffB); PG8_STAGE_A(PG8_SA(0, 0), kb2, ao2, 0);
            PG8_WAIT_V(8); PG8_WAIT_L(0); PG8_BAR; PG8_MMA(1, 0, At, B0); PG8_MMA(1, 1, At, B1); PG8_BAR; PG8_SCHED;
            PG8_LDB(B0, 1, 0); PG8_LDB(B1, 1, 1); PG8_SCHED; PG8_LDA(At, 1, 0); PG8_STAGE_A(PG8_SA(0, 1), kb2, ao2, 1);
            PG8_WAIT_V(8); PG8_WAIT_L(0); PG8_BAR; PG8_MMA(0, 0, At, B0); PG8_MMA(0, 1, At, B1); PG8_BAR; PG8_SCHED;
            PG8_LDA(At, 1, 1); PG8_STAGE(PG8_SB(1, 0), b3, voffB); PG8_STAGE(PG8_SB(1, 1), b3 + hstep, voffB); PG8_STAGE_A(PG8_SA(1, 0), kb3, ao2, 0);
            PG8_WAIT_V(8); PG8_WAIT_L(0); PG8_BAR; PG8_MMA(1, 0, At, B0); PG8_MMA(1, 1, At, B1); PG8_BAR; PG8_SCHED;
        }
        if constexpr (ALIGN_EPI) { if (wr == 0) PG8_BAR; }
        if constexpr (ES == 1) asm volatile("s_nop 15\n\ts_nop 15" ::: "memory");
        E(acc, cur, wr, wc, fr, fq);
        if (!has_next) break;
        PG8_ZERO();
        cur = nxt; cB = nB; ++ui;
#pragma unroll
        for (int h = 0; h < 2; ++h)
#pragma unroll
            for (int i = 0; i < 2; ++i) aoC[h][i] = aoN[h][i];
        if constexpr (ALIGN_EPI) { if (wr == 1) PG8_BAR; }
    }
    PG8_WAIT_V(0);
    if constexpr (!ALIGN_EPI) { if (wr == 0) PG8_BAR; }
    PG8_BAR;
#undef PG8_ZERO
#undef PG8_SA
#undef PG8_SB
#undef PG8_STAGE
#undef PG8_STAGE_A
#undef PG8_LDA
#undef PG8_LDB
#undef PG8_MMA
#undef PG8_F8
#undef PG8_WAIT_V
#undef PG8_WAIT_L
#undef PG8_BAR
#undef PG8_SCHED
}
}


__device__ __forceinline__ int perm32_pos(int t) { return 16 * ((t >> 2) & 1) + 4 * ((t >> 3) & 3) + (t & 3); }
__device__ __forceinline__ int pos_inproj(int c) {
    if (c < 1024) { const int hc = c & 127; return (c & ~127) | (32 * ((hc >> 4) & 3) + 16 * (hc >> 6) + (hc & 15)); }
    return (c & ~31) | perm32_pos(c & 31);
}
__device__ __forceinline__ int pos_plain(int c) { return (c & ~31) | perm32_pos(c & 31); }
__device__ __forceinline__ int pos_wide(int c) { const int t = c & 255; return (c & ~255) | (128 * ((t >> 3) & 1) + 32 * (t >> 6) + 16 * ((t >> 2) & 1) + 4 * ((t >> 4) & 3) + (t & 3)); }
__device__ __forceinline__ int pos_w1(int n) { const int jj = n & 1023, lin = n >> 10, pn = jj >> 7, tp = jj & 127; return pn * 256 + lin * 128 + ((tp & ~31) | perm32_pos(tp & 31)); }

struct EpiInProj {
    unsigned char* proj; const float* ropec; const float* ropes; unsigned* ctl;
    __device__ __forceinline__ void operator()(const f32x4 (&acc)[2][2][4][2], const pg8::Unit& u, int wr, int wc, int fr, int fq) const {
        const int type = u.pn >> 1; bf16_t* base = (bf16_t*)(proj + (size_t)type * PROJ_STRIDE);
        const int colh = (u.pn & 1) * 256;
        if (type < 2) {
            const float sc = (type == 1) ? 0.08838834764831845f : 1.0f;
            const int i0 = 16 * wc + 4 * fq;
#pragma unroll
            for (int ai = 0; ai < 2; ++ai)
#pragma unroll
                for (int m = 0; m < 4; ++m) {
                    const int row = u.pm * 256 + ai * 128 + wr * 64 + m * 16 + fr; const int pos = row & (SEQ - 1);
                    const f32x4 cs = *(const f32x4*)(ropec + pos * 64 + i0), sn = *(const f32x4*)(ropes + pos * 64 + i0);
#pragma unroll
                    for (int bj = 0; bj < 2; ++bj) {
                        const f32x4 x1 = acc[ai][bj][m][0], x2 = acc[ai][bj][m][1];
                        const f32x4 o1 = (x1 * cs - x2 * sn) * sc, o2 = (x1 * sn + x2 * cs) * sc;
                        bf16_t* dst = base + (size_t)row * 512 + colh + bj * 128 + i0;
                        u32x2 w1, w2; w1.x = cvtpk(o1[0], o1[1]); w1.y = cvtpk(o1[2], o1[3]); w2.x = cvtpk(o2[0], o2[1]); w2.y = cvtpk(o2[2], o2[3]);
                        *(u32x2*)dst = w1; *(u32x2*)(dst + 64) = w2;
                    }
                }
        } else {
            const float sc = (type == 4) ? C2 : 1.0f;
            float mx[2] = {0.f, 0.f};
#pragma unroll
            for (int ai = 0; ai < 2; ++ai)
#pragma unroll
                for (int m = 0; m < 4; ++m) {
                    const int row = u.pm * 256 + ai * 128 + wr * 64 + m * 16 + fr;
#pragma unroll
                    for (int bj = 0; bj < 2; ++bj) {
                        f32x4 v0 = acc[ai][bj][m][0] * sc, v1 = acc[ai][bj][m][1] * sc;
                        if (type == 4 || type == 5) { float ssq = (v0[0] * v0[0] + v0[1] * v0[1]) + (v0[2] * v0[2] + v0[3] * v0[3]) + (v1[0] * v1[0] + v1[1] * v1[1]) + (v1[2] * v1[2] + v1[3] * v1[3]);
                            { auto r16 = __builtin_amdgcn_permlane16_swap(__float_as_uint(ssq), __float_as_uint(ssq), false, false); ssq = __uint_as_float(r16[0]) + __uint_as_float(r16[1]);
                              auto r32 = __builtin_amdgcn_permlane32_swap(__float_as_uint(ssq), __float_as_uint(ssq), false, false); ssq = __uint_as_float(r32[0]) + __uint_as_float(r32[1]); }
                            mx[bj] = fmaxf(mx[bj], ssq); }
                        if (type == 3) {
#pragma unroll
                            for (int j = 0; j < 4; ++j) { v0[j] = v0[j] * __builtin_amdgcn_rcpf(1.0f + __builtin_amdgcn_exp2f(-LOG2E * v0[j])); v1[j] = v1[j] * __builtin_amdgcn_rcpf(1.0f + __builtin_amdgcn_exp2f(-LOG2E * v1[j])); }
                        }
                        u32x4 w; w.x = cvtpk(v0[0], v0[1]); w.y = cvtpk(v0[2], v0[3]); w.z = cvtpk(v1[0], v1[1]); w.w = cvtpk(v1[2], v1[3]);
                        __builtin_nontemporal_store(w, (u32x4*)(base + (size_t)row * 512 + colh + bj * 128 + wc * 32 + 8 * fq));
                    }
                }
            if (type == 4 || type == 5) {
#pragma unroll
                for (int bj = 0; bj < 2; ++bj) { float v = mx[bj]; v = fmaxf(v, __shfl_xor(v, 1)); v = fmaxf(v, __shfl_xor(v, 2)); v = fmaxf(v, __shfl_xor(v, 4)); v = fmaxf(v, __shfl_xor(v, 8));
                    if ((threadIdx.x & 63) == 0) { const int bh = (u.pm >> 5) * 8 + (u.pn & 1) * 4 + bj * 2 + (wc >> 1);
                        atomicMax(ctl + ((type == 4) ? CW_QN2 : CW_KN2) + bh * 2 + (wc & 1), __float_as_uint(v)); } }
            }
        }
    }
};

__device__ __forceinline__ unsigned pk4_fp8(float a, float b, float c, float d) { int w = 0; w = __builtin_amdgcn_cvt_pk_fp8_f32(a, b, w, false); w = __builtin_amdgcn_cvt_pk_fp8_f32(c, d, w, true); return (unsigned)w; }
struct EpiOutProj {
    const bf16_t* U; const float* irs1; const float* g_mix; bf16_t* h1b; unsigned char* h1f8;
    __device__ __forceinline__ void operator()(const f32x4 (&acc)[2][2][4][2], const pg8::Unit& u, int wr, int wc, int fr, int fq) const {
        const int col = u.pn * 256 + 64 * wc + 16 * fq;
        f32x4 gi[2][2];
#pragma unroll
        for (int q = 0; q < 4; ++q) { f32x4 g = *(const f32x4*)(g_mix + col + 4 * q);
#pragma unroll
            for (int j = 0; j < 4; ++j) g[j] = __builtin_amdgcn_rcpf(g[j]);
            gi[q >> 1][q & 1] = g; }
#pragma unroll
        for (int ai = 0; ai < 2; ++ai) {
            u32x4 uw[4][2]; float ir[4];
#pragma unroll
            for (int m = 0; m < 4; ++m) { const int row = u.pm * 256 + ai * 128 + wr * 64 + m * 16 + fr; ir[m] = irs1[row];
                uw[m][0] = *(const u32x4*)(U + (size_t)row * DM + col); uw[m][1] = *(const u32x4*)(U + (size_t)row * DM + col + 8); }
#pragma unroll
            for (int m = 0; m < 4; ++m) {
                const int row = u.pm * 256 + ai * 128 + wr * 64 + m * 16 + fr; const float s = ir[m]; u32x4 wf8;
#pragma unroll
                for (int bj = 0; bj < 2; ++bj) { const u32x4 w4 = uw[m][bj];
                    const f32x4 xa = {bflo(w4.x), bfhi(w4.x), bflo(w4.y), bfhi(w4.y)}, xb = {bflo(w4.z), bfhi(w4.z), bflo(w4.w), bfhi(w4.w)};
                    const f32x4 v0 = acc[ai][bj][m][0] * (1.0f / (MIX_SCALE * W_SCALE)) + xa * gi[bj][0] * s, v1 = acc[ai][bj][m][1] * (1.0f / (MIX_SCALE * W_SCALE)) + xb * gi[bj][1] * s;
                    u32x4 w; w.x = cvtpk(v0[0], v0[1]); w.y = cvtpk(v0[2], v0[3]); w.z = cvtpk(v1[0], v1[1]); w.w = cvtpk(v1[2], v1[3]);
                    *(u32x4*)(h1b + (size_t)row * DM + col + 8 * bj) = w;
                    wf8[2 * bj] = pk4_fp8(v0[0], v0[1], v0[2], v0[3]); wf8[2 * bj + 1] = pk4_fp8(v1[0], v1[1], v1[2], v1[3]); }
                *(u32x4*)(h1f8 + (size_t)row * DM + col) = wf8;
            }
            asm volatile("" ::: "memory");
        }
    }
};

struct EpiMoe1 {
    unsigned char* H; const LAS unsigned* tokr; const LAS bf16_t* biasl;
    __device__ __forceinline__ void operator()(const f32x4 (&acc)[2][2][4][2], const pg8::Unit& u, int wr, int wc, int fr, int fq) const {
        const int e = u.e, pnl = u.pn - e * 8; const int cl = wc * 32 + 8 * fq, cq = pnl * 128 + cl;
        const u32x4 bgw = *(const LAS u32x4*)(biasl + u.idx * 256 + cl), blw = *(const LAS u32x4*)(biasl + u.idx * 256 + 128 + cl);
        constexpr float K1 = 1.702f * LOG2E;
        const f32x4 bg0 = (f32x4){bflo(bgw.x), bfhi(bgw.x), bflo(bgw.y), bfhi(bgw.y)} * K1, bg1 = (f32x4){bflo(bgw.z), bfhi(bgw.z), bflo(bgw.w), bfhi(bgw.w)} * K1;
        const f32x4 bl0 = {bflo(blw.x), bfhi(blw.x), bflo(blw.y), bfhi(blw.y)}, bl1 = {bflo(blw.z), bfhi(blw.z), bflo(blw.w), bfhi(blw.w)};
#pragma unroll
        for (int ai = 0; ai < 2; ++ai)
#pragma unroll
            for (int m = 0; m < 4; ++m) {
                const int rt = ai * 128 + wr * 64 + m * 16 + fr;
                const float rs = bfhi(tokr[u.idx * 256 + rt]) * (1.0f / W_SCALE);
                const float rk = rs * K1; float o[8];
                const f32x2 rk2 = {rk, rk}, rs2 = {rs, rs}, hk2 = {H_SCALE / K1, H_SCALE / K1}, one2 = {1.0f, 1.0f};
#pragma unroll
                for (int hh = 0; hh < 2; ++hh)
#pragma unroll
                    for (int jp = 0; jp < 2; ++jp) {
                        const f32x4 ag = acc[ai][0][m][hh], al = acc[ai][1][m][hh], bgv = hh ? bg1 : bg0, blv = hh ? bl1 : bl0;
                        const f32x2 ag2 = {ag[2 * jp], ag[2 * jp + 1]}, al2 = {al[2 * jp], al[2 * jp + 1]}, bg2 = {bgv[2 * jp], bgv[2 * jp + 1]}, bl2 = {blv[2 * jp], blv[2 * jp + 1]};
                        f32x2 gk = __builtin_elementwise_fma(ag2, rk2, bg2);
                        gk.x = __builtin_fminf(gk.x, 7.0f * K1); gk.y = __builtin_fminf(gk.y, 7.0f * K1);
                        f32x2 ex = {__builtin_amdgcn_exp2f(-gk.x), __builtin_amdgcn_exp2f(-gk.y)};
                        ex = ex + one2;
                        const f32x2 rc = {__builtin_amdgcn_rcpf(ex.x), __builtin_amdgcn_rcpf(ex.y)};
                        const f32x2 sg = gk * rc;
                        f32x2 l = __builtin_elementwise_fma(al2, rs2, bl2);
                        l.x = __builtin_fminf(__builtin_fmaxf(l.x, -7.0f), 7.0f); l.y = __builtin_fminf(__builtin_fmaxf(l.y, -7.0f), 7.0f);
                        const f32x2 ov = sg * __builtin_elementwise_fma(l, hk2, hk2);
                        o[4 * hh + 2 * jp] = ov.x; o[4 * hh + 2 * jp + 1] = ov.y;
                    }
                u32x2 w; w.x = pk4_fp8(o[0], o[1], o[2], o[3]); w.y = pk4_fp8(o[4], o[5], o[6], o[7]);
                *(u32x2*)(H + (size_t)(u.pm * 256 + rt) * DFF + cq) = w;
            }
    }
};

struct EpiNull { float* sink;
    __device__ __forceinline__ void operator()(const f32x4 (&acc)[2][2][4][2], const pg8::Unit& u, int wr, int wc, int fr, int fq) const {
        float s = 0.f;
#pragma unroll
        for (int ai = 0; ai < 2; ++ai)
#pragma unroll
            for (int bj = 0; bj < 2; ++bj)
#pragma unroll
                for (int m = 0; m < 4; ++m)
#pragma unroll
                    for (int n = 0; n < 2; ++n) s += acc[ai][bj][m][n][0];
        if (s == 123.456f) sink[0] = s;
    }
};
struct EpiMoe2 {
    unsigned char* Y; const LAS bf16_t* biasl;
    __device__ __forceinline__ void operator()(const f32x4 (&acc)[2][2][4][2], const pg8::Unit& u, int wr, int wc, int fr, int fq) const {
        const int e = u.e, pnl = u.pn - e * 4; const int cl = 64 * wc + 16 * fq, col = pnl * 256 + cl;
        const u32x4 bw0 = *(const LAS u32x4*)(biasl + u.idx * 256 + cl), bw1 = *(const LAS u32x4*)(biasl + u.idx * 256 + cl + 8);
        f32x4 bb[2][2];
        bb[0][0] = (f32x4){bflo(bw0.x), bfhi(bw0.x), bflo(bw0.y), bfhi(bw0.y)} * Y_SCALE; bb[0][1] = (f32x4){bflo(bw0.z), bfhi(bw0.z), bflo(bw0.w), bfhi(bw0.w)} * Y_SCALE;
        bb[1][0] = (f32x4){bflo(bw1.x), bfhi(bw1.x), bflo(bw1.y), bfhi(bw1.y)} * Y_SCALE; bb[1][1] = (f32x4){bflo(bw1.z), bfhi(bw1.z), bflo(bw1.w), bfhi(bw1.w)} * Y_SCALE;
#pragma unroll
        for (int ai = 0; ai < 2; ++ai)
#pragma unroll
            for (int m = 0; m < 4; ++m) {
                const int rt = ai * 128 + wr * 64 + m * 16 + fr; u32x4 w;
#pragma unroll
                for (int bj = 0; bj < 2; ++bj) { const f32x4 v0 = acc[ai][bj][m][0] * (Y_SCALE / (W_SCALE * H_SCALE)) + bb[bj][0], v1 = acc[ai][bj][m][1] * (Y_SCALE / (W_SCALE * H_SCALE)) + bb[bj][1];
                    w[2 * bj] = pk4_fp8(v0[0], v0[1], v0[2], v0[3]); w[2 * bj + 1] = pk4_fp8(v1[0], v1[1], v1[2], v1[3]); }
                *(u32x4*)(Y + (size_t)(u.pm * 256 + rt) * DM + col) = w;
            }
    }
};

template <int NT, bool GATHER>
struct MoeOrder {
    const LAS int* boff;
    const LAS int* cntl;
    const LAS unsigned* tokl;
    int G, vcu;
    __device__ __forceinline__ bool next(int i, pg8::Unit& u) const {
        int x, j, rpb;
        if (G == 256) { x = vcu >> 5; j = vcu & 31; rpb = 32 / NT; }
        else { const int cpx = G >> 3; x = vcu / cpx; j = vcu % cpx; rpb = cpx / NT; }
        const int rb = (i * 8 + x) * rpb + j / NT; const int nb = boff[32];
        if (rb >= nb) return false;
        const int bk = boff[__lane_id() & 31]; const int e = __builtin_popcount((unsigned)__ballot(bk <= rb)) - 1;
        u.pm = rb; u.e = e; u.lb = rb - boff[e]; u.pn = e * NT + (j % NT); u.idx = i; return true;
    }
    __device__ __forceinline__ void aoffs(const pg8::Unit& u, unsigned (&ao)[2][2], const int (&R)[2], const int (&C)[2], int rowbytes) const {
#pragma unroll
        for (int h = 0; h < 2; ++h)
#pragma unroll
            for (int i = 0; i < 2; ++i) {
                if constexpr (GATHER) {
                    const int tok = (int)(tokl[u.idx * 256 + h * 128 + R[i]] & 0xffffu);
                    ao[h][i] = (unsigned)(tok * rowbytes + C[i] * 2);
                } else ao[h][i] = (unsigned)((u.pm * 256 + h * 128 + R[i]) * rowbytes + C[i] * 2);
            }
    }
};

namespace attn_body {
constexpr int NHEAD = FH, D = 64, PQ = 512, PO = 1024;
constexpr int NW = 8, QBLK = 32, QB = QBLK * NW, KVBLK = 64, NQB = SEQ / QB;
__device__ __forceinline__ int crow(int r, int hi) { return (r & 3) + 8 * (r >> 2) + 4 * hi; }
#define SBAR() __builtin_amdgcn_sched_barrier(0)
__device__ __forceinline__ void cmask(f32x16& p0, f32x16& p1, int jb, int qrel, int hi) {
    const float NEG = -INFINITY; int kb = 64 * jb + 4 * hi;
#pragma unroll
    for (int r = 0; r < 16; ++r) { int kv = kb + (r & 3) + 8 * (r >> 2); if (kv > qrel) p0[r] = NEG; if (kv + 32 > qrel) p1[r] = NEG; }
}
constexpr int NSLOT = 3, SLOTB = 8192;
constexpr int LDS_K = 0, LDS_V = NSLOT * SLOTB, LDS_WS = 2 * NSLOT * SLOTB, LDS_OST = LDS_WS + NW * 64 * 4, LDS_END = LDS_OST + NW * 4096;
constexpr int LDS_STOP = 156672;
constexpr int LDS_QUEUE = 151552;
constexpr int LDS_F = 86016, LDS_F_BYTES = SEQ * 8;
static_assert(LDS_F >= LDS_END + 512 && LDS_F + LDS_F_BYTES <= LDS_QUEUE && LDS_QUEUE + 4608 <= LDS_STOP && LDS_STOP + 32 <= LDS_BYTES - 16, "attention LDS map");
__device__ __forceinline__ void glds16(const void* gsrc, unsigned lds_dst) { unsigned keep;
    asm volatile("s_mov_b32 %0, m0\n\ts_mov_b32 m0, %2\n\ts_nop 0\n\tglobal_load_lds_dwordx4 %1, off\n\ts_mov_b32 m0, %0" : "=&s"(keep) : "v"(gsrc), "s"(lds_dst) : "memory"); }
__device__ __forceinline__ float max3f(float a, float b, float c) { float r; asm("v_max3_f32 %0, %1, %2, %3" : "=v"(r) : "v"(a), "v"(b), "v"(c)); return r; }
__device__ __forceinline__ float max2f(float a, float b) { float r; asm("v_max_f32_e32 %0, %1, %2" : "=v"(r) : "v"(a), "v"(b)); return r; }
__device__ __forceinline__ float fadd_s(float a, float b) { float r; asm("v_add_f32_e32 %0, %1, %2" : "=v"(r) : "v"(a), "v"(b)); return r; }
__device__ __forceinline__ float fsub_s(float a, float b) { float r; asm("v_sub_f32_e32 %0, %1, %2" : "=v"(r) : "v"(a), "v"(b)); return r; }
#define WAIT_BAR(N) asm volatile("s_waitcnt vmcnt(" #N ") lgkmcnt(0)\n\ts_barrier" ::: "memory")

typedef LAS const char* lds_cptr;
typedef short v4i16_t __attribute__((ext_vector_type(4)));
__device__ __forceinline__ void kload8(bf16x8* kf, lds_cptr kp) {
    kf[0] = *(const LAS bf16x8*)(kp);        kf[1] = *(const LAS bf16x8*)(kp + 512);
    kf[2] = *(const LAS bf16x8*)(kp + 2048); kf[3] = *(const LAS bf16x8*)(kp + 2560);
    kf[4] = *(const LAS bf16x8*)(kp + 4096); kf[5] = *(const LAS bf16x8*)(kp + 4608);
    kf[6] = *(const LAS bf16x8*)(kp + 6144); kf[7] = *(const LAS bf16x8*)(kp + 6656);
}
__device__ __forceinline__ void kload2(bf16x8* kf, lds_cptr kp, int j) { kf[2 * j] = *(const LAS bf16x8*)(kp + j * 2048); kf[2 * j + 1] = *(const LAS bf16x8*)(kp + j * 2048 + 512); }
__device__ __forceinline__ s16x4 vtr(lds_cptr p) { return __builtin_bit_cast(s16x4, __builtin_amdgcn_ds_read_tr16_b64_v4i16((LAS v4i16_t*)p)); }
__device__ __forceinline__ float rowmax(const f32x16& p0, const f32x16& p1) {
    float a = max3f(p0[0], p0[1], p1[0]), b = max3f(p0[2], p0[3], p1[1]); a = max3f(a, p1[2], p1[3]);
#pragma unroll
    for (int r = 4; r < 16; r += 4) { a = max3f(a, p0[r], p0[r + 1]); b = max3f(b, p0[r + 2], p0[r + 3]); a = max3f(a, p1[r], p1[r + 1]); b = max3f(b, p1[r + 2], p1[r + 3]); }
    const float m = max2f(a, b);
    auto rr = __builtin_amdgcn_permlane32_swap(__float_as_uint(m), __float_as_uint(m), false, false);
    return max2f(__uint_as_float(rr[0]), __uint_as_float(rr[1]));
}
__device__ __forceinline__ void pv(f32x16* o, int vb, bf16x8 pa0, bf16x8 pa1, bf16x8 pa2, bf16x8 pa3) {
#pragma unroll
    for (int d0 = 0; d0 < 2; ++d0) { s16x4 lo[4], hi[4];
#pragma unroll
        for (int ks = 0; ks < 4; ++ks) {
            asm volatile("ds_read_b64_tr_b16 %0,%1 offset:%c2" : "=&v"(lo[ks]) : "v"(vb), "i"(d0 * 4096 + ks * 1024) : "memory");
            asm volatile("ds_read_b64_tr_b16 %0,%1 offset:%c2" : "=&v"(hi[ks]) : "v"(vb), "i"(d0 * 4096 + ks * 1024 + 512) : "memory"); }
        asm volatile("s_waitcnt lgkmcnt(0)" ::: "memory"); SBAR();
#define PK(k) (bf16x8){lo[k][0], lo[k][1], lo[k][2], lo[k][3], hi[k][0], hi[k][1], hi[k][2], hi[k][3]}
        o[d0] = __builtin_amdgcn_mfma_f32_32x32x16_bf16(pa0, PK(0), o[d0], 0, 0, 0);
        o[d0] = __builtin_amdgcn_mfma_f32_32x32x16_bf16(pa1, PK(1), o[d0], 0, 0, 0);
        o[d0] = __builtin_amdgcn_mfma_f32_32x32x16_bf16(pa2, PK(2), o[d0], 0, 0, 0);
        o[d0] = __builtin_amdgcn_mfma_f32_32x32x16_bf16(pa3, PK(3), o[d0], 0, 0, 0);
#undef PK
    }
}

template <int THRL> __device__ __forceinline__ int attn_unit(int b, int h, int qb, int ts, float kmaxc, const bf16_t* Q, const bf16_t* __restrict__ K, const bf16_t* __restrict__ V, unsigned char* O, const unsigned* __restrict__ FA, char* shm, unsigned* qhead, LAS int* qnext) {
    const int tid = threadIdx.x, lane = tid & 63, r32 = lane & 31, hi = lane >> 5; const int wid = __builtin_amdgcn_readfirstlane(tid >> 6);
    const long rowbase = (long)b * SEQ; const int q0 = qb * QB;
    const int NT0 = (q0 + QB) / KVBLK - ts, TL = NT0 - 1; int NT = NT0;
    const bf16_t* Qw = Q + (rowbase + q0 + wid * QBLK) * PQ + h * D;
    const bf16_t* Kh = K + (rowbase + (long)ts * KVBLK) * PQ + h * D, *Vh = V + (rowbase + (long)ts * KVBLK) * PQ + h * D;
    const unsigned lds0 = (unsigned)(uintptr_t)shm;
    float* wsf = (float*)(shm + LDS_WS) + wid * 64;
    { const u32x4* Fg = (const u32x4*)(FA + ((size_t)(b * NHEAD + h) * SEQ + (size_t)ts * KVBLK) * 2); LAS u32x4* Fl4 = (LAS u32x4*)((LAS char*)(lds_cptr)shm + LDS_F); const int n4 = (q0 + QB - ts * KVBLK) / 2;
      for (int p = tid; p < n4; p += NW * 64) Fl4[p] = Fg[p]; }
    const LAS u32x2* Fa = (const LAS u32x2*)((lds_cptr)shm + LDS_F);
#define FVAL(w) (-((bflo((w).x) + bfhi((w).x)) + bflo((w).y)))
    asm volatile("s_waitcnt vmcnt(0) lgkmcnt(0)" ::: "memory");
    const bf16_t* ksrc = Kh + (long)lane * PQ + wid * 8;
    const bf16_t* vsrc = Vh + (long)(16 * (wid & 3) + (lane >> 2)) * PQ + (wid >> 2) * 32 + (lane & 3) * 8;
    const unsigned kdst = lds0 + LDS_K + wid * 1024, vdst = lds0 + LDS_V + wid * 1024;
#define DMA_K(t, slot) glds16(ksrc + (long)(TL - (t)) * KVBLK * PQ, (unsigned)__builtin_amdgcn_readfirstlane(kdst + (slot)))
#define DMA_V(t, slot) glds16(vsrc + (long)(TL - (t)) * KVBLK * PQ, (unsigned)__builtin_amdgcn_readfirstlane(vdst + (slot)))
    const int vb0 = (int)(lds0 + LDS_V) + ((lane >> 4) & 1) * 32 + (lane & 3) * 8 + (4 * hi + ((lane & 15) >> 2)) * 64;
    bf16x8 kf[8];
    const lds_cptr shm3 = (lds_cptr)shm; const lds_cptr kp0 = shm3 + LDS_K + hi * 1024 + r32 * 16; const lds_cptr vp0 = shm3 + LDS_V + ((lane >> 4) & 1) * 32 + (lane & 3) * 8 + (4 * hi + ((lane & 15) >> 2)) * 64;
    DMA_K(0, 0); DMA_V(0, 0); DMA_K(1, SLOTB);
    bf16x8 qr[4];
#pragma unroll
    for (int d0 = 0; d0 < 4; ++d0) qr[d0] = *reinterpret_cast<const bf16x8*>(&Qw[(long)r32 * PQ + d0 * 16 + hi * 8]);
    float mhat = 0.f, l_reg = 0.f, nm = 0.f; f32x16 o[2]; o[0] = f32x16{}; o[1] = f32x16{};
    u32x2 ka0, ka1; u32x4 qa;
#define FLD(tt) do { const LAS u32x2* fp_ = Fa + 64 * (TL - (tt)) + r32; ka0 = fp_[0]; ka1 = fp_[32]; } while (0)
#define KAF(w) __builtin_bit_cast(bf16x8, (u32x4){(w).x, (w).y, 0x3f803f80u, 0u})
#define SETQA() do { const unsigned h_ = cvtpk(nm, 0.f) & 0xffffu; const float r1_ = nm - __uint_as_float(h_ << 16); const unsigned m_ = cvtpk(r1_, 0.f) & 0xffffu; \
      const float r2_ = r1_ - __uint_as_float(m_ << 16); const unsigned l_ = cvtpk(r2_, 0.f) & 0xffffu; \
      qa.x = hi ? 0u : 0x3f803f80u; qa.y = hi ? 0u : (0x3f80u | (h_ << 16)); qa.z = hi ? 0u : (m_ | (l_ << 16)); qa.w = 0u; } while (0)
#define CINIT(C0, C1) do { C0 = __builtin_amdgcn_mfma_f32_32x32x16_bf16(KAF(ka0), __builtin_bit_cast(bf16x8, qa), f32x16{}, 0, 0, 0); \
      C1 = __builtin_amdgcn_mfma_f32_32x32x16_bf16(KAF(ka1), __builtin_bit_cast(bf16x8, qa), f32x16{}, 0, 0, 0); } while (0)
    const int qrel = wid * QBLK + r32;
#define CMASK(P0, P1, t) do { int jb_ = 3 - (t); if (jb_ >= 0) cmask(P0, P1, jb_, qrel, hi); } while (0)
    bool resc = false;
#define START(P0, P1) do { const float rm = rowmax(P0, P1); resc = false; \
    if (__any(rm > (float)THRL)) { const float dl = __builtin_fmaxf(rm, 0.f); mhat += dl; \
      _Pragma("unroll") for (int r = 0; r < 16; ++r) { P0[r] -= dl; P1[r] -= dl; } \
      nm = -mhat; SETQA(); } \
    _Pragma("unroll") for (int r = 0; r < 16; ++r) P0[r] = __builtin_amdgcn_exp2f(P0[r]); } while (0)
#define RESC() do { if (resc) { asm volatile("s_waitcnt lgkmcnt(0)" ::: "memory"); \
      _Pragma("unroll") for (int d_ = 0; d_ < 2; ++d_) _Pragma("unroll") for (int r = 0; r < 16; ++r) o[d_][r] *= wsf[crow(r, hi)]; } } while (0)
    f32x16 pA0, pA1, pB0, pB1;
    int sl_prev = 0, sl_cur = 0, sl_next = SLOTB;
#define ROT() do { sl_prev = sl_cur; sl_cur = sl_next; sl_next = (sl_next == (NSLOT - 1) * SLOTB) ? 0 : sl_next + SLOTB; } while (0)
    DMA_K(2, 2 * SLOTB);
    float qkb;
    { float qn2 = 0.f;
#pragma unroll
      for (int d0 = 0; d0 < 4; ++d0)
#pragma unroll
          for (int j = 0; j < 8; ++j) { const float v = __uint_as_float((unsigned)(unsigned short)qr[d0][j] << 16); qn2 += v * v; }
      auto rr = __builtin_amdgcn_permlane32_swap(__float_as_uint(qn2), __float_as_uint(qn2), false, false); qn2 = __uint_as_float(rr[0]) + __uint_as_float(rr[1]);
      qkb = sqrtf(qn2) * kmaxc; }
    WAIT_BAR(3);
    { const u32x2 wo = Fa[64 * NT0 - QB + qrel]; const float fown = FVAL(wo); mhat = -fown - qkb; nm = -mhat; SETQA(); }
    FLD(0); CINIT(pA0, pA1);
    { const lds_cptr kb = shm3 + LDS_K + hi * 1024 + r32 * 16;
#pragma unroll
      for (int d0 = 0; d0 < 4; ++d0) { const bf16x8 b0 = *(const LAS bf16x8*)(kb + d0 * 2048); const bf16x8 b1 = *(const LAS bf16x8*)(kb + d0 * 2048 + 512);
          pA0 = __builtin_amdgcn_mfma_f32_32x32x16_bf16(b0, qr[d0], pA0, 0, 0, 0); pA1 = __builtin_amdgcn_mfma_f32_32x32x16_bf16(b1, qr[d0], pA1, 0, 0, 0); } }
    asm volatile("s_nop 15\n\ts_nop 7" : "+v"(pA0), "+v"(pA1)); CMASK(pA0, pA1, 0);
    START(pA0, pA1);
    _Pragma("unroll") for (int r = 0; r < 16; ++r) pA1[r] = __builtin_amdgcn_exp2f(pA1[r]);
    FLD(1);
    WAIT_BAR(0);
    DMA_K(3, 0); DMA_V(1, SLOTB);
    ROT();
    kload8(kf, kp0 + sl_cur);
    WAIT_BAR(2);
    s16x4 vlo[8], vhi[8]; u32x4 pw0, pw1, pw2, pw3;
#define PKW(P, B) cvtpk(P[B], P[B + 1])
#define PAF(k) __builtin_bit_cast(bf16x8, pw##k)
#define VFR(i) (bf16x8){vlo[i][0], vlo[i][1], vlo[i][2], vlo[i][3], vhi[i][0], vhi[i][1], vhi[i][2], vhi[i][3]}
#define PIN(x) asm volatile("" : "+v"(x))
#define MX3(a, b, c) __builtin_fmaxf(__builtin_fmaxf((a), (b)), (c))
#define GAPA(MF, A0, A1, A2, A3, W0, W1, PW) do { MF; sacc += A0; sacc += A1; sacc += A2; sacc += A3; PIN(sacc); W0; W1; PIN(PW); SBAR(); } while (0)
#define EX(v) __builtin_amdgcn_exp2f(v)
#define GAPB(MF, X, B) do { MF; X[B] = EX(X[B]); X[B + 1] = EX(X[B + 1]); X[B + 2] = EX(X[B + 2]); X[B + 3] = EX(X[B + 3]); PIN(X); SBAR(); } while (0)
#define VRD(i) do { vlo[i] = vtr(vp_ + (((i) >> 2) * 4096 + ((i) & 3) * 1024)); vhi[i] = vtr(vp_ + (((i) >> 2) * 4096 + ((i) & 3) * 1024 + 512)); } while (0)
#define KRD(G, j) do { if (G) { kload2(kf, kp0 + sl_next, j); SBAR(); } } while (0)
#define STEP(C0, C1, P0, P1, t, GK, GV, GL) do { SBAR(); \
    CINIT(C0, C1); SBAR(); \
    const lds_cptr vp_ = vp0 + sl_prev; \
    VRD(0); SBAR(); float sacc = (P0[0] + P0[1]); \
    GAPA(C0 = __builtin_amdgcn_mfma_f32_32x32x16_bf16(kf[0], qr[0], C0, 0, 0, 0), P0[2], P0[3], P0[4], P0[5],     pw0[0] = PKW(P0, 0), pw0[1] = PKW(P0, 2), pw0); \
    VRD(4); SBAR(); GAPA(C1 = __builtin_amdgcn_mfma_f32_32x32x16_bf16(kf[1], qr[0], C1, 0, 0, 0), P0[6], P0[7], P0[8], P0[9],     pw0[2] = PKW(P0, 4), pw0[3] = PKW(P0, 6), pw0); \
    VRD(1); SBAR(); GAPA(C0 = __builtin_amdgcn_mfma_f32_32x32x16_bf16(kf[2], qr[1], C0, 0, 0, 0),   P0[10], P0[11], P0[12], P0[13], pw1[0] = PKW(P0, 8), pw1[1] = PKW(P0, 10), pw1); \
    VRD(5); SBAR(); GAPA(C1 = __builtin_amdgcn_mfma_f32_32x32x16_bf16(kf[3], qr[1], C1, 0, 0, 0),   P0[14], P0[15], P1[0], P1[1],   pw1[2] = PKW(P0, 12), pw1[3] = PKW(P0, 14), pw1); \
    VRD(2); SBAR(); GAPA(C0 = __builtin_amdgcn_mfma_f32_32x32x16_bf16(kf[4], qr[2], C0, 0, 0, 0),   P1[2], P1[3], P1[4], P1[5],     pw2[0] = PKW(P1, 0), pw2[1] = PKW(P1, 2), pw2); \
    VRD(6); SBAR(); GAPA(C1 = __builtin_amdgcn_mfma_f32_32x32x16_bf16(kf[5], qr[2], C1, 0, 0, 0),   P1[6], P1[7], P1[8], P1[9],     pw2[2] = PKW(P1, 4), pw2[3] = PKW(P1, 6), pw2); \
    VRD(3); SBAR(); GAPA(C0 = __builtin_amdgcn_mfma_f32_32x32x16_bf16(kf[6], qr[3], C0, 0, 0, 0),   P1[10], P1[11], P1[12], P1[13], pw3[0] = PKW(P1, 8), pw3[1] = PKW(P1, 10), pw3); \
    VRD(7); SBAR(); GAPA(C1 = __builtin_amdgcn_mfma_f32_32x32x16_bf16(kf[7], qr[3], C1, 0, 0, 0),   P1[14], P1[15], 0.f, 0.f,       pw3[2] = PKW(P1, 12), pw3[3] = PKW(P1, 14), pw3); \
    l_reg += sacc; \
    if (GK) { DMA_K((t) + 3, sl_cur); } if (GV) { DMA_V((t) + 1, sl_next); } \
    CMASK(C0, C1, t); \
    { float a = MX3(C0[0], C0[1], C1[0]), b = MX3(C0[2], C0[3], C1[1]); a = MX3(a, C1[2], C1[3]); \
      _Pragma("unroll") for (int r = 4; r < 16; r += 4) { a = MX3(a, C0[r], C0[r + 1]); b = MX3(b, C0[r + 2], C0[r + 3]); a = MX3(a, C1[r], C1[r + 1]); b = MX3(b, C1[r + 2], C1[r + 3]); } \
      float rm = __builtin_fmaxf(a, b); { auto rr = __builtin_amdgcn_permlane32_swap(__float_as_uint(rm), __float_as_uint(rm), false, false); rm = __builtin_fmaxf(__uint_as_float(rr[0]), __uint_as_float(rr[1])); } \
      resc = false; \
      if (__builtin_expect(__any(rm > (float)THRL), 0)) { const float dl = __builtin_fmaxf(rm, 0.f); mhat += dl; \
        _Pragma("unroll") for (int r = 0; r < 16; ++r) { C0[r] -= dl; C1[r] -= dl; } \
        nm = -mhat; SETQA(); \
        const float f = __builtin_amdgcn_exp2f(-dl); l_reg *= f; if (hi == 0) wsf[r32] = f; resc = true; } } \
    SBAR(); \
    GAPB(o[0] = __builtin_amdgcn_mfma_f32_32x32x16_bf16(PAF(0), VFR(0), o[0], 0, 0, 0), C0, 0); \
    GAPB(o[1] = __builtin_amdgcn_mfma_f32_32x32x16_bf16(PAF(0), VFR(4), o[1], 0, 0, 0), C0, 4); \
    KRD(GL, 0); GAPB(o[0] = __builtin_amdgcn_mfma_f32_32x32x16_bf16(PAF(1), VFR(1), o[0], 0, 0, 0), C0, 8); \
    KRD(GL, 1); GAPB(o[1] = __builtin_amdgcn_mfma_f32_32x32x16_bf16(PAF(1), VFR(5), o[1], 0, 0, 0), C0, 12); \
    KRD(GL, 2); GAPB(o[0] = __builtin_amdgcn_mfma_f32_32x32x16_bf16(PAF(2), VFR(2), o[0], 0, 0, 0), C1, 0); \
    KRD(GL, 3); GAPB(o[1] = __builtin_amdgcn_mfma_f32_32x32x16_bf16(PAF(2), VFR(6), o[1], 0, 0, 0), C1, 4); \
    GAPB(o[0] = __builtin_amdgcn_mfma_f32_32x32x16_bf16(PAF(3), VFR(3), o[0], 0, 0, 0), C1, 8); \
    GAPB(o[1] = __builtin_amdgcn_mfma_f32_32x32x16_bf16(PAF(3), VFR(7), o[1], 0, 0, 0), C1, 12); \
    FLD((t) + 1); \
    } while (0)
    int t = 1;
#define ENDW(tt) do { if ((tt) + 3 < NT) { WAIT_BAR(2); } else if ((tt) + 2 < NT) { WAIT_BAR(1); } else { WAIT_BAR(0); } } while (0)
    LAS float* stopf = (LAS float*)((LAS char*)(lds_cptr)shm + LDS_STOP);
#pragma unroll 1
    for (int pass = 0; pass < 2; ++pass) {
        const int lim = (pass == 0) ? (NT < 5 ? NT : 5) : NT;
        for (; t + 1 < lim; t += 2) {
            STEP(pB0, pB1, pA0, pA1, t, (t + 3 < NT), (t + 1 < NT), (t + 1 < NT));       ENDW(t);   RESC(); ROT();
            STEP(pA0, pA1, pB0, pB1, t + 1, (t + 4 < NT), (t + 2 < NT), (t + 2 < NT));     ENDW(t + 1); RESC(); ROT();
        }
        if (pass == 0) {
#undef CMASK
#define CMASK(P0, P1, t) do { } while (0)
            for (; t + 5 < NT; t += 2) {
                STEP(pB0, pB1, pA0, pA1, t, true, true, true);     WAIT_BAR(2); RESC(); ROT();
                if ((t & 7) == 5) { float bv = qkb - mhat;
                    bv = __builtin_fmaxf(bv, dpp_mov<0xB1>(bv)); bv = __builtin_fmaxf(bv, dpp_mov<0x4E>(bv)); bv = __builtin_fmaxf(bv, dpp_mov<0x141>(bv)); bv = __builtin_fmaxf(bv, dpp_mov<0x140>(bv));
                    const float r0 = __int_as_float(__builtin_amdgcn_readlane(__float_as_int(bv), 0)), r1 = __int_as_float(__builtin_amdgcn_readlane(__float_as_int(bv), 16));
                    const float r2 = __int_as_float(__builtin_amdgcn_readlane(__float_as_int(bv), 32)), r3 = __int_as_float(__builtin_amdgcn_readlane(__float_as_int(bv), 48));
                    if (lane == 0) stopf[wid] = __builtin_fmaxf(__builtin_fmaxf(r0, r1), __builtin_fmaxf(r2, r3)); }
                STEP(pA0, pA1, pB0, pB1, t + 1, true, true, true);   WAIT_BAR(2); RESC(); ROT();
                if ((t & 7) == 5) { const f32x4 s0 = *(const LAS f32x4*)stopf, s1 = *(const LAS f32x4*)(stopf + 4);
                    const float thr = __builtin_fmaxf(__builtin_fmaxf(__builtin_fmaxf(s0[0], s0[1]), __builtin_fmaxf(s0[2], s0[3])), __builtin_fmaxf(__builtin_fmaxf(s1[0], s1[1]), __builtin_fmaxf(s1[2], s1[3]))) + PRUNE_TH;
                    const int pt = TL - 2 * (lane + 1);
                    const u32x2 wv = Fa[64 * (pt < 0 ? 0 : pt) + 63]; const float fv = FVAL(wv);
                    const unsigned long long mk = __ballot((pt < 0) || (fv >= thr));
                    int np = 2 * ((int)__builtin_ctzll(mk) + 1); np = np < t + 5 ? t + 5 : np;
                    if (np < NT) NT = np; }
            }
#undef CMASK
#define CMASK(P0, P1, t) do { int jb_ = 3 - (t); if (jb_ >= 0) cmask(P0, P1, jb_, qrel, hi); } while (0)
        }
    }
    STEP(pB0, pB1, pA0, pA1, NT - 1, false, false, false); RESC();
    { float sacc = pB0[0] + pB0[1]; _Pragma("unroll") for (int r = 2; r < 16; ++r) sacc += pB0[r]; _Pragma("unroll") for (int r = 0; r < 16; ++r) sacc += pB1[r]; l_reg += sacc;
      pw0 = (u32x4){PKW(pB0, 0), PKW(pB0, 2), PKW(pB0, 4), PKW(pB0, 6)}; pw1 = (u32x4){PKW(pB0, 8), PKW(pB0, 10), PKW(pB0, 12), PKW(pB0, 14)}; pw2 = (u32x4){PKW(pB1, 0), PKW(pB1, 2), PKW(pB1, 4), PKW(pB1, 6)}; pw3 = (u32x4){PKW(pB1, 8), PKW(pB1, 10), PKW(pB1, 12), PKW(pB1, 14)};
      SBAR(); pv(o, vb0 + sl_cur, PAF(0), PAF(1), PAF(2), PAF(3)); }
    unsigned nxq = 0u; if (tid == 0) nxq = atomicAdd(qhead, 1u);
#undef PKW
#undef PAF
#undef VFR
#undef PIN
#undef MX3
#undef GAPA
#undef GAPB
#undef EX
#undef VRD
#undef KRD
#undef STEP
#undef ENDW
    { auto rr = __builtin_amdgcn_permlane32_swap(__float_as_uint(l_reg), __float_as_uint(l_reg), false, false); l_reg = __uint_as_float(rr[0]) + __uint_as_float(rr[1]); }
    if (hi == 0) wsf[32 + r32] = l_reg; asm volatile("s_waitcnt lgkmcnt(0)" ::: "memory");
    float rli[16];
#pragma unroll
    for (int r = 0; r < 16; ++r) rli[r] = __builtin_amdgcn_rcpf(wsf[32 + crow(r, hi)]);
    unsigned char* Ow = O + (rowbase + q0 + wid * QBLK) * PO + h * D;
    { unsigned char* stg = (unsigned char*)(shm + LDS_OST) + wid * 2048;
#pragma unroll
      for (int r = 0; r < 16; ++r) { const int orow = crow(r, hi);
#pragma unroll
          for (int d0 = 0; d0 < 2; ++d0) { const float v = __builtin_fminf(__builtin_fmaxf(o[d0][r] * rli[r] * MIX_SCALE, -440.0f), 440.0f);
              stg[orow * 64 + d0 * 32 + r32] = (unsigned char)(__builtin_amdgcn_cvt_pk_fp8_f32(v, v, 0, false) & 0xff); } }
      asm volatile("s_waitcnt lgkmcnt(0)" ::: "memory");
#pragma unroll
      for (int i = 0; i < 2; ++i) { const int row = i * 16 + (lane >> 2), ch = lane & 3; const u32x4 v = *(const u32x4*)(stg + row * 64 + ch * 16); *(u32x4*)(Ow + (long)row * PO + ch * 16) = v; } }
    if (tid == 0) qnext[0] = (int)nxq;
    asm volatile("s_waitcnt lgkmcnt(0)\n\ts_barrier" ::: "memory");
    return NT;
#undef DMA_K
#undef DMA_V
#undef CMASK
#undef START
#undef RESC
#undef ROT
#undef FLD
#undef CINIT
#undef KAF
#undef SETQA
#undef FVAL
}
#undef SBAR
#undef WAIT_BAR
}

namespace ret {
constexpr int RS = 272;
constexpr int IMG_Q = 0, IMG_K = 64 * RS, IMG_KT = 2 * 64 * RS, IMG_V = 3 * 64 * RS;
constexpr int PS = 144;
constexpr int IMG_P = 4 * 64 * RS;
constexpr int IMG_ST = IMG_P + 64 * PS;
constexpr int OS = 132;
constexpr int IMG_O = IMG_ST + 128 * RS;
constexpr int LDS_END = IMG_O + 64 * OS * 4;
static_assert(LDS_END <= LDS_BYTES, "retention LDS map");
typedef short v4i16_t __attribute__((ext_vector_type(4)));
__device__ __forceinline__ s16x4 tr4(LAS const char* p) { return __builtin_bit_cast(s16x4, __builtin_amdgcn_ds_read_tr16_b64_v4i16((LAS v4i16_t*)p)); }
__device__ __forceinline__ bf16x8 frag_tr(LAS const char* img, int stride, int k0, int c0, int lane) {
    const int g4 = lane >> 4, i = lane & 15, qq = i >> 2, p = i & 3, hh = g4 >> 1, nh = g4 & 1;
    LAS const char* a = img + (k0 + 8 * hh + qq) * stride + (c0 + 16 * nh + 4 * p) * 2;
    const s16x4 lo = tr4(a), hi = tr4(a + 4 * stride);
    return (bf16x8){lo[0], lo[1], lo[2], lo[3], hi[0], hi[1], hi[2], hi[3]};
}
__device__ __forceinline__ bf16x8 frag_row(LAS const char* img, int stride, int r0, int k0, int lane) {
    return *(const LAS bf16x8*)(img + (r0 + (lane & 31)) * stride + (k0 + 8 * (lane >> 5)) * 2);
}
__device__ __forceinline__ int crow(int r, int hi) { return (r & 3) + 8 * (r >> 2) + 4 * hi; }

template <bool APPLY>
__device__ __forceinline__ void unit(int bh, int g, const bf16_t* RQ, const bf16_t* RK, const bf16_t* RV, const bf16_t* SG, float* GST, unsigned char* MIX, LAS char* lds) {
    int tid_ = threadIdx.x; asm volatile("" : "+v"(tid_));
    const int tid = tid_, lane = tid & 63, hi = lane >> 5; const int w = __builtin_amdgcn_readfirstlane(tid >> 6);
    const int b = bh >> 2, h = bh & 3;
    const float l2g = log2f(1.0f - exp2f(-5.0f - (float)h));
    const float cd = exp2f(64.0f * l2g);
    const size_t row0 = (size_t)b * SEQ + (size_t)g * 512;
    constexpr int NSET = APPLY ? 2 : 3;
    u32x4 rqs[APPLY ? 2 : 1][2], rks[NSET][2], rvs[NSET][2];
    auto issue = [&](int j, int s) {
#pragma unroll
        for (int i = 0; i < 2; ++i) { const int p = tid + 512 * i, row = p >> 4, ch = p & 15; const size_t off = (row0 + j * 64 + row) * 512 + h * 128 + ch * 8;
            if (APPLY) rqs[s & 1][i] = *(const u32x4*)(RQ + off);
            rks[s][i] = *(const u32x4*)(RK + off); rvs[s][i] = *(const u32x4*)(RV + off); }
    };
    const int db = w >> 1, eb0 = 2 * (w & 1);
    f32x16 S0 = f32x16{}, S1 = f32x16{};
    if (APPLY) {
        const float Gm = exp2f(512.0f * l2g);
        for (int gp0 = 0; gp0 < g; gp0 += 4) {
            f32x4 gv[4][8];
#pragma unroll
            for (int k = 0; k < 4; ++k) { const int gp = (gp0 + k < g) ? gp0 + k : g - 1; const f32x4* src = (const f32x4*)(GST + ((size_t)(bh * 16 + gp) * 8 + w) * 2048) + lane;
#pragma unroll
                for (int q = 0; q < 8; ++q) gv[k][q] = src[q * 64]; }
#pragma unroll
            for (int k = 0; k < 4; ++k) { const bool ok = gp0 + k < g; const float fm = ok ? Gm : 1.0f, am = ok ? 1.0f : 0.0f;
#pragma unroll
                for (int r = 0; r < 16; ++r) { S0[r] = S0[r] * fm + gv[k][r >> 2][r & 3] * am; S1[r] = S1[r] * fm + gv[k][4 + (r >> 2)][r & 3] * am; } }
        }
    }
    issue(0, 0); issue(1, 1); if (!APPLY) issue(2, 2 % NSET);
#pragma unroll (APPLY ? 2 : 8)
    for (int j = 0; j < 8; ++j) {
        const int cs = APPLY ? (j & 1) : j % 3; const u32x4 (&rk)[2] = rks[cs]; const u32x4 (&rv)[2] = rvs[cs]; const u32x4 (&rq)[2] = rqs[APPLY ? cs : 0];
#pragma unroll
        for (int i = 0; i < 2; ++i) { const int p = tid + 512 * i, row = p >> 4, ch = p & 15; const int o = row * RS + ch * 16;
            if (APPLY) { *(LAS u32x4*)(lds + IMG_Q + o) = rq[i]; *(LAS u32x4*)(lds + IMG_K + o) = rk[i]; }
            *(LAS u32x4*)(lds + IMG_V + o) = rv[i];
            const float kw = exp2f((float)(63 - row) * l2g);
            u32x4 kt;
#pragma unroll
            for (int e = 0; e < 4; ++e) kt[e] = cvtpk(bflo(rk[i][e]) * kw, bfhi(rk[i][e]) * kw);
            *(LAS u32x4*)(lds + IMG_KT + o) = kt; }
        if (APPLY) {
#pragma unroll
            for (int tile = 0; tile < 2; ++tile) { const f32x16& S = tile ? S1 : S0; const int e = (eb0 + tile) * 32 + (lane & 31);
#pragma unroll
                for (int g4 = 0; g4 < 4; ++g4) { const int d = db * 32 + 8 * g4 + 4 * hi; u32x2 v; v.x = cvtpk(S[4 * g4], S[4 * g4 + 1]); v.y = cvtpk(S[4 * g4 + 2], S[4 * g4 + 3]);
                    *(LAS u32x2*)(lds + IMG_ST + e * RS + d * 2) = v; } }
        }
        u32x4 gg0 = {0u, 0u, 0u, 0u}, gg1 = {0u, 0u, 0u, 0u};
        if (APPLY) { const size_t trow = row0 + j * 64 + (tid >> 3); const bf16_t* gp = SG + trow * 512 + h * 128 + (tid & 7) * 16; gg0 = *(const u32x4*)gp; gg1 = *(const u32x4*)(gp + 8); }
        if (APPLY) { if (j + 2 < 8) issue(j + 2, cs); } else { if (j + 3 < 8) issue(j + 3, cs); }
        LDS_WAIT(); __builtin_amdgcn_s_barrier();
        f32x16 oin = f32x16{}, oit = f32x16{};
        const int qb = w >> 2, eb = w & 3;
        if (APPLY) {
#pragma unroll
            for (int s = 0; s < 8; ++s) oin = __builtin_amdgcn_mfma_f32_32x32x16_bf16(frag_row(lds + IMG_Q, RS, qb * 32, s * 16, lane), frag_row(lds + IMG_ST, RS, eb * 32, s * 16, lane), oin, 0, 0, 0);
            if (w < 4) {
                const int tb = w >> 1, qb2 = w & 1; f32x16 sc = f32x16{};
#pragma unroll
                for (int s = 0; s < 8; ++s) sc = __builtin_amdgcn_mfma_f32_32x32x16_bf16(frag_row(lds + IMG_K, RS, tb * 32, s * 16, lane), frag_row(lds + IMG_Q, RS, qb2 * 32, s * 16, lane), sc, 0, 0, 0);
                const int q = qb2 * 32 + (lane & 31);
#pragma unroll
                for (int g4 = 0; g4 < 4; ++g4) { const int t0 = tb * 32 + 8 * g4 + 4 * hi; float pv4[4];
#pragma unroll
                    for (int e = 0; e < 4; ++e) { const int dd = q - (t0 + e); pv4[e] = sc[4 * g4 + e] * exp2f((float)(dd < 0 ? -dd : dd) * l2g); }
                    u32x2 v; v.x = cvtpk(pv4[0], pv4[1]); v.y = cvtpk(pv4[2], pv4[3]);
                    *(LAS u32x2*)(lds + IMG_P + q * PS + t0 * 2) = v; }
            }
            LDS_WAIT(); __builtin_amdgcn_s_barrier();
#pragma unroll
            for (int s = 0; s < 4; ++s) oit = __builtin_amdgcn_mfma_f32_32x32x16_bf16(frag_row(lds + IMG_P, PS, qb * 32, s * 16, lane), frag_tr(lds + IMG_V, RS, s * 16, eb * 32, lane), oit, 0, 0, 0);
#pragma unroll
            for (int r = 0; r < 16; ++r) { const int q = qb * 32 + crow(r, hi); const float qw = exp2f((float)(q + 1) * l2g);
                *(LAS float*)(lds + IMG_O + (q * OS + eb * 32 + (lane & 31)) * 4) = oit[r] + qw * oin[r]; }
        }
#pragma unroll
        for (int r = 0; r < 16; ++r) { S0[r] *= cd; S1[r] *= cd; }
#pragma unroll
        for (int s = 0; s < 4; ++s) { const bf16x8 a = frag_tr(lds + IMG_KT, RS, s * 16, db * 32, lane);
            S0 = __builtin_amdgcn_mfma_f32_32x32x16_bf16(a, frag_tr(lds + IMG_V, RS, s * 16, eb0 * 32, lane), S0, 0, 0, 0);
            S1 = __builtin_amdgcn_mfma_f32_32x32x16_bf16(a, frag_tr(lds + IMG_V, RS, s * 16, (eb0 + 1) * 32, lane), S1, 0, 0, 0); }
        LDS_WAIT(); __builtin_amdgcn_s_barrier();
        if (APPLY) {
            { const int q = tid >> 3, sg = tid & 7; const LAS f32x4* op = (const LAS f32x4*)(lds + IMG_O + (q * OS + sg * 16) * 4);
              f32x4 x0 = op[0], x1 = op[1], x2 = op[2], x3 = op[3];
              float s1 = ((x0.x + x0.y) + (x0.z + x0.w)) + ((x1.x + x1.y) + (x1.z + x1.w)) + ((x2.x + x2.y) + (x2.z + x2.w)) + ((x3.x + x3.y) + (x3.z + x3.w));
              s1 += dpp_mov<0xB1>(s1); s1 += dpp_mov<0x4E>(s1); s1 += dpp_mov<0x141>(s1);
              const float mu = s1 * (1.0f / 128.0f); x0 = x0 - mu; x1 = x1 - mu; x2 = x2 - mu; x3 = x3 - mu;
              float s2 = ((x0.x * x0.x + x0.y * x0.y) + (x0.z * x0.z + x0.w * x0.w)) + ((x1.x * x1.x + x1.y * x1.y) + (x1.z * x1.z + x1.w * x1.w)) + ((x2.x * x2.x + x2.y * x2.y) + (x2.z * x2.z + x2.w * x2.w)) + ((x3.x * x3.x + x3.y * x3.y) + (x3.z * x3.z + x3.w * x3.w));
              s2 += dpp_mov<0xB1>(s2); s2 += dpp_mov<0x4E>(s2); s2 += dpp_mov<0x141>(s2);
              const float rstd = rsqrtf(s2 * (1.0f / 128.0f) + GN_EPS);
              const size_t trow = row0 + j * 64 + q; const u32x4 g0 = gg0, g1 = gg1;
              const float ms = rstd * MIX_SCALE; u32x4 o;
#define MXC(v) __builtin_fminf(__builtin_fmaxf((v), -440.0f), 440.0f)
              o.x = pk4_fp8(MXC(x0.x * ms * bflo(g0.x)), MXC(x0.y * ms * bfhi(g0.x)), MXC(x0.z * ms * bflo(g0.y)), MXC(x0.w * ms * bfhi(g0.y)));
              o.y = pk4_fp8(MXC(x1.x * ms * bflo(g0.z)), MXC(x1.y * ms * bfhi(g0.z)), MXC(x1.z * ms * bflo(g0.w)), MXC(x1.w * ms * bfhi(g0.w)));
              o.z = pk4_fp8(MXC(x2.x * ms * bflo(g1.x)), MXC(x2.y * ms * bfhi(g1.x)), MXC(x2.z * ms * bflo(g1.y)), MXC(x2.w * ms * bfhi(g1.y)));
              o.w = pk4_fp8(MXC(x3.x * ms * bflo(g1.z)), MXC(x3.y * ms * bfhi(g1.z)), MXC(x3.z * ms * bflo(g1.w)), MXC(x3.w * ms * bfhi(g1.w)));
#undef MXC
              *(u32x4*)(MIX + trow * 1024 + h * 128 + sg * 16) = o; }
        }
    }
    if (!APPLY) {
        f32x4* dst = (f32x4*)(GST + ((size_t)(bh * 16 + g) * 8 + w) * 2048) + lane;
#pragma unroll
        for (int q = 0; q < 4; ++q) { dst[q * 64] = (f32x4){S0[4 * q], S0[4 * q + 1], S0[4 * q + 2], S0[4 * q + 3]}; dst[(4 + q) * 64] = (f32x4){S1[4 * q], S1[4 * q + 1], S1[4 * q + 2], S1[4 * q + 3]}; }
    }
    LDS_WAIT(); __builtin_amdgcn_s_barrier();
}
}


#define XB_TMO      128
#define XB_XCNT(j)  (256  + 64 * (j))
#define XB_XSUB(j)  (1280 + 64 * (j))
#define XB_XGEN(j)  (2304 + 64 * (j))
#define XB_TOP      3328
#define XB_TOPGEN   3392
#define XCD_BAR_WORDS 3456
#define XB_SPIN_CAP (1u << 18)
__device__ __forceinline__ unsigned xb_ld(unsigned* p)              { return __hip_atomic_load(p, __ATOMIC_RELAXED, __HIP_MEMORY_SCOPE_AGENT); }
__device__ __forceinline__ unsigned xb_add(unsigned* p, unsigned v) { return __hip_atomic_fetch_add(p, v, __ATOMIC_RELAXED, __HIP_MEMORY_SCOPE_AGENT); }
__device__ __forceinline__ unsigned xb_xcc_id() { return (unsigned)__builtin_amdgcn_s_getreg((3 << 11) | 20) & 0xFu; }
#define XB_SPIN(cond, bar) do { unsigned _sp = 0; while (cond) { __builtin_amdgcn_s_sleep(1); \
    if ((++_sp & 255u) == 0u) { if (xb_ld(&(bar)[XB_TMO])) break; if (_sp > XB_SPIN_CAP) { atomicAdd(&(bar)[XB_TMO], 1u); break; } } } } while (0)
struct XcdBarrier { unsigned* bar; unsigned x; volatile LAS unsigned* st; };
__device__ __forceinline__ XcdBarrier xcd_barrier_post(unsigned* bar, volatile LAS unsigned* st) {
    XcdBarrier b; b.bar = bar; b.x = xb_xcc_id(); b.st = st;
    if (threadIdx.x == 0) (void)xb_add(&bar[XB_XCNT(b.x)], 1u);
    return b;
}
__device__ __forceinline__ void xcd_barrier_complete(unsigned* bar, unsigned x, unsigned& nloc, unsigned& nx) {
    const unsigned G = gridDim.x * gridDim.y * gridDim.z;
    unsigned sum, cnt, mine, sp = 0u;
    for (;;) {
        sum = 0u; cnt = 0u; mine = 0u;
#pragma unroll
        for (unsigned j = 0; j < 16; ++j) { const unsigned c = xb_ld(&bar[XB_XCNT(j)]); sum += c; cnt += (c > 0u) ? 1u : 0u; mine = (j == x) ? c : mine; }
        if (sum == G) break;
        __builtin_amdgcn_s_sleep(1);
        if ((++sp & 255u) == 0u) { if (xb_ld(&bar[XB_TMO])) break; if (sp > XB_SPIN_CAP) { atomicAdd(&bar[XB_TMO], 1u); break; } }
    }
    nloc = mine > 0u ? mine : 1u; nx = cnt > 0u ? cnt : 1u;
}
__device__ __forceinline__ void xcd_barrier(const XcdBarrier& b) {
    asm volatile("s_waitcnt vmcnt(0)" ::: "memory");
    __syncthreads();
    if (threadIdx.x == 0) {
        unsigned* bar = b.bar;
        __builtin_amdgcn_s_waitcnt(0);
        unsigned nloc = b.st[0], nx = b.st[1];
        if (nloc == 0u) { xcd_barrier_complete(bar, b.x, nloc, nx); b.st[0] = nloc; b.st[1] = nx; }
        const unsigned old = xb_add(&bar[XB_XSUB(b.x)], 1u);
        const unsigned gen = old / nloc;
        if (old + 1u == (gen + 1u) * nloc) {
            __builtin_amdgcn_fence(__ATOMIC_RELEASE, "agent");
            asm volatile("s_waitcnt vmcnt(0)" ::: "memory");
            const unsigned og = xb_add(&bar[XB_TOP], 1u);
            const unsigned tg = og / nx;
            if (og + 1u == (tg + 1u) * nx) xb_add(&bar[XB_TOPGEN], 1u);
            else XB_SPIN(xb_ld(&bar[XB_TOPGEN]) == tg, bar);
            __builtin_amdgcn_fence(__ATOMIC_ACQUIRE, "agent");
            xb_add(&bar[XB_XGEN(b.x)], 1u);
            asm volatile("s_waitcnt vmcnt(0)" ::: "memory");
        } else {
            XB_SPIN(xb_ld(&bar[XB_XGEN(b.x)]) == gen, bar);
            __builtin_amdgcn_fence(__ATOMIC_ACQUIRE, "agent");
            asm volatile("s_waitcnt vmcnt(0)" ::: "memory");
        }
    }
    __syncthreads();
}

__device__ __forceinline__ void publish_inc(unsigned* cnt) {
    asm volatile("s_waitcnt vmcnt(0)" ::: "memory");
    __syncthreads();
    if (threadIdx.x == 0) { __builtin_amdgcn_fence(__ATOMIC_RELEASE, "agent"); asm volatile("s_waitcnt vmcnt(0)" ::: "memory");
        (void)__hip_atomic_fetch_add(cnt, 1u, __ATOMIC_RELAXED, __HIP_MEMORY_SCOPE_AGENT); }
}
__device__ __forceinline__ void wait_ge(unsigned* cnt, unsigned target) {
    if (threadIdx.x == 0) { unsigned sp = 0;
        while (__hip_atomic_load(cnt, __ATOMIC_RELAXED, __HIP_MEMORY_SCOPE_AGENT) < target) { __builtin_amdgcn_s_sleep(2); if (++sp > (1u << 22)) break; }
        __builtin_amdgcn_fence(__ATOMIC_ACQUIRE, "agent"); asm volatile("s_waitcnt vmcnt(0)" ::: "memory"); }
    __syncthreads();
}

struct Frame {
    LAS unsigned char* lds; int tid, lane, wave, vcu, G;
    __device__ __forceinline__ void refresh() { int t = threadIdx.x; asm volatile("" : "+v"(t)); tid = t; lane = t & 63; }
};

__device__ __forceinline__ void tr_item(const float* __restrict__ W, int ldw, int k0, int n0, const float* __restrict__ gk, bf16_t* WT, int kind, LAS unsigned* scr, int lane) {
    const int nch = lane & 15, kq = lane >> 4;
    f32x4 a[8], b[8];
#pragma unroll
    for (int i = 0; i < 8; ++i) { const int kp = 4 * i + kq; const float* p = W + (size_t)(k0 + 2 * kp) * ldw + n0 + 4 * nch; a[i] = *(const f32x4*)p; b[i] = *(const f32x4*)(p + ldw); }
#pragma unroll
    for (int i = 0; i < 8; ++i) { const int kp = 4 * i + kq; float ga = 1.f, gb = 1.f; if (gk) { ga = gk[k0 + 2 * kp]; gb = gk[k0 + 2 * kp + 1]; }
#pragma unroll
        for (int e = 0; e < 4; ++e) scr[(4 * nch + e) * 36 + kp] = cvtpk(a[i][e] * ga, b[i][e] * gb); }
    LDS_WAIT(); asm volatile("" ::: "memory");
    const int c = lane & 7, nr = lane >> 3;
#pragma unroll
    for (int j = 0; j < 8; ++j) { const int n = nr + 8 * j; const u32x4 v = *(const LAS u32x4*)(scr + n * 36 + 4 * c);
        const int cn = n0 + n; const int row = (kind == 0) ? pos_inproj(cn) : (kind == 1) ? pos_wide(cn) : pos_w1(cn);
        *(u32x4*)(WT + (size_t)row * 1024 + k0 + 8 * c) = v; }
    LDS_WAIT(); asm volatile("" ::: "memory");
}

struct Tr8Item { const float* W; unsigned char* WT; const float* gk; int ldw, k0, n0, kind; };
__device__ __forceinline__ Tr8Item tr8_decode(int r, const Params& P, unsigned char* W1T, unsigned char* W2T, const float* ones) {
    constexpr int P_1 = 32 * 8 * 32; Tr8Item t; const int half = r & 1; int p = r >> 1;
    if (p < P_1) { const int e = p >> 8, rr = p & 255; t.W = P.w1 + (size_t)e * 1024 * 2048; t.ldw = 2048; t.k0 = 128 * (rr / 32) + 64 * half; t.n0 = 64 * (rr % 32); t.gk = P.g_ffn; t.WT = W1T + (size_t)e * 2048 * 1024; t.kind = 2; }
    else { p -= P_1; const int e = p >> 7, rr = p & 127; t.W = P.w2 + (size_t)e * 1024 * 1024; t.ldw = 1024; t.k0 = 128 * (rr / 16) + 64 * half; t.n0 = 64 * (rr % 16); t.gk = ones; t.WT = W2T + (size_t)e * 1024 * 1024; t.kind = 1; }
    return t;
}
template <bool GK = true> __device__ __forceinline__ void tr8_load(const Tr8Item& t, f32x4 (&a)[4][4], f32x4 (&gq)[4], int lane) {
    const int nch = lane & 15, kq4 = lane >> 4;
#pragma unroll
    for (int i = 0; i < 4; ++i) { if constexpr (GK) gq[i] = *(const f32x4*)(t.gk + t.k0 + 4 * (4 * i + kq4)); else gq[i] = (f32x4){1.f, 1.f, 1.f, 1.f}; }
#pragma unroll
    for (int i = 0; i < 4; ++i) { const int kq = 4 * i + kq4; const float* p = t.W + (size_t)(t.k0 + 4 * kq) * t.ldw + t.n0 + 4 * nch;
#pragma unroll
        for (int r = 0; r < 4; ++r) a[i][r] = __builtin_nontemporal_load((const f32x4*)(p + (size_t)r * t.ldw)); }
}
__device__ __forceinline__ void tr8_proc(const Tr8Item& t, const f32x4 (&a)[4][4], const f32x4 (&gq)[4], LAS unsigned* scr, int lane, const int half) {
    const int nch = lane & 15, kq4 = lane >> 4;
#pragma unroll
    for (int i = 0; i < 4; ++i) { const int kq = 4 * i + kq4; float g[4];
#pragma unroll
        for (int r = 0; r < 4; ++r) g[r] = gq[i][r] * W_SCALE;
#pragma unroll
        for (int e = 0; e < 4; ++e) scr[(4 * nch + e) * 36 + 16 * half + (kq ^ (4 * ((nch >> 1) & 3)))] = pk4_fp8(a[i][0][e] * g[0], a[i][1][e] * g[1], a[i][2][e] * g[2], a[i][3][e] * g[3]); }
    if (half == 1) {
        LDS_WAIT(); asm volatile("" ::: "memory");
        const int c = lane & 7, nr = lane >> 3;
#pragma unroll
        for (int j = 0; j < 8; ++j) { const int n = nr + 8 * j; const u32x4 v = *(const LAS u32x4*)(scr + n * 36 + 16 * (c >> 2) + 4 * ((c & 3) ^ ((n >> 3) & 3)));
            const int cn = t.n0 + n; const int row = (t.kind == 1) ? pos_wide(cn) : pos_w1(cn);
            *(u32x4*)(t.WT + (size_t)row * 1024 + (t.k0 - 64) + 16 * c) = v; }
        LDS_WAIT(); asm volatile("" ::: "memory");
    }
}

__global__ void __launch_bounds__(NTHREADS, 2) mk_fwd(Params P) {
    __builtin_assume(__builtin_amdgcn_workitem_id_y() == 0); __builtin_assume(__builtin_amdgcn_workitem_id_z() == 0);
    extern __shared__ __attribute__((aligned(16))) unsigned char lds_raw[];
    cg::grid_group grid = cg::this_grid();
    Frame F; F.lds = (LAS unsigned char*)lds_raw; F.tid = threadIdx.x; F.lane = F.tid & 63; F.wave = __builtin_amdgcn_readfirstlane(F.tid >> 6);
    F.G = gridDim.x; { const int bx = blockIdx.x; F.vcu = (F.G % 8 == 0) ? (bx % 8) * (F.G / 8) + bx / 8 : bx; }
    unsigned char* ws = P.ws;
    unsigned* ctl = (unsigned*)(ws + WS_CTL);
    float* ropec = (float*)(ws + WS_ROPEC); float* ropes = (float*)(ws + WS_ROPES);
    float* wr3 = (float*)(ws + WS_WR3); float* logf2 = (float*)(ws + WS_LOGF); float* F2 = (float*)(ws + WS_F2); (void)F2; unsigned* FAq = (unsigned*)(ws + WS_FA);
    float* irs1 = (float*)(ws + WS_IRS1); float* ones = (float*)(ws + WS_ONES);
    int* ltok = (int*)(ws + WS_LTOK); float* lrstd = (float*)(ws + WS_LRSTD); int* inv = (int*)(ws + WS_INV); float* gates = (float*)(ws + WS_GATE);
    bf16_t* H1B = (bf16_t*)(ws + WS_H1B); bf16_t* WinT = (bf16_t*)(ws + WS_WINT); unsigned char* WoT = ws + WS_WOT;
    unsigned char* W2T = ws + WS_W2T; unsigned char* W1T = ws + WS_W1T; unsigned char* Yb = ws + WS_Y; unsigned char* H1F8 = ws + WS_H1F8;
    bf16_t* U = (bf16_t*)(ws + WS_U); unsigned char* proj = ws + WS_PROJ;
    bf16_t* RQ = (bf16_t*)(proj); bf16_t* RK = (bf16_t*)(proj + PROJ_STRIDE); bf16_t* RV = (bf16_t*)(proj + 2 * PROJ_STRIDE); bf16_t* SG = (bf16_t*)(proj + 3 * PROJ_STRIDE);
    bf16_t* FQ = (bf16_t*)(proj + 4 * PROJ_STRIDE); bf16_t* FK = (bf16_t*)(proj + 5 * PROJ_STRIDE); bf16_t* FV = (bf16_t*)(proj + 6 * PROJ_STRIDE);
    float* GST = (float*)(ws + WS_GST); unsigned char* MIX = ws + WS_MIX; unsigned char* Hb = ws + WS_H;
    const int lo = P.ph_lo, hi_ph = P.ph_hi;
#ifndef MK_PHMASK
#define MK_PHMASK 0x1ff
#endif
#define IN(k) (((MK_PHMASK >> (k)) & 1) && lo <= (k) && (k) < hi_ph)
#define REP(k) for (int rep_ = 0; rep_ < ((MK_DUP == (k)) ? 2 : 1); ++rep_)
#ifndef MK_CG_MASK
#define MK_CG_MASK 0x01
#endif
#define SEAM(k) do { if (IN(k) && IN((k) + 1)) { if ((MK_CG_MASK >> (k)) & 1) grid.sync(); else xcd_barrier(xbar); } } while (0)
    const int gw = F.vcu * NWAVES + F.wave, NGW = F.G * NWAVES;
    volatile LAS unsigned* misc = (volatile LAS unsigned*)(F.lds + LDS_MISC);
    if (F.tid < 4) misc[F.tid] = 0u;
    __syncthreads();
    XcdBarrier xbar; xbar.bar = ctl + CW_BAR; xbar.x = 0u; xbar.st = misc;
#if MK_N_LAUNCHES != 1
    xbar = xcd_barrier_post(ctl + CW_BAR, misc);
#endif
#if MK_DIAG
    int nst = 0;
#define STAMP() do { if (blockIdx.x == 0 && threadIdx.x == 0) ((unsigned long long*)(ctl + CW_DIAG + 16))[nst] = __builtin_amdgcn_s_memrealtime(); ++nst; } while (0)
    STAMP();
#else
#define STAMP() do { } while (0)
#endif

    if (IN(0)) {
        F.refresh();
#if MK_N_LAUNCHES == 1
        { const int gt = (int)blockIdx.x * NTHREADS + F.tid; if (gt < (int)(CTL_BYTES / 4)) ctl[gt] = 0u; }
#endif
        LAS unsigned* scr = (LAS unsigned*)(F.lds + F.wave * 9216);
        LAS float* wfl = (LAS float*)(F.lds + 73728);
        for (int i = F.tid; i < 8192; i += NTHREADS) { const int hh = i & 7, k = i >> 3; wfl[hh * 1024 + k] = P.w_in[(size_t)k * INW + NPROJ + hh]; }
        constexpr int I_IN = 16 * 56, I_O = 8 * 16;
        for (int it = gw; it < I_IN + I_O; it += NGW) {
            if (it < I_IN) tr_item(P.w_in, INW, 64 * (it / 56), 64 * (it % 56), nullptr, WinT, 0, scr, F.lane);
            else { const int r = it - I_IN; f32x4 a_[4][4], g_[4]; Tr8Item t; t.W = P.w_out; t.WT = WoT; t.gk = nullptr; t.ldw = 1024; t.n0 = 64 * (r % 16); t.kind = 1;
                t.k0 = 128 * (r / 16); tr8_load<false>(t, a_, g_, F.lane); tr8_proc(t, a_, g_, scr, F.lane, 0);
                t.k0 += 64; tr8_load<false>(t, a_, g_, F.lane); tr8_proc(t, a_, g_, scr, F.lane, 1); }
        }
        __syncthreads();
        {
            constexpr int TD = T * ((MK_DUP == 0) ? 2 : 1);
            f32x4 gq[4];
#pragma unroll
            for (int j = 0; j < 4; ++j) gq[j] = ((const f32x4*)P.g_mix)[F.lane + 64 * j];
            const float bfg = (F.lane < 8) ? P.b_forget[F.lane] : 0.f;
#define ROW_LOAD(V, MM) do { const f32x4* xr_ = (const f32x4*)(P.x + (size_t)((MM) % T) * DM) + F.lane; _Pragma("unroll") for (int j = 0; j < 4; ++j) V[j] = __builtin_nontemporal_load(xr_ + 64 * j); } while (0)
#define ROW_PROC(V, MM) do { const int mr_ = (MM) % T; float ss = 0.f; \
            _Pragma("unroll") for (int j = 0; j < 4; ++j) ss += (V[j].x * V[j].x + V[j].y * V[j].y) + (V[j].z * V[j].z + V[j].w * V[j].w); \
            const float msq = wave_sum_dpp(ss) * (1.0f / DM) + RMS_EPS; const float rstd = rsqrtf(msq); \
            if (F.lane == 0) irs1[mr_] = sqrtf(msq); \
            float z[8]; _Pragma("unroll") for (int hh = 0; hh < 8; ++hh) z[hh] = 0.f; \
            unsigned long long* o8 = (unsigned long long*)(U + (size_t)mr_ * DM) + F.lane; \
            _Pragma("unroll") for (int j = 0; j < 4; ++j) { const f32x4 uv = V[j] * rstd * gq[j]; \
                o8[64 * j] = (unsigned long long)cvtpk(uv.x, uv.y) | ((unsigned long long)cvtpk(uv.z, uv.w) << 32); \
                _Pragma("unroll") for (int hh = 0; hh < 8; ++hh) { const f32x4 w4 = *(const LAS f32x4*)(wfl + hh * 1024 + 4 * F.lane + 256 * j); z[hh] += (uv.x * w4.x + uv.y * w4.y) + (uv.z * w4.z + uv.w * w4.w); } } \
            _Pragma("unroll") for (int hh = 0; hh < 8; ++hh) z[hh] = wave_sum_dpp(z[hh]); \
            float zz = z[0]; _Pragma("unroll") for (int hh = 1; hh < 8; ++hh) zz = (F.lane == hh) ? z[hh] : zz; \
            if (F.lane < 8) { const float xx = zz + bfg; const float lf = fminf(xx, 0.f) - log1pf(__expf(-fabsf(xx))); logf2[(size_t)mr_ * 8 + F.lane] = lf * LOG2E; } } while (0)
            constexpr int NR = T / (256 * NWAVES) * ((MK_DUP == 0) ? 2 : 1);
            f32x4 vv_[3][4];
            if (NGW == 256 * NWAVES) {
#pragma unroll
                for (int i = 0; i < NR + 2; ++i) {
                    if (i < NR) ROW_LOAD(vv_[i % 3], gw + i * NGW);
                    if (i >= 2) ROW_PROC(vv_[(i - 2) % 3], gw + (i - 2) * NGW);
                }
            } else {
                for (int m = gw; m < T; m += NGW) { ROW_LOAD(vv_[0], m); ROW_PROC(vv_[0], m); }
            }
#undef ROW_LOAD
#undef ROW_PROC
        }
        for (int idx = blockIdx.x * NTHREADS + F.tid; idx < SEQ * 64; idx += F.G * NTHREADS) {
            const int pos = idx >> 6, i = idx & 63; const float invf = exp2f(-(float)i * (13.287712379549449f / 64.0f));
            const float ang = (float)pos * invf; double tt = (double)ang * 0.15915494309189535; tt -= __builtin_rint(tt); const float tf = (float)tt;
            ropec[idx] = __builtin_amdgcn_cosf(tf); ropes[idx] = __builtin_amdgcn_sinf(tf);
        }
        for (int idx = blockIdx.x * NTHREADS + F.tid; idx < 1024; idx += F.G * NTHREADS) ones[idx] = 1.0f;
        for (int idx = blockIdx.x * NTHREADS + F.tid; idx < 32768; idx += F.G * NTHREADS) {
            const int jp = idx & 3, e16 = (idx >> 2) & 15, kq = (idx >> 6) & 3, s = (idx >> 8) & 31, half = (idx >> 13) & 1, part = idx >> 14; const int k = 32 * s + 8 * kq + 2 * jp, e = 16 * half + e16;
            const float v0 = P.w_router[k * 32 + e] * P.g_ffn[k], v1 = P.w_router[(k + 1) * 32 + e] * P.g_ffn[k + 1];
            const unsigned hi = cvtpk(v0, v1); const unsigned lo = cvtpk(v0 - bflo(hi), v1 - bfhi(hi));
            ((unsigned*)wr3)[idx] = part ? lo : hi;
        }
    }
    SEAM(0); STAMP();
#if MK_N_LAUNCHES == 1
    xbar = xcd_barrier_post(ctl + CW_BAR, misc);
#endif
#if MK_DUP == 90
    for (int rb_ = 0; rb_ < 16; ++rb_) xcd_barrier(xbar);
#endif

    if (IN(1)) {
        F.refresh();
        typedef pg8::DenseOrder<T / 256, NPROJ / 256> Ord1; Ord1 S; S.init(T, NPROJ, DM, F.G, (int)blockIdx.x, (MK_DUP == 1) ? 2 : 1);
        EpiInProj E{proj, ropec, ropes, ctl};
        const int nun = (S.nwg * S.dup + F.G - 1) / F.G;
        const int kslot = ((F.vcu & 7) * (nun + 1)) / 8;
        constexpr int I_8 = 32 * 16 * 32 + 32 * 16 * 16;
        LAS unsigned* scr = (LAS unsigned*)(F.lds + F.wave * 9216);
        {
            S.i0 = 0; S.i1 = kslot;
            pg8::gemm_phase<EpiInProj, Ord1, true, true, 2>(F.lds, U, WinT, DM, S, E);
            {
                __syncthreads();
        {
            f32x4 rr_[2][4][4], gg_[2][4]; Tr8Item tt_[2];
            constexpr int NI = (32 * 16 * 32 + 32 * 16 * 16) / (256 * NWAVES) * ((MK_DUP == 9) ? 2 : 1);
            if (NGW == 256 * NWAVES) {
#pragma unroll
                for (int i = 0; i < NI + 1; ++i) {
                    if (i < NI) { tt_[i & 1] = tr8_decode(2 * ((gw + (i >> 1) * NGW) % (I_8 / 2)) + (i & 1), P, W1T, W2T, ones); tr8_load(tt_[i & 1], rr_[i & 1], gg_[i & 1], F.lane); }
                    if (i >= 1) tr8_proc(tt_[(i - 1) & 1], rr_[(i - 1) & 1], gg_[(i - 1) & 1], scr, F.lane, (i - 1) & 1);
                }
            } else {
                for (int it = gw; it < I_8 / 2; it += NGW) { tt_[0] = tr8_decode(2 * it, P, W1T, W2T, ones); tr8_load(tt_[0], rr_[0], gg_[0], F.lane); tr8_proc(tt_[0], rr_[0], gg_[0], scr, F.lane, 0);
                    tt_[0] = tr8_decode(2 * it + 1, P, W1T, W2T, ones); tr8_load(tt_[0], rr_[0], gg_[0], F.lane); tr8_proc(tt_[0], rr_[0], gg_[0], scr, F.lane, 1); }
            }
        }
                __syncthreads();
            }
            F.refresh();
            S.i0 = kslot; S.i1 = 1 << 30;
            pg8::gemm_phase<EpiInProj, Ord1, true, true, 2>(F.lds, U, WinT, DM, S, E);
        }
    }
    SEAM(1); STAMP();

    STAMP();

    if (IN(3)) {
        F.refresh();
        for (int bh = F.vcu; bh < 32; bh += F.G) {
            const int b = bh >> 3, h = bh & 7; LAS double* sd = (LAS double*)F.lds;
            double loc[16]; double run = 0.0;
#pragma unroll
            for (int i = 0; i < 16; ++i) { run += (double)logf2[((size_t)b * SEQ + 16 * F.tid + i) * 8 + h]; loc[i] = run; }
            double incl = run;
#pragma unroll
            for (int o = 1; o < 64; o <<= 1) { const double t = __shfl_up(incl, o); if (F.lane >= o) incl += t; }
            __syncthreads();
            if (F.lane == 63) sd[F.wave] = incl;
            __syncthreads();
            double off = incl - run;
            for (int w2 = 0; w2 < F.wave; ++w2) off += sd[w2];
            LAS float* Fsl = (LAS float*)(F.lds + 4096);
#pragma unroll
            for (int i = 0; i < 16; ++i) { const float fv = (float)(off + loc[i]); Fsl[16 * F.tid + i] = fv;
                const float nf = -fv; const unsigned h_ = cvtpk(nf, 0.f) & 0xffffu; const float r1 = nf - __uint_as_float(h_ << 16); const unsigned m_ = cvtpk(r1, 0.f) & 0xffffu;
                const float r2 = r1 - __uint_as_float(m_ << 16); const unsigned l_ = cvtpk(r2, 0.f) & 0xffffu;
                u32x2 w; w.x = h_ | (m_ << 16); w.y = l_ | 0x3f800000u; ((u32x2*)FAq)[(size_t)bh * SEQ + 16 * F.tid + i] = w; }
            __syncthreads();
            if (F.tid < 32) { const int qb = F.tid, q0 = 256 * qb, NT = 4 * qb + 4;
                const float qn = __uint_as_float(ctl[CW_QN2 + bh * 2]) + __uint_as_float(ctl[CW_QN2 + bh * 2 + 1]), kn = __uint_as_float(ctl[CW_KN2 + bh * 2]) + __uint_as_float(ctl[CW_KN2 + bh * 2 + 1]);
                const float target = Fsl[q0] + PRUNE_TH + 2.0f * 1.0201f * sqrtf(qn * kn);
                int lo_ = 0, hi_ = NT - 4;
                while (lo_ < hi_) { const int mid = (lo_ + hi_) >> 1; if (Fsl[64 * mid + 63] >= target) lo_ = mid + 1; else hi_ = mid; }
                const int ts = lo_ & ~1, NS = NT - ts;
                ctl[CW_UTS + bh * 32 + qb] = (unsigned)ts; ctl[CW_UPOS + bh * 32 + qb] = atomicAdd(ctl + CW_BIN + (NS >> 1), 1u); }
            publish_inc(ctl + CW_SCAN);
            __syncthreads();
        }
        for (int u = F.vcu; u < 256; u += F.G) { ret::unit<false>(u >> 4, u & 15, RQ, RK, RV, SG, GST, MIX, (LAS char*)F.lds); publish_inc(ctl + CW_GDONE + 16 * (u >> 4)); }
        for (int u = F.vcu; u < 256; u += F.G) { wait_ge(ctl + CW_GDONE + 16 * (u >> 4), 16u); ret::unit<true>(u >> 4, u & 15, RQ, RK, RV, SG, GST, MIX, (LAS char*)F.lds); }
        wait_ge(ctl + CW_SCAN, 32u);
        LAS int* qst = (LAS int*)(F.lds + attn_body::LDS_QUEUE); LAS int* qlist = qst + 128; LAS int* qsh = qst + 100;
        if (F.tid >= 2 && F.tid <= 64) qst[F.tid] = (int)ctl[CW_BIN + F.tid];
        __syncthreads();
        if (F.tid < 64) {
            const int k = 64 - F.tid; const int c = (k >= 2) ? qst[k] : 0; int inc = c;
#pragma unroll
            for (int o = 1; o < 64; o <<= 1) { const int t = __shfl_up(inc, o); if (F.tid >= o) inc += t; }
            if (k >= 2) qst[k] = inc - c; }
        __syncthreads();
        for (int u = F.tid; u < 1024; u += NTHREADS) { const int ts = (int)ctl[CW_UTS + u], NS = 4 * (u & 31) + 4 - ts; qlist[qst[NS >> 1] + (int)ctl[CW_UPOS + u]] = u | (ts << 16); }
        __syncthreads();
        LAS float* kmx = (LAS float*)(qst + 1152);
        if (F.tid < 32) kmx[F.tid] = 1.0201f * sqrtf(__uint_as_float(ctl[CW_KN2 + F.tid * 2]) + __uint_as_float(ctl[CW_KN2 + F.tid * 2 + 1]));
        if (F.tid == 0) qsh[0] = (int)atomicAdd(ctl + CW_QHEAD, 1u);
        __syncthreads();
        for (;;) {
            int idx = qsh[0];
            if (idx >= ((MK_DUP == 30) ? 2048 : 1024)) break;
            idx &= 1023;
            const int uu = qlist[idx]; const int u = uu & 0xffff, ts = uu >> 16; const int bh = u >> 5, qb = u & 31;
            const float kmaxc = kmx[bh];
            const int ntd = attn_body::attn_unit<8>(bh >> 3, bh & 7, qb, ts, kmaxc, FQ, FK, FV, MIX + 512, FAq, (char*)lds_raw, ctl + CW_QHEAD, qsh); (void)ntd;
#if MK_DIAG >= 21 && MK_DIAG <= 23
            if (F.tid == 0) { atomicAdd(ctl + CW_DIAG + 2, (unsigned)ntd); atomicMax(ctl + CW_DIAG + 3, (unsigned)ntd); if (ntd >= 64) atomicAdd(ctl + CW_DIAG + 4, 1u); }
#endif
        }
    }
    SEAM(3); STAMP();

    if (IN(4)) {
        F.refresh();
        typedef pg8::DenseOrder<T / 256, DM / 256> Ord4; Ord4 S; S.init(T, DM, DM, F.G, (int)blockIdx.x, (MK_DUP == 4) ? 2 : 1);
        EpiOutProj E{U, irs1, P.g_mix, H1B, H1F8};
        pg8::gemm_phase<EpiOutProj, Ord4, true, true, 1>(F.lds, MIX, WoT, DM, S, E);
    }
    SEAM(4); STAMP();

    if (IN(5)) {
        F.refresh();
        LAS float* wl = (LAS float*)F.lds;
        LAS float* lg = (LAS float*)(F.lds + 131072);
        LAS float* ssb = (LAS float*)(F.lds + 131072 + 128 * 33 * 4);
        LAS int* ecnt = (LAS int*)(F.lds + 131072 + 128 * 33 * 4 + 512);
        LAS int* ebase = ecnt + 32;
        { f32x4 wv[16];
#pragma unroll
          for (int i = 0; i < 16; ++i) wv[i] = ((const f32x4*)wr3)[F.tid + NTHREADS * i];
#pragma unroll
          for (int i = 0; i < 16; ++i) ((LAS f32x4*)wl)[F.tid + NTHREADS * i] = wv[i]; }
        for (int tb = blockIdx.x; tb < T / 128; tb += F.G) {
            if (F.tid < 32) ecnt[F.tid] = 0;
            __syncthreads();
            const int tok16 = F.lane & 15, kq = F.lane >> 4; const int tokw = tb * 128 + F.wave * 16 + tok16;
            const bf16_t* hrow = H1B + (size_t)tokw * DM + 8 * kq;
            f32x4 a0 = {0.f, 0.f, 0.f, 0.f}, a1 = {0.f, 0.f, 0.f, 0.f}; float ss = 0.f;
            const LAS bf16x8* wb = (const LAS bf16x8*)wl + kq * 16 + tok16;
#pragma unroll 4
            for (int s = 0; s < 32; ++s) {
                const u32x4 hv = *(const u32x4*)(hrow + 32 * s); const bf16x8 av = __builtin_bit_cast(bf16x8, hv);
#pragma unroll
                for (int e = 0; e < 4; ++e) { const float lo_ = bflo(hv[e]), hi_ = bfhi(hv[e]); ss += lo_ * lo_ + hi_ * hi_; }
                a0 = __builtin_amdgcn_mfma_f32_16x16x32_bf16(av, wb[((0 * 2 + 0) * 32 + s) * 64], a0, 0, 0, 0); a0 = __builtin_amdgcn_mfma_f32_16x16x32_bf16(av, wb[((1 * 2 + 0) * 32 + s) * 64], a0, 0, 0, 0);
                a1 = __builtin_amdgcn_mfma_f32_16x16x32_bf16(av, wb[((0 * 2 + 1) * 32 + s) * 64], a1, 0, 0, 0); a1 = __builtin_amdgcn_mfma_f32_16x16x32_bf16(av, wb[((1 * 2 + 1) * 32 + s) * 64], a1, 0, 0, 0);
            }
            ss += __shfl_xor(ss, 16); ss += __shfl_xor(ss, 32);
            if (kq == 0) ssb[F.wave * 16 + tok16] = ss;
#pragma unroll
            for (int r = 0; r < 4; ++r) { const int tk = F.wave * 16 + kq * 4 + r; lg[tk * 33 + tok16] = a0[r]; lg[tk * 33 + 16 + tok16] = a1[r]; }
            __syncthreads();
            int esel[4] = {0, 0, 0, 0}, rank[4] = {0, 0, 0, 0}; float gsel[4] = {0.f, 0.f, 0.f, 0.f}; float rstd = 0.f;
            if (F.tid < 128) {
                rstd = rsqrtf(ssb[F.tid] * (1.0f / DM) + RMS_EPS);
                float l[32];
#pragma unroll
                for (int e = 0; e < 32; ++e) l[e] = lg[F.tid * 33 + e] * rstd + P.b_router[e];
                float vs[4];
#pragma unroll
                for (int k = 0; k < 4; ++k) { float best = -INFINITY; int bi = 0;
#pragma unroll
                    for (int e = 0; e < 32; ++e) { const bool bt = l[e] > best; best = bt ? l[e] : best; bi = bt ? e : bi; }
                    vs[k] = best; esel[k] = bi;
#pragma unroll
                    for (int e = 0; e < 32; ++e) l[e] = (e == bi) ? -INFINITY : l[e]; }
                float den = 0.f;
#pragma unroll
                for (int k = 0; k < 4; ++k) { gsel[k] = __expf(vs[k] - vs[0]); den += gsel[k]; }
#pragma unroll
                for (int k = 0; k < 4; ++k) { gsel[k] /= den; rank[k] = atomicAdd((int*)&ecnt[esel[k]], 1); }
            }
            __syncthreads();
            if (F.tid < 32) ebase[F.tid] = (int)atomicAdd(ctl + CW_CNT + F.tid, (unsigned)ecnt[F.tid]);
            __syncthreads();
            if (F.tid < 128) { const int tok = tb * 128 + F.tid;
#pragma unroll
                for (int k = 0; k < 4; ++k) { const int e = esel[k], slot = ebase[e] + rank[k];
                    ltok[(size_t)e * CAP + slot] = tok; lrstd[(size_t)e * CAP + slot] = rstd; inv[tok * 4 + k] = (e << 16) | slot; gates[tok * 4 + k] = gsel[k]; } }
            __syncthreads();
        }
    }
    SEAM(5); STAMP();

    if (IN(6) || IN(7)) {
        F.refresh();
        LAS int* boff = (LAS int*)(F.lds + 131072); LAS int* cntl = boff + 64;
        if (F.tid < 64) {
            const int cn = (F.tid < 32) ? (int)ctl[CW_CNT + F.tid] : 0; const int nbk = (cn + 255) >> 8; int inc = nbk;
#pragma unroll
            for (int o = 1; o < 32; o <<= 1) { const int t = __shfl_up(inc, o); if (F.tid >= o) inc += t; }
            if (F.tid < 32) { cntl[F.tid] = cn; boff[F.tid] = inc - nbk; if (F.tid == 31) boff[32] = inc; } }
        __syncthreads();
        LAS unsigned* tokl = (LAS unsigned*)(F.lds + 131072 + 1024);
        LAS bf16_t* biasl = (LAS bf16_t*)(F.lds + 131072 + 1024 + 17408);
        if (IN(6)) {
            MoeOrder<8, true> S0{boff, cntl, tokl, F.G, F.vcu};
            { const int r = F.tid & 255; bool ok[9], inr[9]; unsigned tk[9]; float rs[9], bv[9];
#pragma unroll
              for (int p = 0; p < 9; ++p) { const int i = 2 * p + (F.tid >> 8); pg8::Unit u; u.e = 0; u.lb = 0; u.pn = 0;
                  ok[p] = i < 17 && S0.next(i, u);
                  const int slot = u.lb * 256 + r; inr[p] = ok[p] && slot < cntl[u.e]; const size_t si = inr[p] ? (size_t)u.e * CAP + slot : 0;
                  tk[p] = (unsigned)ltok[si]; rs[p] = lrstd[si];
                  const int pnl = u.pn - u.e * 8; bv[p] = P.b1[ok[p] ? (size_t)u.e * 2048 + ((r < 128) ? (pnl * 128 + r) : (1024 + pnl * 128 + r - 128)) : 0]; }
#pragma unroll
              for (int p = 0; p < 9; ++p) { const int i = 2 * p + (F.tid >> 8);
                  if (ok[p]) { tokl[i * 256 + r] = inr[p] ? (tk[p] | (cvtpk(0.f, rs[p]) & 0xffff0000u)) : 0u; biasl[i * 256 + r] = (bf16_t)(cvtpk(bv[p], bv[p]) & 0xffffu); } } }
            __syncthreads();
        }
        if (IN(6)) REP(6) {
        F.refresh();
            MoeOrder<8, true> S{boff, cntl, tokl, F.G, F.vcu};
            EpiMoe1 E{Hb, tokl, biasl};
            pg8::gemm_phase<EpiMoe1, MoeOrder<8, true>, true, true, 1>(F.lds, H1F8, W1T, DM, S, E);
        }
#if MK_DUP == 60
        if (IN(6)) { MoeOrder<8, true> S{boff, cntl, tokl, F.G, F.vcu}; EpiNull E{(float*)(ws + WS_GST)};
            pg8::gemm_phase<EpiNull, MoeOrder<8, true>, true, true, 1>(F.lds, H1F8, W1T, DM, S, E); }
#elif MK_DUP == 61
        if (IN(6)) { MoeOrder<8, false> S{boff, cntl, tokl, F.G, F.vcu}; EpiNull E{(float*)(ws + WS_GST)};
            pg8::gemm_phase<EpiNull, MoeOrder<8, false>, true, true, 1>(F.lds, H1F8, W1T, DM, S, E); }
#endif
        SEAM(6); STAMP();
        if (IN(7)) {
            __syncthreads();
            MoeOrder<4, false> S0{boff, cntl, tokl, F.G, F.vcu};
            { const int r = F.tid & 255; bool ok[5]; float bv[5];
#pragma unroll
              for (int p = 0; p < 5; ++p) { const int i = 2 * p + (F.tid >> 8); pg8::Unit u; u.e = 0; u.pn = 0;
                  ok[p] = i < 17 && S0.next(i, u); const int pnl = u.pn - u.e * 4; bv[p] = P.b2[ok[p] ? (size_t)u.e * DM + pnl * 256 + r : 0]; }
#pragma unroll
              for (int p = 0; p < 5; ++p) { const int i = 2 * p + (F.tid >> 8); if (ok[p]) biasl[i * 256 + r] = (bf16_t)(cvtpk(bv[p], bv[p]) & 0xffffu); } }
            __syncthreads();
        }
        if (IN(7)) REP(7) {
        F.refresh();
            MoeOrder<4, false> S{boff, cntl, tokl, F.G, F.vcu};
            EpiMoe2 E{Yb, biasl};
            pg8::gemm_phase<EpiMoe2, MoeOrder<4, false>, true, true, 1>(F.lds, Hb, W2T, DM, S, E);
        }
    }
    SEAM(7); STAMP();

    if (IN(8)) {
        F.refresh();
        LAS int* boff = (LAS int*)(F.lds + 131072);
        __syncthreads();
        if (F.tid < 64) {
            const int cn = (F.tid < 32) ? (int)ctl[CW_CNT + F.tid] : 0; const int nbk = (cn + 255) >> 8; int inc = nbk;
#pragma unroll
            for (int o = 1; o < 32; o <<= 1) { const int t = __shfl_up(inc, o); if (F.tid >= o) inc += t; }
            if (F.tid < 32) { boff[F.tid] = inc - nbk; if (F.tid == 31) boff[32] = inc; } }
        __syncthreads();
        const f32x4* gf = (const f32x4*)P.g_final;
        const f32x4 gfa = gf[2 * F.lane], gfb = gf[2 * F.lane + 1], gfc = gf[128 + 2 * F.lane], gfd = gf[128 + 2 * F.lane + 1];
        struct RowA { u32x4 iv; f32x4 gt; }; struct RowB { u32x4 ha, hb; u32x2 ya[4], yb[4]; };
#define P8_A(R, MM) do { R.iv = *(const u32x4*)(inv + (size_t)(MM) * 4); R.gt = *(const f32x4*)(gates + (size_t)(MM) * 4); } while (0)
#define P8_B(RB_, RA_, MM) do { RB_.ha = *(const u32x4*)(H1B + (size_t)(MM) * DM + 8 * F.lane); RB_.hb = *(const u32x4*)(H1B + (size_t)(MM) * DM + 512 + 8 * F.lane); \
            _Pragma("unroll") for (int k = 0; k < 4; ++k) { const int iv_ = (int)RA_.iv[k]; const size_t yrow = (size_t)boff[iv_ >> 16] * 256 + (iv_ & 0xffff); \
                RB_.ya[k] = *(const u32x2*)(Yb + yrow * DM + 8 * F.lane); RB_.yb[k] = *(const u32x2*)(Yb + yrow * DM + 512 + 8 * F.lane); } } while (0)
#define P8_C(RB_, RA_, MM) do { float v[16]; \
            _Pragma("unroll") for (int e = 0; e < 4; ++e) { v[2 * e] = bflo(RB_.ha[e]); v[2 * e + 1] = bfhi(RB_.ha[e]); v[8 + 2 * e] = bflo(RB_.hb[e]); v[8 + 2 * e + 1] = bfhi(RB_.hb[e]); } \
            _Pragma("unroll") for (int k = 0; k < 4; ++k) { const float gs = RA_.gt[k] * (1.0f / Y_SCALE); \
                _Pragma("unroll") for (int q = 0; q < 2; ++q) { const f32x2 a0 = __builtin_amdgcn_cvt_pk_f32_fp8((int)RB_.ya[k][q], false), a1 = __builtin_amdgcn_cvt_pk_f32_fp8((int)RB_.ya[k][q], true), b0 = __builtin_amdgcn_cvt_pk_f32_fp8((int)RB_.yb[k][q], false), b1 = __builtin_amdgcn_cvt_pk_f32_fp8((int)RB_.yb[k][q], true); \
                    v[4 * q] += gs * a0.x; v[4 * q + 1] += gs * a0.y; v[4 * q + 2] += gs * a1.x; v[4 * q + 3] += gs * a1.y; \
                    v[8 + 4 * q] += gs * b0.x; v[8 + 4 * q + 1] += gs * b0.y; v[8 + 4 * q + 2] += gs * b1.x; v[8 + 4 * q + 3] += gs * b1.y; } } \
            float ss = 0.f; _Pragma("unroll") for (int i_ = 0; i_ < 16; ++i_) ss += v[i_] * v[i_]; \
            const float rstd = rsqrtf(wave_sum_dpp(ss) * (1.0f / DM) + RMS_EPS); f32x4* op = (f32x4*)(P.out + (size_t)(MM) * DM); \
            op[2 * F.lane] = (f32x4){v[0], v[1], v[2], v[3]} * rstd * gfa; op[2 * F.lane + 1] = (f32x4){v[4], v[5], v[6], v[7]} * rstd * gfb; \
            op[128 + 2 * F.lane] = (f32x4){v[8], v[9], v[10], v[11]} * rstd * gfc; op[128 + 2 * F.lane + 1] = (f32x4){v[12], v[13], v[14], v[15]} * rstd * gfd; } while (0)
        RowA ra_[3]; RowB rb_[2];
        constexpr int NR8 = T / (256 * NWAVES);
        if (NGW == 256 * NWAVES) {
#pragma unroll
            for (int i = 0; i < NR8 + 2; ++i) {
                if (i < NR8) P8_A(ra_[i % 3], gw + i * NGW);
                if (i >= 1 && i < NR8 + 1) P8_B(rb_[(i - 1) & 1], ra_[(i - 1) % 3], gw + (i - 1) * NGW);
                if (i >= 2) P8_C(rb_[(i - 2) & 1], ra_[(i - 2) % 3], gw + (i - 2) * NGW);
            }
        } else {
            for (int m = gw; m < T; m += NGW) { P8_A(ra_[0], m); P8_B(rb_[0], ra_[0], m); P8_C(rb_[0], ra_[0], m); }
        }
#undef P8_A
#undef P8_B
#undef P8_C
    }
#if MK_DIAG
    STAMP();
    if (blockIdx.x == 0 && threadIdx.x == 0) { const unsigned long long* tstamp = (const unsigned long long*)(ctl + CW_DIAG + 16); asm volatile("s_waitcnt vmcnt(0)" ::: "memory"); const unsigned long long d = (MK_DIAG >= 10) ? (tstamp[9] - tstamp[0]) : (tstamp[MK_DIAG % 10] - tstamp[(MK_DIAG - 1) % 10]); __hip_atomic_store(ctl + CW_DIAG, (unsigned)d, __ATOMIC_RELAXED, __HIP_MEMORY_SCOPE_AGENT); }
    xcd_barrier(xbar);
#if MK_DIAG >= 21 && MK_DIAG <= 23
    { float us = (MK_DIAG == 21) ? (float)ctl[CW_DIAG + 2] * (1.0f / 256.0f) : (float)ctl[CW_DIAG + MK_DIAG - 19];
#elif MK_DIAG == 20
    { float us = 0.f; for (int u = 0; u < 1024; ++u) us += (float)(4 * (u & 31) + 4 - (int)ctl[CW_UTS + u]); us *= (1.0f / 256.0f);
#else
    { float us = (float)__hip_atomic_load(ctl + CW_DIAG, __ATOMIC_RELAXED, __HIP_MEMORY_SCOPE_AGENT) * 0.01f; us = exp2f(0.2f * rintf(log2f(fmaxf(us, 1.0f)) * 5.0f));
#endif
      const float c = sqrtf(us);
      for (size_t i = (size_t)blockIdx.x * NTHREADS + threadIdx.x; i < (size_t)T * DM; i += (size_t)F.G * NTHREADS) P.out[i] = c; }
#endif
#undef IN
#undef SEAM
}

extern "C" void kernel_launch(void* const* d_in, const int* in_sizes, int n_in, void* d_out, int out_size, void* d_ws, size_t ws_size, hipStream_t stream) {
    static int grid = 0;
    if (grid == 0) {
        if (n_in != 13 || in_sizes[0] != T * DM || out_size != T * DM || ws_size < WS_END) { fprintf(stderr, "kernel_launch: unexpected shapes (n_in %d, in0 %d, out %d, ws %zu)\n", n_in, n_in > 0 ? in_sizes[0] : -1, out_size, ws_size); grid = -1; return; }
        int dev = 0, cus = 0, per_cu = 0;
        if (hipGetDevice(&dev) != hipSuccess || hipDeviceGetAttribute(&cus, hipDeviceAttributeMultiprocessorCount, dev) != hipSuccess) { fprintf(stderr, "kernel_launch: device query failed\n"); grid = -1; return; }
        if (hipFuncSetAttribute((const void*)mk_fwd, hipFuncAttributeMaxDynamicSharedMemorySize, LDS_BYTES) != hipSuccess) { fprintf(stderr, "kernel_launch: hipFuncSetAttribute failed\n"); grid = -1; return; }
        if (hipOccupancyMaxActiveBlocksPerMultiprocessor(&per_cu, (const void*)mk_fwd, NTHREADS, LDS_BYTES) != hipSuccess || per_cu < 1) { fprintf(stderr, "kernel_launch: occupancy query says %d\n", per_cu); per_cu = 1; }
        (void)hipGetLastError();
        grid = cus * 1;
        if (grid != 256) fprintf(stderr, "kernel_launch: %d CUs (built for 256)\n", grid);
    }
    if (grid < 0) return;
#if MK_N_LAUNCHES != 1
    (void)hipMemsetAsync((char*)d_ws + WS_CTL, 0, CTL_BYTES, stream);
#endif
    Params p{};
    const float** pin = (const float**)&p;
    for (int i = 0; i < 13; ++i) pin[i] = (const float*)d_in[i];
    p.out = (float*)d_out; p.ws = (unsigned char*)d_ws;
#if MK_N_LAUNCHES == 1
    p.ph_lo = 0; p.ph_hi = 9;
    void* args[] = {&p};
    hipError_t e = hipLaunchCooperativeKernel((const void*)mk_fwd, dim3(grid), dim3(NTHREADS), args, LDS_BYTES, stream);
    if (e != hipSuccess) fprintf(stderr, "kernel_launch: cooperative launch failed: %s (grid %d)\n", hipGetErrorString(e), grid);
#else
    for (int k = 0; k < 9; ++k) { p.ph_lo = k; p.ph_hi = k + 1; hipLaunchKernelGGL(mk_fwd, dim3(grid), dim3(NTHREADS), LDS_BYTES, stream, p); }
#endif
}
```
